# Optimizing an MI355X kernel written in HIP

```python
import math
import jax, jax.numpy as jnp
from jax import lax
import numpy as np

D_MODEL = 1024
BATCH = 16
SEQ = 2048
DEPTH = 2

N_EVEN = (DEPTH + 1) // 2
N_ODD = DEPTH // 2
DN_ALPHA = (2.0 * DEPTH) ** 0.25
DN_BETA = (8.0 * DEPTH) ** -0.25
LN_EPS = 1e-5
NEG = -1e30
Q_BLOCK = 128

GM_WIDTH = D_MODEL // 2
GM_GROUPS = 4
GM_GROUP_DIM = GM_WIDTH // GM_GROUPS
GM_CHUNK = 128

MLA_HEADS = 8
MLA_NOPE = 64
MLA_ROPE = 32
MLA_V = 64
MLA_Q_RANK = D_MODEL // 4
MLA_KV_RANK = D_MODEL // 8
ROPE_BASE = 10000.0
AB_IN = 2 * GM_WIDTH + MLA_Q_RANK + MLA_KV_RANK + MLA_ROPE
AB_MIX = GM_WIDTH + MLA_HEADS * MLA_V
AB_SPLITS = (GM_WIDTH, 2 * GM_WIDTH, 2 * GM_WIDTH + MLA_Q_RANK,
             2 * GM_WIDTH + MLA_Q_RANK + MLA_KV_RANK)

NSA_HEADS = 16
NSA_GROUPS = 2
NSA_HPG = NSA_HEADS // NSA_GROUPS
NSA_DH = 64
NSA_CMP_LEN = 32
NSA_CMP_STRIDE = 16
NSA_CMP_HIDDEN = 256
NSA_SEL_LEN = 64
NSA_TOPK = 8
NSA_SEL_QBLOCK = 64
NSA_WINDOW = 512
NSA_BRANCHES = 3
NSA_KV = NSA_GROUPS * NSA_DH
C_MIX = NSA_HEADS * NSA_DH
C_IN = C_MIX + 6 * NSA_KV + NSA_BRANCHES * NSA_HEADS
NSA_SPLITS = tuple(C_MIX + i * NSA_KV for i in range(7))
NSA_FORCE = 1e4

MOE_GROUPS = 4
MOE_EPG = 8
MOE_EXPERTS = MOE_GROUPS * MOE_EPG
MOE_TOPK = 2
MOE_HIDDEN = D_MODEL // 4

kernel_name = 'hybrid_gmlp_mla_nsa_hmoe_deepnorm'


def layer_norm(x, g, b):
    xf = x.astype(jnp.float32)
    mu = xf.mean(-1, keepdims=True)
    var = jnp.square(xf - mu).mean(-1, keepdims=True)
    return ((xf - mu) * lax.rsqrt(var + LN_EPS) * g + b).astype(x.dtype)


def rms_norm(x, g):
    xf = x.astype(jnp.float32)
    return (xf * lax.rsqrt(jnp.mean(xf * xf, -1, keepdims=True) + LN_EPS) * g).astype(x.dtype)


def rope(x, pos):
    half = x.shape[-1] // 2
    freq = jnp.exp(-math.log(ROPE_BASE) * jnp.arange(half, dtype=jnp.float32) / half)
    ang = pos.astype(jnp.float32)[:, :, None, None] * freq
    cos, sin = jnp.cos(ang), jnp.sin(ang)
    x1 = x[..., :half].astype(jnp.float32)
    x2 = x[..., half:].astype(jnp.float32)
    return jnp.concatenate([x1 * cos - x2 * sin, x1 * sin + x2 * cos], -1).astype(x.dtype)


def gmlp_mix(u, v, ln_g, ln_b, w_s, b_s):
    B, S, _ = u.shape
    nc = S // GM_CHUNK
    vn = layer_norm(v, ln_g, ln_b).reshape(B, nc, GM_CHUNK, GM_GROUPS, GM_GROUP_DIM)
    causal = jnp.tril(jnp.ones((GM_CHUNK, GM_CHUNK), dtype=bool))
    ws = jnp.where(causal, w_s, 0.0).astype(vn.dtype)
    s = jnp.einsum('gts,bnsgc->bntgc', ws, vn) + jnp.transpose(b_s)[:, :, None]
    return u * s.reshape(B, S, GM_WIDTH)


def mla_mix(c_q, c_kv, k_r, pos, q_norm_g, kv_norm_g, w_uq, w_uk, w_uv):
    B, S, _ = c_q.shape
    q = (rms_norm(c_q, q_norm_g) @ w_uq).reshape(B, S, MLA_HEADS, MLA_NOPE + MLA_ROPE)
    q_nope = q[..., :MLA_NOPE]
    q_rope = rope(q[..., MLA_NOPE:], pos)
    ckv = rms_norm(c_kv, kv_norm_g)
    k_nope = (ckv @ w_uk).reshape(B, S, MLA_HEADS, MLA_NOPE)
    v = (ckv @ w_uv).reshape(B, S, MLA_HEADS, MLA_V)
    k_rope = rope(k_r[:, :, None, :], pos)[:, :, 0]
    scale = (MLA_NOPE + MLA_ROPE) ** -0.5
    outs = []
    for i in range(S // Q_BLOCK):
        q0, q1 = i * Q_BLOCK, (i + 1) * Q_BLOCK
        s = (jnp.einsum('bqhd,bkhd->bhqk', q_nope[:, q0:q1], k_nope[:, :q1])
             + jnp.einsum('bqhr,bkr->bhqk', q_rope[:, q0:q1], k_rope[:, :q1]))
        mask = (q0 + jnp.arange(Q_BLOCK))[:, None] >= jnp.arange(q1)[None, :]
        s = jnp.where(mask, s.astype(jnp.float32) * scale, NEG)
        p = jax.nn.softmax(s, axis=-1).astype(v.dtype)
        outs.append(jnp.einsum('bhqk,bkhd->bqhd', p, v[:, :q1]))
    return jnp.concatenate(outs, axis=1).reshape(B, S, MLA_HEADS * MLA_V)


def ab_mixer(x, pos, w_in, gm_ln_g, gm_ln_b, gm_ws, gm_bs, q_norm_g, kv_norm_g,
             w_uq, w_uk, w_uv, w_o):
    h = x @ w_in
    u, v, c_q, c_kv, k_r = jnp.split(h, AB_SPLITS, axis=-1)
    y_a = gmlp_mix(jax.nn.gelu(u), jax.nn.gelu(v), gm_ln_g, gm_ln_b, gm_ws, gm_bs)
    y_b = mla_mix(c_q, c_kv, k_r, pos, q_norm_g, kv_norm_g, w_uq, w_uk, w_uv)
    return jnp.concatenate([y_a, y_b], axis=-1) @ w_o


def compress_kv(k, pos_emb, w1, w2):
    B, S, G, D = k.shape
    r = NSA_CMP_LEN // NSA_CMP_STRIDE
    sub = k.reshape(B, S // NSA_CMP_STRIDE, NSA_CMP_STRIDE, G, D)
    nc = S // NSA_CMP_STRIDE - r + 1
    blocks = jnp.concatenate([sub[:, j:j + nc] for j in range(r)], axis=2) + pos_emb[:, None, :]
    flat = blocks.transpose(0, 1, 3, 2, 4).reshape(B, nc, G, NSA_CMP_LEN * D)
    return jax.nn.gelu(flat @ w1) @ w2


def nsa_compressed(q, k_cmp, v_cmp):
    S, nc = q.shape[1], k_cmp.shape[1]
    s = jnp.einsum('btgid,bngd->bgitn', q, k_cmp).astype(jnp.float32) * NSA_DH ** -0.5
    end = jnp.arange(nc) * NSA_CMP_STRIDE + NSA_CMP_LEN - 1
    mask = jnp.arange(S)[:, None] >= end[None, :]
    p = jnp.where(mask, jax.nn.softmax(jnp.where(mask, s, NEG), axis=-1), 0.0)
    o = jnp.einsum('bgitn,bngd->btgid', p.astype(v_cmp.dtype), v_cmp)
    return o, p


def nsa_select_blocks(p_cmp):
    S, nc = p_cmp.shape[3], p_cmp.shape[4]
    nsel = S // NSA_SEL_LEN
    c0 = jnp.arange(nc) * NSA_CMP_STRIDE
    s0 = jnp.arange(nsel) * NSA_SEL_LEN
    cover = ((c0[:, None] < s0[None, :] + NSA_SEL_LEN)
             & (c0[:, None] + NSA_CMP_LEN > s0[None, :])).astype(jnp.float32)
    imp = jnp.einsum('bgitn,nj->bgtj', p_cmp, cover)
    jj = jnp.arange(nsel)[None, :]
    tb = (jnp.arange(S) // NSA_SEL_LEN)[:, None]
    forced = (jj == 0) | (jj == tb) | (jj == tb - 1)
    score = jnp.where(forced, NSA_FORCE, jnp.where(jj <= tb, imp, -NSA_FORCE))
    _, idx = lax.top_k(score, min(NSA_TOPK, nsel))
    return idx


def nsa_selected(q, k_s, v_s, sel_idx):
    B, S, G, HPG, D = q.shape
    K = sel_idx.shape[-1]
    nsel = S // NSA_SEL_LEN
    kb = k_s.reshape(B, nsel, NSA_SEL_LEN, G, D).transpose(0, 3, 1, 2, 4)
    vb = v_s.reshape(B, nsel, NSA_SEL_LEN, G, D).transpose(0, 3, 1, 2, 4)
    nqb = S // NSA_SEL_QBLOCK
    q_b = q.reshape(B, nqb, NSA_SEL_QBLOCK, G, HPG, D).transpose(1, 0, 2, 3, 4, 5)
    idx_b = sel_idx.reshape(B, G, nqb, NSA_SEL_QBLOCK, K).transpose(2, 0, 1, 3, 4)
    bi = jnp.arange(B)[:, None, None, None]
    gi = jnp.arange(G)[None, :, None, None]

    def one_block(args):
        i, qi, idx = args
        tq = i * NSA_SEL_QBLOCK + jnp.arange(NSA_SEL_QBLOCK)
        kg = kb[bi, gi, idx]
        vg = vb[bi, gi, idx]
        kpos = idx[..., None] * NSA_SEL_LEN + jnp.arange(NSA_SEL_LEN)
        mask = kpos <= tq[None, None, :, None, None]
        s = jnp.einsum('bqgid,bgqkld->bgiqkl', qi, kg).astype(jnp.float32) * NSA_DH ** -0.5
        s = jnp.where(mask[:, :, None], s, NEG)
        p = jax.nn.softmax(s.reshape(B, G, HPG, NSA_SEL_QBLOCK, K * NSA_SEL_LEN), axis=-1)
        p = p.reshape(s.shape).astype(vg.dtype)
        return jnp.einsum('bgiqkl,bgqkld->bqgid', p, vg)

    o = lax.map(one_block, (jnp.arange(nqb), q_b, idx_b))
    return o.transpose(1, 0, 2, 3, 4, 5).reshape(B, S, G, HPG, D)


def nsa_window(q, k_w, v_w):
    B, S, G, HPG, D = q.shape
    nb = S // Q_BLOCK
    span = NSA_WINDOW + Q_BLOCK
    kp = jnp.pad(k_w, ((0, 0), (NSA_WINDOW, 0), (0, 0), (0, 0)))
    vp = jnp.pad(v_w, ((0, 0), (NSA_WINDOW, 0), (0, 0), (0, 0)))
    q_b = q.reshape(B, nb, Q_BLOCK, G, HPG, D).transpose(1, 0, 2, 3, 4, 5)

    def one_block(args):
        i, qi = args
        start = i * Q_BLOCK
        kb = lax.dynamic_slice_in_dim(kp, start, span, axis=1)
        vb = lax.dynamic_slice_in_dim(vp, start, span, axis=1)
        tq = (start + jnp.arange(Q_BLOCK))[:, None]
        kpos = (start - NSA_WINDOW + jnp.arange(span))[None, :]
        mask = (kpos <= tq) & (kpos > tq - NSA_WINDOW) & (kpos >= 0)
        s = jnp.einsum('bqgid,bkgd->bgiqk', qi, kb).astype(jnp.float32) * NSA_DH ** -0.5
        p = jax.nn.softmax(jnp.where(mask, s, NEG), axis=-1).astype(vb.dtype)
        return jnp.einsum('bgiqk,bkgd->bqgid', p, vb)

    o = lax.map(one_block, (jnp.arange(nb), q_b))
    return o.transpose(1, 0, 2, 3, 4, 5).reshape(B, S, G, HPG, D)


def nsa_mixer(x, w_in, cmp_pos, w_ck1, w_ck2, w_cv1, w_cv2, gate_b, w_o):
    B, S, _ = x.shape
    h = x @ w_in
    q, kc, vc, ks, vs, kw, vw, g = jnp.split(h, NSA_SPLITS, axis=-1)
    q = q.reshape(B, S, NSA_GROUPS, NSA_HPG, NSA_DH)

    def kv(t):
        return t.reshape(B, S, NSA_GROUPS, NSA_DH)

    k_cmp = compress_kv(kv(kc), cmp_pos[0], w_ck1, w_ck2)
    v_cmp = compress_kv(kv(vc), cmp_pos[1], w_cv1, w_cv2)
    o_cmp, p_cmp = nsa_compressed(q, k_cmp, v_cmp)
    sel_idx = nsa_select_blocks(p_cmp)
    o_slc = nsa_selected(q, kv(ks), kv(vs), sel_idx)
    o_win = nsa_window(q, kv(kw), kv(vw))
    gates = jax.nn.sigmoid(g + gate_b).reshape(B, S, NSA_BRANCHES, NSA_GROUPS, NSA_HPG, 1)
    o = gates[:, :, 0] * o_cmp + gates[:, :, 1] * o_slc + gates[:, :, 2] * o_win
    return o.reshape(B, S, C_MIX) @ w_o


def hier_moe(x, w_rg, b_rg, w_re, b_re, w_gate, w_up, w_down):
    B, S, D = x.shape
    T = B * S
    xt = x.reshape(T, D)
    g_logits = (xt @ w_rg + b_rg).astype(jnp.float32)
    g_prob = jax.nn.softmax(g_logits, axis=-1)
    g_sel = jnp.argmax(g_logits, axis=-1)
    g_w = jnp.take_along_axis(g_prob, g_sel[:, None], axis=-1)
    e_logits = (xt @ w_re + b_re).astype(jnp.float32).reshape(T, MOE_GROUPS, MOE_EPG)
    e_sel = jnp.take_along_axis(e_logits, g_sel[:, None, None], axis=1)[:, 0]
    top_p, top_i = lax.top_k(jax.nn.softmax(e_sel, axis=-1), MOE_TOPK)
    top_p = top_p / top_p.sum(-1, keepdims=True)
    w_grp = (jax.nn.one_hot(top_i, MOE_EPG, dtype=jnp.float32) * top_p[..., None]).sum(1) * g_w
    y = jnp.zeros_like(xt)
    for gi in range(MOE_GROUPS):
        e0 = gi * MOE_EPG
        wg = jnp.where(g_sel[:, None] == gi, w_grp, 0.0).astype(x.dtype)
        hg = (jax.nn.silu(jnp.einsum('td,edf->tef', xt, w_gate[e0:e0 + MOE_EPG]))
              * jnp.einsum('td,edf->tef', xt, w_up[e0:e0 + MOE_EPG]))
        y = y + jnp.einsum('tef,efd->td', hg * wg[..., None], w_down[e0:e0 + MOE_EPG])
    return y.reshape(B, S, D)


def setup_inputs(seed: int = 0) -> dict:
    key = jax.random.key(seed)
    keys = iter(jax.random.split(key, 48))

    def nrm(shape, scale):
        return jax.random.normal(next(keys), shape, jnp.float32) * scale

    def gain(shape):
        return 1.0 + nrm(shape, 0.1)

    x = nrm((BATCH, SEQ, D_MODEL), 1.0)
    offset = jax.random.randint(next(keys), (BATCH, 1), 0, 4096, dtype=jnp.int32)
    positions = (offset + jnp.arange(SEQ, dtype=jnp.int32)[None, :]).astype(jnp.int32)
    return {
        'x': x,
        'positions': positions,
        'ab_w_in': nrm((N_EVEN, D_MODEL, AB_IN), D_MODEL ** -0.5),
        'ab_gm_ln_g': gain((N_EVEN, GM_WIDTH)),
        'ab_gm_ln_b': nrm((N_EVEN, GM_WIDTH), 0.02),
        'ab_gm_ws': nrm((N_EVEN, GM_GROUPS, GM_CHUNK, GM_CHUNK), GM_CHUNK ** -0.5),
        'ab_gm_bs': gain((N_EVEN, GM_GROUPS, GM_CHUNK)),
        'ab_mla_q_norm': gain((N_EVEN, MLA_Q_RANK)),
        'ab_mla_kv_norm': gain((N_EVEN, MLA_KV_RANK)),
        'ab_mla_w_uq': nrm((N_EVEN, MLA_Q_RANK, MLA_HEADS * (MLA_NOPE + MLA_ROPE)), MLA_Q_RANK ** -0.5),
        'ab_mla_w_uk': nrm((N_EVEN, MLA_KV_RANK, MLA_HEADS * MLA_NOPE), MLA_KV_RANK ** -0.5),
        'ab_mla_w_uv': nrm((N_EVEN, MLA_KV_RANK, MLA_HEADS * MLA_V), MLA_KV_RANK ** -0.5),
        'ab_w_o': nrm((N_EVEN, AB_MIX, D_MODEL), AB_MIX ** -0.5 * DN_BETA),
        'c_w_in': nrm((N_ODD, D_MODEL, C_IN), D_MODEL ** -0.5),
        'c_cmp_pos': nrm((N_ODD, 2, NSA_CMP_LEN, NSA_DH), 0.1),
        'c_w_ck1': nrm((N_ODD, NSA_CMP_LEN * NSA_DH, NSA_CMP_HIDDEN), (NSA_CMP_LEN * NSA_DH) ** -0.5),
        'c_w_ck2': nrm((N_ODD, NSA_CMP_HIDDEN, NSA_DH), NSA_CMP_HIDDEN ** -0.5),
        'c_w_cv1': nrm((N_ODD, NSA_CMP_LEN * NSA_DH, NSA_CMP_HIDDEN), (NSA_CMP_LEN * NSA_DH) ** -0.5),
        'c_w_cv2': nrm((N_ODD, NSA_CMP_HIDDEN, NSA_DH), NSA_CMP_HIDDEN ** -0.5),
        'c_gate_b': nrm((N_ODD, NSA_BRANCHES * NSA_HEADS), 0.1),
        'c_w_o': nrm((N_ODD, C_MIX, D_MODEL), C_MIX ** -0.5 * DN_BETA),
        'moe_w_rg': nrm((DEPTH, D_MODEL, MOE_GROUPS), D_MODEL ** -0.5),
        'moe_b_rg': nrm((DEPTH, MOE_GROUPS), 0.01),
        'moe_w_re': nrm((DEPTH, D_MODEL, MOE_EXPERTS), D_MODEL ** -0.5),
        'moe_b_re': nrm((DEPTH, MOE_EXPERTS), 0.01),
        'moe_w_gate': nrm((DEPTH, MOE_EXPERTS, D_MODEL, MOE_HIDDEN), D_MODEL ** -0.5),
        'moe_w_up': nrm((DEPTH, MOE_EXPERTS, D_MODEL, MOE_HIDDEN), D_MODEL ** -0.5),
        'moe_w_down': nrm((DEPTH, MOE_EXPERTS, MOE_HIDDEN, D_MODEL), MOE_HIDDEN ** -0.5 * DN_BETA),
        'ln1_g': gain((DEPTH, D_MODEL)),
        'ln1_b': nrm((DEPTH, D_MODEL), 0.02),
        'ln2_g': gain((DEPTH, D_MODEL)),
        'ln2_b': nrm((DEPTH, D_MODEL), 0.02),
    }


def reference(x, positions, ab_w_in, ab_gm_ln_g, ab_gm_ln_b, ab_gm_ws, ab_gm_bs,
              ab_mla_q_norm, ab_mla_kv_norm, ab_mla_w_uq, ab_mla_w_uk, ab_mla_w_uv, ab_w_o,
              c_w_in, c_cmp_pos, c_w_ck1, c_w_ck2, c_w_cv1, c_w_cv2, c_gate_b, c_w_o,
              moe_w_rg, moe_b_rg, moe_w_re, moe_b_re, moe_w_gate, moe_w_up, moe_w_down,
              ln1_g, ln1_b, ln2_g, ln2_b):
    for layer in range(DEPTH):
        j = layer // 2
        if layer % 2 == 0:
            mix = ab_mixer(x, positions, ab_w_in[j], ab_gm_ln_g[j], ab_gm_ln_b[j], ab_gm_ws[j],
                           ab_gm_bs[j], ab_mla_q_norm[j], ab_mla_kv_norm[j], ab_mla_w_uq[j],
                           ab_mla_w_uk[j], ab_mla_w_uv[j], ab_w_o[j])
        else:
            mix = nsa_mixer(x, c_w_in[j], c_cmp_pos[j], c_w_ck1[j], c_w_ck2[j], c_w_cv1[j],
                            c_w_cv2[j], c_gate_b[j], c_w_o[j])
        x = layer_norm(DN_ALPHA * x + mix, ln1_g[layer], ln1_b[layer])
        ffn = hier_moe(x, moe_w_rg[layer], moe_b_rg[layer], moe_w_re[layer], moe_b_re[layer],
                       moe_w_gate[layer], moe_w_up[layer], moe_w_down[layer])
        x = layer_norm(DN_ALPHA * x + ffn, ln2_g[layer], ln2_b[layer])
    return x
```

```cpp
#include <hip/hip_runtime.h>
#include <stdint.h>
#include <math.h>

namespace nv {
constexpr int B_ = 16, S_ = 2048, D_ = 1024, T_ = B_ * S_;
constexpr float ALPHA = 1.41421356237309515f;
constexpr float LN_EPS = 1e-5f;
constexpr size_t MiB = 1u << 20;

__device__ __forceinline__ float gelu_tanh(float x) { const float c = 0.7978845608028654f; float u = c * (x + 0.044715f * x * x * x); return 0.5f * x * (1.f + tanhf(u)); }
__device__ __forceinline__ float wsum(float v) {
#pragma unroll
    for (int o = 1; o < 64; o <<= 1) v += __shfl_xor(v, o);
    return v;
}

struct EpiStore { float* C; int ldc; int pad; __device__ void operator()(int r, int c, float v) const { C[(size_t)r * ldc + c] = v; } };
struct EpiGelu  { float* C; int ldc; int pad; __device__ void operator()(int r, int c, float v) const { C[(size_t)r * ldc + c] = gelu_tanh(v); } };
struct EpiResid { const float* X; float* Z; int ldc; int pad; __device__ void operator()(int r, int c, float v) const { Z[(size_t)r * ldc + c] = ALPHA * X[(size_t)r * ldc + c] + v; } };
struct EpiMoeDown { const int* rowtok; const float* roww; float* z2; __device__ void operator()(int r, int c, float v) const { int t = rowtok[r]; if (t >= 0) atomicAdd(&z2[(size_t)t * D_ + c], roww[r] * v); } };

template <class Epi>
__global__ void __launch_bounds__(256) k_gemm(const float* __restrict__ A, int lda, const int* __restrict__ arow, const float* __restrict__ Bw, int ldb, size_t bstride,
                                              const int* __restrict__ tile_e, int M, int N, int K, Epi epi) {
    __shared__ float As[16][68];
    __shared__ float Bs[16][68];
    const int tid = threadIdx.x, tx = tid & 15, ty = tid >> 4;
    const int m0 = blockIdx.y * 64, n0 = blockIdx.x * 64;
    const float* Bp = Bw;
    if (tile_e) { int e = tile_e[blockIdx.y]; if (e < 0) return; Bp = Bw + (size_t)e * bstride; }
    float acc[4][4];
#pragma unroll
    for (int i = 0; i < 4; ++i)
#pragma unroll
        for (int j = 0; j < 4; ++j) acc[i][j] = 0.f;
    const int ar = tid >> 2, ak = (tid & 3) * 4;
    int arow_i = m0 + ar; if (arow) arow_i = arow[m0 + ar];
    const int bk = tid >> 4, bn = (tid & 15) * 4;
    for (int k0 = 0; k0 < K; k0 += 16) {
        float4 av = make_float4(0.f, 0.f, 0.f, 0.f);
        if (arow_i >= 0 && (m0 + ar) < M) av = *(const float4*)(A + (size_t)arow_i * lda + k0 + ak);
        float4 bv = make_float4(0.f, 0.f, 0.f, 0.f);
        if (n0 + bn < N) bv = *(const float4*)(Bp + (size_t)(k0 + bk) * ldb + n0 + bn);
        As[ak + 0][ar] = av.x; As[ak + 1][ar] = av.y; As[ak + 2][ar] = av.z; As[ak + 3][ar] = av.w;
        *(float4*)&Bs[bk][bn] = bv;
        __syncthreads();
#pragma unroll
        for (int kk = 0; kk < 16; ++kk) {
            const float4 a = *(const float4*)&As[kk][ty * 4];
            const float4 b = *(const float4*)&Bs[kk][tx * 4];
            const float aa[4] = {a.x, a.y, a.z, a.w}, bb[4] = {b.x, b.y, b.z, b.w};
#pragma unroll
            for (int i = 0; i < 4; ++i)
#pragma unroll
                for (int j = 0; j < 4; ++j) acc[i][j] += aa[i] * bb[j];
        }
        __syncthreads();
    }
#pragma unroll
    for (int i = 0; i < 4; ++i)
#pragma unroll
        for (int j = 0; j < 4; ++j) { const int r = m0 + ty * 4 + i, c = n0 + tx * 4 + j; if (r < M && c < N) epi(r, c, acc[i][j]); }
}

__global__ void __launch_bounds__(256) k_moe_up(const float* __restrict__ X, const int* __restrict__ rowtok, const float* __restrict__ Wg, const float* __restrict__ Wu,
                                                const int* __restrict__ tile_e, float* __restrict__ H) {
    __shared__ float As[16][68];
    __shared__ float Bg[16][68];
    __shared__ float Bu[16][68];
    const int tid = threadIdx.x, tx = tid & 15, ty = tid >> 4;
    const int m0 = blockIdx.y * 64, n0 = blockIdx.x * 64;
    const int e = tile_e[blockIdx.y]; if (e < 0) return;
    const float* wg = Wg + (size_t)e * 1024 * 256; const float* wu = Wu + (size_t)e * 1024 * 256;
    float ag[4][4], au[4][4];
#pragma unroll
    for (int i = 0; i < 4; ++i)
#pragma unroll
        for (int j = 0; j < 4; ++j) { ag[i][j] = 0.f; au[i][j] = 0.f; }
    const int ar = tid >> 2, ak = (tid & 3) * 4;
    const int arow_i = rowtok[m0 + ar];
    const int bk = tid >> 4, bn = (tid & 15) * 4;
    for (int k0 = 0; k0 < 1024; k0 += 16) {
        float4 av = make_float4(0.f, 0.f, 0.f, 0.f);
        if (arow_i >= 0) av = *(const float4*)(X + (size_t)arow_i * 1024 + k0 + ak);
        const float4 g4 = *(const float4*)(wg + (size_t)(k0 + bk) * 256 + n0 + bn);
        const float4 u4 = *(const float4*)(wu + (size_t)(k0 + bk) * 256 + n0 + bn);
        As[ak + 0][ar] = av.x; As[ak + 1][ar] = av.y; As[ak + 2][ar] = av.z; As[ak + 3][ar] = av.w;
        *(float4*)&Bg[bk][bn] = g4; *(float4*)&Bu[bk][bn] = u4;
        __syncthreads();
#pragma unroll
        for (int kk = 0; kk < 16; ++kk) {
            const float4 a = *(const float4*)&As[kk][ty * 4];
            const float4 g = *(const float4*)&Bg[kk][tx * 4];
            const float4 u = *(const float4*)&Bu[kk][tx * 4];
            const float aa[4] = {a.x, a.y, a.z, a.w}, gg[4] = {g.x, g.y, g.z, g.w}, uu[4] = {u.x, u.y, u.z, u.w};
#pragma unroll
            for (int i = 0; i < 4; ++i)
#pragma unroll
                for (int j = 0; j < 4; ++j) { ag[i][j] += aa[i] * gg[j]; au[i][j] += aa[i] * uu[j]; }
        }
        __syncthreads();
    }
#pragma unroll
    for (int i = 0; i < 4; ++i)
#pragma unroll
        for (int j = 0; j < 4; ++j) { const int r = m0 + ty * 4 + i, c = n0 + tx * 4 + j; const float g = ag[i][j]; H[(size_t)r * 256 + c] = (g / (1.f + expf(-g))) * au[i][j]; }
}

__global__ void __launch_bounds__(256) k_ab_prep(const float* __restrict__ H0, const int* __restrict__ pos, const float* __restrict__ lng, const float* __restrict__ lnb,
                                                 const float* __restrict__ qg, const float* __restrict__ kvg, float* __restrict__ VN, float* __restrict__ CQN, float* __restrict__ CKVN, float* __restrict__ KR) {
    const int lane = threadIdx.x & 63, tok = blockIdx.x * 4 + (threadIdx.x >> 6);
    const float* h = H0 + (size_t)tok * 1440;
    float v[8]; float s = 0.f;
#pragma unroll
    for (int j = 0; j < 8; ++j) { v[j] = gelu_tanh(h[512 + lane + 64 * j]); s += v[j]; }
    const float mean = wsum(s) * (1.f / 512.f); float q = 0.f;
#pragma unroll
    for (int j = 0; j < 8; ++j) { v[j] -= mean; q += v[j] * v[j]; }
    const float rstd = rsqrtf(wsum(q) * (1.f / 512.f) + LN_EPS);
#pragma unroll
    for (int j = 0; j < 8; ++j) { const int c = lane + 64 * j; VN[(size_t)tok * 512 + c] = v[j] * rstd * lng[c] + lnb[c]; }
    float c4[4]; float ss = 0.f;
#pragma unroll
    for (int j = 0; j < 4; ++j) { c4[j] = h[1024 + lane + 64 * j]; ss += c4[j] * c4[j]; }
    const float rq = rsqrtf(wsum(ss) * (1.f / 256.f) + LN_EPS);
#pragma unroll
    for (int j = 0; j < 4; ++j) { const int c = lane + 64 * j; CQN[(size_t)tok * 256 + c] = c4[j] * rq * qg[c]; }
    float k2[2]; float s2 = 0.f;
#pragma unroll
    for (int j = 0; j < 2; ++j) { k2[j] = h[1280 + lane + 64 * j]; s2 += k2[j] * k2[j]; }
    const float rk = rsqrtf(wsum(s2) * (1.f / 128.f) + LN_EPS);
#pragma unroll
    for (int j = 0; j < 2; ++j) { const int c = lane + 64 * j; CKVN[(size_t)tok * 128 + c] = k2[j] * rk * kvg[c]; }
    if (lane < 16) {
        const double ang = (double)pos[tok] * exp(-log(10000.0) * (double)lane / 16.0);
        const float cs = (float)cos(ang), sn = (float)sin(ang); const float x1 = h[1408 + lane], x2 = h[1408 + 16 + lane];
        KR[(size_t)tok * 32 + lane] = x1 * cs - x2 * sn; KR[(size_t)tok * 32 + 16 + lane] = x1 * sn + x2 * cs;
    }
}
__global__ void __launch_bounds__(256) k_gmlp(const float* __restrict__ H0, const float* __restrict__ VN, const float* __restrict__ ws, const float* __restrict__ bs, float* __restrict__ Y) {
    const int c = threadIdx.x + 256 * (blockIdx.x & 1), tok = blockIdx.x >> 1;
    const int ti = tok & 127, base = tok - ti, g = c >> 7;
    const float* w = ws + ((size_t)g * 128 + ti) * 128;
    float s = 0.f;
    for (int j = 0; j <= ti; ++j) s += w[j] * VN[(size_t)(base + j) * 512 + c];
    s += bs[g * 128 + ti];
    Y[(size_t)tok * 1024 + c] = gelu_tanh(H0[(size_t)tok * 1440 + c]) * s;
}
__global__ void __launch_bounds__(256) k_rope_q(float* __restrict__ Q, const int* __restrict__ pos) {
    const int idx = blockIdx.x * 256 + threadIdx.x; const int j = idx & 15, h = (idx >> 4) & 7, tok = idx >> 7;
    const double ang = (double)pos[tok] * exp(-log(10000.0) * (double)j / 16.0);
    const float cs = (float)cos(ang), sn = (float)sin(ang);
    float* q = Q + (size_t)tok * 768 + h * 96 + 64;
    const float x1 = q[j], x2 = q[16 + j];
    q[j] = x1 * cs - x2 * sn; q[16 + j] = x1 * sn + x2 * cs;
}
__global__ void __launch_bounds__(64) k_mla_attn(const float* __restrict__ Q, const float* __restrict__ KN, const float* __restrict__ KR, const float* __restrict__ V, float* __restrict__ Y) {
    const int t = blockIdx.x * 64 + threadIdx.x, h = blockIdx.y, b = blockIdx.z;
    const size_t tok = (size_t)b * S_ + t;
    const float scale = 0.10206207261596575f;
    float q[96], o[64];
#pragma unroll
    for (int d = 0; d < 96; ++d) q[d] = Q[tok * 768 + h * 96 + d] * scale;
#pragma unroll
    for (int d = 0; d < 64; ++d) o[d] = 0.f;
    float m = -1e30f, l = 0.f;
    const int kmax = blockIdx.x * 64 + 63;
    for (int k = 0; k <= kmax; ++k) {
        const size_t kt = (size_t)b * S_ + k;
        const float4* kp = (const float4*)(KN + kt * 512 + h * 64);
        const float4* rp = (const float4*)(KR + kt * 32);
        float s = 0.f;
#pragma unroll
        for (int i = 0; i < 16; ++i) { const float4 kv = kp[i]; s += q[4 * i] * kv.x + q[4 * i + 1] * kv.y + q[4 * i + 2] * kv.z + q[4 * i + 3] * kv.w; }
#pragma unroll
        for (int i = 0; i < 8; ++i) { const float4 kv = rp[i]; s += q[64 + 4 * i] * kv.x + q[64 + 4 * i + 1] * kv.y + q[64 + 4 * i + 2] * kv.z + q[64 + 4 * i + 3] * kv.w; }
        if (k <= t) {
            const float mn = fmaxf(m, s), a = expf(m - mn), p = expf(s - mn);
            l = l * a + p; m = mn;
            const float4* vp = (const float4*)(V + kt * 512 + h * 64);
#pragma unroll
            for (int i = 0; i < 16; ++i) { const float4 vv = vp[i]; o[4 * i] = o[4 * i] * a + p * vv.x; o[4 * i + 1] = o[4 * i + 1] * a + p * vv.y; o[4 * i + 2] = o[4 * i + 2] * a + p * vv.z; o[4 * i + 3] = o[4 * i + 3] * a + p * vv.w; }
        }
    }
    const float inv = 1.f / l;
#pragma unroll
    for (int d = 0; d < 64; ++d) Y[tok * 1024 + 512 + h * 64 + d] = o[d] * inv;
}

__global__ void __launch_bounds__(256) k_ln_route(const float* __restrict__ Z, const float* __restrict__ g, const float* __restrict__ bta, const float* __restrict__ wrg, const float* __restrict__ brg,
                                                  const float* __restrict__ wre, const float* __restrict__ bre, float* __restrict__ X1, float* __restrict__ Z2,
                                                  int* __restrict__ cnt, int* __restrict__ tok_e, int* __restrict__ tok_pos, float* __restrict__ tok_w) {
    const int lane = threadIdx.x & 63, tok = blockIdx.x * 4 + (threadIdx.x >> 6);
    const float* z = Z + (size_t)tok * D_;
    float v[16]; float s = 0.f;
#pragma unroll
    for (int j = 0; j < 16; ++j) { v[j] = z[lane + 64 * j]; s += v[j]; }
    const float mean = wsum(s) * (1.f / D_); float q = 0.f;
#pragma unroll
    for (int j = 0; j < 16; ++j) { v[j] -= mean; q += v[j] * v[j]; }
    const float rstd = rsqrtf(wsum(q) * (1.f / D_) + LN_EPS);
#pragma unroll
    for (int j = 0; j < 16; ++j) { const int c = lane + 64 * j; v[j] = v[j] * rstd * g[c] + bta[c]; X1[(size_t)tok * D_ + c] = v[j]; Z2[(size_t)tok * D_ + c] = ALPHA * v[j]; }
    __shared__ float slog[4][40];
    float* lg = slog[threadIdx.x >> 6]; float* le = lg + 4;
    for (int n = 0; n < 4; ++n) { float a = 0.f;
#pragma unroll
        for (int j = 0; j < 16; ++j) a += v[j] * wrg[(size_t)(lane + 64 * j) * 4 + n];
        a = wsum(a) + brg[n]; if (lane == 0) lg[n] = a; }
    for (int n = 0; n < 32; ++n) { float a = 0.f;
#pragma unroll
        for (int j = 0; j < 16; ++j) a += v[j] * wre[(size_t)(lane + 64 * j) * 32 + n];
        a = wsum(a) + bre[n]; if (lane == 0) le[n] = a; }
    if (lane == 0) {
        int gs = 0; float gm = lg[0];
#pragma unroll
        for (int n = 1; n < 4; ++n) if (lg[n] > gm) { gm = lg[n]; gs = n; }
        float den = 0.f;
#pragma unroll
        for (int n = 0; n < 4; ++n) den += expf(lg[n] - gm);
        const float gw = 1.f / den;
        float es[8];
#pragma unroll
        for (int n = 0; n < 8; ++n) es[n] = le[gs * 8 + n];
        int i0 = 0; float m0 = es[0];
#pragma unroll
        for (int n = 1; n < 8; ++n) if (es[n] > m0) { m0 = es[n]; i0 = n; }
        int i1 = -1; float m1 = -1e30f;
#pragma unroll
        for (int n = 0; n < 8; ++n) if (n != i0 && es[n] > m1) { m1 = es[n]; i1 = n; }
        const float r = expf(m1 - m0); const float p0 = 1.f / (1.f + r), p1 = r / (1.f + r);
        const int e0 = gs * 8 + i0, e1 = gs * 8 + i1;
        tok_e[tok * 2] = e0; tok_e[tok * 2 + 1] = e1;
        tok_w[tok * 2] = p0 * gw; tok_w[tok * 2 + 1] = p1 * gw;
        tok_pos[tok * 2] = atomicAdd(&cnt[e0], 1); tok_pos[tok * 2 + 1] = atomicAdd(&cnt[e1], 1);
    }
}
__global__ void k_moe_offsets(const int* __restrict__ cnt, int* __restrict__ base, int* __restrict__ tile_e, int nt64) {
    __shared__ int sb[33];
    if (threadIdx.x == 0) { int a = 0; for (int e = 0; e < 32; ++e) { sb[e] = a; a += (cnt[e] + 255) & ~255; } sb[32] = a; }
    __syncthreads();
    if (threadIdx.x < 33) base[threadIdx.x] = sb[threadIdx.x];
    for (int t = threadIdx.x; t < nt64; t += blockDim.x) { const int r = t * 64; int e = -1; for (int k = 0; k < 32; ++k) if (r >= sb[k] && r < sb[k + 1]) e = k; tile_e[t] = e; }
}
__global__ void __launch_bounds__(256) k_moe_scatter(const int* __restrict__ base, const int* __restrict__ tok_e, const int* __restrict__ tok_pos, const float* __restrict__ tok_w, int* __restrict__ rowtok, float* __restrict__ roww) {
    const int i = blockIdx.x * 256 + threadIdx.x;
    const int row = base[tok_e[i]] + tok_pos[i]; rowtok[row] = i >> 1; roww[row] = tok_w[i];
}
__global__ void __launch_bounds__(256) k_ln_out(const float* __restrict__ Z, const float* __restrict__ g, const float* __restrict__ bta, float* __restrict__ X) {
    const int lane = threadIdx.x & 63, tok = blockIdx.x * 4 + (threadIdx.x >> 6);
    const float* z = Z + (size_t)tok * D_;
    float v[16]; float s = 0.f;
#pragma unroll
    for (int j = 0; j < 16; ++j) { v[j] = z[lane + 64 * j]; s += v[j]; }
    const float mean = wsum(s) * (1.f / D_); float q = 0.f;
#pragma unroll
    for (int j = 0; j < 16; ++j) { v[j] -= mean; q += v[j] * v[j]; }
    const float rstd = rsqrtf(wsum(q) * (1.f / D_) + LN_EPS);
#pragma unroll
    for (int j = 0; j < 16; ++j) { const int c = lane + 64 * j; X[(size_t)tok * D_ + c] = v[j] * rstd * g[c] + bta[c]; }
}

__global__ void __launch_bounds__(256) k_flat(const float* __restrict__ H1, const float* __restrict__ cpos, float* __restrict__ FK, float* __restrict__ FV) {
    const size_t idx = (size_t)blockIdx.x * 256 + threadIdx.x;
    const int k = (int)(idx & 2047); const int row = (int)((idx >> 11) % 4064); const int kv = (int)(idx / ((size_t)4064 * 2048));
    const int g = row & 1, bn = row >> 1, n = bn % 127, b = bn / 127, l = k >> 6, d = k & 63;
    const float v = H1[((size_t)b * S_ + 16 * n + l) * 1840 + 1024 + kv * 128 + g * 64 + d] + cpos[(kv * 32 + l) * 64 + d];
    (kv ? FV : FK)[(size_t)row * 2048 + k] = v;
}
__device__ __forceinline__ float sigmoidf_(float x) { return 1.f / (1.f + expf(-x)); }
__global__ void __launch_bounds__(64) k_nsa_cmp(const float* __restrict__ H1, const float* __restrict__ KC, const float* __restrict__ VC, const float* __restrict__ gate_b, float* __restrict__ O, unsigned* __restrict__ SEL) {
    const int t = blockIdx.x * 64 + threadIdx.x, g = blockIdx.y, b = blockIdx.z;
    const size_t tok = (size_t)b * S_ + t;
    float imp[32];
#pragma unroll
    for (int j = 0; j < 32; ++j) imp[j] = 0.f;
    const int nvalid_max = (blockIdx.x * 64 + 63 - 31) / 16 + 1;
    for (int i = 0; i < 8; ++i) {
        const int h = g * 8 + i;
        float q[64], o[64];
#pragma unroll
        for (int d = 0; d < 64; ++d) { q[d] = H1[tok * 1840 + h * 64 + d] * 0.125f; o[d] = 0.f; }
        float m = -1e30f;
        for (int n = 0; n < nvalid_max && n < 127; ++n) {
            const float4* kp = (const float4*)(KC + ((size_t)(b * 127 + n) * 2 + g) * 64);
            float s = 0.f;
#pragma unroll
            for (int c = 0; c < 16; ++c) { const float4 kv = kp[c]; s += q[4 * c] * kv.x + q[4 * c + 1] * kv.y + q[4 * c + 2] * kv.z + q[4 * c + 3] * kv.w; }
            if (t >= 16 * n + 31) m = fmaxf(m, s);
        }
        float l = 0.f;
        for (int n = 0; n < nvalid_max && n < 127; ++n) {
            const float4* kp = (const float4*)(KC + ((size_t)(b * 127 + n) * 2 + g) * 64);
            float s = 0.f;
#pragma unroll
            for (int c = 0; c < 16; ++c) { const float4 kv = kp[c]; s += q[4 * c] * kv.x + q[4 * c + 1] * kv.y + q[4 * c + 2] * kv.z + q[4 * c + 3] * kv.w; }
            if (t >= 16 * n + 31) l += expf(s - m);
        }
        const float inv = l > 0.f ? 1.f / l : 0.f;
        for (int n = 0; n < nvalid_max && n < 127; ++n) {
            const float4* kp = (const float4*)(KC + ((size_t)(b * 127 + n) * 2 + g) * 64);
            float s = 0.f;
#pragma unroll
            for (int c = 0; c < 16; ++c) { const float4 kv = kp[c]; s += q[4 * c] * kv.x + q[4 * c + 1] * kv.y + q[4 * c + 2] * kv.z + q[4 * c + 3] * kv.w; }
            const float p = (t >= 16 * n + 31) ? expf(s - m) * inv : 0.f;
            const float4* vp = (const float4*)(VC + ((size_t)(b * 127 + n) * 2 + g) * 64);
#pragma unroll
            for (int c = 0; c < 16; ++c) { const float4 vv = vp[c]; o[4 * c] += p * vv.x; o[4 * c + 1] += p * vv.y; o[4 * c + 2] += p * vv.z; o[4 * c + 3] += p * vv.w; }
            const int j0 = n >> 2;
#pragma unroll
            for (int j = 0; j < 32; ++j) { if (j == j0) imp[j] += p; if ((n & 3) == 3 && j == j0 + 1) imp[j] += p; }
        }
        const float gt = sigmoidf_(H1[tok * 1840 + 1792 + h] + gate_b[h]);
#pragma unroll
        for (int d = 0; d < 64; ++d) O[tok * 1024 + h * 64 + d] = gt * o[d];
    }
    const int tb = t >> 6;
    float sc[32];
#pragma unroll
    for (int j = 0; j < 32; ++j) { const bool forced = (j == 0) || (j == tb) || (j == tb - 1); sc[j] = forced ? 1e4f : (j <= tb ? imp[j] : -1e4f); }
    unsigned sel = 0u;
#pragma unroll
    for (int it = 0; it < 8; ++it) { float best = -3e38f; int bi = 0;
#pragma unroll
        for (int j = 0; j < 32; ++j) { const bool free_ = ((sel >> j) & 1u) == 0u; if (free_ && sc[j] > best) { best = sc[j]; bi = j; } }
        sel |= 1u << bi; }
    SEL[tok * 2 + g] = sel;
}
template <int MODE  >
__global__ void __launch_bounds__(64) k_nsa_sw(const float* __restrict__ H1, const unsigned* __restrict__ SEL, const float* __restrict__ gate_b, float* __restrict__ O) {
    const int t = blockIdx.x * 64 + threadIdx.x, h = blockIdx.y, b = blockIdx.z, g = h >> 3;
    const size_t tok = (size_t)b * S_ + t;
    const int kcol = (MODE == 1 ? 1280 : 1536) + g * 64, vcol = kcol + 128;
    float q[64], o[64];
#pragma unroll
    for (int d = 0; d < 64; ++d) { q[d] = H1[tok * 1840 + h * 64 + d] * 0.125f; o[d] = 0.f; }
    float m = -1e30f, l = 0.f;
    const unsigned sel = (MODE == 1) ? SEL[tok * 2 + g] : 0u;
    const int tmax = blockIdx.x * 64 + 63, tmin = blockIdx.x * 64;
    const int k_lo = (MODE == 1) ? 0 : (tmin - 511 > 0 ? tmin - 511 : 0);
    for (int k = k_lo; k <= tmax; ++k) {
        bool ok = (k <= t);
        if (MODE == 1) ok = ok && ((sel >> (k >> 6)) & 1u);
        else ok = ok && (k > t - 512);
        if (MODE == 1) { if (!__any(ok)) { k |= 63; continue; } }
        const size_t kt = (size_t)b * S_ + k;
        const float4* kp = (const float4*)(H1 + kt * 1840 + kcol);
        float s = 0.f;
#pragma unroll
        for (int c = 0; c < 16; ++c) { const float4 kv = kp[c]; s += q[4 * c] * kv.x + q[4 * c + 1] * kv.y + q[4 * c + 2] * kv.z + q[4 * c + 3] * kv.w; }
        if (ok) {
            const float mn = fmaxf(m, s), a = expf(m - mn), p = expf(s - mn);
            l = l * a + p; m = mn;
            const float4* vp = (const float4*)(H1 + kt * 1840 + vcol);
#pragma unroll
            for (int c = 0; c < 16; ++c) { const float4 vv = vp[c]; o[4 * c] = o[4 * c] * a + p * vv.x; o[4 * c + 1] = o[4 * c + 1] * a + p * vv.y; o[4 * c + 2] = o[4 * c + 2] * a + p * vv.z; o[4 * c + 3] = o[4 * c + 3] * a + p * vv.w; }
        }
    }
    const float gt = sigmoidf_(H1[tok * 1840 + 1792 + MODE * 16 + h] + gate_b[MODE * 16 + h]) / l;
#pragma unroll
    for (int d = 0; d < 64; ++d) O[tok * 1024 + h * 64 + d] += gt * o[d];
}

template <class Epi>
static void gemm(hipStream_t st, const float* A, int lda, const int* arow, const float* Bw, int ldb, size_t bstride, const int* tile_e, int M, int N, int K, Epi epi) {
    dim3 grid((N + 63) / 64, (M + 63) / 64);
    hipLaunchKernelGGL(k_gemm<Epi>, grid, dim3(256), 0, st, A, lda, arow, Bw, ldb, bstride, tile_e, M, N, K, epi);
}
constexpr int MOE_ROWS = 73728, NT64 = MOE_ROWS / 64;

static void moe_and_ln2(hipStream_t st, int layer, void* const* d_in, const float* Z1, unsigned char* ws, size_t off_x1, size_t off_z2, size_t off_h, size_t off_rt, float* xout) {
    const float* wrg = (const float*)d_in[21] + (size_t)layer * 1024 * 4; const float* brg = (const float*)d_in[22] + layer * 4;
    const float* wre = (const float*)d_in[23] + (size_t)layer * 1024 * 32; const float* bre = (const float*)d_in[24] + layer * 32;
    const float* wg = (const float*)d_in[25] + (size_t)layer * 32 * 1024 * 256; const float* wu = (const float*)d_in[26] + (size_t)layer * 32 * 1024 * 256;
    const float* wd = (const float*)d_in[27] + (size_t)layer * 32 * 256 * 1024;
    const float* g1 = (const float*)d_in[28] + layer * 1024; const float* b1 = (const float*)d_in[29] + layer * 1024;
    const float* g2 = (const float*)d_in[30] + layer * 1024; const float* b2 = (const float*)d_in[31] + layer * 1024;
    float* X1 = (float*)(ws + off_x1); float* Z2 = (float*)(ws + off_z2); float* H = (float*)(ws + off_h);
    unsigned char* rt = ws + off_rt;
    int* cnt = (int*)rt; int* base = cnt + 64; int* tile_e = base + 64; int* tok_e = tile_e + 2048; int* tok_pos = tok_e + 2 * T_; float* tok_w = (float*)(tok_pos + 2 * T_);
    int* rowtok = (int*)(tok_w + 2 * T_); float* roww = (float*)(rowtok + MOE_ROWS);
    hipMemsetAsync(cnt, 0, 64 * 4, st);
    hipMemsetAsync(rowtok, 0xFF, MOE_ROWS * 4, st);
    hipLaunchKernelGGL(k_ln_route, dim3(T_ / 4), dim3(256), 0, st, Z1, g1, b1, wrg, brg, wre, bre, X1, Z2, cnt, tok_e, tok_pos, tok_w);
    hipLaunchKernelGGL(k_moe_offsets, dim3(1), dim3(256), 0, st, cnt, base, tile_e, NT64);
    hipLaunchKernelGGL(k_moe_scatter, dim3(2 * T_ / 256), dim3(256), 0, st, base, tok_e, tok_pos, tok_w, rowtok, roww);
    hipLaunchKernelGGL(k_moe_up, dim3(4, NT64), dim3(256), 0, st, X1, rowtok, wg, wu, tile_e, H);
    gemm(st, H, 256, nullptr, wd, 1024, (size_t)256 * 1024, tile_e, MOE_ROWS, 1024, 256, EpiMoeDown{rowtok, roww, Z2});
    hipLaunchKernelGGL(k_ln_out, dim3(T_ / 4), dim3(256), 0, st, Z2, g2, b2, xout);
}

static void forward(void* const* d_in, float* out, unsigned char* ws, hipStream_t st) {
    const float* x = (const float*)d_in[0]; const int* pos = (const int*)d_in[1];
    float* H0 = (float*)(ws + 0 * MiB); float* VN = (float*)(ws + 180 * MiB); float* CQN = (float*)(ws + 244 * MiB); float* CKVN = (float*)(ws + 276 * MiB); float* KR = (float*)(ws + 292 * MiB);
    float* Q = (float*)(ws + 0 * MiB); float* KN = (float*)(ws + 96 * MiB); float* V = (float*)(ws + 160 * MiB);
    float* Y = out; float* Z1 = (float*)(ws + 300 * MiB);
    gemm(st, x, 1024, nullptr, (const float*)d_in[2], 1440, 0, nullptr, T_, 1440, 1024, EpiStore{H0, 1440, 0});
    hipLaunchKernelGGL(k_ab_prep, dim3(T_ / 4), dim3(256), 0, st, H0, pos, (const float*)d_in[3], (const float*)d_in[4], (const float*)d_in[7], (const float*)d_in[8], VN, CQN, CKVN, KR);
    hipLaunchKernelGGL(k_gmlp, dim3(T_ * 2), dim3(256), 0, st, H0, VN, (const float*)d_in[5], (const float*)d_in[6], Y);
    gemm(st, CQN, 256, nullptr, (const float*)d_in[9], 768, 0, nullptr, T_, 768, 256, EpiStore{Q, 768, 0});
    hipLaunchKernelGGL(k_rope_q, dim3(T_ * 128 / 256), dim3(256), 0, st, Q, pos);
    gemm(st, CKVN, 128, nullptr, (const float*)d_in[10], 512, 0, nullptr, T_, 512, 128, EpiStore{KN, 512, 0});
    gemm(st, CKVN, 128, nullptr, (const float*)d_in[11], 512, 0, nullptr, T_, 512, 128, EpiStore{V, 512, 0});
    hipLaunchKernelGGL(k_mla_attn, dim3(S_ / 64, 8, B_), dim3(64), 0, st, Q, KN, KR, V, Y);
    gemm(st, Y, 1024, nullptr, (const float*)d_in[12], 1024, 0, nullptr, T_, 1024, 1024, EpiResid{x, Z1, 1024, 0});
    moe_and_ln2(st, 0, d_in, Z1, ws, 0 * MiB, 128 * MiB, 300 * MiB, 470 * MiB, out);
    const float* xm = out;
    float* H1 = (float*)(ws + 0 * MiB); float* FK = (float*)(ws + 230 * MiB); float* FV = (float*)(ws + 262 * MiB); float* HK = (float*)(ws + 294 * MiB); float* HV = (float*)(ws + 298 * MiB);
    float* KC = (float*)(ws + 302 * MiB); float* VC = (float*)(ws + 303 * MiB); unsigned* SEL = (unsigned*)(ws + 304 * MiB); float* O = (float*)(ws + 306 * MiB);
    gemm(st, xm, 1024, nullptr, (const float*)d_in[13], 1840, 0, nullptr, T_, 1840, 1024, EpiStore{H1, 1840, 0});
    hipLaunchKernelGGL(k_flat, dim3((unsigned)((size_t)2 * 4064 * 2048 / 256)), dim3(256), 0, st, H1, (const float*)d_in[14], FK, FV);
    gemm(st, FK, 2048, nullptr, (const float*)d_in[15], 256, 0, nullptr, 4064, 256, 2048, EpiGelu{HK, 256, 0});
    gemm(st, HK, 256, nullptr, (const float*)d_in[16], 64, 0, nullptr, 4064, 64, 256, EpiStore{KC, 64, 0});
    gemm(st, FV, 2048, nullptr, (const float*)d_in[17], 256, 0, nullptr, 4064, 256, 2048, EpiGelu{HV, 256, 0});
    gemm(st, HV, 256, nullptr, (const float*)d_in[18], 64, 0, nullptr, 4064, 64, 256, EpiStore{VC, 64, 0});
    hipLaunchKernelGGL(k_nsa_cmp, dim3(S_ / 64, 2, B_), dim3(64), 0, st, H1, KC, VC, (const float*)d_in[19], O, SEL);
    hipLaunchKernelGGL(k_nsa_sw<1>, dim3(S_ / 64, 16, B_), dim3(64), 0, st, H1, SEL, (const float*)d_in[19], O);
    hipLaunchKernelGGL(k_nsa_sw<2>, dim3(S_ / 64, 16, B_), dim3(64), 0, st, H1, SEL, (const float*)d_in[19], O);
    float* Z1b = (float*)(ws + 0 * MiB);
    gemm(st, O, 1024, nullptr, (const float*)d_in[20], 1024, 0, nullptr, T_, 1024, 1024, EpiResid{xm, Z1b, 1024, 0});
    moe_and_ln2(st, 1, d_in, Z1b, ws, 128 * MiB, 256 * MiB, 384 * MiB, 470 * MiB, out);
}
}

extern "C" void kernel_launch(void* const* d_in, const int* in_sizes, int n_in, void* d_out, int out_size, void* d_ws, size_t ws_size, hipStream_t stream) {
    nv::forward(d_in, (float*)d_out, (unsigned char*)d_ws, stream);
}
```

```cpp
#define DUP_PHASE 11
#include <hip/hip_runtime.h>
#include <stdint.h>
#include <math.h>
#include <cstdio>
namespace pg8 {
#define PG8_LAS __attribute__((address_space(3)))
typedef unsigned short bf16_t;
typedef short bf16x8 __attribute__((ext_vector_type(8)));
typedef float f32x4 __attribute__((ext_vector_type(4)));
typedef unsigned u32x4 __attribute__((ext_vector_type(4)));
constexpr int BM = 256, BK = 64, HALF = 128, HTB = HALF * BK * 2  , STAGE_BYTES = 8 * HTB, NXCD = 8, WGM = 8;

__host__ __device__ __forceinline__ int lds_byte(int r, int c) { const int st = (r >> 4) * 2 + (c >> 5), rr = r & 15, cc = c & 31, ob = rr * 64 + cc * 2; return st * 1024 + (ob ^ (((ob >> 9) & 1) << 5)); }
__host__ __device__ __forceinline__ void stage_rc(int b, int& R, int& C) { const int st = b / 1024, sb = b % 1024, swz = sb ^ (((sb >> 9) & 1) << 5); R = (st >> 1) * 16 + swz / 64; C = (st & 1) * 32 + (swz % 64) / 2; }
__host__ __device__ __forceinline__ int perm32(int rho) { const int n = rho >> 4, i = rho & 15; return 8 * (i >> 2) + 4 * n + (i & 3); }

struct Unit { int pm, pn; };
struct Gemm { const bf16_t* A; const bf16_t* Bt; int M, N, K, lda; };

struct StaticOrder {
    int nM, nN, nwg, G, c;
    __host__ __device__ void init(int M, int N, int G_, int c_) { nM = M / BM; nN = N / BM; nwg = nM * nN; G = G_; c = c_; }
    __host__ __device__ bool next(int i, Unit& u) const {
        const long L = (long)i * G + c; if (L >= nwg) return false;
        int wgid = (int)L; { const int q = nwg / NXCD, r = nwg % NXCD, xcd = wgid % NXCD, off = wgid / NXCD; wgid = (xcd < r ? xcd * (q + 1) : r * (q + 1) + (xcd - r) * q) + off; }
        const int nig = WGM * nN, gid = wgid / nig, fm = gid * WGM, gsz = (nM - fm) < WGM ? (nM - fm) : WGM;
        u.pm = fm + ((wgid % nig) % gsz); u.pn = (wgid % nig) / gsz; return true;
    }
    __device__ __forceinline__ void a_ready(const Unit&) const {}
    __device__ __forceinline__ void done(const Unit&) const {}
};

__device__ __forceinline__ unsigned cvt_pk_bf16(float lo, float hi) { unsigned r; asm volatile("v_cvt_pk_bf16_f32 %0, %1, %2" : "=v"(r) : "v"(lo), "v"(hi)); return r; }
typedef float f32x2 __attribute__((ext_vector_type(2)));
template <class Epi, class Sched, bool ALIGN_EPI = false, bool SP2 = false>
__device__ __forceinline__ void gemm_phase(PG8_LAS unsigned char* lds, const Gemm g, const Sched& S, const Epi& E) {
    int tid_l = (int)threadIdx.x; asm volatile("" : "+v"(tid_l));
    const int tid = tid_l, wid = __builtin_amdgcn_readfirstlane(tid >> 6), lane = tid & 63, wr = wid >> 2, wc = wid & 3, fr = lane & 15, fq = lane >> 4;
    const int K = g.K, nt = K / BK;
    unsigned voffA[2], voffB[2];
#pragma unroll
    for (int i = 0; i < 2; ++i) { int R, C; stage_rc(tid * 16 + i * 8192, R, C); const int Rb = Epi::PERM ? ((R & ~31) + perm32(R & 31)) : R;
        voffA[i] = (unsigned)(R * g.lda + C) * 2u; voffB[i] = (unsigned)(Rb * K + C) * 2u; }
    const size_t kstep = (size_t)(BK * 2);
    const size_t hstepA = (size_t)HALF * g.lda * 2, hstepB = (size_t)HALF * K * 2;
    const size_t tstepA = 2 * hstepA, tstepB = 2 * hstepB;
    const unsigned ldsw = (unsigned)wid * 1024u;
    const int aoff = lds_byte(wr * 64 + fr, fq * 8), boff = lds_byte(wc * 32 + fr, fq * 8);
#define PG8_SA(b, h) (((b) * 2 + (h)) * HTB)
#define PG8_SB(b, h) ((4 + (b) * 2 + (h)) * HTB)
#define PG8_STAGE(bufoff, gbase, voff) do { _Pragma("unroll") for (int _i = 0; _i < 2; ++_i) \
        __builtin_amdgcn_global_load_lds((const unsigned*)((const char*)(gbase) + (voff)[_i]), (PG8_LAS unsigned*)(lds + (bufoff) + ldsw + _i * 8192), 16, 0, 0); } while (0)
#define PG8_LDA(dst, b, h) do { _Pragma("unroll") for (int m = 0; m < 4; ++m) _Pragma("unroll") for (int k = 0; k < 2; ++k) dst[m][k] = *(const PG8_LAS bf16x8*)(lds + PG8_SA(b, h) + aoff + m * 2048 + k * 1024); } while (0)
#define PG8_LDB(dst, b, h) do { _Pragma("unroll") for (int n = 0; n < 2; ++n) _Pragma("unroll") for (int k = 0; k < 2; ++k) dst[n][k] = *(const PG8_LAS bf16x8*)(lds + PG8_SB(b, h) + boff + n * 2048 + k * 1024); } while (0)
#define PG8_MMA(ai, bj, At, Bt) do { __builtin_amdgcn_s_setprio(1); _Pragma("unroll") for (int m = 0; m < 4; ++m) _Pragma("unroll") for (int n = 0; n < 2; ++n) _Pragma("unroll") for (int k = 0; k < 2; ++k) \
        acc[ai][bj][m][n] = __builtin_amdgcn_mfma_f32_16x16x32_bf16(Bt[n][k], At[m][k], acc[ai][bj][m][n], 0, 0, 0); __builtin_amdgcn_s_setprio(0); } while (0)
#define PG8_WAIT_V(n) asm volatile("s_waitcnt vmcnt(" #n ")" ::: "memory")
#define PG8_WAIT_L(n) asm volatile("s_waitcnt lgkmcnt(" #n ")" ::: "memory")
#define PG8_BAR __builtin_amdgcn_s_barrier()
#define PG8_SCHED __builtin_amdgcn_sched_barrier(0)
    Unit cur, nxt; int ui = 0;
    if (!S.next(0, cur)) return;
    f32x4 acc[2][2][4][2];
#pragma unroll
    for (int a = 0; a < 2; ++a)
#pragma unroll
        for (int b = 0; b < 2; ++b)
#pragma unroll
            for (int m = 0; m < 4; ++m)
#pragma unroll
                for (int n = 0; n < 2; ++n) acc[a][b][m][n] = (f32x4){0.f, 0.f, 0.f, 0.f};
    bf16x8 At[4][2], B0[2][2], B1[2][2];
    const char* cA = (const char*)g.A + (size_t)cur.pm * tstepA; const char* cB = (const char*)g.Bt + (size_t)cur.pn * tstepB;
    S.a_ready(cur);
    if constexpr (SP2) {
        PG8_STAGE(PG8_SB(0, 0), cB, voffB); PG8_STAGE(PG8_SB(0, 1), cB + hstepB, voffB); PG8_STAGE(PG8_SA(0, 0), cA, voffA); PG8_STAGE(PG8_SA(0, 1), cA + hstepA, voffA);
        if (wr == 1) PG8_BAR;
        PG8_WAIT_V(2); PG8_BAR;
        PG8_STAGE(PG8_SB(1, 0), cB + kstep, voffB); PG8_STAGE(PG8_SA(1, 0), cA + kstep, voffA); PG8_STAGE(PG8_SB(1, 1), cB + hstepB + kstep, voffB);
        PG8_WAIT_V(6); PG8_BAR;
    } else {
        PG8_STAGE(PG8_SB(0, 0), cB, voffB); PG8_STAGE(PG8_SA(0, 0), cA, voffA); PG8_STAGE(PG8_SB(0, 1), cB + hstepB, voffB); PG8_STAGE(PG8_SA(0, 1), cA + hstepA, voffA);
        if (wr == 1) PG8_BAR;
        PG8_WAIT_V(4); PG8_BAR;
        PG8_STAGE(PG8_SB(1, 0), cB + kstep, voffB); PG8_STAGE(PG8_SA(1, 0), cA + kstep, voffA); PG8_STAGE(PG8_SB(1, 1), cB + hstepB + kstep, voffB);
        PG8_WAIT_V(6); PG8_BAR;
    }
    for (;;) {
        const bool has_next = S.next(ui + 1, nxt);
        const char* nA = has_next ? (const char*)g.A + (size_t)nxt.pm * tstepA : cA; const char* nB = has_next ? (const char*)g.Bt + (size_t)nxt.pn * tstepB : cB;
        for (int t = 0; t < nt; t += 2) {
            const bool last = (t == nt - 2);
            const char* a1 = cA + (size_t)(t + 1) * kstep;
            const char* a2 = last ? nA : cA + (size_t)(t + 2) * kstep; const char* b2 = last ? nB : cB + (size_t)(t + 2) * kstep;
            const char* a3 = a2 + kstep; const char* b3 = b2 + kstep;
            if (last && has_next) S.a_ready(nxt);
            if constexpr (SP2) {
            PG8_LDB(B0, 0, 0); PG8_LDB(B1, 0, 1); PG8_SCHED; PG8_LDA(At, 0, 0); PG8_STAGE(PG8_SA(1, 1), a1 + hstepA, voffA);
            PG8_WAIT_V(8); PG8_WAIT_L(0); PG8_BAR; PG8_MMA(0, 0, At, B0); PG8_MMA(0, 1, At, B1); PG8_BAR; PG8_SCHED;
            PG8_LDA(At, 0, 1); PG8_STAGE(PG8_SB(0, 0), b2, voffB); PG8_STAGE(PG8_SB(0, 1), b2 + hstepB, voffB); PG8_STAGE(PG8_SA(0, 0), a2, voffA);
            PG8_WAIT_V(8); PG8_WAIT_L(0); PG8_BAR; PG8_MMA(1, 0, At, B0); PG8_MMA(1, 1, At, B1); PG8_BAR; PG8_SCHED;
            PG8_LDB(B0, 1, 0); PG8_LDB(B1, 1, 1); PG8_SCHED; PG8_LDA(At, 1, 0); PG8_STAGE(PG8_SA(0, 1), a2 + hstepA, voffA);
            PG8_WAIT_V(8); PG8_WAIT_L(0); PG8_BAR; PG8_MMA(0, 0, At, B0); PG8_MMA(0, 1, At, B1); PG8_BAR; PG8_SCHED;
            PG8_LDA(At, 1, 1); PG8_STAGE(PG8_SB(1, 0), b3, voffB); PG8_STAGE(PG8_SB(1, 1), b3 + hstepB, voffB); PG8_STAGE(PG8_SA(1, 0), a3, voffA);
            PG8_WAIT_V(8); PG8_WAIT_L(0); PG8_BAR; PG8_MMA(1, 0, At, B0); PG8_MMA(1, 1, At, B1); PG8_BAR; PG8_SCHED;
            } else {
            PG8_LDB(B0, 0, 0); PG8_SCHED; PG8_LDA(At, 0, 0); PG8_STAGE(PG8_SA(1, 1), a1 + hstepA, voffA);
            PG8_WAIT_L(8); PG8_BAR; PG8_WAIT_L(0); PG8_MMA(0, 0, At, B0); PG8_BAR; PG8_SCHED;
            PG8_LDB(B1, 0, 1); PG8_STAGE(PG8_SB(0, 0), b2, voffB);
            PG8_BAR; PG8_WAIT_L(0); PG8_MMA(0, 1, At, B1); PG8_BAR;
            PG8_LDA(At, 0, 1); PG8_STAGE(PG8_SA(0, 0), a2, voffA);
            PG8_BAR; PG8_WAIT_L(0); PG8_MMA(1, 0, At, B0); PG8_BAR; PG8_SCHED;
            PG8_STAGE(PG8_SB(0, 1), b2 + hstepB, voffB);
            PG8_WAIT_V(6); PG8_BAR; PG8_MMA(1, 1, At, B1); PG8_BAR;
            PG8_LDB(B0, 1, 0); PG8_SCHED; PG8_LDA(At, 1, 0); PG8_STAGE(PG8_SA(0, 1), a2 + hstepA, voffA);
            PG8_WAIT_L(8); PG8_BAR; PG8_WAIT_L(0); PG8_MMA(0, 0, At, B0); PG8_BAR; PG8_SCHED;
            PG8_LDB(B1, 1, 1); PG8_STAGE(PG8_SB(1, 0), b3, voffB);
            PG8_BAR; PG8_WAIT_L(0); PG8_MMA(0, 1, At, B1); PG8_BAR;
            PG8_LDA(At, 1, 1); PG8_STAGE(PG8_SA(1, 0), a3, voffA);
            PG8_BAR; PG8_WAIT_L(0); PG8_MMA(1, 0, At, B0); PG8_BAR; PG8_SCHED;
            PG8_STAGE(PG8_SB(1, 1), b3 + hstepB, voffB);
            PG8_WAIT_V(6); PG8_BAR; PG8_MMA(1, 1, At, B1); PG8_BAR;
            }
        }
        if constexpr (ALIGN_EPI) { if (wr == 0) PG8_BAR; }
        if constexpr (!Epi::AFTER_DRAIN) { E(acc, cur, wr, wc, fr, fq); S.done(cur); }
        if (!has_next) break;
#pragma unroll
        for (int a = 0; a < 2; ++a)
#pragma unroll
            for (int b = 0; b < 2; ++b)
#pragma unroll
                for (int m = 0; m < 4; ++m)
#pragma unroll
                    for (int n = 0; n < 2; ++n) acc[a][b][m][n] = (f32x4){0.f, 0.f, 0.f, 0.f};
        cur = nxt; cA = nA; cB = nB; ++ui;
        if constexpr (ALIGN_EPI) { if (wr == 1) PG8_BAR; }
    }
    PG8_WAIT_V(0);
    if constexpr (!ALIGN_EPI) { if (wr == 0) PG8_BAR; }
    PG8_BAR;
    if constexpr (Epi::AFTER_DRAIN) { E.fused(acc, cur, wr, wc, fr, fq, lds, wid, lane); S.done(cur); }
#undef PG8_SA
#undef PG8_SB
#undef PG8_STAGE
#undef PG8_LDA
#undef PG8_LDB
#undef PG8_MMA
#undef PG8_WAIT_V
#undef PG8_WAIT_L
#undef PG8_BAR
#undef PG8_SCHED
}
}
#define GAS __attribute__((address_space(1)))
#define LAS __attribute__((address_space(3)))
typedef unsigned short bf16;
typedef unsigned v4u __attribute__((ext_vector_type(4)));
typedef float f32x4 __attribute__((ext_vector_type(4)));
typedef short bf16x8 __attribute__((ext_vector_type(8)));
typedef GAS unsigned gu32;
typedef GAS unsigned long long gu64;
#define RLX_AGENT __ATOMIC_RELAXED, __HIP_MEMORY_SCOPE_AGENT
#define LDS_WAIT() asm volatile("s_waitcnt lgkmcnt(0)" ::: "memory")
#define VM_WAIT() asm volatile("s_waitcnt vmcnt(0)" ::: "memory")
__device__ __forceinline__ unsigned long long rt() { return __builtin_amdgcn_s_memrealtime(); }
__device__ __forceinline__ unsigned f2bf(float f) { unsigned u = __builtin_bit_cast(unsigned, f); return (u + 0x7fffu + ((u >> 16) & 1u)) >> 16; }
__device__ __forceinline__ unsigned pk2(float lo, float hi) { return f2bf(lo) | (f2bf(hi) << 16); }

#define XB_TMO      128
#define XB_XCNT(j)  (256  + 64 * (j))
#define XB_XSUB(j)  (1280 + 64 * (j))
#define XB_XGEN(j)  (2304 + 64 * (j))
#define XB_TOP      3328
#define XB_TOPGEN   3392
#define XCD_BAR_WORDS 3456
#define XB_SPIN_CAP (1u << 18)

__device__ __forceinline__ unsigned xb_ld(unsigned* p)              { return __hip_atomic_load(p, __ATOMIC_RELAXED, __HIP_MEMORY_SCOPE_AGENT); }
__device__ __forceinline__ unsigned xb_add(unsigned* p, unsigned v) { return __hip_atomic_fetch_add(p, v, __ATOMIC_RELAXED, __HIP_MEMORY_SCOPE_AGENT); }
__device__ __forceinline__ unsigned xb_xcc_id() { return (unsigned)__builtin_amdgcn_s_getreg((3 << 11) | 20) & 0xFu; }
#define XB_SPIN(cond, bar) do { unsigned _sp = 0; while (cond) { __builtin_amdgcn_s_sleep(1); \
    if ((++_sp & 255u) == 0u) { if (xb_ld(&(bar)[XB_TMO])) break; if (_sp > XB_SPIN_CAP) { atomicAdd(&(bar)[XB_TMO], 1u); break; } } } } while (0)

struct XcdBarrier {
    unsigned* bar; unsigned x;
    volatile LAS unsigned* st;
};

__device__ __forceinline__ XcdBarrier xcd_barrier_post(unsigned* bar, volatile LAS unsigned* st) {
    XcdBarrier b; b.bar = bar; b.x = xb_xcc_id(); b.st = st;
    if (threadIdx.x == 0) (void)xb_add(&bar[XB_XCNT(b.x)], 1u);
    return b;
}
__device__ __forceinline__ void xcd_barrier_complete(unsigned* bar, unsigned x, unsigned& nloc, unsigned& nx) {
    const unsigned G = gridDim.x * gridDim.y * gridDim.z;
    unsigned sum, cnt, mine, sp = 0u;
    for (;;) {
        sum = 0u; cnt = 0u; mine = 0u;
#pragma unroll
        for (unsigned j = 0; j < 16; ++j) { const unsigned c = xb_ld(&bar[XB_XCNT(j)]); sum += c; cnt += (c > 0u) ? 1u : 0u; mine = (j == x) ? c : mine; }
        if (sum == G) break;
        __builtin_amdgcn_s_sleep(1);
        if ((++sp & 255u) == 0u) { if (xb_ld(&bar[XB_TMO])) break; if (sp > XB_SPIN_CAP) { atomicAdd(&bar[XB_TMO], 1u); break; } }
    }
    nloc = mine > 0u ? mine : 1u; nx = cnt > 0u ? cnt : 1u;
}

__device__ __forceinline__ void xcd_barrier(const XcdBarrier& b) {
    asm volatile("s_waitcnt vmcnt(0)" ::: "memory");
    __syncthreads();
    if (threadIdx.x == 0) {
        unsigned* bar = b.bar;
        __builtin_amdgcn_s_waitcnt(0);
        unsigned nloc = b.st[0], nx = b.st[1];
        if (nloc == 0u) { xcd_barrier_complete(bar, b.x, nloc, nx); b.st[0] = nloc; b.st[1] = nx; }
        const unsigned old = xb_add(&bar[XB_XSUB(b.x)], 1u);
        const unsigned gen = old / nloc;
        if (old + 1u == (gen + 1u) * nloc) {
            __builtin_amdgcn_fence(__ATOMIC_RELEASE, "agent");
            asm volatile("s_waitcnt vmcnt(0)" ::: "memory");
            const unsigned og = xb_add(&bar[XB_TOP], 1u);
            const unsigned tg = og / nx;
            if (og + 1u == (tg + 1u) * nx) xb_add(&bar[XB_TOPGEN], 1u);
            else XB_SPIN(xb_ld(&bar[XB_TOPGEN]) == tg, bar);
            __builtin_amdgcn_fence(__ATOMIC_ACQUIRE, "agent");
            xb_add(&bar[XB_XGEN(b.x)], 1u);
            asm volatile("s_waitcnt vmcnt(0)" ::: "memory");
        } else {
            XB_SPIN(xb_ld(&bar[XB_XGEN(b.x)]) == gen, bar);
            __builtin_amdgcn_fence(__ATOMIC_ACQUIRE, "agent");
            asm volatile("s_waitcnt vmcnt(0)" ::: "memory");
        }
    }
    __syncthreads();
}
namespace fk {
using pg8::bf16_t; using pg8::f32x4; using pg8::u32x4; using pg8::Unit; using pg8::Gemm;
typedef float f32x16 __attribute__((ext_vector_type(16)));
typedef float f32x2 __attribute__((ext_vector_type(2)));
typedef unsigned u32x2 __attribute__((ext_vector_type(2)));
typedef short s16x4 __attribute__((ext_vector_type(4)));
constexpr int NB = 16, S = 2048, D = 1024, T = NB * S;
constexpr float ALPHA = 1.41421356237309515f, LN_EPS = 1e-5f, LOG2E = 1.4426950408889634f;
constexpr float QS_MLA = 0.10206207261596575f * LOG2E;
constexpr float QS_NSA = 0.125f * LOG2E;
constexpr int NWAVES = 8, NTHR = 512;
constexpr int MOE_ROWS = 73728, MOE_PANELS = MOE_ROWS / 256;

constexpr size_t MiB = 1u << 20;
constexpr size_t WS_CTL = 0, CTL_ZERO_BYTES = 1 * MiB;
constexpr size_t WS_W0IN = 1 * MiB, WS_WUQ = 4 * MiB, WS_WUKV = WS_WUQ + 512 * 1024, WS_W0O = 5 * MiB, WS_W1IN = 7 * MiB, WS_WCK1 = 11 * MiB, WS_WCV1 = 12 * MiB,
                 WS_WCK2 = 13 * MiB, WS_WCV2 = 13 * MiB + 64 * 1024, WS_WSB = 13 * MiB + 128 * 1024, WS_CBIAS = 13 * MiB + 512 * 1024, WS_W1O = 14 * MiB, WS_WGU = 16 * MiB, WS_WD = 80 * MiB;
constexpr size_t WS_Z1 = 113 * MiB;
constexpr size_t WS_STATS = 241 * MiB;
constexpr size_t WS_ROUTE = WS_STATS + 256 * 1024;
constexpr size_t WS_S = 242 * MiB;
constexpr size_t S_XB = WS_S, S_H0B = WS_S + 64 * MiB, S_Q96 = WS_S, S_KN = WS_S + 160 * MiB, S_V = WS_S + 192 * MiB, S_KRB = WS_S + 224 * MiB;
constexpr size_t S_X1B = WS_S, S_XP = WS_S + 64 * MiB, S_HP = WS_S + 208 * MiB, S_YP = WS_S, S_X2B = WS_S + 144 * MiB;
constexpr size_t S_H1B = WS_S, S_KCMP = WS_S + 208 * MiB, S_VCMP = S_KCMP + 1 * MiB;
constexpr size_t WS_END = WS_S + 244 * MiB;
static_assert(WS_END <= 512 * MiB, "workspace map");
constexpr int CW_BAR = 4096, CW_CNT = 16384  ;

constexpr int RING_OFF = 0, LDS_MISC = 139264, LDS_SCR = LDS_MISC + 256, LDS_BYTES = 163840;

struct Args { const void* in[32]; float* out; unsigned char* ws; int ph_lo, ph_hi; };

__device__ __forceinline__ float bf2f(unsigned short b) { return __uint_as_float((unsigned)b << 16); }
__device__ __forceinline__ unsigned pk(float lo, float hi) { return pg8::cvt_pk_bf16(lo, hi); }
template <int CTRL> __device__ __forceinline__ float dppf(float v) { return __builtin_bit_cast(float, __builtin_amdgcn_update_dpp(0, __builtin_bit_cast(int, v), CTRL, 0xf, 0xf, true)); }
__device__ __forceinline__ float wsum(float v) {
    v += dppf<0xB1>(v); v += dppf<0x4E>(v); v += dppf<0x141>(v); v += dppf<0x140>(v);
    const int b = __builtin_bit_cast(int, v);
    return (__builtin_bit_cast(float, __builtin_amdgcn_readlane(b, 0)) + __builtin_bit_cast(float, __builtin_amdgcn_readlane(b, 16))) + (__builtin_bit_cast(float, __builtin_amdgcn_readlane(b, 32)) + __builtin_bit_cast(float, __builtin_amdgcn_readlane(b, 48)));
}
__device__ __forceinline__ int launder(int x) { asm volatile("" : "+v"(x)); return x; }
__device__ __forceinline__ float ex2(float x) { return __builtin_amdgcn_exp2f(x); }
__device__ __forceinline__ float gelu_t(float x) {
    const float u = 0.7978845608028654f * (x + 0.044715f * x * x * x);
    return x * __builtin_amdgcn_rcpf(1.f + ex2(-2.f * LOG2E * u));
}
__device__ __forceinline__ int crow(int r, int hi) { return (r & 3) + 8 * (r >> 2) + 4 * hi; }
__device__ __forceinline__ f32x16 mfma32(bf16x8 a, bf16x8 b, f32x16 c) { return __builtin_amdgcn_mfma_f32_32x32x16_bf16(a, b, c, 0, 0, 0); }
__device__ __forceinline__ bf16x8 ld8g(const bf16_t* p) { return *(const bf16x8*)p; }
typedef short v4i16_t __attribute__((ext_vector_type(4)));
__device__ __forceinline__ s16x4 trld(const LAS unsigned char* p) { return __builtin_bit_cast(s16x4, __builtin_amdgcn_ds_read_tr16_b64_v4i16((LAS v4i16_t*)p)); }

struct Frame {
    LAS unsigned char* lds; gu32* ctl; unsigned char* ws;
    int tid, lane, wave, vcu, G;
    const void* const* in; float* out;
};

struct EpiTile {
    static constexpr bool PERM = true, AFTER_DRAIN = false;
    bf16_t* O; int ldc; int ngelu; int nscale; float scale; int pad;
    __device__ __forceinline__ void operator()(const f32x4 (&acc)[2][2][4][2], const Unit& u, int wr, int wc, int fr, int fq) const {
        const int row0 = u.pm * 256 + wr * 64 + fr, col0 = u.pn * 256 + wc * 32 + 8 * fq;
        const bool dg = u.pn < ngelu; const float sc = (u.pn < nscale) ? scale : 1.f;
#pragma unroll
        for (int ai = 0; ai < 2; ++ai)
#pragma unroll
            for (int m = 0; m < 4; ++m) { bf16_t* rowp = O + (size_t)(row0 + ai * 128 + m * 16) * ldc + col0;
#pragma unroll
                for (int bj = 0; bj < 2; ++bj) { f32x4 v0 = acc[ai][bj][m][0], v1 = acc[ai][bj][m][1];
                    if (dg) { v0 = (f32x4){gelu_t(v0[0]), gelu_t(v0[1]), gelu_t(v0[2]), gelu_t(v0[3])}; v1 = (f32x4){gelu_t(v1[0]), gelu_t(v1[1]), gelu_t(v1[2]), gelu_t(v1[3])}; }
                    v0 = v0 * sc; v1 = v1 * sc;
                    u32x4 w; w.x = pk(v0[0], v0[1]); w.y = pk(v0[2], v0[3]); w.z = pk(v1[0], v1[1]); w.w = pk(v1[2], v1[3]);
                    *(u32x4*)(rowp + bj * 128) = w; } }
    }
};
struct EpiResid {
    static constexpr bool PERM = false, AFTER_DRAIN = false;
    const float* X; float* Z;
    __device__ __forceinline__ void operator()(const f32x4 (&acc)[2][2][4][2], const Unit& u, int wr, int wc, int fr, int fq) const {
        const int col0 = u.pn * 256 + wc * 32 + 4 * fq;
#pragma unroll
        for (int ai = 0; ai < 2; ++ai)
#pragma unroll
            for (int m = 0; m < 4; ++m) { const size_t off = (size_t)(u.pm * 256 + ai * 128 + wr * 64 + m * 16 + fr) * D + col0;
#pragma unroll
                for (int bj = 0; bj < 2; ++bj)
#pragma unroll
                    for (int n = 0; n < 2; ++n) { const f32x4 x = *(const f32x4*)(X + off + bj * 128 + n * 16); *(f32x4*)(Z + off + bj * 128 + n * 16) = x * ALPHA + acc[ai][bj][m][n]; } }
    }
};
struct EpiMoeUp {
    static constexpr bool PERM = true, AFTER_DRAIN = false;
    bf16_t* H;
    __device__ __forceinline__ void operator()(const f32x4 (&acc)[2][2][4][2], const Unit& u, int wr, int wc, int fr, int fq) const {
        const int row0 = u.pm * 256 + wr * 64 + fr, col0 = (u.pn & 1) * 128 + wc * 16 + 4 * fq;
#pragma unroll
        for (int ai = 0; ai < 2; ++ai)
#pragma unroll
            for (int m = 0; m < 4; ++m) { bf16_t* rowp = H + (size_t)(row0 + ai * 128 + m * 16) * 256 + col0;
#pragma unroll
                for (int bj = 0; bj < 2; ++bj) { const f32x4 g = acc[ai][bj][m][0], up = acc[ai][bj][m][1]; f32x4 h;
#pragma unroll
                    for (int e = 0; e < 4; ++e) h[e] = g[e] * __builtin_amdgcn_rcpf(1.f + ex2(-LOG2E * g[e])) * up[e];
                    u32x2 w; w.x = pk(h[0], h[1]); w.y = pk(h[2], h[3]); *(u32x2*)(rowp + bj * 64) = w; } }
    }
};
struct EpiMoeDown {
    static constexpr bool PERM = true, AFTER_DRAIN = false;
    bf16_t* Y;
    __device__ __forceinline__ void operator()(const f32x4 (&acc)[2][2][4][2], const Unit& u, int wr, int wc, int fr, int fq) const {
        const int row0 = u.pm * 256 + wr * 64 + fr, col0 = (u.pn & 3) * 256 + wc * 32 + 8 * fq;
#pragma unroll
        for (int ai = 0; ai < 2; ++ai)
#pragma unroll
            for (int m = 0; m < 4; ++m) { bf16_t* rowp = Y + (size_t)(row0 + ai * 128 + m * 16) * D + col0;
#pragma unroll
                for (int bj = 0; bj < 2; ++bj) { const f32x4 v0 = acc[ai][bj][m][0], v1 = acc[ai][bj][m][1];
                    u32x4 w; w.x = pk(v0[0], v0[1]); w.y = pk(v0[2], v0[3]); w.z = pk(v1[0], v1[1]); w.w = pk(v1[2], v1[3]);
                    *(u32x4*)(rowp + bj * 128) = w; } }
    }
};
template <int NC> struct MoeOrder {
    const LAS int* pe; int nunits, G, c;
    __device__ __forceinline__ bool next(int i, Unit& u) const { const int L = i * G + c; if (L >= nunits) return false; const int p = L / NC; u.pm = p; u.pn = pe[p] * NC + (L % NC); return true; }
    __device__ __forceinline__ void a_ready(const Unit&) const {}
    __device__ __forceinline__ void done(const Unit&) const {}
};

__device__ __forceinline__ void p0_item(const float* W, int ldw, int K, int N, bf16_t* WT, int rmode, int row_off, const float* kscale, LAS float* scr, int item, int lane) {
    const int nblk = (N + 31) / 32, kb = item / nblk, nb = item % nblk, k0 = 64 * kb, n0 = 32 * nb;
    const int nn = n0 + (lane & 31);
    float wv[32];
#pragma unroll
    for (int i = 0; i < 32; ++i) { const int kk = 2 * i + (lane >> 5); wv[i] = (nn < N) ? W[(size_t)(k0 + kk) * ldw + nn] : 0.f; }
#pragma unroll
    for (int i = 0; i < 32; ++i) { const int kk = 2 * i + (lane >> 5); float v = wv[i]; if (kscale) v *= kscale[k0 + kk]; scr[kk * 33 + (lane & 31)] = v; }
    LDS_WAIT(); asm volatile("" ::: "memory");
    const int c = lane & 7;
#pragma unroll
    for (int j = 0; j < 4; ++j) { const int n = (lane >> 3) + 8 * j; const LAS float* s = scr + (8 * c) * 33 + n;
        v4u o; o.x = pk(s[0 * 33], s[1 * 33]); o.y = pk(s[2 * 33], s[3 * 33]); o.z = pk(s[4 * 33], s[5 * 33]); o.w = pk(s[6 * 33], s[7 * 33]);
        const int ng = n0 + n; const int r = (rmode == 0) ? row_off + ng : (row_off + (ng >> 2) * 8 + (rmode == 2 ? 4 : 0) + (ng & 3));
        *(GAS v4u*)(WT + (size_t)r * K + k0 + 8 * c) = o; }
    LDS_WAIT(); asm volatile("" ::: "memory");
}
struct ConvJob { const float* W; int ldw, K, N; bf16_t* WT; int rmode, row_off; const float* kscale; int nitems; };

__device__ __forceinline__ void p0_prologue(Frame& F) {
    LAS float* scr = (LAS float*)(F.lds + RING_OFF + F.wave * 16384);
    const int gw = F.vcu * NWAVES + F.wave, NGW = F.G * NWAVES;
    unsigned char* ws = F.ws;
    {
        const float* in2 = (const float*)F.in[2];
#define JOB(Wp, ldw_, K_, N_, dst, rm, ro, ks) { const int nit = ((K_) / 64) * (((N_) + 31) / 32); if (it < nit) { p0_item((const float*)(Wp), ldw_, K_, N_, (bf16_t*)(dst), rm, ro, ks, scr, it, F.lane); continue; } it -= nit; }
        constexpr int TOT = 16 * 45 + 4 * 24 + 2 * 16 + 2 * 16 + 16 * 32 + 16 * 58 + 32 * 8 * 2 + 4 * 2 * 2 + 16 * 32;
        for (int it0 = gw; it0 < TOT; it0 += NGW) { int it = it0;
            JOB(in2, 1440, 1024, 1440, ws + WS_W0IN, 0, 0, nullptr)
            JOB(F.in[9], 768, 256, 768, ws + WS_WUQ, 0, 0, (const float*)F.in[7])
            JOB(F.in[10], 512, 128, 512, ws + WS_WUKV, 0, 0, (const float*)F.in[8])
            JOB(F.in[11], 512, 128, 512, ws + WS_WUKV, 0, 512, (const float*)F.in[8])
            JOB(F.in[12], 1024, 1024, 1024, ws + WS_W0O, 0, 0, nullptr)
            JOB(F.in[13], 1840, 1024, 1840, ws + WS_W1IN, 0, 0, nullptr)
            JOB(F.in[15], 256, 2048, 256, ws + WS_WCK1, 0, 0, nullptr)
            JOB(F.in[17], 256, 2048, 256, ws + WS_WCV1, 0, 0, nullptr)
            JOB(F.in[16], 64, 256, 64, ws + WS_WCK2, 0, 0, nullptr)
            JOB(F.in[18], 64, 256, 64, ws + WS_WCV2, 0, 0, nullptr)
            JOB(F.in[20], 1024, 1024, 1024, ws + WS_W1O, 0, 0, nullptr)
        }
#undef JOB
    }
    {
        constexpr int IG = 16 * 8, ID = 4 * 32, PER = 2 * IG + ID;
        for (int it0 = gw; it0 < 64 * PER; it0 += NGW) { const int le = it0 / PER; int it = it0 % PER;
            bf16_t* gu = (bf16_t*)(ws + WS_WGU) + (size_t)le * 512 * 1024; bf16_t* wd = (bf16_t*)(ws + WS_WD) + (size_t)le * 1024 * 256;
            if (it < IG) { p0_item((const float*)F.in[25] + (size_t)le * 1024 * 256, 256, 1024, 256, gu, 1, 0, nullptr, scr, it, F.lane); continue; } it -= IG;
            if (it < IG) { p0_item((const float*)F.in[26] + (size_t)le * 1024 * 256, 256, 1024, 256, gu, 2, 0, nullptr, scr, it, F.lane); continue; } it -= IG;
            p0_item((const float*)F.in[27] + (size_t)le * 256 * 1024, 1024, 256, 1024, wd, 0, 0, nullptr, scr, it, F.lane);
        }
    }
    const int gt = F.vcu * NTHR + F.tid, NGT = F.G * NTHR;
    { v4u z = {0u, 0u, 0u, 0u};
      for (int i = gt; i < 96 * 128; i += NGT) *(GAS v4u*)((bf16_t*)(ws + WS_W0IN) + (size_t)1440 * 1024 + (size_t)i * 8) = z;
      for (int i = gt; i < 192 * 128; i += NGT) *(GAS v4u*)((bf16_t*)(ws + WS_W1IN) + (size_t)1856 * 1024 + (size_t)i * 8) = z; }
    { const float* gws = (const float*)F.in[5]; bf16_t* wsb = (bf16_t*)(ws + WS_WSB);
      for (int i = gt; i < 4 * 128 * 128; i += NGT) { const int s = i & 127, t = (i >> 7) & 127; wsb[i] = (bf16_t)(pk(s <= t ? gws[i] : 0.f, 0.f) & 0xffffu); } }
    {
      float* cb = (float*)(ws + WS_CBIAS);
      for (int o = gw; o < 512; o += NGW) { const int kv = o >> 8, h = o & 255; const float* pos = (const float*)F.in[14] + kv * 2048; const float* w1 = (const float*)F.in[kv ? 17 : 15];
          float a = 0.f; for (int k = F.lane; k < 2048; k += 64) a += pos[k] * w1[(size_t)k * 256 + h];
          a = wsum(a); if (F.lane == 0) cb[o] = a; } }
    { const float* x = (const float*)F.in[0]; bf16_t* xb = (bf16_t*)(ws + S_XB);
#pragma unroll 4
      for (int i = gt; i < T * D / 8; i += NGT) { const f32x4 a = *(const GAS f32x4*)(x + (size_t)i * 8), b = *(const GAS f32x4*)(x + (size_t)i * 8 + 4);
          v4u o; o.x = pk(a[0], a[1]); o.y = pk(a[2], a[3]); o.z = pk(b[0], b[1]); o.w = pk(b[2], b[3]); *(GAS v4u*)(xb + (size_t)i * 8) = o; } }
}

__device__ __forceinline__ void wt_load(u32x4 (&v)[4], const unsigned char* base, unsigned pitch, int lane) {
#pragma unroll
    for (int i = 0; i < 4; ++i) v[i] = *(const u32x4*)(base + (size_t)(8 * i + (lane >> 3)) * pitch + (lane & 7) * 16);
}
__device__ __forceinline__ void wt_store(LAS unsigned char* t, const u32x4 (&v)[4], int lane) {
#pragma unroll
    for (int i = 0; i < 4; ++i) { const int row = 8 * i + (lane >> 3); *(LAS u32x4*)(t + row * 128 + (((lane & 7) ^ ((row >> 1) & 7)) << 4)) = v[i]; }
}
__device__ __forceinline__ bf16x8 wt_frag(const LAS unsigned char* t, int ks, int lane) { const int r32 = lane & 31; return *(const LAS bf16x8*)(t + r32 * 128 + (((2 * ks + (lane >> 5)) ^ ((r32 >> 1) & 7)) << 4)); }

__device__ __forceinline__ void store4(bf16_t* p, float a, float b, float c, float d) { u32x2 w; w.x = pk(a, b); w.y = pk(c, d); *(u32x2*)p = w; }
__device__ __forceinline__ void mla_up_item(Frame& F, int item) {
    const int lane = F.lane, r32 = lane & 31, hi = lane >> 5, part = item & 1, tok = (item >> 1) * 32 + r32;
    const bf16_t* hrow = (const bf16_t*)(F.ws + S_H0B) + (size_t)tok * 1536;
    const float p = (float)((const int*)F.in[1])[tok];
    LAS unsigned char* wl = F.lds + RING_OFF + F.wave * 16384;
    float cs[8], sn[8];
#pragma unroll
    for (int r = 0; r < 8; ++r) { const int j = crow(r, hi); const float fr = expf(-9.210340371976184f * (float)j * (1.f / 16.f)); const float ang = p * fr; cs[r] = cosf(ang); sn[r] = sinf(ang); }
    if (part == 0) {
        bf16x8 xf[16]; float ss = 0.f;
#pragma unroll
        for (int ks = 0; ks < 16; ++ks) { xf[ks] = ld8g(hrow + 1024 + ks * 16 + hi * 8);
#pragma unroll
            for (int e = 0; e < 8; ++e) { const float v = bf2f((unsigned short)xf[ks][e]); ss += v * v; } }
        ss += __shfl_xor(ss, 32);
        const float sc = rsqrtf(ss * (1.f / 256.f) + LN_EPS) * QS_MLA;
        const unsigned char* W = (const unsigned char*)(F.ws + WS_WUQ); bf16_t* Q = (bf16_t*)(F.ws + S_Q96) + (size_t)tok * 768;
        u32x4 wv[2][4];
#pragma unroll
        for (int c = 0; c < 2; ++c) wt_load(wv[c], W + c * 128, 512u, lane);
#pragma unroll 1
        for (int nt = 0; nt < 24; ++nt) {
            f32x16 acc = {};
#pragma unroll
            for (int h = 0; h < 2; ++h) {
#pragma unroll
                for (int c = 0; c < 2; ++c) wt_store(wl + (2 * h + c) * 4096, wv[c], lane);
                { const int nn = h ? nt + 1 : nt, hh = h ^ 1; if (nn < 24) {
#pragma unroll
                    for (int c = 0; c < 2; ++c) wt_load(wv[c], W + (size_t)nn * 32 * 512 + (2 * hh + c) * 128, 512u, lane); } }
#pragma unroll
                for (int ks = 0; ks < 8; ++ks) acc = mfma32(wt_frag(wl + (2 * h + (ks >> 2)) * 4096, ks & 3, lane), xf[8 * h + ks], acc);
            }
#pragma unroll
            for (int r = 0; r < 16; ++r) acc[r] *= sc;
            if (nt % 3 == 2) {
#pragma unroll
                for (int r = 0; r < 8; ++r) { const float x1 = acc[r], x2 = acc[r + 8]; acc[r] = x1 * cs[r] - x2 * sn[r]; acc[r + 8] = x1 * sn[r] + x2 * cs[r]; } }
#pragma unroll
            for (int g4 = 0; g4 < 4; ++g4) store4(Q + nt * 32 + 8 * g4 + 4 * hi, acc[4 * g4], acc[4 * g4 + 1], acc[4 * g4 + 2], acc[4 * g4 + 3]);
        }
    } else {
        bf16x8 xf[8]; float ss = 0.f;
#pragma unroll
        for (int ks = 0; ks < 8; ++ks) { xf[ks] = ld8g(hrow + 1280 + ks * 16 + hi * 8);
#pragma unroll
            for (int e = 0; e < 8; ++e) { const float v = bf2f((unsigned short)xf[ks][e]); ss += v * v; } }
        ss += __shfl_xor(ss, 32);
        const float sc = rsqrtf(ss * (1.f / 128.f) + LN_EPS);
        const unsigned char* W = (const unsigned char*)(F.ws + WS_WUKV);
        bf16_t* KN = (bf16_t*)(F.ws + S_KN) + (size_t)tok * 512; bf16_t* V = (bf16_t*)(F.ws + S_V) + (size_t)tok * 512;
        u32x4 wv[2][4];
#pragma unroll
        for (int c = 0; c < 2; ++c) wt_load(wv[c], W + c * 128, 256u, lane);
#pragma unroll 1
        for (int nt = 0; nt < 32; ++nt) { LAS unsigned char* tl = wl + (nt & 1) * 8192;
#pragma unroll
            for (int c = 0; c < 2; ++c) wt_store(tl + c * 4096, wv[c], lane);
            if (nt + 1 < 32) {
#pragma unroll
                for (int c = 0; c < 2; ++c) wt_load(wv[c], W + (size_t)(nt + 1) * 32 * 256 + c * 128, 256u, lane); }
            f32x16 acc = {};
#pragma unroll
            for (int ks = 0; ks < 8; ++ks) acc = mfma32(wt_frag(tl + (ks >> 2) * 4096, ks & 3, lane), xf[ks], acc);
            bf16_t* o = (nt < 16) ? (KN + nt * 32) : (V + (nt - 16) * 32);
#pragma unroll
            for (int g4 = 0; g4 < 4; ++g4) store4(o + 8 * g4 + 4 * hi, acc[4 * g4] * sc, acc[4 * g4 + 1] * sc, acc[4 * g4 + 2] * sc, acc[4 * g4 + 3] * sc);
        }
        bf16_t* KR = (bf16_t*)(F.ws + S_KRB) + (size_t)tok * 32;
#pragma unroll
        for (int g2 = 0; g2 < 2; ++g2) { const int c0 = 8 * g2 + 4 * hi; const s16x4 a = *(const s16x4*)(hrow + 1408 + c0), b = *(const s16x4*)(hrow + 1408 + 16 + c0);
            float o1[4], o2[4];
#pragma unroll
            for (int e = 0; e < 4; ++e) { const float x1 = bf2f((unsigned short)a[e]), x2 = bf2f((unsigned short)b[e]); const int r = 4 * g2 + e; o1[e] = x1 * cs[r] - x2 * sn[r]; o2[e] = x1 * sn[r] + x2 * cs[r]; }
            store4(KR + c0, o1[0], o1[1], o1[2], o1[3]); store4(KR + 16 + c0, o2[0], o2[1], o2[2], o2[3]); }
    }
}

constexpr int VN_STR = 1088;
__device__ __forceinline__ void gmlp_chunk(Frame& F, int chunk, bool dry = false) {
    const int lane = F.lane, wave = F.wave, r32 = lane & 31, hi = lane >> 5;
    bf16_t* H0B = (bf16_t*)(F.ws + S_H0B);
    const float* lng = (const float*)F.in[3]; const float* lnb = (const float*)F.in[4];
    LAS unsigned char* img = F.lds + RING_OFF;
    float g8[8], b8[8];
#pragma unroll
    for (int e = 0; e < 8; ++e) { g8[e] = lng[lane * 8 + e]; b8[e] = lnb[lane * 8 + e]; }
#pragma unroll 4
    for (int i = 0; i < 16; ++i) { const int row = wave * 16 + i; const bf16x8 x = ld8g(H0B + (size_t)(chunk * 128 + row) * 1536 + 512 + lane * 8);
        float v[8]; float s = 0.f;
#pragma unroll
        for (int e = 0; e < 8; ++e) { v[e] = bf2f((unsigned short)x[e]); s += v[e]; }
        const float mean = wsum(s) * (1.f / 512.f); float q = 0.f;
#pragma unroll
        for (int e = 0; e < 8; ++e) { v[e] -= mean; q += v[e] * v[e]; }
        const float rstd = rsqrtf(wsum(q) * (1.f / 512.f) + LN_EPS);
#pragma unroll
        for (int e = 0; e < 8; ++e) v[e] = v[e] * rstd * g8[e] + b8[e];
        u32x4 w; w.x = pk(v[0], v[1]); w.y = pk(v[2], v[3]); w.z = pk(v[4], v[5]); w.w = pk(v[6], v[7]);
        *(LAS u32x4*)(img + row * VN_STR + lane * 16) = w; }
    __syncthreads();
    const int g = wave >> 1, th = wave & 1;
    const bf16_t* wsb = (const bf16_t*)(F.ws + WS_WSB) + (size_t)g * 128 * 128;
    const float* bs = (const float*)F.in[6] + g * 128;
    const int i15 = lane & 15, g1 = (lane >> 4) & 1;
#pragma unroll 1
    for (int nt = 0; nt < 2; ++nt) {
        const int t = th * 64 + nt * 32 + r32;
        const int nks = (th * 64 + nt * 32 + 31) / 16 + 1;
        bf16x8 bw[8];
#pragma unroll
        for (int ks = 0; ks < 8; ++ks) bw[ks] = ld8g(wsb + (size_t)t * 128 + ks * 16 + hi * 8);
        const float bias = bs[t];
#pragma unroll 1
        for (int ct = 0; ct < 4; ++ct) {
            const LAS unsigned char* abase = img + (8 * hi + (i15 >> 2)) * VN_STR + (g * 128 + ct * 32 + 16 * g1 + 4 * (i15 & 3)) * 2;
            f32x16 acc = {};
#pragma unroll
            for (int ks = 0; ks < 8; ++ks) { if (ks < nks) {
                const s16x4 lo = trld(abase + (16 * ks) * VN_STR), hi4 = trld(abase + (16 * ks + 4) * VN_STR);
                const bf16x8 a = {lo[0], lo[1], lo[2], lo[3], hi4[0], hi4[1], hi4[2], hi4[3]};
                acc = mfma32(a, bw[ks], acc); } }
            bf16_t* urow = H0B + (size_t)(chunk * 128 + t) * 1536 + g * 128 + ct * 32 + 4 * hi;
            bf16_t* orow = dry ? ((bf16_t*)(F.ws + WS_Z1) + (urow - H0B)) : urow;
#pragma unroll
            for (int g4 = 0; g4 < 4; ++g4) { const s16x4 uu = *(const s16x4*)(urow + 8 * g4);
                store4(orow + 8 * g4, bf2f((unsigned short)uu[0]) * (acc[4 * g4] + bias), bf2f((unsigned short)uu[1]) * (acc[4 * g4 + 1] + bias),
                       bf2f((unsigned short)uu[2]) * (acc[4 * g4 + 2] + bias), bf2f((unsigned short)uu[3]) * (acc[4 * g4 + 3] + bias)); }
        }
    }
    __syncthreads();
}

constexpr float NEGF = -1e30f;
__device__ __forceinline__ void pack_p(u32x4 (&pw)[4], const f32x16& p0, const f32x16& p1) {
    pw[0] = (u32x4){pk(p0[0], p0[1]), pk(p0[2], p0[3]), pk(p0[4], p0[5]), pk(p0[6], p0[7])}; pw[1] = (u32x4){pk(p0[8], p0[9]), pk(p0[10], p0[11]), pk(p0[12], p0[13]), pk(p0[14], p0[15])};
    pw[2] = (u32x4){pk(p1[0], p1[1]), pk(p1[2], p1[3]), pk(p1[4], p1[5]), pk(p1[6], p1[7])}; pw[3] = (u32x4){pk(p1[8], p1[9]), pk(p1[10], p1[11]), pk(p1[12], p1[13]), pk(p1[14], p1[15])};
}
struct AttnSt { f32x16 o[2]; f32x16 negm; float mref, l; int started; };
__device__ __forceinline__ void attn_reset(AttnSt& st) { st.o[0] = f32x16{}; st.o[1] = f32x16{}; st.negm = f32x16{}; st.mref = 0.f; st.l = 0.f; st.started = 0; }
constexpr int KVBUF = 20480, KV_ROPE = 8192, KV_V = 12288, NKVBUF = 4;
template <int NKS>
__device__ __forceinline__ void qk_tile(f32x16& p0, f32x16& p1, const LAS unsigned char* Kt, const bf16x8* qf, const f32x16& cinit, int lane) {
    const int r32 = lane & 31, hi = lane >> 5, sw = (r32 >> 1) & 7;
    const LAS unsigned char* kp = Kt + r32 * 128;
#pragma unroll
    for (int ks = 0; ks < NKS; ++ks) {
        bf16x8 a0, a1;
        if (ks < 4) { const int off = ((2 * ks + hi) ^ sw) << 4; a0 = *(const LAS bf16x8*)(kp + off); a1 = *(const LAS bf16x8*)(kp + 4096 + off); }
        else { const LAS unsigned char* rp = Kt + KV_ROPE + r32 * 64 + (((2 * (ks - 4) + hi) ^ ((r32 >> 2) & 3)) << 4); a0 = *(const LAS bf16x8*)rp; a1 = *(const LAS bf16x8*)(rp + 2048); }
        if (ks == 0) { p0 = mfma32(a0, qf[0], cinit); p1 = mfma32(a1, qf[0], cinit); } else { p0 = mfma32(a0, qf[ks], p0); p1 = mfma32(a1, qf[ks], p1); } }
}
__device__ __forceinline__ float max3(float a, float b, float c) { return fmaxf(fmaxf(a, b), c); }
constexpr float ATT_THR = 8.f;
template <class Mask>
__device__ __forceinline__ void softmax2(f32x16& p0, f32x16& p1, AttnSt& st, bool need_mask, const Mask& valid, bool lanebit, int lane, u32x4 (&pw)[4], f32x16& n0, f32x16& n1) {
    const int hi = lane >> 5;
    if (need_mask) {
#pragma unroll
        for (int r = 0; r < 16; ++r) { const int k0 = crow(r, hi); if (!valid(k0)) p0[r] = NEGF; if (!valid(k0 + 32)) p1[r] = NEGF; } }
    float ma = max3(p0[0], p0[1], p1[0]), mb = max3(p0[2], p0[3], p1[1]); ma = max3(ma, p1[2], p1[3]);
#pragma unroll
    for (int r = 4; r < 16; r += 4) { ma = max3(ma, p0[r], p0[r + 1]); mb = max3(mb, p0[r + 2], p0[r + 3]); ma = max3(ma, p1[r], p1[r + 1]); mb = max3(mb, p1[r + 2], p1[r + 3]); }
    float mx = fmaxf(ma, mb); mx = fmaxf(mx, __shfl_xor(mx, 32));
    if (!lanebit) mx = NEGF;
    const bool has = mx > -1e29f, fresh = has && !st.started;
    if (__any((mx > ATT_THR) || fresh)) {
        const float dl = has ? (fresh ? mx : fmaxf(mx, 0.f)) : 0.f;
        st.mref += dl; const float f = ex2(-dl); st.l *= f;
#pragma unroll
        for (int r = 0; r < 16; ++r) { p0[r] -= dl; p1[r] -= dl; n0[r] -= dl; n1[r] -= dl; st.o[0][r] *= f; st.o[1][r] *= f; st.negm[r] = -st.mref; }
        st.started |= has ? 1 : 0;
    }
    float sa = 0.f, sb = 0.f;
#pragma unroll
    for (int r = 0; r < 16; ++r) { p0[r] = ex2(p0[r]); p1[r] = ex2(p1[r]); sa += p0[r]; sb += p1[r]; }
    pack_p(pw, p0, p1);
    float sum = sa + sb;
    if (!lanebit) { sum = 0.f;
#pragma unroll
        for (int i = 0; i < 4; ++i) pw[i] = (u32x4){0u, 0u, 0u, 0u}; }
    st.l += sum;
}
__device__ __forceinline__ void pv_packed(f32x16 (&o)[2], const LAS unsigned char* Vt, const u32x4 (&pw)[4], int lane) {
    const int i15 = lane & 15, g1 = (lane >> 4) & 1, hi = lane >> 5, bsw = (i15 >> 3) & 1;
    const LAS unsigned char* vrow = Vt + (4 * hi + (i15 >> 2)) * 128 + (2 * g1 + ((i15 & 3) >> 1)) * 16 + (i15 & 1) * 8;
    const LAS unsigned char* vb0 = vrow + 64 * bsw; const LAS unsigned char* vb1 = vrow + 64 * (bsw ^ 1);
#pragma unroll
    for (int db = 0; db < 2; ++db)
#pragma unroll
        for (int s = 0; s < 4; ++s) { const LAS unsigned char* vb = db ? vb1 : vb0; const s16x4 lo = trld(vb + s * 2048), h4 = trld(vb + s * 2048 + 1024);
            const bf16x8 a = {lo[0], lo[1], lo[2], lo[3], h4[0], h4[1], h4[2], h4[3]};
            o[db] = mfma32(a, __builtin_bit_cast(bf16x8, pw[s]), o[db]); }
}
#define LDS_BAR() asm volatile("s_waitcnt lgkmcnt(0)\n\ts_barrier" ::: "memory")
__device__ __forceinline__ void glds16(const void* gsrc, unsigned lds_dst) { unsigned keep;
    asm volatile("s_mov_b32 %0, m0\n\ts_mov_b32 m0, %2\n\ts_nop 0\n\tglobal_load_lds_dwordx4 %1, off\n\ts_mov_b32 m0, %0" : "=&s"(keep) : "v"(gsrc), "s"(lds_dst) : "memory"); }
template <bool ROPE, class Src>
__device__ __forceinline__ void dma_tile(const Src& src, int j, LAS unsigned char* buf, int wave, unsigned koff, unsigned voff, unsigned roff) {
    const unsigned b = (unsigned)(size_t)buf;
    glds16(src.kbase(j) + koff, (unsigned)__builtin_amdgcn_readfirstlane(b + wave * 1024));
    glds16(src.vbase(j) + voff, (unsigned)__builtin_amdgcn_readfirstlane(b + KV_V + wave * 1024));
    if (ROPE) glds16(src.rbase(j) + roff, (unsigned)__builtin_amdgcn_readfirstlane(b + KV_ROPE + (wave & 3) * 1024));
}
#define VMW(n) asm volatile("s_waitcnt vmcnt(" #n ")" ::: "memory")
template <int NKS, class It, class Src, class Act, class Mask>
__device__ __forceinline__ void attn_loop(AttnSt& st, const bf16x8* qf, It it, const Src& src, const Act& active, const Mask& mask, LAS unsigned char* kv, int tid_, int lane_, int abl = 0) {
    const int tid = launder(tid_), lane = tid & 63, wave = __builtin_amdgcn_readfirstlane(tid >> 6); (void)lane_;
    constexpr bool ROPE = (NKS > 4);
    int jc = it.next(); if (jc < 0) return;
    unsigned koff, voff, roff;
    { const int row = wave * 8 + (lane >> 3), c = lane & 7; koff = (unsigned)row * src.kpitch + (unsigned)((c ^ ((row >> 1) & 7)) << 4); voff = (unsigned)row * src.vpitch + (unsigned)((c ^ (((row >> 1) & 1) << 2)) << 4);
      const int rr = (wave & 3) * 16 + (lane >> 2), rc = lane & 3; roff = (unsigned)rr * 64u + (unsigned)((rc ^ ((rr >> 2) & 3)) << 4); }
    int j1 = it.next(), j2 = (j1 >= 0) ? it.next() : -1, j3 = (j2 >= 0) ? it.next() : -1;
    dma_tile<ROPE>(src, jc, kv, wave, koff, voff, roff);
    if (j1 >= 0) dma_tile<ROPE>(src, j1, kv + KVBUF, wave, koff, voff, roff);
    if (j2 >= 0) dma_tile<ROPE>(src, j2, kv + 2 * KVBUF, wave, koff, voff, roff);
    if (j2 >= 0) { if (ROPE) VMW(3); else VMW(2); } else VMW(0);
    LDS_BAR();
    int bc = 0;
    f32x16 sa0, sa1, sb0, sb1;
    if (active(jc)) qk_tile<NKS>(sa0, sa1, kv, qf, st.negm, lane); else { sa0 = f32x16{}; sa1 = f32x16{}; }
#define STEP(SC0, SC1, SN0, SN1) { \
        const int bn = (bc + 1) & 3; \
        if (j3 >= 0 && !(abl & 8)) dma_tile<ROPE>(src, j3, kv + ((bc + 3) & 3) * KVBUF, wave, koff, voff, roff); \
        const bool act = active(jc); \
        __builtin_amdgcn_sched_barrier(0); \
        if (j1 >= 0 && active(j1)) { if (!(abl & 1)) qk_tile<NKS>(SN0, SN1, kv + bn * KVBUF, qf, st.negm, lane); else { SN0 = st.negm; SN1 = st.negm; } } \
        __builtin_amdgcn_sched_barrier(0); \
        u32x4 pw[4]; \
        if (act) { if (!(abl & 2)) softmax2(SC0, SC1, st, mask.need(jc), [&](int key) { return mask.valid(jc, key); }, mask.lanebit(jc), lane, pw, SN0, SN1); else pack_p(pw, SC0, SC1); __builtin_amdgcn_sched_barrier(0); \
            if (!(abl & 4)) pv_packed(st.o, kv + bc * KVBUF + KV_V, pw, lane); else st.o[0][0] += __uint_as_float(pw[0].x ^ pw[1].y ^ pw[2].z ^ pw[3].w); __builtin_amdgcn_sched_barrier(0); } \
        if (j1 < 0) break; \
          \
        if (abl & 8) VMW(0); else if (j3 >= 0) { if (ROPE) VMW(3); else VMW(2); } else VMW(0); \
        if (!(abl & 16)) LDS_BAR(); \
        jc = j1; j1 = j2; j2 = j3; j3 = (j3 >= 0) ? it.next() : -1; bc = bn; }
    for (;;) { STEP(sa0, sa1, sb0, sb1) STEP(sb0, sb1, sa0, sa1) }
#undef STEP
    LDS_BAR();
}
struct RangeIt { int j, end; __device__ __forceinline__ int next() { return (j < end) ? j++ : -1; } };
struct BitIt { unsigned m; __device__ __forceinline__ int next() { if (!m) return -1; const int j = __builtin_ctz(m); m &= m - 1; return j; } };

__device__ __forceinline__ void mla_attn_unit(Frame& F, int b, int h, int qb, int abl = 0) {
    const int lane = F.lane, wave = F.wave, r32 = lane & 31, hi = lane >> 5;
    const int q0 = qb * 256 + wave * 32, t = q0 + r32;
    const size_t rb = (size_t)b * S;
    const bf16_t* Q = (const bf16_t*)(F.ws + S_Q96) + (rb + t) * 768 + h * 96;
    const bf16_t* KN = (const bf16_t*)(F.ws + S_KN) + rb * 512 + h * 64; const bf16_t* KR = (const bf16_t*)(F.ws + S_KRB) + rb * 32; const bf16_t* V = (const bf16_t*)(F.ws + S_V) + rb * 512 + h * 64;
    bf16x8 qf[6];
#pragma unroll
    for (int ks = 0; ks < 6; ++ks) qf[ks] = ld8g(Q + ks * 16 + hi * 8);
    asm volatile("" : "+v"(qf[0]), "+v"(qf[1]), "+v"(qf[2]), "+v"(qf[3]), "+v"(qf[4]), "+v"(qf[5]));
    AttnSt st; attn_reset(st);
    struct Src { const unsigned char *KN, *KR, *V; unsigned kpitch, vpitch;
        __device__ __forceinline__ const unsigned char* kbase(int j) const { return KN + (size_t)j * 64 * 1024; }
        __device__ __forceinline__ const unsigned char* vbase(int j) const { return V + (size_t)j * 64 * 1024; }
        __device__ __forceinline__ const unsigned char* rbase(int j) const { return KR + (size_t)j * 64 * 64; } } src{(const unsigned char*)KN, (const unsigned char*)KR, (const unsigned char*)V, 1024u, 1024u};
    const int wlast = (q0 + 31) >> 6;
    struct MaskC { int t, tmin; __device__ __forceinline__ bool need(int j) const { return j * 64 + 63 > tmin; } __device__ __forceinline__ bool valid(int j, int key) const { return j * 64 + key <= t; }
        __device__ __forceinline__ bool lanebit(int) const { return true; } } mk{t, q0};
    if (!(abl & 32)) attn_loop<6>(st, qf, RangeIt{0, qb * 4 + 4}, src, [&](int j) { return j <= wlast; }, mk, F.lds + RING_OFF, F.tid, lane, abl); if (abl & 64) return;
    float l = st.l + __shfl_xor(st.l, 32); const float inv = 1.f / l;
    bf16_t* O = (bf16_t*)(F.ws + S_H0B) + (rb + t) * 1536 + 512 + h * 64 + 4 * hi;
#pragma unroll
    for (int db = 0; db < 2; ++db)
#pragma unroll
        for (int g4 = 0; g4 < 4; ++g4) store4(O + db * 32 + 8 * g4, st.o[db][4 * g4] * inv, st.o[db][4 * g4 + 1] * inv, st.o[db][4 * g4 + 2] * inv, st.o[db][4 * g4 + 3] * inv);
}

constexpr int NSA_IMP_OFF = NKVBUF * KVBUF, NSA_SEL_OFF = NSA_IMP_OFF + 8 * 32 * 33 * 4;
__device__ __forceinline__ void ob_add(u32x2 (&ob)[2][4], const f32x16 (&o)[2], float f, bool first) {
#pragma unroll
    for (int db = 0; db < 2; ++db)
#pragma unroll
        for (int g4 = 0; g4 < 4; ++g4) { float a0 = 0.f, a1 = 0.f, a2 = 0.f, a3 = 0.f;
            if (!first) { a0 = __uint_as_float(ob[db][g4].x << 16); a1 = __uint_as_float(ob[db][g4].x & 0xffff0000u); a2 = __uint_as_float(ob[db][g4].y << 16); a3 = __uint_as_float(ob[db][g4].y & 0xffff0000u); }
            ob[db][g4].x = pk(a0 + f * o[db][4 * g4], a1 + f * o[db][4 * g4 + 1]); ob[db][g4].y = pk(a2 + f * o[db][4 * g4 + 2], a3 + f * o[db][4 * g4 + 3]); }
}
__device__ __forceinline__ void nsa_unit(Frame& F, int b, int g, int tblk  , bool dry = false, int abl = 0) {
    const int lane = F.lane, wave = F.wave, tid = F.tid, r32 = lane & 31, hi = lane >> 5;
    const int t0 = tblk * 32, t = t0 + r32, tb = t0 >> 6, h = g * 8 + wave;
    const size_t rb = (size_t)b * S;
    bf16_t* H1B = (bf16_t*)(F.ws + S_H1B);
    bf16_t* qrow = H1B + (rb + t) * 2048;
    bf16x8 qf[4];
#pragma unroll
    for (int ks = 0; ks < 4; ++ks) qf[ks] = ld8g(qrow + h * 64 + ks * 16 + hi * 8);
    bf16_t* orow = (dry ? ((bf16_t*)(F.ws + WS_Z1) + (qrow - H1B)) : qrow) + h * 64 + 4 * hi;
    const float* gate_b = (const float*)F.in[19];
    float gate[3];
#pragma unroll
    for (int br = 0; br < 3; ++br) { const float x = bf2f(qrow[1792 + br * 16 + h]) + gate_b[br * 16 + h]; gate[br] = __builtin_amdgcn_rcpf(1.f + ex2(-LOG2E * x)); }
    asm volatile("" : "+v"(qf[0]), "+v"(qf[1]), "+v"(qf[2]), "+v"(qf[3]), "+v"(gate[0]), "+v"(gate[1]), "+v"(gate[2]));
    LAS unsigned char* kv = F.lds + RING_OFF;
    LAS float* impw = (LAS float*)(F.lds + NSA_IMP_OFF); LAS unsigned* selw = (LAS unsigned*)(F.lds + NSA_SEL_OFF);
    if (tid == 0) selw[32] = 0u;
    u32x2 ob[2][4];
    struct Src { const unsigned char *K, *V; unsigned kpitch, vpitch;
        __device__ __forceinline__ const unsigned char* kbase(int j) const { return K + (size_t)j * 64 * kpitch; }
        __device__ __forceinline__ const unsigned char* vbase(int j) const { return V + (size_t)j * 64 * vpitch; }
        __device__ __forceinline__ const unsigned char* rbase(int) const { return K; } };
    {
        const int tid = launder(F.tid), lane = tid & 63, r32 = lane & 31, hi = lane >> 5;
        const int nk = (t0 >> 4) + 1;
        const int ntile = (nk + 63) >> 6;
        { Src sc{(const unsigned char*)((const bf16_t*)(F.ws + S_KCMP) + (size_t)(b * 2 + g) * 128 * 64), (const unsigned char*)((const bf16_t*)(F.ws + S_VCMP) + (size_t)(b * 2 + g) * 128 * 64), 128u, 128u};
          const int row = wave * 8 + (lane >> 3), c = lane & 7; const unsigned koff = (unsigned)row * 128u + (unsigned)((c ^ ((row >> 1) & 7)) << 4), voff = (unsigned)row * 128u + (unsigned)((c ^ (((row >> 1) & 1) << 2)) << 4);
          dma_tile<false>(sc, 0, kv, wave, koff, voff, 0u); if (ntile > 1) dma_tile<false>(sc, 1, kv + KVBUF, wave, koff, voff, 0u); }
        VMW(0); LDS_BAR();
        f32x16 p[2][2]; float mx = NEGF;
#pragma unroll
        for (int tl = 0; tl < 2; ++tl) { __builtin_amdgcn_sched_barrier(0); if (tl < ntile) { qk_tile<4>(p[tl][0], p[tl][1], kv + tl * KVBUF, qf, f32x16{}, lane);
#pragma unroll
                for (int kb = 0; kb < 2; ++kb)
#pragma unroll
                    for (int r = 0; r < 16; ++r) { const int n = tl * 64 + kb * 32 + crow(r, hi); if (t < 16 * n + 31) p[tl][kb][r] = NEGF; mx = fmaxf(mx, p[tl][kb][r]); } }
            else { p[tl][0] = f32x16{}; p[tl][1] = f32x16{};
#pragma unroll
                for (int r = 0; r < 16; ++r) { p[tl][0][r] = NEGF; p[tl][1][r] = NEGF; } } }
        mx = fmaxf(mx, __shfl_xor(mx, 32));
        const float muse = (mx < -1e29f) ? 0.f : mx; float sum = 0.f;
#pragma unroll
        for (int tl = 0; tl < 2; ++tl)
#pragma unroll
            for (int kb = 0; kb < 2; ++kb)
#pragma unroll
                for (int r = 0; r < 16; ++r) { p[tl][kb][r] = ex2(p[tl][kb][r] - muse); sum += p[tl][kb][r]; }
        sum += __shfl_xor(sum, 32);
        const float inv = (sum > 0.f) ? __builtin_amdgcn_rcpf(sum) : 0.f;
#pragma unroll
        for (int tl = 0; tl < 2; ++tl)
#pragma unroll
            for (int kb = 0; kb < 2; ++kb)
#pragma unroll
                for (int r = 0; r < 16; ++r) p[tl][kb][r] *= inv;
        { float carried = 0.f;
#pragma unroll
        for (int tl = 0; tl < 2; ++tl)
#pragma unroll
            for (int kb = 0; kb < 2; ++kb)
#pragma unroll
                for (int q4 = 0; q4 < 4; ++q4) { const int m = 8 * tl + 4 * kb + q4;
                    const float Gm = (p[tl][kb][4 * q4] + p[tl][kb][4 * q4 + 1]) + (p[tl][kb][4 * q4 + 2] + p[tl][kb][4 * q4 + 3]);
                    const float other = __shfl_xor(p[tl][kb][4 * q4 + 3], 32);
                    const float prev = hi ? other : carried; carried = other;
                    impw[(wave * 32 + r32) * 33 + 2 * m + hi] = Gm + prev; } }
        __builtin_amdgcn_sched_barrier(0);
        { f32x16 oc[2] = {f32x16{}, f32x16{}}; u32x4 pwa[4], pwb[4]; pack_p(pwa, p[0][0], p[0][1]); pack_p(pwb, p[1][0], p[1][1]); __builtin_amdgcn_sched_barrier(0);
          pv_packed(oc, kv + KV_V, pwa, lane); __builtin_amdgcn_sched_barrier(0);
          if (ntile > 1) pv_packed(oc, kv + KVBUF + KV_V, pwb, lane); __builtin_amdgcn_sched_barrier(0);
          ob_add(ob, oc, gate[0], true); }
        LDS_BAR();
    }
#pragma unroll 1
    for (int ps = 0; ps < 2; ++ps) { const int lane = launder(F.tid) & 63, r32 = lane & 31, hi = lane >> 5; const int tokl = 4 * wave + 2 * ps + hi, j = r32; float a = 0.f;
#pragma unroll
        for (int w = 0; w < 8; ++w) a += impw[(w * 32 + tokl) * 33 + j];
        const bool forced = (j == 0) || (j == tb) || (j == tb - 1); const float sc = forced ? 1e4f : (j <= tb ? a : -1e4f);
        const int scb = __builtin_bit_cast(int, sc); int rank = 0;
#pragma unroll
        for (int k = 0; k < 32; ++k) { const float o0 = __builtin_bit_cast(float, __builtin_amdgcn_readlane(scb, k)), o1 = __builtin_bit_cast(float, __builtin_amdgcn_readlane(scb, 32 + k)); const float o = hi ? o1 : o0;
            rank += ((o > sc) || (o == sc && k < j)) ? 1 : 0; }
        const unsigned long long bal = __ballot(rank < 8);
        const unsigned mine = hi ? (unsigned)(bal >> 32) : (unsigned)bal;
        if (r32 == 0) { selw[tokl] = mine; __hip_atomic_fetch_or(&selw[32], mine, __ATOMIC_RELAXED, __HIP_MEMORY_SCOPE_WORKGROUP); } }
    LDS_BAR();
    const unsigned mysel = selw[r32]; const unsigned uni = selw[32] & ((tb >= 31) ? 0xffffffffu : ((2u << tb) - 1u));
    {
        AttnSt st; attn_reset(st);
        Src src{(const unsigned char*)(H1B + rb * 2048 + 1280 + g * 64), (const unsigned char*)(H1B + rb * 2048 + 1408 + g * 64), 4096u, 4096u};
        struct MaskS { int t, tb; unsigned sel; __device__ __forceinline__ bool need(int j) const { return j == tb; } __device__ __forceinline__ bool valid(int j, int key) const { return j * 64 + key <= t; }
            __device__ __forceinline__ bool lanebit(int j) const { return (sel >> j) & 1u; } } mk{t, tb, mysel};
        attn_loop<4>(st, qf, BitIt{uni}, src, [&](int) { return true; }, mk, kv, tid, lane, abl);
        const float l = st.l + __shfl_xor(st.l, 32); ob_add(ob, st.o, gate[1] * __builtin_amdgcn_rcpf(l), false);
    }
    {
        AttnSt st; attn_reset(st);
        Src src{(const unsigned char*)(H1B + rb * 2048 + 1536 + g * 64), (const unsigned char*)(H1B + rb * 2048 + 1664 + g * 64), 4096u, 4096u};
        const int jlo = (t0 - 511 > 0) ? ((t0 - 511) >> 6) : 0;
        struct MaskW { int t, tb, t0; __device__ __forceinline__ bool need(int j) const { return (j == tb) || (64 * j <= t0 + 31 - 512); }
            __device__ __forceinline__ bool valid(int j, int key) const { const int k = j * 64 + key; return (k <= t) && (k > t - 512); } __device__ __forceinline__ bool lanebit(int) const { return true; } } mk{t, tb, t0};
        attn_loop<4>(st, qf, RangeIt{jlo, tb + 1}, src, [&](int) { return true; }, mk, kv, tid, lane, abl);
        const float l = st.l + __shfl_xor(st.l, 32); ob_add(ob, st.o, gate[2] * __builtin_amdgcn_rcpf(l), false);
    }
#pragma unroll
    for (int db = 0; db < 2; ++db)
#pragma unroll
        for (int g4 = 0; g4 < 4; ++g4) *(u32x2*)(orow + db * 32 + 8 * g4) = ob[db][g4];
}

__device__ __forceinline__ void cmp_item(Frame& F, int item) {
    const int lane = F.lane, wave = F.wave, r32 = lane & 31, hi = lane >> 5;
    const int rblk = item & 63, gk = item >> 6, g = gk & 1, kvsel = gk >> 1;
    const int row = rblk * 32 + r32, b = row >> 7, n = row & 127;
    const bf16_t* H1B = (const bf16_t*)(F.ws + S_H1B);
    const int ncl = (n < 127) ? n : 126;
    const bf16_t* src = H1B + ((size_t)b * S + 16 * ncl) * 2048 + 1024 + kvsel * 128 + g * 64 + hi * 8;
    (void)src;
    const unsigned char* W1 = (const unsigned char*)(F.ws + (kvsel ? WS_WCV1 : WS_WCK1)) + (size_t)(wave * 32) * 4096;
    LAS unsigned char* wl = F.lds + RING_OFF + wave * 16384;
    const unsigned char* xrow[4];
#pragma unroll
    for (int i = 0; i < 4; ++i) { const int rr = rblk * 32 + 8 * i + (lane >> 3), bb = rr >> 7, nn = rr & 127, nc = (nn < 127) ? nn : 126;
        xrow[i] = (const unsigned char*)(H1B + ((size_t)bb * S + 16 * nc) * 2048 + 1024 + kvsel * 128 + g * 64) + (lane & 7) * 16; }
    f32x16 acc = {};
    u32x4 wv[2][4], xv[2][4];
#pragma unroll
    for (int c = 0; c < 2; ++c) { wt_load(wv[c], W1 + c * 128, 4096u, lane);
#pragma unroll
        for (int i = 0; i < 4; ++i) xv[c][i] = *(const u32x4*)(xrow[i] + (size_t)c * 4096); }
#pragma unroll 1
    for (int l0 = 0; l0 < 32; l0 += 2) {
#pragma unroll
        for (int c = 0; c < 2; ++c) { wt_store(wl + c * 4096, wv[c], lane); wt_store(wl + (2 + c) * 4096, xv[c], lane); }
        if (l0 + 2 < 32) {
#pragma unroll
            for (int c = 0; c < 2; ++c) { wt_load(wv[c], W1 + (size_t)(l0 + 2 + c) * 128, 4096u, lane);
#pragma unroll
                for (int i = 0; i < 4; ++i) xv[c][i] = *(const u32x4*)(xrow[i] + (size_t)(l0 + 2 + c) * 4096); } }
#pragma unroll
        for (int c = 0; c < 2; ++c)
#pragma unroll
            for (int q = 0; q < 4; ++q) acc = mfma32(wt_frag(wl + c * 4096, q, lane), wt_frag(wl + (2 + c) * 4096, q, lane), acc);
    }
    const float* cb = (const float*)(F.ws + WS_CBIAS) + kvsel * 256 + wave * 32;
    LAS unsigned char* hid = F.lds + RING_OFF;
    __syncthreads();
#pragma unroll
    for (int g4 = 0; g4 < 4; ++g4) { const int c = 8 * g4 + 4 * hi; u32x2 w; w.x = pk(gelu_t(acc[4 * g4] + cb[c]), gelu_t(acc[4 * g4 + 1] + cb[c + 1])); w.y = pk(gelu_t(acc[4 * g4 + 2] + cb[c + 2]), gelu_t(acc[4 * g4 + 3] + cb[c + 3]));
        *(LAS u32x2*)(hid + r32 * 528 + (wave * 32 + c) * 2) = w; }
    __syncthreads();
    if (wave < 2) {
        const bf16_t* W2 = (const bf16_t*)(F.ws + (kvsel ? WS_WCV2 : WS_WCK2)) + (size_t)(wave * 32 + r32) * 256 + hi * 8;
        f32x16 o = {};
#pragma unroll
        for (int ks = 0; ks < 16; ++ks) o = mfma32(ld8g(W2 + ks * 16), *(const LAS bf16x8*)(hid + r32 * 528 + ks * 32 + hi * 16), o);
        bf16_t* dst = (bf16_t*)(F.ws + (kvsel ? S_VCMP : S_KCMP)) + ((size_t)(b * 2 + g) * 128 + n) * 64 + wave * 32 + 4 * hi;
        const float z = (n < 127) ? 1.f : 0.f;
#pragma unroll
        for (int g4 = 0; g4 < 4; ++g4) store4(dst + 8 * g4, o[4 * g4] * z, o[4 * g4 + 1] * z, o[4 * g4 + 2] * z, o[4 * g4 + 3] * z);
    }
    __syncthreads();
}

__device__ __forceinline__ void ln_route_wg(Frame& F, int layer, int cset) {
    const int lane = F.lane, wave = F.wave, tid = F.tid, r32 = lane & 31, hi = lane >> 5;
    const int tok0 = F.vcu * 128;
    const float* Z = (const float*)(F.ws + WS_Z1);
    const float* g1 = (const float*)F.in[28] + layer * 1024; const float* b1 = (const float*)F.in[29] + layer * 1024;
    const float* wrg = (const float*)F.in[21] + (size_t)layer * 4096; const float* brg = (const float*)F.in[22] + layer * 4;
    const float* wre = (const float*)F.in[23] + (size_t)layer * 32768; const float* bre = (const float*)F.in[24] + layer * 32;
    LAS float* part = (LAS float*)(F.lds + RING_OFF);
    LAS float* glog = (LAS float*)(F.lds + LDS_SCR); LAS float* stl = (LAS float*)(F.lds + LDS_SCR + 2048);
    LAS int* lcnt = (LAS int*)(F.lds + LDS_SCR + 3072); LAS int* gbase = (LAS int*)(F.lds + LDS_SCR + 3200); LAS int* ent = (LAS int*)(F.lds + LDS_SCR + 3328);
    bf16_t* X1B = (bf16_t*)(F.ws + S_X1B); bf16_t* X1L = (bf16_t*)(F.ws + S_XP); float* stats = (float*)(F.ws + WS_STATS);
    if (tid < 32) lcnt[tid] = 0;
    {
        f32x4 gg[4], bb[4];
#pragma unroll
        for (int j = 0; j < 4; ++j) { gg[j] = *(const f32x4*)(g1 + lane * 4 + 256 * j); bb[j] = *(const f32x4*)(b1 + lane * 4 + 256 * j); }
#pragma unroll 1
        for (int i0 = 0; i0 < 16; i0 += 4) {
            f32x4 v[4][4]; float mean[4], rstd[4];
#pragma unroll
            for (int u = 0; u < 4; ++u) { const float* z = Z + (size_t)(tok0 + wave * 16 + i0 + u) * D;
#pragma unroll
                for (int j = 0; j < 4; ++j) v[u][j] = *(const f32x4*)(z + lane * 4 + 256 * j); }
#pragma unroll
            for (int u = 0; u < 4; ++u) { float s = 0.f;
#pragma unroll
                for (int j = 0; j < 4; ++j) s += (v[u][j][0] + v[u][j][1]) + (v[u][j][2] + v[u][j][3]);
                mean[u] = wsum(s) * (1.f / D); float q = 0.f;
#pragma unroll
                for (int j = 0; j < 4; ++j) { v[u][j] = v[u][j] - mean[u]; q += (v[u][j][0] * v[u][j][0] + v[u][j][1] * v[u][j][1]) + (v[u][j][2] * v[u][j][2] + v[u][j][3] * v[u][j][3]); }
                rstd[u] = rsqrtf(wsum(q) * (1.f / D) + LN_EPS); }
            f32x4 lg[4] = {f32x4{0.f, 0.f, 0.f, 0.f}, f32x4{0.f, 0.f, 0.f, 0.f}, f32x4{0.f, 0.f, 0.f, 0.f}, f32x4{0.f, 0.f, 0.f, 0.f}};
#pragma unroll
            for (int j = 0; j < 4; ++j) {
#pragma unroll
                for (int u = 0; u < 4; ++u) v[u][j] = v[u][j] * rstd[u] * gg[j] + bb[j];
#pragma unroll
                for (int e = 0; e < 4; ++e) { const f32x4 wv = *(const f32x4*)(wrg + (size_t)(lane * 4 + 256 * j + e) * 4);
#pragma unroll
                    for (int u = 0; u < 4; ++u) lg[u] += wv * v[u][j][e]; } }
#pragma unroll
            for (int u = 0; u < 4; ++u) { const int row = wave * 16 + i0 + u;
#pragma unroll
                for (int j = 0; j < 4; ++j) { const f32x4 x = v[u][j];
                    u32x2 w; w.x = pk(x[0], x[1]); w.y = pk(x[2], x[3]); *(u32x2*)(X1B + (size_t)(tok0 + row) * D + lane * 4 + 256 * j) = w;
                    u32x2 wl2; wl2.x = pk(x[0] - __uint_as_float(w.x << 16), x[1] - __uint_as_float(w.x & 0xffff0000u)); wl2.y = pk(x[2] - __uint_as_float(w.y << 16), x[3] - __uint_as_float(w.y & 0xffff0000u));
                    *(u32x2*)(X1L + (size_t)(tok0 + row) * D + lane * 4 + 256 * j) = wl2; }
                float l4[4];
#pragma unroll
                for (int e = 0; e < 4; ++e) l4[e] = wsum(lg[u][e]);
                if (lane == 0) { glog[row * 4 + 0] = l4[0] + brg[0]; glog[row * 4 + 1] = l4[1] + brg[1]; glog[row * 4 + 2] = l4[2] + brg[2]; glog[row * 4 + 3] = l4[3] + brg[3];
                    stl[row * 2] = mean[u]; stl[row * 2 + 1] = rstd[u]; stats[(size_t)(tok0 + row) * 2] = mean[u]; stats[(size_t)(tok0 + row) * 2 + 1] = rstd[u]; } }
        }
    }
    __syncthreads();
    { const int lane = launder(F.tid) & 63, r32 = lane & 31, hi = lane >> 5;
        bf16x8 wh[8], wl[8];
#pragma unroll
        for (int ks = 0; ks < 8; ++ks) { unsigned hh[4], ll[4];
#pragma unroll
            for (int e2 = 0; e2 < 4; ++e2) { float a[2], ah[2];
#pragma unroll
                for (int q = 0; q < 2; ++q) { const int k = wave * 128 + ks * 16 + hi * 8 + e2 * 2 + q; a[q] = wre[(size_t)k * 32 + r32]; }
                hh[e2] = pk(a[0], a[1]); ah[0] = __uint_as_float(hh[e2] << 16); ah[1] = __uint_as_float(hh[e2] & 0xffff0000u); ll[e2] = pk(a[0] - ah[0], a[1] - ah[1]); }
            wh[ks] = __builtin_bit_cast(bf16x8, (u32x4){hh[0], hh[1], hh[2], hh[3]}); wl[ks] = __builtin_bit_cast(bf16x8, (u32x4){ll[0], ll[1], ll[2], ll[3]}); asm volatile("" ::: "memory"); }
        for (int blk = 0; blk < 4; ++blk) { const int row = blk * 32 + r32; const size_t xo = (size_t)(tok0 + row) * D + wave * 128 + hi * 8;
            f32x16 acc = {};
#pragma unroll
            for (int ks = 0; ks < 8; ++ks) { const bf16x8 xh = ld8g(X1B + xo + ks * 16), xl = ld8g(X1L + xo + ks * 16);
                acc = mfma32(wh[ks], xh, acc); acc = mfma32(wh[ks], xl, acc); acc = mfma32(wl[ks], xh, acc); }
#pragma unroll
            for (int r = 0; r < 16; ++r) part[(wave * 128 + row) * 33 + crow(r, hi)] = acc[r];
        }
    }
    __syncthreads();
    const int tid2 = launder(F.tid);
    int e0 = 0, e1 = 0; float w0 = 0.f, w1 = 0.f; int rk0 = 0, rk1 = 0;
    if (tid2 < 128) {
        const float l0 = glog[tid2 * 4], l1 = glog[tid2 * 4 + 1], l2 = glog[tid2 * 4 + 2], l3 = glog[tid2 * 4 + 3];
        int gs = 0; float gm = l0; if (l1 > gm) { gm = l1; gs = 1; } if (l2 > gm) { gm = l2; gs = 2; } if (l3 > gm) { gm = l3; gs = 3; }
        const float gw = 1.f / (expf(l0 - gm) + expf(l1 - gm) + expf(l2 - gm) + expf(l3 - gm));
        float es[8];
#pragma unroll
        for (int n = 0; n < 8; ++n) { float a = bre[gs * 8 + n];
#pragma unroll
            for (int w = 0; w < 8; ++w) a += part[(w * 128 + tid2) * 33 + gs * 8 + n];
            es[n] = a; }
        int i0 = 0; float m0 = es[0];
#pragma unroll
        for (int n = 1; n < 8; ++n) if (es[n] > m0) { m0 = es[n]; i0 = n; }
        int i1 = 0; float m1 = -3e38f;
#pragma unroll
        for (int n = 0; n < 8; ++n) if (n != i0 && es[n] > m1) { m1 = es[n]; i1 = n; }
        const float r = expf(m1 - m0); w0 = gw / (1.f + r); w1 = gw * r / (1.f + r);
        e0 = gs * 8 + i0; e1 = gs * 8 + i1;
        rk0 = __hip_atomic_fetch_add(&lcnt[e0], 1, __ATOMIC_RELAXED, __HIP_MEMORY_SCOPE_WORKGROUP); rk1 = __hip_atomic_fetch_add(&lcnt[e1], 1, __ATOMIC_RELAXED, __HIP_MEMORY_SCOPE_WORKGROUP);
    }
    __syncthreads();
    if (tid2 < 32) gbase[tid2] = (int)__hip_atomic_fetch_add((int*)(F.ctl + CW_CNT + cset * 64) + tid2, lcnt[tid2], __ATOMIC_RELAXED, __HIP_MEMORY_SCOPE_AGENT);
    __syncthreads();
    if (tid2 < 128) {
        int* rt = (int*)(F.ws + WS_ROUTE); float* rw = (float*)(F.ws + WS_ROUTE + (size_t)T * 8);
        const int tok = tok0 + tid2;
        rt[tok * 2] = (e0 << 20) | (gbase[e0] + rk0); rt[tok * 2 + 1] = (e1 << 20) | (gbase[e1] + rk1);
        rw[tok * 2] = w0; rw[tok * 2 + 1] = w1;
    }
    __syncthreads();
}
__device__ __forceinline__ void moe_tables(Frame& F, int layer) {
    LAS int* ebase = (LAS int*)(F.lds + LDS_SCR + 4352); LAS int* pe = (LAS int*)(F.lds + LDS_SCR + 4608);
    if (F.tid == 0) { int a = 0; for (int e = 0; e < 32; ++e) { ebase[e] = a; const int c = (int)__hip_atomic_load((int*)(F.ctl + CW_CNT + layer * 64) + e, __ATOMIC_RELAXED, __HIP_MEMORY_SCOPE_AGENT); a += (c + 255) & ~255; } ebase[32] = a; }
    __syncthreads();
    for (int p = F.tid; p < MOE_PANELS; p += NTHR) { int e = 0; for (int k = 1; k < 32; ++k) if (p * 256 >= ebase[k]) e = k; pe[p] = e; }
    __syncthreads();
}
__device__ __forceinline__ void moe_gather_wg(Frame& F, int layer) {
    moe_tables(F, layer);
    LAS int* ebase = (LAS int*)(F.lds + LDS_SCR + 4352);
    const int tok0 = F.vcu * 128; int* rt = (int*)(F.ws + WS_ROUTE);
    const bf16_t* X1B = (const bf16_t*)(F.ws + S_X1B); bf16_t* XP = (bf16_t*)(F.ws + S_XP);
    for (int i = 0; i < 32; ++i) { const int ent = F.wave * 32 + i, tok = tok0 + (ent >> 1);
        const int v = rt[tok * 2 + (ent & 1)]; const int row = ebase[v >> 20] + (v & 0xfffff);
        const u32x4 a = *(const u32x4*)(X1B + (size_t)tok * D + F.lane * 8), b = *(const u32x4*)(X1B + (size_t)tok * D + 512 + F.lane * 8);
        *(u32x4*)(XP + (size_t)row * D + F.lane * 8) = a; *(u32x4*)(XP + (size_t)row * D + 512 + F.lane * 8) = b;
        if (F.lane == 0) rt[2 * T + T * 2 + tok * 2 + (ent & 1)] = row; }
}
__device__ __forceinline__ void combine_wg(Frame& F, int layer, float* xout, bf16_t* xb) {
    const int lane = F.lane, tok0 = F.vcu * 128;
    const float* Z = (const float*)(F.ws + WS_Z1); const float* stats = (const float*)(F.ws + WS_STATS);
    const int* rt = (const int*)(F.ws + WS_ROUTE); const float* rw = (const float*)(F.ws + WS_ROUTE + (size_t)T * 8);
    const bf16_t* YP = (const bf16_t*)(F.ws + S_YP);
    const float* g1 = (const float*)F.in[28] + layer * 1024; const float* b1 = (const float*)F.in[29] + layer * 1024;
    const float* g2 = (const float*)F.in[30] + layer * 1024; const float* b2 = (const float*)F.in[31] + layer * 1024;
    f32x4 G1[4], B1[4], G2[4], B2[4];
#pragma unroll
    for (int j = 0; j < 4; ++j) { const int c = lane * 4 + 256 * j; G1[j] = *(const f32x4*)(g1 + c); B1[j] = *(const f32x4*)(b1 + c); G2[j] = *(const f32x4*)(g2 + c); B2[j] = *(const f32x4*)(b2 + c); }
#pragma unroll 1
    for (int i0 = 0; i0 < 16; i0 += 4) {
        f32x4 z[4][4]; s16x4 ya[4][4], yb[4][4]; float mean[4], rstd[4], w0[4], w1[4];
#pragma unroll
        for (int u = 0; u < 4; ++u) { const int tok = tok0 + F.wave * 16 + i0 + u;
            mean[u] = stats[(size_t)tok * 2]; rstd[u] = stats[(size_t)tok * 2 + 1]; w0[u] = rw[tok * 2]; w1[u] = rw[tok * 2 + 1];
            const bf16_t* y0 = YP + (size_t)rt[4 * T + tok * 2] * D; const bf16_t* y1 = YP + (size_t)rt[4 * T + tok * 2 + 1] * D;
#pragma unroll
            for (int j = 0; j < 4; ++j) { const int c = lane * 4 + 256 * j; z[u][j] = *(const f32x4*)(Z + (size_t)tok * D + c); ya[u][j] = *(const s16x4*)(y0 + c); yb[u][j] = *(const s16x4*)(y1 + c); } }
        float s[4], q[4];
#pragma unroll
        for (int u = 0; u < 4; ++u) { s[u] = 0.f;
#pragma unroll
            for (int j = 0; j < 4; ++j) { const f32x4 x1 = (z[u][j] - mean[u]) * rstd[u] * G1[j] + B1[j]; f32x4 f;
#pragma unroll
                for (int e = 0; e < 4; ++e) f[e] = w0[u] * bf2f((unsigned short)ya[u][j][e]) + w1[u] * bf2f((unsigned short)yb[u][j][e]);
                z[u][j] = x1 * ALPHA + f; s[u] += (z[u][j][0] + z[u][j][1]) + (z[u][j][2] + z[u][j][3]); } }
#pragma unroll
        for (int u = 0; u < 4; ++u) { const float m2 = wsum(s[u]) * (1.f / D); q[u] = 0.f;
#pragma unroll
            for (int j = 0; j < 4; ++j) { z[u][j] = z[u][j] - m2; q[u] += (z[u][j][0] * z[u][j][0] + z[u][j][1] * z[u][j][1]) + (z[u][j][2] * z[u][j][2] + z[u][j][3] * z[u][j][3]); } }
#pragma unroll
        for (int u = 0; u < 4; ++u) { const int tok = tok0 + F.wave * 16 + i0 + u; const float r2 = rsqrtf(wsum(q[u]) * (1.f / D) + LN_EPS);
#pragma unroll
            for (int j = 0; j < 4; ++j) { const int c = lane * 4 + 256 * j; const f32x4 o = z[u][j] * r2 * G2[j] + B2[j];
                *(f32x4*)(xout + (size_t)tok * D + c) = o;
                if (xb) { u32x2 w; w.x = pk(o[0], o[1]); w.y = pk(o[2], o[3]); *(u32x2*)(xb + (size_t)tok * D + c) = w; } } }
    }
}
constexpr int NPHASE = 19;
__global__ void __launch_bounds__(NTHR, 2) mega(Args args) {
    extern __shared__ __attribute__((aligned(16))) unsigned char lds_[];
#define PHASE_FRAME() Frame F; { int t_ = (int)threadIdx.x; asm volatile("" : "+v"(t_)); GAS unsigned char* wg_ = (GAS unsigned char*)args.ws; asm volatile("" : "+s"(wg_)); unsigned char* w_ = (unsigned char*)wg_; int bx_ = (int)blockIdx.x; asm volatile("" : "+s"(bx_)); \
        F.lds = (LAS unsigned char*)lds_; F.ws = w_; F.ctl = (gu32*)(w_ + WS_CTL); F.in = args.in; F.out = args.out; F.tid = t_; F.lane = t_ & 63; F.wave = __builtin_amdgcn_readfirstlane(t_ >> 6); \
        F.G = (int)gridDim.x; F.vcu = (F.G % 8 == 0) ? (bx_ % 8) * (F.G / 8) + bx_ / 8 : bx_; } unsigned char* ws = F.ws; LAS unsigned char* ring = F.lds + RING_OFF; (void)ws; (void)ring
    Frame F0; { F0.lds = (LAS unsigned char*)lds_; F0.ws = args.ws; F0.ctl = (gu32*)(args.ws + WS_CTL); F0.tid = threadIdx.x; }
    volatile LAS unsigned* MISC = (volatile LAS unsigned*)(F0.lds + LDS_MISC);
    if (F0.tid < 64) MISC[F0.tid] = 0u;
    __syncthreads();
    const int lo = args.ph_lo, hi = args.ph_hi;
    const bool one = (hi - lo) > 1;
    XcdBarrier bar; bar.bar = (unsigned*)(F0.ctl + CW_BAR); bar.x = 0; bar.st = nullptr;
    if (one) bar = xcd_barrier_post((unsigned*)(F0.ctl + CW_BAR), MISC + 8);
#ifndef PH_MASK
#define PH_MASK 0xFFFFFFFFu
#endif
#define IN(k) ((((PH_MASK) >> (k)) & 1u) && lo <= (k) && (k) < hi)
#ifndef ABL
#define ABL 0
#endif
#ifndef DUP_PHASE
#define DUP_PHASE -1
#endif
#define REP(k) for (int rep = ((k) == DUP_PHASE ? 0 : 1); rep < 2; ++rep)
#define REPSYNC() do { if (rep == 0) xcd_barrier(bar); } while (0)
#define SEAM(k) do { if (IN(k) && IN((k) + 1)) xcd_barrier(bar); } while (0)

    if (IN(0)) REP(0) { PHASE_FRAME(); const bool dry = (rep == 0); (void)dry; p0_prologue(F); REPSYNC(); } SEAM(0);
    if (IN(1)) REP(1) { PHASE_FRAME(); const bool dry = (rep == 0); (void)dry; Gemm g{(const bf16_t*)(ws + S_XB), (const bf16_t*)(ws + WS_W0IN), T, 1536, 1024, 1024}; pg8::StaticOrder So; So.init(T, 1536, F.G, (int)blockIdx.x);
        EpiTile E{(bf16_t*)(ws + S_H0B), 1536, 4, 0, 1.f, 0};
        pg8::gemm_phase<EpiTile, pg8::StaticOrder, true, true>(ring, g, So, E); REPSYNC(); } SEAM(1);
    if (IN(2)) REP(2) { PHASE_FRAME(); const bool dry = (rep == 0); (void)dry; for (int it = F.vcu * NWAVES + F.wave; it < 2048; it += F.G * NWAVES) mla_up_item(F, it);
        __syncthreads();
        for (int ch = F.vcu; ch < 256; ch += F.G) gmlp_chunk(F, ch, dry); REPSYNC(); } SEAM(2);
    if (IN(3)) REP(3) { PHASE_FRAME(); const bool dry = (rep == 0); (void)dry; for (int c = F.vcu; c < 256; c += F.G) { const int bh = c >> 1;
#pragma unroll 1
            for (int i = 0; i < 4; ++i) { const int qb = (c & 1) ? ((i == 0) ? 6 : (i == 1) ? 1 : (i == 2) ? 5 : 2) : ((i == 0) ? 7 : (i == 1) ? 0 : (i == 2) ? 4 : 3); mla_attn_unit(F, bh >> 3, bh & 7, qb, dry ? ABL : 0); } } REPSYNC(); } SEAM(3);
    if (IN(4)) REP(4) { PHASE_FRAME(); const bool dry = (rep == 0); (void)dry; Gemm g{(const bf16_t*)(ws + S_H0B), (const bf16_t*)(ws + WS_W0O), T, 1024, 1024, 1536}; pg8::StaticOrder So; So.init(T, 1024, F.G, (int)blockIdx.x);
        EpiResid E{(const float*)args.in[0], (float*)(ws + WS_Z1)};
        pg8::gemm_phase<EpiResid, pg8::StaticOrder, true, true>(ring, g, So, E); REPSYNC(); } SEAM(4);
#pragma unroll
    for (int layer = 0; layer < 2; ++layer) {
        const int pb = layer ? 14 : 5;
        if (IN(pb)) REP(pb) { PHASE_FRAME(); const bool dry = (rep == 0); (void)dry; for (int c = F.vcu; c < 256; c += F.G) { Frame F2 = F; F2.vcu = c; ln_route_wg(F2, layer, dry ? 2 + layer : layer); } REPSYNC(); } SEAM(pb);
        if (IN(pb + 1)) REP(pb + 1) { PHASE_FRAME(); const bool dry = (rep == 0); (void)dry; for (int c = F.vcu; c < 256; c += F.G) { Frame F2 = F; F2.vcu = c; moe_gather_wg(F2, layer); } REPSYNC(); } SEAM(pb + 1);
        if (IN(pb + 2)) REP(pb + 2) { PHASE_FRAME(); const bool dry = (rep == 0); (void)dry; moe_tables(F, layer); const LAS int* eb = (const LAS int*)(F.lds + LDS_SCR + 4352);
            Gemm g{(const bf16_t*)(ws + S_XP), (const bf16_t*)(ws + WS_WGU) + (size_t)layer * 32 * 512 * 1024, MOE_ROWS, 512, 1024, 1024};
            MoeOrder<2> So{(const LAS int*)(F.lds + LDS_SCR + 4608), (eb[32] >> 8) * 2, F.G, F.vcu}; EpiMoeUp E{(bf16_t*)(ws + S_HP)};
            pg8::gemm_phase<EpiMoeUp, MoeOrder<2>, true, true>(ring, g, So, E); REPSYNC(); } SEAM(pb + 2);
        if (IN(pb + 3)) REP(pb + 3) { PHASE_FRAME(); const bool dry = (rep == 0); (void)dry; moe_tables(F, layer); const LAS int* eb = (const LAS int*)(F.lds + LDS_SCR + 4352);
            Gemm g{(const bf16_t*)(ws + S_HP), (const bf16_t*)(ws + WS_WD) + (size_t)layer * 32 * 1024 * 256, MOE_ROWS, 1024, 256, 256};
            MoeOrder<4> So{(const LAS int*)(F.lds + LDS_SCR + 4608), (eb[32] >> 8) * 4, F.G, F.vcu}; EpiMoeDown E{(bf16_t*)(ws + S_YP)};
            pg8::gemm_phase<EpiMoeDown, MoeOrder<4>, false, true>(ring, g, So, E); REPSYNC(); } SEAM(pb + 3);
        if (IN(pb + 4)) REP(pb + 4) { PHASE_FRAME(); const bool dry = (rep == 0); (void)dry; for (int c = F.vcu; c < 256; c += F.G) { Frame F2 = F; F2.vcu = c; combine_wg(F2, layer, args.out, layer ? nullptr : (bf16_t*)(ws + S_X2B)); } REPSYNC(); }
        if (layer == 0) {
            SEAM(9);
            if (IN(10)) REP(10) { PHASE_FRAME(); const bool dry = (rep == 0); (void)dry; Gemm g{(const bf16_t*)(ws + S_X2B), (const bf16_t*)(ws + WS_W1IN), T, 2048, 1024, 1024}; pg8::StaticOrder So; So.init(T, 2048, F.G, (int)blockIdx.x);
                EpiTile E{(bf16_t*)(ws + S_H1B), 2048, 0, 4, QS_NSA, 0};
                pg8::gemm_phase<EpiTile, pg8::StaticOrder, true, true>(ring, g, So, E); REPSYNC(); } SEAM(10);
            if (IN(11)) REP(11) { PHASE_FRAME(); const bool dry = (rep == 0); (void)dry; for (int it = F.vcu; it < 256; it += F.G) cmp_item(F, it); REPSYNC(); } SEAM(11);
            if (IN(12)) REP(12) { PHASE_FRAME(); const bool dry = (rep == 0); (void)dry; for (int c = F.vcu; c < 256; c += F.G) { const int bg = c >> 3, s = c & 7;
#pragma unroll 1
                    for (int i = 0; i < 8; ++i) { const int k = i >> 1; const int blk = (k == 0) ? 31 - s : (k == 1) ? 16 + s : (k == 2) ? 15 - s : s; nsa_unit(F, bg >> 1, bg & 1, blk * 2 + (i & 1), dry, dry ? ABL : 0); } } REPSYNC(); } SEAM(12);
            if (IN(13)) REP(13) { PHASE_FRAME(); const bool dry = (rep == 0); (void)dry; Gemm g{(const bf16_t*)(ws + S_H1B), (const bf16_t*)(ws + WS_W1O), T, 1024, 1024, 2048}; pg8::StaticOrder So; So.init(T, 1024, F.G, (int)blockIdx.x);
                EpiResid E{(const float*)args.out, (float*)(ws + WS_Z1)};
                pg8::gemm_phase<EpiResid, pg8::StaticOrder, true, true>(ring, g, So, E); REPSYNC(); } SEAM(13);
        }
    }
#undef IN
#undef SEAM
}

#ifndef MK_SPLIT
#define MK_SPLIT 0
#endif
static void launch_all(void* const* d_in, float* out, unsigned char* ws, hipStream_t stream) {
    static int grid = 0;
    if (grid == 0) {
        int dev = 0, cus = 0, per_cu = 0;
        if (hipGetDevice(&dev) != hipSuccess || hipDeviceGetAttribute(&cus, hipDeviceAttributeMultiprocessorCount, dev) != hipSuccess) { grid = -1; return; }
        if (hipFuncSetAttribute((const void*)mega, hipFuncAttributeMaxDynamicSharedMemorySize, LDS_BYTES) != hipSuccess) { fprintf(stderr, "kernel_launch: hipFuncSetAttribute failed\n"); grid = -1; return; }
        if (hipOccupancyMaxActiveBlocksPerMultiprocessor(&per_cu, (const void*)mega, NTHR, LDS_BYTES) != hipSuccess || per_cu < 1) fprintf(stderr, "kernel_launch: occupancy query says %d\n", per_cu);
        (void)hipGetLastError();
        grid = cus < 256 ? cus : 256;
    }
    if (grid < 0) return;
    (void)hipMemsetAsync(ws + WS_CTL, 0, CTL_ZERO_BYTES, stream);
    Args a{};
    for (int i = 0; i < 32; ++i) a.in[i] = d_in[i];
    a.out = out; a.ws = ws;
#if MK_SPLIT
    for (int p = 0; p < NPHASE; ++p) { a.ph_lo = p; a.ph_hi = p + 1; hipLaunchKernelGGL(mega, dim3(grid), dim3(NTHR), LDS_BYTES, stream, a); }
#else
    a.ph_lo = 0; a.ph_hi = NPHASE; hipLaunchKernelGGL(mega, dim3(grid), dim3(NTHR), LDS_BYTES, stream, a);
#endif
}
}

extern "C" void kernel_launch(void* const* d_in, const int* in_sizes, int n_in, void* d_out, int out_size, void* d_ws, size_t ws_size, hipStream_t stream) {
    fk::launch_all(d_in, (float*)d_out, (unsigned char*)d_ws, stream);
}
```

```cpp
#include <hip/hip_runtime.h>
#include <stdint.h>
#include <math.h>
#include <cstdio>
namespace pg8 {
#define PG8_LAS __attribute__((address_space(3)))
typedef unsigned short bf16_t;
typedef short bf16x8 __attribute__((ext_vector_type(8)));
typedef float f32x4 __attribute__((ext_vector_type(4)));
typedef unsigned u32x4 __attribute__((ext_vector_type(4)));
constexpr int BM = 256, BK = 64, HALF = 128, HTB = HALF * BK * 2  , STAGE_BYTES = 8 * HTB, NXCD = 8, WGM = 8;

__host__ __device__ __forceinline__ int lds_byte(int r, int c) { const int st = (r >> 4) * 2 + (c >> 5), rr = r & 15, cc = c & 31, ob = rr * 64 + cc * 2; return st * 1024 + (ob ^ (((ob >> 9) & 1) << 5)); }
__host__ __device__ __forceinline__ void stage_rc(int b, int& R, int& C) { const int st = b / 1024, sb = b % 1024, swz = sb ^ (((sb >> 9) & 1) << 5); R = (st >> 1) * 16 + swz / 64; C = (st & 1) * 32 + (swz % 64) / 2; }
__host__ __device__ __forceinline__ int perm32(int rho) { const int n = rho >> 4, i = rho & 15; return 8 * (i >> 2) + 4 * n + (i & 3); }

struct Unit { int pm, pn; };
struct Gemm { const bf16_t* A; const bf16_t* Bt; int M, N, K, lda; const int* rowsrc; };

struct StaticOrder {
    int nM, nN, nwg, G, c;
    __host__ __device__ void init(int M, int N, int G_, int c_) { nM = M / BM; nN = N / BM; nwg = nM * nN; G = G_; c = c_; }
    __host__ __device__ bool next(int i, Unit& u) const {
        const long L = (long)i * G + c; if (L >= nwg) return false;
        int wgid = (int)L; { const int q = nwg / NXCD, r = nwg % NXCD, xcd = wgid % NXCD, off = wgid / NXCD; wgid = (xcd < r ? xcd * (q + 1) : r * (q + 1) + (xcd - r) * q) + off; }
        const int nig = WGM * nN, gid = wgid / nig, fm = gid * WGM, gsz = (nM - fm) < WGM ? (nM - fm) : WGM;
        u.pm = fm + ((wgid % nig) % gsz); u.pn = (wgid % nig) / gsz; return true;
    }
    __device__ __forceinline__ void a_ready(const Unit&) const {}
    __device__ __forceinline__ void done(const Unit&) const {}
};

__device__ __forceinline__ unsigned cvt_pk_bf16(float lo, float hi) { unsigned r; asm volatile("v_cvt_pk_bf16_f32 %0, %1, %2" : "=v"(r) : "v"(lo), "v"(hi)); return r; }
typedef float f32x2 __attribute__((ext_vector_type(2)));
template <class Epi, class Sched, bool ALIGN_EPI = false, bool SP2 = false, bool GATHER = false>
__device__ __forceinline__ void gemm_phase(PG8_LAS unsigned char* lds, const Gemm g, const Sched& S, const Epi& E) {
    int tid_l = (int)threadIdx.x; asm volatile("" : "+v"(tid_l));
    const int tid = tid_l, wid = __builtin_amdgcn_readfirstlane(tid >> 6), lane = tid & 63, wr = wid >> 2, wc = wid & 3, fr = lane & 15, fq = lane >> 4;
    const int K = g.K, nt = K / BK;
    unsigned voffA[2], voffB[2], voffA1[2] = {0u, 0u}, nvoffA[2] = {0u, 0u}, nvoffA1[2] = {0u, 0u}; int RA[2], CA[2];
#pragma unroll
    for (int i = 0; i < 2; ++i) { int R, C; stage_rc(tid * 16 + i * 8192, R, C); const int Rb = Epi::PERM ? ((R & ~31) + perm32(R & 31)) : R;
        voffA[i] = (unsigned)(R * g.lda + C) * 2u; voffB[i] = (unsigned)(Rb * K + C) * 2u; RA[i] = R; CA[i] = C; }
    const size_t kstep = (size_t)(BK * 2);
    const size_t hstepA = (size_t)HALF * g.lda * 2, hstepB = (size_t)HALF * K * 2;
    const size_t tstepA = 2 * hstepA, tstepB = 2 * hstepB;
    const unsigned ldsw = (unsigned)wid * 1024u;
    const int aoff = lds_byte(wr * 64 + fr, fq * 8), boff = lds_byte(wc * 32 + fr, fq * 8);
#define PG8_SA(b, h) (((b) * 2 + (h)) * HTB)
#define PG8_SB(b, h) ((4 + (b) * 2 + (h)) * HTB)
#define PG8_STAGE(bufoff, gbase, voff) do { _Pragma("unroll") for (int _i = 0; _i < 2; ++_i) \
        __builtin_amdgcn_global_load_lds((const unsigned*)((const char*)(gbase) + (voff)[_i]), (PG8_LAS unsigned*)(lds + (bufoff) + ldsw + _i * 8192), 16, 0, 0); } while (0)
#define PG8_GSET(u, v0, v1) do { _Pragma("unroll") for (int _i = 0; _i < 2; ++_i) { v0[_i] = (unsigned)(g.rowsrc[(u).pm * BM + RA[_i]] * g.lda + CA[_i]) * 2u; v1[_i] = (unsigned)(g.rowsrc[(u).pm * BM + HALF + RA[_i]] * g.lda + CA[_i]) * 2u; } } while (0)
#define PG8_STA0(slot, P, NX) do { if constexpr (GATHER) { if (NX) PG8_STAGE(slot, P, nvoffA); else PG8_STAGE(slot, P, voffA); } else PG8_STAGE(slot, P, voffA); } while (0)
#define PG8_STA1(slot, P, NX) do { if constexpr (GATHER) { if (NX) PG8_STAGE(slot, P, nvoffA1); else PG8_STAGE(slot, P, voffA1); } else PG8_STAGE(slot, (P) + hstepA, voffA); } while (0)
#define PG8_LDA(dst, b, h) do { _Pragma("unroll") for (int m = 0; m < 4; ++m) _Pragma("unroll") for (int k = 0; k < 2; ++k) dst[m][k] = *(const PG8_LAS bf16x8*)(lds + PG8_SA(b, h) + aoff + m * 2048 + k * 1024); } while (0)
#define PG8_LDB(dst, b, h) do { _Pragma("unroll") for (int n = 0; n < 2; ++n) _Pragma("unroll") for (int k = 0; k < 2; ++k) dst[n][k] = *(const PG8_LAS bf16x8*)(lds + PG8_SB(b, h) + boff + n * 2048 + k * 1024); } while (0)
#define PG8_MMA(ai, bj, At, Bt) do { __builtin_amdgcn_s_setprio(1); _Pragma("unroll") for (int m = 0; m < 4; ++m) _Pragma("unroll") for (int n = 0; n < 2; ++n) _Pragma("unroll") for (int k = 0; k < 2; ++k) \
        acc[ai][bj][m][n] = __builtin_amdgcn_mfma_f32_16x16x32_bf16(Bt[n][k], At[m][k], acc[ai][bj][m][n], 0, 0, 0); __builtin_amdgcn_s_setprio(0); } while (0)
#define PG8_WAIT_V(n) asm volatile("s_waitcnt vmcnt(" #n ")" ::: "memory")
#define PG8_WAIT_L(n) asm volatile("s_waitcnt lgkmcnt(" #n ")" ::: "memory")
#define PG8_BAR __builtin_amdgcn_s_barrier()
#define PG8_SCHED __builtin_amdgcn_sched_barrier(0)
    Unit cur, nxt; int ui = 0;
    if (!S.next(0, cur)) return;
    f32x4 acc[2][2][4][2];
#pragma unroll
    for (int a = 0; a < 2; ++a)
#pragma unroll
        for (int b = 0; b < 2; ++b)
#pragma unroll
            for (int m = 0; m < 4; ++m)
#pragma unroll
                for (int n = 0; n < 2; ++n) acc[a][b][m][n] = (f32x4){0.f, 0.f, 0.f, 0.f};
    bf16x8 At[4][2], B0[2][2], B1[2][2];
    const char* cA = GATHER ? (const char*)g.A : (const char*)g.A + (size_t)cur.pm * tstepA; if constexpr (GATHER) PG8_GSET(cur, voffA, voffA1);
    const char* cB = (const char*)g.Bt + (size_t)cur.pn * tstepB;
    S.a_ready(cur);
    if constexpr (SP2) {
        PG8_STAGE(PG8_SB(0, 0), cB, voffB); PG8_STAGE(PG8_SB(0, 1), cB + hstepB, voffB); PG8_STA0(PG8_SA(0, 0), cA, false); PG8_STA1(PG8_SA(0, 1), cA, false);
        if (wr == 1) PG8_BAR;
        PG8_WAIT_V(2); PG8_BAR;
        PG8_STAGE(PG8_SB(1, 0), cB + kstep, voffB); PG8_STA0(PG8_SA(1, 0), cA + kstep, false); PG8_STAGE(PG8_SB(1, 1), cB + hstepB + kstep, voffB);
        PG8_WAIT_V(6); PG8_BAR;
    } else {
        PG8_STAGE(PG8_SB(0, 0), cB, voffB); PG8_STA0(PG8_SA(0, 0), cA, false); PG8_STAGE(PG8_SB(0, 1), cB + hstepB, voffB); PG8_STA1(PG8_SA(0, 1), cA, false);
        if (wr == 1) PG8_BAR;
        PG8_WAIT_V(4); PG8_BAR;
        PG8_STAGE(PG8_SB(1, 0), cB + kstep, voffB); PG8_STA0(PG8_SA(1, 0), cA + kstep, false); PG8_STAGE(PG8_SB(1, 1), cB + hstepB + kstep, voffB);
        PG8_WAIT_V(6); PG8_BAR;
    }
    for (;;) {
        const bool has_next = S.next(ui + 1, nxt);
        const char* nA = has_next ? (GATHER ? (const char*)g.A : (const char*)g.A + (size_t)nxt.pm * tstepA) : cA; if constexpr (GATHER) { if (has_next) PG8_GSET(nxt, nvoffA, nvoffA1); } const char* nB = has_next ? (const char*)g.Bt + (size_t)nxt.pn * tstepB : cB;
        for (int t = 0; t < nt; t += 2) {
            const bool last = (t == nt - 2);
            const char* a1 = cA + (size_t)(t + 1) * kstep;
            const char* a2 = last ? nA : cA + (size_t)(t + 2) * kstep; const char* b2 = last ? nB : cB + (size_t)(t + 2) * kstep;
            const char* a3 = a2 + kstep; const char* b3 = b2 + kstep;
            if (last && has_next) S.a_ready(nxt);
            if constexpr (SP2) {
            PG8_LDB(B0, 0, 0); PG8_LDB(B1, 0, 1); PG8_SCHED; PG8_LDA(At, 0, 0); PG8_STA1(PG8_SA(1, 1), a1, false);
            PG8_WAIT_V(8); PG8_WAIT_L(0); PG8_BAR; PG8_MMA(0, 0, At, B0); PG8_MMA(0, 1, At, B1); PG8_BAR; PG8_SCHED;
            PG8_LDA(At, 0, 1); PG8_STAGE(PG8_SB(0, 0), b2, voffB); PG8_STAGE(PG8_SB(0, 1), b2 + hstepB, voffB); PG8_STA0(PG8_SA(0, 0), a2, last && has_next);
            PG8_WAIT_V(8); PG8_WAIT_L(0); PG8_BAR; PG8_MMA(1, 0, At, B0); PG8_MMA(1, 1, At, B1); PG8_BAR; PG8_SCHED;
            PG8_LDB(B0, 1, 0); PG8_LDB(B1, 1, 1); PG8_SCHED; PG8_LDA(At, 1, 0); PG8_STA1(PG8_SA(0, 1), a2, last && has_next);
            PG8_WAIT_V(8); PG8_WAIT_L(0); PG8_BAR; PG8_MMA(0, 0, At, B0); PG8_MMA(0, 1, At, B1); PG8_BAR; PG8_SCHED;
            PG8_LDA(At, 1, 1); PG8_STAGE(PG8_SB(1, 0), b3, voffB); PG8_STAGE(PG8_SB(1, 1), b3 + hstepB, voffB); PG8_STA0(PG8_SA(1, 0), a3, last && has_next);
            PG8_WAIT_V(8); PG8_WAIT_L(0); PG8_BAR; PG8_MMA(1, 0, At, B0); PG8_MMA(1, 1, At, B1); PG8_BAR; PG8_SCHED;
            } else {
            PG8_LDB(B0, 0, 0); PG8_SCHED; PG8_LDA(At, 0, 0); PG8_STA1(PG8_SA(1, 1), a1, false);
            PG8_WAIT_L(8); PG8_BAR; PG8_WAIT_L(0); PG8_MMA(0, 0, At, B0); PG8_BAR; PG8_SCHED;
            PG8_LDB(B1, 0, 1); PG8_STAGE(PG8_SB(0, 0), b2, voffB);
            PG8_BAR; PG8_WAIT_L(0); PG8_MMA(0, 1, At, B1); PG8_BAR;
            PG8_LDA(At, 0, 1); PG8_STA0(PG8_SA(0, 0), a2, last && has_next);
            PG8_BAR; PG8_WAIT_L(0); PG8_MMA(1, 0, At, B0); PG8_BAR; PG8_SCHED;
            PG8_STAGE(PG8_SB(0, 1), b2 + hstepB, voffB);
            PG8_WAIT_V(6); PG8_BAR; PG8_MMA(1, 1, At, B1); PG8_BAR;
            PG8_LDB(B0, 1, 0); PG8_SCHED; PG8_LDA(At, 1, 0); PG8_STA1(PG8_SA(0, 1), a2, last && has_next);
            PG8_WAIT_L(8); PG8_BAR; PG8_WAIT_L(0); PG8_MMA(0, 0, At, B0); PG8_BAR; PG8_SCHED;
            PG8_LDB(B1, 1, 1); PG8_STAGE(PG8_SB(1, 0), b3, voffB);
            PG8_BAR; PG8_WAIT_L(0); PG8_MMA(0, 1, At, B1); PG8_BAR;
            PG8_LDA(At, 1, 1); PG8_STA0(PG8_SA(1, 0), a3, last && has_next);
            PG8_BAR; PG8_WAIT_L(0); PG8_MMA(1, 0, At, B0); PG8_BAR; PG8_SCHED;
            PG8_STAGE(PG8_SB(1, 1), b3 + hstepB, voffB);
            PG8_WAIT_V(6); PG8_BAR; PG8_MMA(1, 1, At, B1); PG8_BAR;
            }
        }
        if constexpr (ALIGN_EPI) { if (wr == 0) PG8_BAR; }
        if constexpr (!Epi::AFTER_DRAIN) { E(acc, cur, wr, wc, fr, fq); S.done(cur); }
        if (!has_next) break;
#pragma unroll
        for (int a = 0; a < 2; ++a)
#pragma unroll
            for (int b = 0; b < 2; ++b)
#pragma unroll
                for (int m = 0; m < 4; ++m)
#pragma unroll
                    for (int n = 0; n < 2; ++n) acc[a][b][m][n] = (f32x4){0.f, 0.f, 0.f, 0.f};
        cur = nxt; cA = nA; cB = nB; ++ui;
        if constexpr (GATHER) { voffA[0] = nvoffA[0]; voffA[1] = nvoffA[1]; voffA1[0] = nvoffA1[0]; voffA1[1] = nvoffA1[1]; }
        if constexpr (ALIGN_EPI) { if (wr == 1) PG8_BAR; }
    }
    PG8_WAIT_V(0);
    if constexpr (!ALIGN_EPI) { if (wr == 0) PG8_BAR; }
    PG8_BAR;
    if constexpr (Epi::AFTER_DRAIN) { E.fused(acc, cur, wr, wc, fr, fq, lds, wid, lane); S.done(cur); }
#undef PG8_SA
#undef PG8_SB
#undef PG8_STAGE
#undef PG8_GSET
#undef PG8_STA0
#undef PG8_STA1
#undef PG8_LDA
#undef PG8_LDB
#undef PG8_MMA
#undef PG8_WAIT_V
#undef PG8_WAIT_L
#undef PG8_BAR
#undef PG8_SCHED
}
}
#define GAS __attribute__((address_space(1)))
#define LAS __attribute__((address_space(3)))
typedef unsigned short bf16;
typedef unsigned v4u __attribute__((ext_vector_type(4)));
typedef float f32x4 __attribute__((ext_vector_type(4)));
typedef short bf16x8 __attribute__((ext_vector_type(8)));
typedef GAS unsigned gu32;
typedef GAS unsigned long long gu64;
#define RLX_AGENT __ATOMIC_RELAXED, __HIP_MEMORY_SCOPE_AGENT
#define LDS_WAIT() asm volatile("s_waitcnt lgkmcnt(0)" ::: "memory")
#define VM_WAIT() asm volatile("s_waitcnt vmcnt(0)" ::: "memory")
__device__ __forceinline__ unsigned long long rt() { return __builtin_amdgcn_s_memrealtime(); }
__device__ __forceinline__ unsigned f2bf(float f) { unsigned u = __builtin_bit_cast(unsigned, f); return (u + 0x7fffu + ((u >> 16) & 1u)) >> 16; }
__device__ __forceinline__ unsigned pk2(float lo, float hi) { return f2bf(lo) | (f2bf(hi) << 16); }

#define XB_TMO      128
#define XB_XCNT(j)  (256  + 64 * (j))
#define XB_XSUB(j)  (1280 + 64 * (j))
#define XB_XGEN(j)  (2304 + 64 * (j))
#define XB_TOP      3328
#define XB_TOPGEN   3392
#define XCD_BAR_WORDS 3456
#define XB_SPIN_CAP (1u << 18)

__device__ __forceinline__ unsigned xb_ld(unsigned* p)              { return __hip_atomic_load(p, __ATOMIC_RELAXED, __HIP_MEMORY_SCOPE_AGENT); }
__device__ __forceinline__ unsigned xb_add(unsigned* p, unsigned v) { return __hip_atomic_fetch_add(p, v, __ATOMIC_RELAXED, __HIP_MEMORY_SCOPE_AGENT); }
__device__ __forceinline__ unsigned xb_xcc_id() { return (unsigned)__builtin_amdgcn_s_getreg((3 << 11) | 20) & 0xFu; }
#define XB_SPIN(cond, bar) do { unsigned _sp = 0; while (cond) { __builtin_amdgcn_s_sleep(1); \
    if ((++_sp & 255u) == 0u) { if (xb_ld(&(bar)[XB_TMO])) break; if (_sp > XB_SPIN_CAP) { atomicAdd(&(bar)[XB_TMO], 1u); break; } } } } while (0)

struct XcdBarrier {
    unsigned* bar; unsigned x;
    volatile LAS unsigned* st;
};

__device__ __forceinline__ XcdBarrier xcd_barrier_post(unsigned* bar, volatile LAS unsigned* st) {
    XcdBarrier b; b.bar = bar; b.x = xb_xcc_id(); b.st = st;
    if (threadIdx.x == 0) (void)xb_add(&bar[XB_XCNT(b.x)], 1u);
    return b;
}
__device__ __forceinline__ void xcd_barrier_complete(unsigned* bar, unsigned x, unsigned& nloc, unsigned& nx) {
    const unsigned G = gridDim.x * gridDim.y * gridDim.z;
    unsigned sum, cnt, mine, sp = 0u;
    for (;;) {
        sum = 0u; cnt = 0u; mine = 0u;
#pragma unroll
        for (unsigned j = 0; j < 16; ++j) { const unsigned c = xb_ld(&bar[XB_XCNT(j)]); sum += c; cnt += (c > 0u) ? 1u : 0u; mine = (j == x) ? c : mine; }
        if (sum == G) break;
        __builtin_amdgcn_s_sleep(1);
        if ((++sp & 255u) == 0u) { if (xb_ld(&bar[XB_TMO])) break; if (sp > XB_SPIN_CAP) { atomicAdd(&bar[XB_TMO], 1u); break; } }
    }
    nloc = mine > 0u ? mine : 1u; nx = cnt > 0u ? cnt : 1u;
}

__device__ __forceinline__ void xcd_barrier(const XcdBarrier& b) {
    asm volatile("s_waitcnt vmcnt(0)" ::: "memory");
    __syncthreads();
    if (threadIdx.x == 0) {
        unsigned* bar = b.bar;
        __builtin_amdgcn_s_waitcnt(0);
        unsigned nloc = b.st[0], nx = b.st[1];
        if (nloc == 0u) { xcd_barrier_complete(bar, b.x, nloc, nx); b.st[0] = nloc; b.st[1] = nx; }
        const unsigned old = xb_add(&bar[XB_XSUB(b.x)], 1u);
        const unsigned gen = old / nloc;
        if (old + 1u == (gen + 1u) * nloc) {
            __builtin_amdgcn_fence(__ATOMIC_RELEASE, "agent");
            asm volatile("s_waitcnt vmcnt(0)" ::: "memory");
            const unsigned og = xb_add(&bar[XB_TOP], 1u);
            const unsigned tg = og / nx;
            if (og + 1u == (tg + 1u) * nx) xb_add(&bar[XB_TOPGEN], 1u);
            else XB_SPIN(xb_ld(&bar[XB_TOPGEN]) == tg, bar);
            __builtin_amdgcn_fence(__ATOMIC_ACQUIRE, "agent");
            xb_add(&bar[XB_XGEN(b.x)], 1u);
            asm volatile("s_waitcnt vmcnt(0)" ::: "memory");
        } else {
            XB_SPIN(xb_ld(&bar[XB_XGEN(b.x)]) == gen, bar);
            __builtin_amdgcn_fence(__ATOMIC_ACQUIRE, "agent");
            asm volatile("s_waitcnt vmcnt(0)" ::: "memory");
        }
    }
    __syncthreads();
}
namespace fk {
using pg8::bf16_t; using pg8::f32x4; using pg8::u32x4; using pg8::Unit; using pg8::Gemm;
typedef float f32x16 __attribute__((ext_vector_type(16)));
typedef float f32x2 __attribute__((ext_vector_type(2)));
typedef unsigned u32x2 __attribute__((ext_vector_type(2)));
typedef short s16x4 __attribute__((ext_vector_type(4)));
constexpr int NB = 16, S = 2048, D = 1024, T = NB * S;
constexpr float ALPHA = 1.41421356237309515f, LN_EPS = 1e-5f, LOG2E = 1.4426950408889634f;
constexpr float QS_MLA = 0.10206207261596575f * LOG2E;
constexpr float QS_NSA = 0.125f * LOG2E;
constexpr int NWAVES = 8, NTHR = 512;
constexpr int MOE_ROWS = 73728, MOE_PANELS = MOE_ROWS / 256;

constexpr size_t MiB = 1u << 20;
constexpr size_t WS_CTL = 0, CTL_ZERO_BYTES = 1 * MiB;
constexpr size_t WS_W0IN = 1 * MiB, WS_WUQ = 4 * MiB, WS_WUKV = WS_WUQ + 512 * 1024, WS_W0O = 5 * MiB, WS_W1IN = 7 * MiB, WS_WCK1 = 11 * MiB, WS_WCV1 = 12 * MiB,
                 WS_WCK2 = 13 * MiB, WS_WCV2 = 13 * MiB + 64 * 1024, WS_WSB = 13 * MiB + 128 * 1024, WS_CBIAS = 13 * MiB + 512 * 1024, WS_W1O = 14 * MiB, WS_WGU = 16 * MiB, WS_WD = 80 * MiB;
constexpr size_t WS_Z1 = 113 * MiB;
constexpr size_t WS_STATS = 241 * MiB;
constexpr size_t WS_ROUTE = WS_STATS + 256 * 1024;
constexpr size_t WS_S = 242 * MiB;
constexpr size_t S_XB = WS_S, S_H0B = WS_S + 64 * MiB, S_Q96 = WS_S, S_KN = WS_S + 160 * MiB, S_V = WS_S + 192 * MiB, S_KRB = WS_S + 224 * MiB;
constexpr size_t S_X1B = WS_S, S_XP = WS_S + 64 * MiB, S_HP = WS_S + 208 * MiB, S_YP = WS_S, S_X2B = WS_S + 144 * MiB;
constexpr size_t S_H1B = WS_S, S_KCMP = WS_S + 208 * MiB, S_VCMP = S_KCMP + 1 * MiB;
constexpr size_t WS_END = WS_S + 244 * MiB;
static_assert(WS_END <= 512 * MiB, "workspace map");
constexpr int CW_BAR = 4096, CW_CNT = 16384  , CW_ROWSRC = 32768  ;
static_assert((CW_ROWSRC + 2 * 73728) * 4 <= (int)CTL_ZERO_BYTES, "control words inside the per-call memset");

constexpr int RING_OFF = 0, LDS_MISC = 139264, LDS_SCR = LDS_MISC + 256, LDS_BYTES = 163840;

struct Args { const void* in[32]; float* out; unsigned char* ws; int ph_lo, ph_hi; };

__device__ __forceinline__ float bf2f(unsigned short b) { return __uint_as_float((unsigned)b << 16); }
__device__ __forceinline__ unsigned pk(float lo, float hi) { return pg8::cvt_pk_bf16(lo, hi); }
template <int CTRL> __device__ __forceinline__ float dppf(float v) { return __builtin_bit_cast(float, __builtin_amdgcn_update_dpp(0, __builtin_bit_cast(int, v), CTRL, 0xf, 0xf, true)); }
__device__ __forceinline__ float wsum(float v) {
    v += dppf<0xB1>(v); v += dppf<0x4E>(v); v += dppf<0x141>(v); v += dppf<0x140>(v);
    const int b = __builtin_bit_cast(int, v);
    return (__builtin_bit_cast(float, __builtin_amdgcn_readlane(b, 0)) + __builtin_bit_cast(float, __builtin_amdgcn_readlane(b, 16))) + (__builtin_bit_cast(float, __builtin_amdgcn_readlane(b, 32)) + __builtin_bit_cast(float, __builtin_amdgcn_readlane(b, 48)));
}
__device__ __forceinline__ int launder(int x) { asm volatile("" : "+v"(x)); return x; }
__device__ __forceinline__ float ex2(float x) { return __builtin_amdgcn_exp2f(x); }
__device__ __forceinline__ float gelu_t(float x) {
    const float u = 0.7978845608028654f * (x + 0.044715f * x * x * x);
    return x * __builtin_amdgcn_rcpf(1.f + ex2(-2.f * LOG2E * u));
}
__device__ __forceinline__ int crow(int r, int hi) { return (r & 3) + 8 * (r >> 2) + 4 * hi; }
__device__ __forceinline__ f32x16 mfma32(bf16x8 a, bf16x8 b, f32x16 c) { return __builtin_amdgcn_mfma_f32_32x32x16_bf16(a, b, c, 0, 0, 0); }
__device__ __forceinline__ bf16x8 ld8g(const bf16_t* p) { return *(const bf16x8*)p; }
typedef short v4i16_t __attribute__((ext_vector_type(4)));
__device__ __forceinline__ s16x4 trld(const LAS unsigned char* p) { return __builtin_bit_cast(s16x4, __builtin_amdgcn_ds_read_tr16_b64_v4i16((LAS v4i16_t*)p)); }

struct Frame {
    LAS unsigned char* lds; gu32* ctl; unsigned char* ws;
    int tid, lane, wave, vcu, G;
    const void* const* in; float* out;
};

struct EpiTile {
    static constexpr bool PERM = true, AFTER_DRAIN = false;
    bf16_t* O; int ldc; int ngelu; int nscale; float scale; int pad;
    __device__ __forceinline__ void operator()(const f32x4 (&acc)[2][2][4][2], const Unit& u, int wr, int wc, int fr, int fq) const {
        const int row0 = u.pm * 256 + wr * 64 + fr, col0 = u.pn * 256 + wc * 32 + 8 * fq;
        const bool dg = u.pn < ngelu; const float sc = (u.pn < nscale) ? scale : 1.f;
#pragma unroll
        for (int ai = 0; ai < 2; ++ai)
#pragma unroll
            for (int m = 0; m < 4; ++m) { bf16_t* rowp = O + (size_t)(row0 + ai * 128 + m * 16) * ldc + col0;
#pragma unroll
                for (int bj = 0; bj < 2; ++bj) { f32x4 v0 = acc[ai][bj][m][0], v1 = acc[ai][bj][m][1];
                    if (dg) { v0 = (f32x4){gelu_t(v0[0]), gelu_t(v0[1]), gelu_t(v0[2]), gelu_t(v0[3])}; v1 = (f32x4){gelu_t(v1[0]), gelu_t(v1[1]), gelu_t(v1[2]), gelu_t(v1[3])}; }
                    v0 = v0 * sc; v1 = v1 * sc;
                    u32x4 w; w.x = pk(v0[0], v0[1]); w.y = pk(v0[2], v0[3]); w.z = pk(v1[0], v1[1]); w.w = pk(v1[2], v1[3]);
                    *(u32x4*)(rowp + bj * 128) = w; } }
    }
};
struct EpiResid {
    static constexpr bool PERM = false, AFTER_DRAIN = false;
    const float* X; float* Z;
    __device__ __forceinline__ void operator()(const f32x4 (&acc)[2][2][4][2], const Unit& u, int wr, int wc, int fr, int fq) const {
        const int col0 = u.pn * 256 + wc * 32 + 4 * fq;
#pragma unroll
        for (int ai = 0; ai < 2; ++ai)
#pragma unroll
            for (int m = 0; m < 4; ++m) { const size_t off = (size_t)(u.pm * 256 + ai * 128 + wr * 64 + m * 16 + fr) * D + col0;
#pragma unroll
                for (int bj = 0; bj < 2; ++bj)
#pragma unroll
                    for (int n = 0; n < 2; ++n) { const f32x4 x = *(const f32x4*)(X + off + bj * 128 + n * 16); *(f32x4*)(Z + off + bj * 128 + n * 16) = x * ALPHA + acc[ai][bj][m][n]; } }
    }
};
struct EpiMoeUp {
    static constexpr bool PERM = true, AFTER_DRAIN = false;
    bf16_t* H;
    __device__ __forceinline__ void operator()(const f32x4 (&acc)[2][2][4][2], const Unit& u, int wr, int wc, int fr, int fq) const {
        const int row0 = u.pm * 256 + wr * 64 + fr, col0 = (u.pn & 1) * 128 + wc * 16 + 4 * fq;
#pragma unroll
        for (int ai = 0; ai < 2; ++ai)
#pragma unroll
            for (int m = 0; m < 4; ++m) { bf16_t* rowp = H + (size_t)(row0 + ai * 128 + m * 16) * 256 + col0;
#pragma unroll
                for (int bj = 0; bj < 2; ++bj) { const f32x4 g = acc[ai][bj][m][0], up = acc[ai][bj][m][1]; f32x4 h;
#pragma unroll
                    for (int e = 0; e < 4; ++e) h[e] = g[e] * __builtin_amdgcn_rcpf(1.f + ex2(-LOG2E * g[e])) * up[e];
                    u32x2 w; w.x = pk(h[0], h[1]); w.y = pk(h[2], h[3]); *(u32x2*)(rowp + bj * 64) = w; } }
    }
};
struct EpiMoeDown {
    static constexpr bool PERM = true, AFTER_DRAIN = false;
    bf16_t* Y;
    __device__ __forceinline__ void operator()(const f32x4 (&acc)[2][2][4][2], const Unit& u, int wr, int wc, int fr, int fq) const {
        const int row0 = u.pm * 256 + wr * 64 + fr, col0 = (u.pn & 3) * 256 + wc * 32 + 8 * fq;
#pragma unroll
        for (int ai = 0; ai < 2; ++ai)
#pragma unroll
            for (int m = 0; m < 4; ++m) { bf16_t* rowp = Y + (size_t)(row0 + ai * 128 + m * 16) * D + col0;
#pragma unroll
                for (int bj = 0; bj < 2; ++bj) { const f32x4 v0 = acc[ai][bj][m][0], v1 = acc[ai][bj][m][1];
                    u32x4 w; w.x = pk(v0[0], v0[1]); w.y = pk(v0[2], v0[3]); w.z = pk(v1[0], v1[1]); w.w = pk(v1[2], v1[3]);
                    *(u32x4*)(rowp + bj * 128) = w; } }
    }
};
template <int NC> struct MoeOrder {
    const LAS int* pe; int nunits, G, c;
    __device__ __forceinline__ bool next(int i, Unit& u) const { const int L = i * G + c; if (L >= nunits) return false; const int p = L / NC; u.pm = p; u.pn = pe[p] * NC + (L % NC); return true; }
    __device__ __forceinline__ void a_ready(const Unit&) const {}
    __device__ __forceinline__ void done(const Unit&) const {}
};

__device__ __forceinline__ void p0_item(const float* W, int ldw, int K, int N, bf16_t* WT, int rmode, int row_off, const float* kscale, LAS float* scr, int item, int lane) {
    const int nblk = (N + 31) / 32, kb = item / nblk, nb = item % nblk, k0 = 64 * kb, n0 = 32 * nb;
    const int nn = n0 + (lane & 31);
    float wv[32];
#pragma unroll
    for (int i = 0; i < 32; ++i) { const int kk = 2 * i + (lane >> 5); wv[i] = (nn < N) ? W[(size_t)(k0 + kk) * ldw + nn] : 0.f; }
#pragma unroll
    for (int i = 0; i < 32; ++i) { const int kk = 2 * i + (lane >> 5); float v = wv[i]; if (kscale) v *= kscale[k0 + kk]; scr[kk * 33 + (lane & 31)] = v; }
    LDS_WAIT(); asm volatile("" ::: "memory");
    const int c = lane & 7;
#pragma unroll
    for (int j = 0; j < 4; ++j) { const int n = (lane >> 3) + 8 * j; const LAS float* s = scr + (8 * c) * 33 + n;
        v4u o; o.x = pk(s[0 * 33], s[1 * 33]); o.y = pk(s[2 * 33], s[3 * 33]); o.z = pk(s[4 * 33], s[5 * 33]); o.w = pk(s[6 * 33], s[7 * 33]);
        const int ng = n0 + n; const int r = (rmode == 0) ? row_off + ng : (row_off + (ng >> 2) * 8 + (rmode == 2 ? 4 : 0) + (ng & 3));
        *(GAS v4u*)(WT + (size_t)r * K + k0 + 8 * c) = o; }
    LDS_WAIT(); asm volatile("" ::: "memory");
}
struct ConvJob { const float* W; int ldw, K, N; bf16_t* WT; int rmode, row_off; const float* kscale; int nitems; };

__device__ __forceinline__ void p0_prologue(Frame& F) {
    LAS float* scr = (LAS float*)(F.lds + RING_OFF + F.wave * 16384);
    const int gw = F.vcu * NWAVES + F.wave, NGW = F.G * NWAVES;
    unsigned char* ws = F.ws;
    {
        const float* in2 = (const float*)F.in[2];
#define JOB(Wp, ldw_, K_, N_, dst, rm, ro, ks) { const int nit = ((K_) / 64) * (((N_) + 31) / 32); if (it < nit) { p0_item((const float*)(Wp), ldw_, K_, N_, (bf16_t*)(dst), rm, ro, ks, scr, it, F.lane); continue; } it -= nit; }
        constexpr int TOT = 16 * 45 + 4 * 24 + 2 * 16 + 2 * 16 + 16 * 32 + 16 * 58 + 32 * 8 * 2 + 4 * 2 * 2 + 16 * 32;
        for (int it0 = gw; it0 < TOT; it0 += NGW) { int it = it0;
            JOB(in2, 1440, 1024, 1440, ws + WS_W0IN, 0, 0, nullptr)
            JOB(F.in[9], 768, 256, 768, ws + WS_WUQ, 0, 0, (const float*)F.in[7])
            JOB(F.in[10], 512, 128, 512, ws + WS_WUKV, 0, 0, (const float*)F.in[8])
            JOB(F.in[11], 512, 128, 512, ws + WS_WUKV, 0, 512, (const float*)F.in[8])
            JOB(F.in[12], 1024, 1024, 1024, ws + WS_W0O, 0, 0, nullptr)
            JOB(F.in[13], 1840, 1024, 1840, ws + WS_W1IN, 0, 0, nullptr)
            JOB(F.in[15], 256, 2048, 256, ws + WS_WCK1, 0, 0, nullptr)
            JOB(F.in[17], 256, 2048, 256, ws + WS_WCV1, 0, 0, nullptr)
            JOB(F.in[16], 64, 256, 64, ws + WS_WCK2, 0, 0, nullptr)
            JOB(F.in[18], 64, 256, 64, ws + WS_WCV2, 0, 0, nullptr)
            JOB(F.in[20], 1024, 1024, 1024, ws + WS_W1O, 0, 0, nullptr)
        }
#undef JOB
    }
    {
        constexpr int IG = 16 * 8, ID = 4 * 32, PER = 2 * IG + ID;
        for (int it0 = gw; it0 < 64 * PER; it0 += NGW) { const int le = it0 / PER; int it = it0 % PER;
            bf16_t* gu = (bf16_t*)(ws + WS_WGU) + (size_t)le * 512 * 1024; bf16_t* wd = (bf16_t*)(ws + WS_WD) + (size_t)le * 1024 * 256;
            if (it < IG) { p0_item((const float*)F.in[25] + (size_t)le * 1024 * 256, 256, 1024, 256, gu, 1, 0, nullptr, scr, it, F.lane); continue; } it -= IG;
            if (it < IG) { p0_item((const float*)F.in[26] + (size_t)le * 1024 * 256, 256, 1024, 256, gu, 2, 0, nullptr, scr, it, F.lane); continue; } it -= IG;
            p0_item((const float*)F.in[27] + (size_t)le * 256 * 1024, 1024, 256, 1024, wd, 0, 0, nullptr, scr, it, F.lane);
        }
    }
    const int gt = F.vcu * NTHR + F.tid, NGT = F.G * NTHR;
    { v4u z = {0u, 0u, 0u, 0u};
      for (int i = gt; i < 96 * 128; i += NGT) *(GAS v4u*)((bf16_t*)(ws + WS_W0IN) + (size_t)1440 * 1024 + (size_t)i * 8) = z;
      for (int i = gt; i < 192 * 128; i += NGT) *(GAS v4u*)((bf16_t*)(ws + WS_W1IN) + (size_t)1856 * 1024 + (size_t)i * 8) = z; }
    { const float* gws = (const float*)F.in[5]; bf16_t* wsb = (bf16_t*)(ws + WS_WSB);
      for (int i = gt; i < 4 * 128 * 128; i += NGT) { const int s = i & 127, t = (i >> 7) & 127; wsb[i] = (bf16_t)(pk(s <= t ? gws[i] : 0.f, 0.f) & 0xffffu); } }
    {
      float* cb = (float*)(ws + WS_CBIAS);
      for (int o = gw; o < 512; o += NGW) { const int kv = o >> 8, h = o & 255; const float* pos = (const float*)F.in[14] + kv * 2048; const float* w1 = (const float*)F.in[kv ? 17 : 15];
          float a = 0.f; for (int k = F.lane; k < 2048; k += 64) a += pos[k] * w1[(size_t)k * 256 + h];
          a = wsum(a); if (F.lane == 0) cb[o] = a; } }
    { const float* x = (const float*)F.in[0]; bf16_t* xb = (bf16_t*)(ws + S_XB);
#pragma unroll 4
      for (int i = gt; i < T * D / 8; i += NGT) { const f32x4 a = *(const GAS f32x4*)(x + (size_t)i * 8), b = *(const GAS f32x4*)(x + (size_t)i * 8 + 4);
          v4u o; o.x = pk(a[0], a[1]); o.y = pk(a[2], a[3]); o.z = pk(b[0], b[1]); o.w = pk(b[2], b[3]); *(GAS v4u*)(xb + (size_t)i * 8) = o; } }
}

__device__ __forceinline__ void wt_load(u32x4 (&v)[4], const unsigned char* base, unsigned pitch, int lane) {
#pragma unroll
    for (int i = 0; i < 4; ++i) v[i] = *(const u32x4*)(base + (size_t)(8 * i + (lane >> 3)) * pitch + (lane & 7) * 16);
}
__device__ __forceinline__ void wt_store(LAS unsigned char* t, const u32x4 (&v)[4], int lane) {
#pragma unroll
    for (int i = 0; i < 4; ++i) { const int row = 8 * i + (lane >> 3); *(LAS u32x4*)(t + row * 128 + (((lane & 7) ^ ((row >> 1) & 7)) << 4)) = v[i]; }
}
__device__ __forceinline__ bf16x8 wt_frag(const LAS unsigned char* t, int ks, int lane) { const int r32 = lane & 31; return *(const LAS bf16x8*)(t + r32 * 128 + (((2 * ks + (lane >> 5)) ^ ((r32 >> 1) & 7)) << 4)); }

__device__ __forceinline__ void store4(bf16_t* p, float a, float b, float c, float d) { u32x2 w; w.x = pk(a, b); w.y = pk(c, d); *(u32x2*)p = w; }
__device__ __forceinline__ void mla_up_item(Frame& F, int item) {
    const int lane = F.lane, r32 = lane & 31, hi = lane >> 5, part = item & 1, tok = (item >> 1) * 32 + r32;
    const bf16_t* hrow = (const bf16_t*)(F.ws + S_H0B) + (size_t)tok * 1536;
    const float p = (float)((const int*)F.in[1])[tok];
    LAS unsigned char* wl = F.lds + RING_OFF + F.wave * 16384;
    float cs[8], sn[8];
#pragma unroll
    for (int r = 0; r < 8; ++r) { const int j = crow(r, hi); const float fr = expf(-9.210340371976184f * (float)j * (1.f / 16.f)); const float ang = p * fr; cs[r] = cosf(ang); sn[r] = sinf(ang); }
    if (part == 0) {
        bf16x8 xf[16]; float ss = 0.f;
#pragma unroll
        for (int ks = 0; ks < 16; ++ks) { xf[ks] = ld8g(hrow + 1024 + ks * 16 + hi * 8);
#pragma unroll
            for (int e = 0; e < 8; ++e) { const float v = bf2f((unsigned short)xf[ks][e]); ss += v * v; } }
        ss += __shfl_xor(ss, 32);
        const float sc = rsqrtf(ss * (1.f / 256.f) + LN_EPS) * QS_MLA;
        const unsigned char* W = (const unsigned char*)(F.ws + WS_WUQ); bf16_t* Q = (bf16_t*)(F.ws + S_Q96) + (size_t)tok * 768;
        u32x4 wv[2][4];
#pragma unroll
        for (int c = 0; c < 2; ++c) wt_load(wv[c], W + c * 128, 512u, lane);
#pragma unroll 1
        for (int nt = 0; nt < 24; ++nt) {
            f32x16 acc = {};
#pragma unroll
            for (int h = 0; h < 2; ++h) {
#pragma unroll
                for (int c = 0; c < 2; ++c) wt_store(wl + (2 * h + c) * 4096, wv[c], lane);
                { const int nn = h ? nt + 1 : nt, hh = h ^ 1; if (nn < 24) {
#pragma unroll
                    for (int c = 0; c < 2; ++c) wt_load(wv[c], W + (size_t)nn * 32 * 512 + (2 * hh + c) * 128, 512u, lane); } }
#pragma unroll
                for (int ks = 0; ks < 8; ++ks) acc = mfma32(wt_frag(wl + (2 * h + (ks >> 2)) * 4096, ks & 3, lane), xf[8 * h + ks], acc);
            }
#pragma unroll
            for (int r = 0; r < 16; ++r) acc[r] *= sc;
            if (nt % 3 == 2) {
#pragma unroll
                for (int r = 0; r < 8; ++r) { const float x1 = acc[r], x2 = acc[r + 8]; acc[r] = x1 * cs[r] - x2 * sn[r]; acc[r + 8] = x1 * sn[r] + x2 * cs[r]; } }
#pragma unroll
            for (int g4 = 0; g4 < 4; ++g4) store4(Q + nt * 32 + 8 * g4 + 4 * hi, acc[4 * g4], acc[4 * g4 + 1], acc[4 * g4 + 2], acc[4 * g4 + 3]);
        }
    } else {
        bf16x8 xf[8]; float ss = 0.f;
#pragma unroll
        for (int ks = 0; ks < 8; ++ks) { xf[ks] = ld8g(hrow + 1280 + ks * 16 + hi * 8);
#pragma unroll
            for (int e = 0; e < 8; ++e) { const float v = bf2f((unsigned short)xf[ks][e]); ss += v * v; } }
        ss += __shfl_xor(ss, 32);
        const float sc = rsqrtf(ss * (1.f / 128.f) + LN_EPS);
        const unsigned char* W = (const unsigned char*)(F.ws + WS_WUKV);
        bf16_t* KN = (bf16_t*)(F.ws + S_KN) + (size_t)tok * 512; bf16_t* V = (bf16_t*)(F.ws + S_V) + (size_t)tok * 512;
        u32x4 wv[2][4];
#pragma unroll
        for (int c = 0; c < 2; ++c) wt_load(wv[c], W + c * 128, 256u, lane);
#pragma unroll 1
        for (int nt = 0; nt < 32; ++nt) { LAS unsigned char* tl = wl + (nt & 1) * 8192;
#pragma unroll
            for (int c = 0; c < 2; ++c) wt_store(tl + c * 4096, wv[c], lane);
            if (nt + 1 < 32) {
#pragma unroll
                for (int c = 0; c < 2; ++c) wt_load(wv[c], W + (size_t)(nt + 1) * 32 * 256 + c * 128, 256u, lane); }
            f32x16 acc = {};
#pragma unroll
            for (int ks = 0; ks < 8; ++ks) acc = mfma32(wt_frag(tl + (ks >> 2) * 4096, ks & 3, lane), xf[ks], acc);
            bf16_t* o = (nt < 16) ? (KN + nt * 32) : (V + (nt - 16) * 32);
#pragma unroll
            for (int g4 = 0; g4 < 4; ++g4) store4(o + 8 * g4 + 4 * hi, acc[4 * g4] * sc, acc[4 * g4 + 1] * sc, acc[4 * g4 + 2] * sc, acc[4 * g4 + 3] * sc);
        }
        bf16_t* KR = (bf16_t*)(F.ws + S_KRB) + (size_t)tok * 32;
#pragma unroll
        for (int g2 = 0; g2 < 2; ++g2) { const int c0 = 8 * g2 + 4 * hi; const s16x4 a = *(const s16x4*)(hrow + 1408 + c0), b = *(const s16x4*)(hrow + 1408 + 16 + c0);
            float o1[4], o2[4];
#pragma unroll
            for (int e = 0; e < 4; ++e) { const float x1 = bf2f((unsigned short)a[e]), x2 = bf2f((unsigned short)b[e]); const int r = 4 * g2 + e; o1[e] = x1 * cs[r] - x2 * sn[r]; o2[e] = x1 * sn[r] + x2 * cs[r]; }
            store4(KR + c0, o1[0], o1[1], o1[2], o1[3]); store4(KR + 16 + c0, o2[0], o2[1], o2[2], o2[3]); }
    }
}

constexpr int VN_STR = 1088;
__device__ __forceinline__ void gmlp_chunk(Frame& F, int chunk, bool dry = false) {
    const int lane = F.lane, wave = F.wave, r32 = lane & 31, hi = lane >> 5;
    bf16_t* H0B = (bf16_t*)(F.ws + S_H0B);
    const float* lng = (const float*)F.in[3]; const float* lnb = (const float*)F.in[4];
    LAS unsigned char* img = F.lds + RING_OFF;
    float g8[8], b8[8];
#pragma unroll
    for (int e = 0; e < 8; ++e) { g8[e] = lng[lane * 8 + e]; b8[e] = lnb[lane * 8 + e]; }
#pragma unroll 4
    for (int i = 0; i < 16; ++i) { const int row = wave * 16 + i; const bf16x8 x = ld8g(H0B + (size_t)(chunk * 128 + row) * 1536 + 512 + lane * 8);
        float v[8]; float s = 0.f;
#pragma unroll
        for (int e = 0; e < 8; ++e) { v[e] = bf2f((unsigned short)x[e]); s += v[e]; }
        const float mean = wsum(s) * (1.f / 512.f); float q = 0.f;
#pragma unroll
        for (int e = 0; e < 8; ++e) { v[e] -= mean; q += v[e] * v[e]; }
        const float rstd = rsqrtf(wsum(q) * (1.f / 512.f) + LN_EPS);
#pragma unroll
        for (int e = 0; e < 8; ++e) v[e] = v[e] * rstd * g8[e] + b8[e];
        u32x4 w; w.x = pk(v[0], v[1]); w.y = pk(v[2], v[3]); w.z = pk(v[4], v[5]); w.w = pk(v[6], v[7]);
        *(LAS u32x4*)(img + row * VN_STR + lane * 16) = w; }
    __syncthreads();
    const int g = wave >> 1, th = wave & 1;
    const bf16_t* wsb = (const bf16_t*)(F.ws + WS_WSB) + (size_t)g * 128 * 128;
    const float* bs = (const float*)F.in[6] + g * 128;
    const int i15 = lane & 15, g1 = (lane >> 4) & 1;
#pragma unroll 1
    for (int nt = 0; nt < 2; ++nt) {
        const int t = th * 64 + nt * 32 + r32;
        const int nks = (th * 64 + nt * 32 + 31) / 16 + 1;
        bf16x8 bw[8];
#pragma unroll
        for (int ks = 0; ks < 8; ++ks) bw[ks] = ld8g(wsb + (size_t)t * 128 + ks * 16 + hi * 8);
        const float bias = bs[t];
#pragma unroll 1
        for (int ct = 0; ct < 4; ++ct) {
            const LAS unsigned char* abase = img + (8 * hi + (i15 >> 2)) * VN_STR + (g * 128 + ct * 32 + 16 * g1 + 4 * (i15 & 3)) * 2;
            f32x16 acc = {};
#pragma unroll
            for (int ks = 0; ks < 8; ++ks) { if (ks < nks) {
                const s16x4 lo = trld(abase + (16 * ks) * VN_STR), hi4 = trld(abase + (16 * ks + 4) * VN_STR);
                const bf16x8 a = {lo[0], lo[1], lo[2], lo[3], hi4[0], hi4[1], hi4[2], hi4[3]};
                acc = mfma32(a, bw[ks], acc); } }
            bf16_t* urow = H0B + (size_t)(chunk * 128 + t) * 1536 + g * 128 + ct * 32 + 4 * hi;
            bf16_t* orow = dry ? ((bf16_t*)(F.ws + WS_Z1) + (urow - H0B)) : urow;
#pragma unroll
            for (int g4 = 0; g4 < 4; ++g4) { const s16x4 uu = *(const s16x4*)(urow + 8 * g4);
                store4(orow + 8 * g4, bf2f((unsigned short)uu[0]) * (acc[4 * g4] + bias), bf2f((unsigned short)uu[1]) * (acc[4 * g4 + 1] + bias),
                       bf2f((unsigned short)uu[2]) * (acc[4 * g4 + 2] + bias), bf2f((unsigned short)uu[3]) * (acc[4 * g4 + 3] + bias)); }
        }
    }
    __syncthreads();
}

constexpr float NEGF = -1e30f;
__device__ __forceinline__ void pack_p(u32x4 (&pw)[4], const f32x16& p0, const f32x16& p1) {
    pw[0] = (u32x4){pk(p0[0], p0[1]), pk(p0[2], p0[3]), pk(p0[4], p0[5]), pk(p0[6], p0[7])}; pw[1] = (u32x4){pk(p0[8], p0[9]), pk(p0[10], p0[11]), pk(p0[12], p0[13]), pk(p0[14], p0[15])};
    pw[2] = (u32x4){pk(p1[0], p1[1]), pk(p1[2], p1[3]), pk(p1[4], p1[5]), pk(p1[6], p1[7])}; pw[3] = (u32x4){pk(p1[8], p1[9]), pk(p1[10], p1[11]), pk(p1[12], p1[13]), pk(p1[14], p1[15])};
}
struct AttnSt { f32x16 o[2]; f32x16 negm; float mref, l; int started; };
__device__ __forceinline__ void attn_reset(AttnSt& st) { st.o[0] = f32x16{}; st.o[1] = f32x16{}; st.negm = f32x16{}; st.mref = 0.f; st.l = 0.f; st.started = 0; }
constexpr int KVBUF = 20480, KV_ROPE = 8192, KV_V = 12288, NKVBUF = 4;
template <int NKS>
__device__ __forceinline__ void qk_tile(f32x16& p0, f32x16& p1, const LAS unsigned char* Kt, const bf16x8* qf, const f32x16& cinit, int lane) {
    const int r32 = lane & 31, hi = lane >> 5, sw = (r32 >> 1) & 7;
    const LAS unsigned char* kp = Kt + r32 * 128;
#pragma unroll
    for (int ks = 0; ks < NKS; ++ks) {
        bf16x8 a0, a1;
        if (ks < 4) { const int off = ((2 * ks + hi) ^ sw) << 4; a0 = *(const LAS bf16x8*)(kp + off); a1 = *(const LAS bf16x8*)(kp + 4096 + off); }
        else { const LAS unsigned char* rp = Kt + KV_ROPE + r32 * 64 + (((2 * (ks - 4) + hi) ^ ((r32 >> 2) & 3)) << 4); a0 = *(const LAS bf16x8*)rp; a1 = *(const LAS bf16x8*)(rp + 2048); }
        if (ks == 0) { p0 = mfma32(a0, qf[0], cinit); p1 = mfma32(a1, qf[0], cinit); } else { p0 = mfma32(a0, qf[ks], p0); p1 = mfma32(a1, qf[ks], p1); } }
}
__device__ __forceinline__ float max3(float a, float b, float c) { return fmaxf(fmaxf(a, b), c); }
constexpr float ATT_THR = 8.f;
template <class Mask>
__device__ __forceinline__ void softmax2(f32x16& p0, f32x16& p1, AttnSt& st, bool need_mask, const Mask& valid, bool lanebit, int lane, u32x4 (&pw)[4], f32x16& n0, f32x16& n1) {
    const int hi = lane >> 5;
    if (need_mask) {
#pragma unroll
        for (int r = 0; r < 16; ++r) { const int k0 = crow(r, hi); if (!valid(k0)) p0[r] = NEGF; if (!valid(k0 + 32)) p1[r] = NEGF; } }
    float ma = max3(p0[0], p0[1], p1[0]), mb = max3(p0[2], p0[3], p1[1]); ma = max3(ma, p1[2], p1[3]);
#pragma unroll
    for (int r = 4; r < 16; r += 4) { ma = max3(ma, p0[r], p0[r + 1]); mb = max3(mb, p0[r + 2], p0[r + 3]); ma = max3(ma, p1[r], p1[r + 1]); mb = max3(mb, p1[r + 2], p1[r + 3]); }
    float mx = fmaxf(ma, mb); mx = fmaxf(mx, __shfl_xor(mx, 32));
    if (!lanebit) mx = NEGF;
    const bool has = mx > -1e29f, fresh = has && !st.started;
    if (__any((mx > ATT_THR) || fresh)) {
        const float dl = has ? (fresh ? mx : fmaxf(mx, 0.f)) : 0.f;
        st.mref += dl; const float f = ex2(-dl); st.l *= f;
#pragma unroll
        for (int r = 0; r < 16; ++r) { p0[r] -= dl; p1[r] -= dl; n0[r] -= dl; n1[r] -= dl; st.o[0][r] *= f; st.o[1][r] *= f; st.negm[r] = -st.mref; }
        st.started |= has ? 1 : 0;
    }
    float sa = 0.f, sb = 0.f;
#pragma unroll
    for (int r = 0; r < 16; ++r) { p0[r] = ex2(p0[r]); p1[r] = ex2(p1[r]); sa += p0[r]; sb += p1[r]; }
    pack_p(pw, p0, p1);
    float sum = sa + sb;
    if (!lanebit) { sum = 0.f;
#pragma unroll
        for (int i = 0; i < 4; ++i) pw[i] = (u32x4){0u, 0u, 0u, 0u}; }
    st.l += sum;
}
__device__ __forceinline__ void pv_packed(f32x16 (&o)[2], const LAS unsigned char* Vt, const u32x4 (&pw)[4], int lane) {
    const int i15 = lane & 15, g1 = (lane >> 4) & 1, hi = lane >> 5, bsw = (i15 >> 3) & 1;
    const LAS unsigned char* vrow = Vt + (4 * hi + (i15 >> 2)) * 128 + (2 * g1 + ((i15 & 3) >> 1)) * 16 + (i15 & 1) * 8;
    const LAS unsigned char* vb0 = vrow + 64 * bsw; const LAS unsigned char* vb1 = vrow + 64 * (bsw ^ 1);
#pragma unroll
    for (int db = 0; db < 2; ++db)
#pragma unroll
        for (int s = 0; s < 4; ++s) { const LAS unsigned char* vb = db ? vb1 : vb0; const s16x4 lo = trld(vb + s * 2048), h4 = trld(vb + s * 2048 + 1024);
            const bf16x8 a = {lo[0], lo[1], lo[2], lo[3], h4[0], h4[1], h4[2], h4[3]};
            o[db] = mfma32(a, __builtin_bit_cast(bf16x8, pw[s]), o[db]); }
}
#define LDS_BAR() asm volatile("s_waitcnt lgkmcnt(0)\n\ts_barrier" ::: "memory")
__device__ __forceinline__ void glds16(const void* gsrc, unsigned lds_dst) { unsigned keep;
    asm volatile("s_mov_b32 %0, m0\n\ts_mov_b32 m0, %2\n\ts_nop 0\n\tglobal_load_lds_dwordx4 %1, off\n\ts_mov_b32 m0, %0" : "=&s"(keep) : "v"(gsrc), "s"(lds_dst) : "memory"); }
template <bool ROPE, class Src>
__device__ __forceinline__ void dma_tile(const Src& src, int j, LAS unsigned char* buf, int wave, unsigned koff, unsigned voff, unsigned roff) {
    const unsigned b = (unsigned)(size_t)buf;
    glds16(src.kbase(j) + koff, (unsigned)__builtin_amdgcn_readfirstlane(b + wave * 1024));
    glds16(src.vbase(j) + voff, (unsigned)__builtin_amdgcn_readfirstlane(b + KV_V + wave * 1024));
    if (ROPE) glds16(src.rbase(j) + roff, (unsigned)__builtin_amdgcn_readfirstlane(b + KV_ROPE + (wave & 3) * 1024));
}
#define VMW(n) asm volatile("s_waitcnt vmcnt(" #n ")" ::: "memory")
template <int NKS, class It, class Src, class Act, class Mask>
__device__ __forceinline__ void attn_loop(AttnSt& st, const bf16x8* qf, It it, const Src& src, const Act& active, const Mask& mask, LAS unsigned char* kv, int tid_, int lane_, int abl = 0) {
    const int tid = launder(tid_), lane = tid & 63, wave = __builtin_amdgcn_readfirstlane(tid >> 6); (void)lane_;
    constexpr bool ROPE = (NKS > 4);
    int jc = it.next(); if (jc < 0) return;
    unsigned koff, voff, roff;
    { const int row = wave * 8 + (lane >> 3), c = lane & 7; koff = (unsigned)row * src.kpitch + (unsigned)((c ^ ((row >> 1) & 7)) << 4); voff = (unsigned)row * src.vpitch + (unsigned)((c ^ (((row >> 1) & 1) << 2)) << 4);
      const int rr = (wave & 3) * 16 + (lane >> 2), rc = lane & 3; roff = (unsigned)rr * 64u + (unsigned)((rc ^ ((rr >> 2) & 3)) << 4); }
    int j1 = it.next(), j2 = (j1 >= 0) ? it.next() : -1, j3 = (j2 >= 0) ? it.next() : -1;
    dma_tile<ROPE>(src, jc, kv, wave, koff, voff, roff);
    if (j1 >= 0) dma_tile<ROPE>(src, j1, kv + KVBUF, wave, koff, voff, roff);
    if (j2 >= 0) dma_tile<ROPE>(src, j2, kv + 2 * KVBUF, wave, koff, voff, roff);
    if (j2 >= 0) { if (ROPE) VMW(3); else VMW(2); } else VMW(0);
    LDS_BAR();
    int bc = 0;
    f32x16 sa0, sa1, sb0, sb1;
    if (active(jc)) qk_tile<NKS>(sa0, sa1, kv, qf, st.negm, lane); else { sa0 = f32x16{}; sa1 = f32x16{}; }
#define STEP(SC0, SC1, SN0, SN1) { \
        const int bn = (bc + 1) & 3; \
        if (j3 >= 0 && !(abl & 8)) dma_tile<ROPE>(src, j3, kv + ((bc + 3) & 3) * KVBUF, wave, koff, voff, roff); \
        const bool act = active(jc); \
        __builtin_amdgcn_sched_barrier(0); \
        if (j1 >= 0 && active(j1)) { if (!(abl & 1)) qk_tile<NKS>(SN0, SN1, kv + bn * KVBUF, qf, st.negm, lane); else { SN0 = st.negm; SN1 = st.negm; } } \
        __builtin_amdgcn_sched_barrier(0); \
        u32x4 pw[4]; \
        if (act) { if (!(abl & 2)) softmax2(SC0, SC1, st, mask.need(jc), [&](int key) { return mask.valid(jc, key); }, mask.lanebit(jc), lane, pw, SN0, SN1); else pack_p(pw, SC0, SC1); __builtin_amdgcn_sched_barrier(0); \
            if (!(abl & 4)) pv_packed(st.o, kv + bc * KVBUF + KV_V, pw, lane); else st.o[0][0] += __uint_as_float(pw[0].x ^ pw[1].y ^ pw[2].z ^ pw[3].w); __builtin_amdgcn_sched_barrier(0); } \
        if (j1 < 0) break; \
          \
        if (abl & 8) VMW(0); else if (j3 >= 0) { if (ROPE) VMW(3); else VMW(2); } else VMW(0); \
        if (!(abl & 16)) LDS_BAR(); \
        jc = j1; j1 = j2; j2 = j3; j3 = (j3 >= 0) ? it.next() : -1; bc = bn; }
    for (;;) { STEP(sa0, sa1, sb0, sb1) STEP(sb0, sb1, sa0, sa1) }
#undef STEP
    LDS_BAR();
}
struct RangeIt { int j, end; __device__ __forceinline__ int next() { return (j < end) ? j++ : -1; } };
struct BitIt { unsigned m; __device__ __forceinline__ int next() { if (!m) return -1; const int j = __builtin_ctz(m); m &= m - 1; return j; } };

__device__ __forceinline__ void mla_attn_unit(Frame& F, int b, int h, int qb, int abl = 0) {
    const int lane = F.lane, wave = F.wave, r32 = lane & 31, hi = lane >> 5;
    const int q0 = qb * 256 + wave * 32, t = q0 + r32;
    const size_t rb = (size_t)b * S;
    const bf16_t* Q = (const bf16_t*)(F.ws + S_Q96) + (rb + t) * 768 + h * 96;
    const bf16_t* KN = (const bf16_t*)(F.ws + S_KN) + rb * 512 + h * 64; const bf16_t* KR = (const bf16_t*)(F.ws + S_KRB) + rb * 32; const bf16_t* V = (const bf16_t*)(F.ws + S_V) + rb * 512 + h * 64;
    bf16x8 qf[6];
#pragma unroll
    for (int ks = 0; ks < 6; ++ks) qf[ks] = ld8g(Q + ks * 16 + hi * 8);
    asm volatile("" : "+v"(qf[0]), "+v"(qf[1]), "+v"(qf[2]), "+v"(qf[3]), "+v"(qf[4]), "+v"(qf[5]));
    AttnSt st; attn_reset(st);
    struct Src { const unsigned char *KN, *KR, *V; unsigned kpitch, vpitch;
        __device__ __forceinline__ const unsigned char* kbase(int j) const { return KN + (size_t)j * 64 * 1024; }
        __device__ __forceinline__ const unsigned char* vbase(int j) const { return V + (size_t)j * 64 * 1024; }
        __device__ __forceinline__ const unsigned char* rbase(int j) const { return KR + (size_t)j * 64 * 64; } } src{(const unsigned char*)KN, (const unsigned char*)KR, (const unsigned char*)V, 1024u, 1024u};
    const int wlast = (q0 + 31) >> 6;
    struct MaskC { int t, tmin; __device__ __forceinline__ bool need(int j) const { return j * 64 + 63 > tmin; } __device__ __forceinline__ bool valid(int j, int key) const { return j * 64 + key <= t; }
        __device__ __forceinline__ bool lanebit(int) const { return true; } } mk{t, q0};
    if (!(abl & 32)) attn_loop<6>(st, qf, RangeIt{0, qb * 4 + 4}, src, [&](int j) { return j <= wlast; }, mk, F.lds + RING_OFF, F.tid, lane, abl); if (abl & 64) return;
    float l = st.l + __shfl_xor(st.l, 32); const float inv = 1.f / l;
    bf16_t* O = (bf16_t*)(F.ws + S_H0B) + (rb + t) * 1536 + 512 + h * 64 + 4 * hi;
#pragma unroll
    for (int db = 0; db < 2; ++db)
#pragma unroll
        for (int g4 = 0; g4 < 4; ++g4) store4(O + db * 32 + 8 * g4, st.o[db][4 * g4] * inv, st.o[db][4 * g4 + 1] * inv, st.o[db][4 * g4 + 2] * inv, st.o[db][4 * g4 + 3] * inv);
}

constexpr int NSA_IMP_OFF = NKVBUF * KVBUF, NSA_SEL_OFF = NSA_IMP_OFF + 8 * 32 * 33 * 4;
__device__ __forceinline__ void ob_add(u32x2 (&ob)[2][4], const f32x16 (&o)[2], float f, bool first) {
#pragma unroll
    for (int db = 0; db < 2; ++db)
#pragma unroll
        for (int g4 = 0; g4 < 4; ++g4) { float a0 = 0.f, a1 = 0.f, a2 = 0.f, a3 = 0.f;
            if (!first) { a0 = __uint_as_float(ob[db][g4].x << 16); a1 = __uint_as_float(ob[db][g4].x & 0xffff0000u); a2 = __uint_as_float(ob[db][g4].y << 16); a3 = __uint_as_float(ob[db][g4].y & 0xffff0000u); }
            ob[db][g4].x = pk(a0 + f * o[db][4 * g4], a1 + f * o[db][4 * g4 + 1]); ob[db][g4].y = pk(a2 + f * o[db][4 * g4 + 2], a3 + f * o[db][4 * g4 + 3]); }
}
__device__ __forceinline__ void nsa_unit(Frame& F, int b, int g, int tblk  , bool dry = false, int abl = 0) {
    const int lane = F.lane, wave = F.wave, tid = F.tid, r32 = lane & 31, hi = lane >> 5;
    const int t0 = tblk * 32, t = t0 + r32, tb = t0 >> 6, h = g * 8 + wave;
    const size_t rb = (size_t)b * S;
    bf16_t* H1B = (bf16_t*)(F.ws + S_H1B);
    bf16_t* qrow = H1B + (rb + t) * 2048;
    bf16x8 qf[4];
#pragma unroll
    for (int ks = 0; ks < 4; ++ks) qf[ks] = ld8g(qrow + h * 64 + ks * 16 + hi * 8);
    bf16_t* orow = (dry ? ((bf16_t*)(F.ws + WS_Z1) + (qrow - H1B)) : qrow) + h * 64 + 4 * hi;
    const float* gate_b = (const float*)F.in[19];
    float gate[3];
#pragma unroll
    for (int br = 0; br < 3; ++br) { const float x = bf2f(qrow[1792 + br * 16 + h]) + gate_b[br * 16 + h]; gate[br] = __builtin_amdgcn_rcpf(1.f + ex2(-LOG2E * x)); }
    asm volatile("" : "+v"(qf[0]), "+v"(qf[1]), "+v"(qf[2]), "+v"(qf[3]), "+v"(gate[0]), "+v"(gate[1]), "+v"(gate[2]));
    LAS unsigned char* kv = F.lds + RING_OFF;
    LAS float* impw = (LAS float*)(F.lds + NSA_IMP_OFF); LAS unsigned* selw = (LAS unsigned*)(F.lds + NSA_SEL_OFF);
    if (tid == 0) selw[32] = 0u;
    u32x2 ob[2][4];
    struct Src { const unsigned char *K, *V; unsigned kpitch, vpitch;
        __device__ __forceinline__ const unsigned char* kbase(int j) const { return K + (size_t)j * 64 * kpitch; }
        __device__ __forceinline__ const unsigned char* vbase(int j) const { return V + (size_t)j * 64 * vpitch; }
        __device__ __forceinline__ const unsigned char* rbase(int) const { return K; } };
    {
        const int tid = launder(F.tid), lane = tid & 63, r32 = lane & 31, hi = lane >> 5;
        const int nk = (t0 >> 4) + 1;
        const int ntile = (nk + 63) >> 6;
        { Src sc{(const unsigned char*)((const bf16_t*)(F.ws + S_KCMP) + (size_t)(b * 2 + g) * 128 * 64), (const unsigned char*)((const bf16_t*)(F.ws + S_VCMP) + (size_t)(b * 2 + g) * 128 * 64), 128u, 128u};
          const int row = wave * 8 + (lane >> 3), c = lane & 7; const unsigned koff = (unsigned)row * 128u + (unsigned)((c ^ ((row >> 1) & 7)) << 4), voff = (unsigned)row * 128u + (unsigned)((c ^ (((row >> 1) & 1) << 2)) << 4);
          dma_tile<false>(sc, 0, kv, wave, koff, voff, 0u); if (ntile > 1) dma_tile<false>(sc, 1, kv + KVBUF, wave, koff, voff, 0u); }
        VMW(0); LDS_BAR();
        f32x16 p[2][2]; float mx = NEGF;
#pragma unroll
        for (int tl = 0; tl < 2; ++tl) { __builtin_amdgcn_sched_barrier(0); if (tl < ntile) { qk_tile<4>(p[tl][0], p[tl][1], kv + tl * KVBUF, qf, f32x16{}, lane);
#pragma unroll
                for (int kb = 0; kb < 2; ++kb)
#pragma unroll
                    for (int r = 0; r < 16; ++r) { const int n = tl * 64 + kb * 32 + crow(r, hi); if (t < 16 * n + 31) p[tl][kb][r] = NEGF; mx = fmaxf(mx, p[tl][kb][r]); } }
            else { p[tl][0] = f32x16{}; p[tl][1] = f32x16{};
#pragma unroll
                for (int r = 0; r < 16; ++r) { p[tl][0][r] = NEGF; p[tl][1][r] = NEGF; } } }
        mx = fmaxf(mx, __shfl_xor(mx, 32));
        const float muse = (mx < -1e29f) ? 0.f : mx; float sum = 0.f;
#pragma unroll
        for (int tl = 0; tl < 2; ++tl)
#pragma unroll
            for (int kb = 0; kb < 2; ++kb)
#pragma unroll
                for (int r = 0; r < 16; ++r) { p[tl][kb][r] = ex2(p[tl][kb][r] - muse); sum += p[tl][kb][r]; }
        sum += __shfl_xor(sum, 32);
        const float inv = (sum > 0.f) ? __builtin_amdgcn_rcpf(sum) : 0.f;
#pragma unroll
        for (int tl = 0; tl < 2; ++tl)
#pragma unroll
            for (int kb = 0; kb < 2; ++kb)
#pragma unroll
                for (int r = 0; r < 16; ++r) p[tl][kb][r] *= inv;
        { float carried = 0.f;
#pragma unroll
        for (int tl = 0; tl < 2; ++tl)
#pragma unroll
            for (int kb = 0; kb < 2; ++kb)
#pragma unroll
                for (int q4 = 0; q4 < 4; ++q4) { const int m = 8 * tl + 4 * kb + q4;
                    const float Gm = (p[tl][kb][4 * q4] + p[tl][kb][4 * q4 + 1]) + (p[tl][kb][4 * q4 + 2] + p[tl][kb][4 * q4 + 3]);
                    const float other = __shfl_xor(p[tl][kb][4 * q4 + 3], 32);
                    const float prev = hi ? other : carried; carried = other;
                    impw[(wave * 32 + r32) * 33 + 2 * m + hi] = Gm + prev; } }
        __builtin_amdgcn_sched_barrier(0);
        { f32x16 oc[2] = {f32x16{}, f32x16{}}; u32x4 pwa[4], pwb[4]; pack_p(pwa, p[0][0], p[0][1]); pack_p(pwb, p[1][0], p[1][1]); __builtin_amdgcn_sched_barrier(0);
          pv_packed(oc, kv + KV_V, pwa, lane); __builtin_amdgcn_sched_barrier(0);
          if (ntile > 1) pv_packed(oc, kv + KVBUF + KV_V, pwb, lane); __builtin_amdgcn_sched_barrier(0);
          ob_add(ob, oc, gate[0], true); }
        LDS_BAR();
    }
#pragma unroll 1
    for (int ps = 0; ps < 2; ++ps) { const int lane = launder(F.tid) & 63, r32 = lane & 31, hi = lane >> 5; const int tokl = 4 * wave + 2 * ps + hi, j = r32; float a = 0.f;
#pragma unroll
        for (int w = 0; w < 8; ++w) a += impw[(w * 32 + tokl) * 33 + j];
        const bool forced = (j == 0) || (j == tb) || (j == tb - 1); const float sc = forced ? 1e4f : (j <= tb ? a : -1e4f);
        const int scb = __builtin_bit_cast(int, sc); int rank = 0;
#pragma unroll
        for (int k = 0; k < 32; ++k) { const float o0 = __builtin_bit_cast(float, __builtin_amdgcn_readlane(scb, k)), o1 = __builtin_bit_cast(float, __builtin_amdgcn_readlane(scb, 32 + k)); const float o = hi ? o1 : o0;
            rank += ((o > sc) || (o == sc && k < j)) ? 1 : 0; }
        const unsigned long long bal = __ballot(rank < 8);
        const unsigned mine = hi ? (unsigned)(bal >> 32) : (unsigned)bal;
        if (r32 == 0) { selw[tokl] = mine; __hip_atomic_fetch_or(&selw[32], mine, __ATOMIC_RELAXED, __HIP_MEMORY_SCOPE_WORKGROUP); } }
    LDS_BAR();
    const unsigned mysel = selw[r32]; const unsigned uni = selw[32] & ((tb >= 31) ? 0xffffffffu : ((2u << tb) - 1u));
    {
        AttnSt st; attn_reset(st);
        Src src{(const unsigned char*)(H1B + rb * 2048 + 1280 + g * 64), (const unsigned char*)(H1B + rb * 2048 + 1408 + g * 64), 4096u, 4096u};
        struct MaskS { int t, tb; unsigned sel; __device__ __forceinline__ bool need(int j) const { return j == tb; } __device__ __forceinline__ bool valid(int j, int key) const { return j * 64 + key <= t; }
            __device__ __forceinline__ bool lanebit(int j) const { return (sel >> j) & 1u; } } mk{t, tb, mysel};
        attn_loop<4>(st, qf, BitIt{uni}, src, [&](int) { return true; }, mk, kv, tid, lane, abl);
        const float l = st.l + __shfl_xor(st.l, 32); ob_add(ob, st.o, gate[1] * __builtin_amdgcn_rcpf(l), false);
    }
    {
        AttnSt st; attn_reset(st);
        Src src{(const unsigned char*)(H1B + rb * 2048 + 1536 + g * 64), (const unsigned char*)(H1B + rb * 2048 + 1664 + g * 64), 4096u, 4096u};
        const int jlo = (t0 - 511 > 0) ? ((t0 - 511) >> 6) : 0;
        struct MaskW { int t, tb, t0; __device__ __forceinline__ bool need(int j) const { return (j == tb) || (64 * j <= t0 + 31 - 512); }
            __device__ __forceinline__ bool valid(int j, int key) const { const int k = j * 64 + key; return (k <= t) && (k > t - 512); } __device__ __forceinline__ bool lanebit(int) const { return true; } } mk{t, tb, t0};
        attn_loop<4>(st, qf, RangeIt{jlo, tb + 1}, src, [&](int) { return true; }, mk, kv, tid, lane, abl);
        const float l = st.l + __shfl_xor(st.l, 32); ob_add(ob, st.o, gate[2] * __builtin_amdgcn_rcpf(l), false);
    }
#pragma unroll
    for (int db = 0; db < 2; ++db)
#pragma unroll
        for (int g4 = 0; g4 < 4; ++g4) *(u32x2*)(orow + db * 32 + 8 * g4) = ob[db][g4];
}

__device__ __forceinline__ void cmp_item(Frame& F, int item) {
    const int lane = F.lane, wave = F.wave, r32 = lane & 31, hi = lane >> 5;
    const int rblk = item & 63, gk = item >> 6, g = gk & 1, kvsel = gk >> 1;
    const int row = rblk * 32 + r32, b = row >> 7, n = row & 127;
    const bf16_t* H1B = (const bf16_t*)(F.ws + S_H1B);
    const int ncl = (n < 127) ? n : 126;
    const bf16_t* src = H1B + ((size_t)b * S + 16 * ncl) * 2048 + 1024 + kvsel * 128 + g * 64 + hi * 8;
    (void)src;
    const unsigned char* W1 = (const unsigned char*)(F.ws + (kvsel ? WS_WCV1 : WS_WCK1)) + (size_t)(wave * 32) * 4096;
    LAS unsigned char* wl = F.lds + RING_OFF + wave * 16384;
    const unsigned char* xrow[4];
#pragma unroll
    for (int i = 0; i < 4; ++i) { const int rr = rblk * 32 + 8 * i + (lane >> 3), bb = rr >> 7, nn = rr & 127, nc = (nn < 127) ? nn : 126;
        xrow[i] = (const unsigned char*)(H1B + ((size_t)bb * S + 16 * nc) * 2048 + 1024 + kvsel * 128 + g * 64) + (lane & 7) * 16; }
    f32x16 acc = {};
    u32x4 wv[2][4], xv[2][4];
#pragma unroll
    for (int c = 0; c < 2; ++c) { wt_load(wv[c], W1 + c * 128, 4096u, lane);
#pragma unroll
        for (int i = 0; i < 4; ++i) xv[c][i] = *(const u32x4*)(xrow[i] + (size_t)c * 4096); }
#pragma unroll 1
    for (int l0 = 0; l0 < 32; l0 += 2) {
#pragma unroll
        for (int c = 0; c < 2; ++c) { wt_store(wl + c * 4096, wv[c], lane); wt_store(wl + (2 + c) * 4096, xv[c], lane); }
        if (l0 + 2 < 32) {
#pragma unroll
            for (int c = 0; c < 2; ++c) { wt_load(wv[c], W1 + (size_t)(l0 + 2 + c) * 128, 4096u, lane);
#pragma unroll
                for (int i = 0; i < 4; ++i) xv[c][i] = *(const u32x4*)(xrow[i] + (size_t)(l0 + 2 + c) * 4096); } }
#pragma unroll
        for (int c = 0; c < 2; ++c)
#pragma unroll
            for (int q = 0; q < 4; ++q) acc = mfma32(wt_frag(wl + c * 4096, q, lane), wt_frag(wl + (2 + c) * 4096, q, lane), acc);
    }
    const float* cb = (const float*)(F.ws + WS_CBIAS) + kvsel * 256 + wave * 32;
    LAS unsigned char* hid = F.lds + RING_OFF;
    __syncthreads();
#pragma unroll
    for (int g4 = 0; g4 < 4; ++g4) { const int c = 8 * g4 + 4 * hi; u32x2 w; w.x = pk(gelu_t(acc[4 * g4] + cb[c]), gelu_t(acc[4 * g4 + 1] + cb[c + 1])); w.y = pk(gelu_t(acc[4 * g4 + 2] + cb[c + 2]), gelu_t(acc[4 * g4 + 3] + cb[c + 3]));
        *(LAS u32x2*)(hid + r32 * 528 + (wave * 32 + c) * 2) = w; }
    __syncthreads();
    if (wave < 2) {
        const bf16_t* W2 = (const bf16_t*)(F.ws + (kvsel ? WS_WCV2 : WS_WCK2)) + (size_t)(wave * 32 + r32) * 256 + hi * 8;
        f32x16 o = {};
#pragma unroll
        for (int ks = 0; ks < 16; ++ks) o = mfma32(ld8g(W2 + ks * 16), *(const LAS bf16x8*)(hid + r32 * 528 + ks * 32 + hi * 16), o);
        bf16_t* dst = (bf16_t*)(F.ws + (kvsel ? S_VCMP : S_KCMP)) + ((size_t)(b * 2 + g) * 128 + n) * 64 + wave * 32 + 4 * hi;
        const float z = (n < 127) ? 1.f : 0.f;
#pragma unroll
        for (int g4 = 0; g4 < 4; ++g4) store4(dst + 8 * g4, o[4 * g4] * z, o[4 * g4 + 1] * z, o[4 * g4 + 2] * z, o[4 * g4 + 3] * z);
    }
    __syncthreads();
}

__device__ __forceinline__ void ln_route_wg(Frame& F, int layer, int cset) {
    const int lane = F.lane, wave = F.wave, tid = F.tid, r32 = lane & 31, hi = lane >> 5;
    const int tok0 = F.vcu * 128;
    const float* Z = (const float*)(F.ws + WS_Z1);
    const float* g1 = (const float*)F.in[28] + layer * 1024; const float* b1 = (const float*)F.in[29] + layer * 1024;
    const float* wrg = (const float*)F.in[21] + (size_t)layer * 4096; const float* brg = (const float*)F.in[22] + layer * 4;
    const float* wre = (const float*)F.in[23] + (size_t)layer * 32768; const float* bre = (const float*)F.in[24] + layer * 32;
    LAS float* part = (LAS float*)(F.lds + RING_OFF);
    LAS float* glog = (LAS float*)(F.lds + LDS_SCR); LAS float* stl = (LAS float*)(F.lds + LDS_SCR + 2048);
    LAS int* lcnt = (LAS int*)(F.lds + LDS_SCR + 3072); LAS int* gbase = (LAS int*)(F.lds + LDS_SCR + 3200); LAS int* ent = (LAS int*)(F.lds + LDS_SCR + 3328);
    bf16_t* X1B = (bf16_t*)(F.ws + S_X1B); bf16_t* X1L = (bf16_t*)(F.ws + S_XP); float* stats = (float*)(F.ws + WS_STATS);
    if (tid < 32) lcnt[tid] = 0;
    {
        f32x4 gg[4], bb[4];
#pragma unroll
        for (int j = 0; j < 4; ++j) { gg[j] = *(const f32x4*)(g1 + lane * 4 + 256 * j); bb[j] = *(const f32x4*)(b1 + lane * 4 + 256 * j); }
#pragma unroll 1
        for (int i0 = 0; i0 < 16; i0 += 4) {
            f32x4 v[4][4]; float mean[4], rstd[4];
#pragma unroll
            for (int u = 0; u < 4; ++u) { const float* z = Z + (size_t)(tok0 + wave * 16 + i0 + u) * D;
#pragma unroll
                for (int j = 0; j < 4; ++j) v[u][j] = *(const f32x4*)(z + lane * 4 + 256 * j); }
#pragma unroll
            for (int u = 0; u < 4; ++u) { float s = 0.f;
#pragma unroll
                for (int j = 0; j < 4; ++j) s += (v[u][j][0] + v[u][j][1]) + (v[u][j][2] + v[u][j][3]);
                mean[u] = wsum(s) * (1.f / D); float q = 0.f;
#pragma unroll
                for (int j = 0; j < 4; ++j) { v[u][j] = v[u][j] - mean[u]; q += (v[u][j][0] * v[u][j][0] + v[u][j][1] * v[u][j][1]) + (v[u][j][2] * v[u][j][2] + v[u][j][3] * v[u][j][3]); }
                rstd[u] = rsqrtf(wsum(q) * (1.f / D) + LN_EPS); }
            f32x4 lg[4] = {f32x4{0.f, 0.f, 0.f, 0.f}, f32x4{0.f, 0.f, 0.f, 0.f}, f32x4{0.f, 0.f, 0.f, 0.f}, f32x4{0.f, 0.f, 0.f, 0.f}};
#pragma unroll
            for (int j = 0; j < 4; ++j) {
#pragma unroll
                for (int u = 0; u < 4; ++u) v[u][j] = v[u][j] * rstd[u] * gg[j] + bb[j];
#pragma unroll
                for (int e = 0; e < 4; ++e) { const f32x4 wv = *(const f32x4*)(wrg + (size_t)(lane * 4 + 256 * j + e) * 4);
#pragma unroll
                    for (int u = 0; u < 4; ++u) lg[u] += wv * v[u][j][e]; } }
#pragma unroll
            for (int u = 0; u < 4; ++u) { const int row = wave * 16 + i0 + u;
#pragma unroll
                for (int j = 0; j < 4; ++j) { const f32x4 x = v[u][j];
                    u32x2 w; w.x = pk(x[0], x[1]); w.y = pk(x[2], x[3]); *(u32x2*)(X1B + (size_t)(tok0 + row) * D + lane * 4 + 256 * j) = w;
                    u32x2 wl2; wl2.x = pk(x[0] - __uint_as_float(w.x << 16), x[1] - __uint_as_float(w.x & 0xffff0000u)); wl2.y = pk(x[2] - __uint_as_float(w.y << 16), x[3] - __uint_as_float(w.y & 0xffff0000u));
                    *(u32x2*)(X1L + (size_t)(tok0 + row) * D + lane * 4 + 256 * j) = wl2; }
                float l4[4];
#pragma unroll
                for (int e = 0; e < 4; ++e) l4[e] = wsum(lg[u][e]);
                if (lane == 0) { glog[row * 4 + 0] = l4[0] + brg[0]; glog[row * 4 + 1] = l4[1] + brg[1]; glog[row * 4 + 2] = l4[2] + brg[2]; glog[row * 4 + 3] = l4[3] + brg[3];
                    stl[row * 2] = mean[u]; stl[row * 2 + 1] = rstd[u]; stats[(size_t)(tok0 + row) * 2] = mean[u]; stats[(size_t)(tok0 + row) * 2 + 1] = rstd[u]; } }
        }
    }
    __syncthreads();
    { const int lane = launder(F.tid) & 63, r32 = lane & 31, hi = lane >> 5;
        bf16x8 wh[8], wl[8];
#pragma unroll
        for (int ks = 0; ks < 8; ++ks) { unsigned hh[4], ll[4];
#pragma unroll
            for (int e2 = 0; e2 < 4; ++e2) { float a[2], ah[2];
#pragma unroll
                for (int q = 0; q < 2; ++q) { const int k = wave * 128 + ks * 16 + hi * 8 + e2 * 2 + q; a[q] = wre[(size_t)k * 32 + r32]; }
                hh[e2] = pk(a[0], a[1]); ah[0] = __uint_as_float(hh[e2] << 16); ah[1] = __uint_as_float(hh[e2] & 0xffff0000u); ll[e2] = pk(a[0] - ah[0], a[1] - ah[1]); }
            wh[ks] = __builtin_bit_cast(bf16x8, (u32x4){hh[0], hh[1], hh[2], hh[3]}); wl[ks] = __builtin_bit_cast(bf16x8, (u32x4){ll[0], ll[1], ll[2], ll[3]}); asm volatile("" ::: "memory"); }
        for (int blk = 0; blk < 4; ++blk) { const int row = blk * 32 + r32; const size_t xo = (size_t)(tok0 + row) * D + wave * 128 + hi * 8;
            f32x16 acc = {};
#pragma unroll
            for (int ks = 0; ks < 8; ++ks) { const bf16x8 xh = ld8g(X1B + xo + ks * 16), xl = ld8g(X1L + xo + ks * 16);
                acc = mfma32(wh[ks], xh, acc); acc = mfma32(wh[ks], xl, acc); acc = mfma32(wl[ks], xh, acc); }
#pragma unroll
            for (int r = 0; r < 16; ++r) part[(wave * 128 + row) * 33 + crow(r, hi)] = acc[r];
        }
    }
    __syncthreads();
    const int tid2 = launder(F.tid);
    int e0 = 0, e1 = 0; float w0 = 0.f, w1 = 0.f; int rk0 = 0, rk1 = 0;
    if (tid2 < 128) {
        const float l0 = glog[tid2 * 4], l1 = glog[tid2 * 4 + 1], l2 = glog[tid2 * 4 + 2], l3 = glog[tid2 * 4 + 3];
        int gs = 0; float gm = l0; if (l1 > gm) { gm = l1; gs = 1; } if (l2 > gm) { gm = l2; gs = 2; } if (l3 > gm) { gm = l3; gs = 3; }
        const float gw = 1.f / (expf(l0 - gm) + expf(l1 - gm) + expf(l2 - gm) + expf(l3 - gm));
        float es[8];
#pragma unroll
        for (int n = 0; n < 8; ++n) { float a = bre[gs * 8 + n];
#pragma unroll
            for (int w = 0; w < 8; ++w) a += part[(w * 128 + tid2) * 33 + gs * 8 + n];
            es[n] = a; }
        int i0 = 0; float m0 = es[0];
#pragma unroll
        for (int n = 1; n < 8; ++n) if (es[n] > m0) { m0 = es[n]; i0 = n; }
        int i1 = 0; float m1 = -3e38f;
#pragma unroll
        for (int n = 0; n < 8; ++n) if (n != i0 && es[n] > m1) { m1 = es[n]; i1 = n; }
        const float r = expf(m1 - m0); w0 = gw / (1.f + r); w1 = gw * r / (1.f + r);
        e0 = gs * 8 + i0; e1 = gs * 8 + i1;
        rk0 = __hip_atomic_fetch_add(&lcnt[e0], 1, __ATOMIC_RELAXED, __HIP_MEMORY_SCOPE_WORKGROUP); rk1 = __hip_atomic_fetch_add(&lcnt[e1], 1, __ATOMIC_RELAXED, __HIP_MEMORY_SCOPE_WORKGROUP);
    }
    __syncthreads();
    if (tid2 < 32) gbase[tid2] = (int)__hip_atomic_fetch_add((int*)(F.ctl + CW_CNT + cset * 64) + tid2, lcnt[tid2], __ATOMIC_RELAXED, __HIP_MEMORY_SCOPE_AGENT);
    __syncthreads();
    if (tid2 < 128) {
        int* rt = (int*)(F.ws + WS_ROUTE); float* rw = (float*)(F.ws + WS_ROUTE + (size_t)T * 8);
        const int tok = tok0 + tid2;
        rt[tok * 2] = (e0 << 20) | (gbase[e0] + rk0); rt[tok * 2 + 1] = (e1 << 20) | (gbase[e1] + rk1);
        rw[tok * 2] = w0; rw[tok * 2 + 1] = w1;
    }
    __syncthreads();
}
__device__ __forceinline__ void moe_tables(Frame& F, int layer) {
    LAS int* ebase = (LAS int*)(F.lds + LDS_SCR + 4352); LAS int* pe = (LAS int*)(F.lds + LDS_SCR + 4608);
    if (F.tid == 0) { int a = 0; for (int e = 0; e < 32; ++e) { ebase[e] = a; const int c = (int)__hip_atomic_load((int*)(F.ctl + CW_CNT + layer * 64) + e, __ATOMIC_RELAXED, __HIP_MEMORY_SCOPE_AGENT); a += (c + 255) & ~255; } ebase[32] = a; }
    __syncthreads();
    for (int p = F.tid; p < MOE_PANELS; p += NTHR) { int e = 0; for (int k = 1; k < 32; ++k) if (p * 256 >= ebase[k]) e = k; pe[p] = e; }
    __syncthreads();
}
__device__ __forceinline__ void moe_gather_wg(Frame& F, int layer) {
    moe_tables(F, layer);
    LAS int* ebase = (LAS int*)(F.lds + LDS_SCR + 4352);
    const int tok0 = F.vcu * 128; int* rt = (int*)(F.ws + WS_ROUTE);
    int* rowsrc = (int*)(F.ctl + CW_ROWSRC) + layer * MOE_ROWS;
    if (F.tid < 256) { const int tok = tok0 + (F.tid >> 1), sl = F.tid & 1; const int v = rt[tok * 2 + sl]; const int row = ebase[v >> 20] + (v & 0xfffff);
        rowsrc[row] = tok; rt[4 * T + tok * 2 + sl] = row; }
}
__device__ __forceinline__ void combine_wg(Frame& F, int layer, float* xout, bf16_t* xb) {
    const int lane = F.lane, tok0 = F.vcu * 128;
    const float* Z = (const float*)(F.ws + WS_Z1); const float* stats = (const float*)(F.ws + WS_STATS);
    const int* rt = (const int*)(F.ws + WS_ROUTE); const float* rw = (const float*)(F.ws + WS_ROUTE + (size_t)T * 8);
    const bf16_t* YP = (const bf16_t*)(F.ws + S_YP);
    const float* g1 = (const float*)F.in[28] + layer * 1024; const float* b1 = (const float*)F.in[29] + layer * 1024;
    const float* g2 = (const float*)F.in[30] + layer * 1024; const float* b2 = (const float*)F.in[31] + layer * 1024;
    f32x4 G1[4], B1[4], G2[4], B2[4];
#pragma unroll
    for (int j = 0; j < 4; ++j) { const int c = lane * 4 + 256 * j; G1[j] = *(const f32x4*)(g1 + c); B1[j] = *(const f32x4*)(b1 + c); G2[j] = *(const f32x4*)(g2 + c); B2[j] = *(const f32x4*)(b2 + c); }
#pragma unroll 1
    for (int i0 = 0; i0 < 16; i0 += 4) {
        f32x4 z[4][4]; s16x4 ya[4][4], yb[4][4]; float mean[4], rstd[4], w0[4], w1[4];
#pragma unroll
        for (int u = 0; u < 4; ++u) { const int tok = tok0 + F.wave * 16 + i0 + u;
            mean[u] = stats[(size_t)tok * 2]; rstd[u] = stats[(size_t)tok * 2 + 1]; w0[u] = rw[tok * 2]; w1[u] = rw[tok * 2 + 1];
            const bf16_t* y0 = YP + (size_t)rt[4 * T + tok * 2] * D; const bf16_t* y1 = YP + (size_t)rt[4 * T + tok * 2 + 1] * D;
#pragma unroll
            for (int j = 0; j < 4; ++j) { const int c = lane * 4 + 256 * j; z[u][j] = *(const f32x4*)(Z + (size_t)tok * D + c); ya[u][j] = *(const s16x4*)(y0 + c); yb[u][j] = *(const s16x4*)(y1 + c); } }
        float s[4], q[4];
#pragma unroll
        for (int u = 0; u < 4; ++u) { s[u] = 0.f;
#pragma unroll
            for (int j = 0; j < 4; ++j) { const f32x4 x1 = (z[u][j] - mean[u]) * rstd[u] * G1[j] + B1[j]; f32x4 f;
#pragma unroll
                for (int e = 0; e < 4; ++e) f[e] = w0[u] * bf2f((unsigned short)ya[u][j][e]) + w1[u] * bf2f((unsigned short)yb[u][j][e]);
                z[u][j] = x1 * ALPHA + f; s[u] += (z[u][j][0] + z[u][j][1]) + (z[u][j][2] + z[u][j][3]); } }
#pragma unroll
        for (int u = 0; u < 4; ++u) { const float m2 = wsum(s[u]) * (1.f / D); q[u] = 0.f;
#pragma unroll
            for (int j = 0; j < 4; ++j) { z[u][j] = z[u][j] - m2; q[u] += (z[u][j][0] * z[u][j][0] + z[u][j][1] * z[u][j][1]) + (z[u][j][2] * z[u][j][2] + z[u][j][3] * z[u][j][3]); } }
#pragma unroll
        for (int u = 0; u < 4; ++u) { const int tok = tok0 + F.wave * 16 + i0 + u; const float r2 = rsqrtf(wsum(q[u]) * (1.f / D) + LN_EPS);
#pragma unroll
            for (int j = 0; j < 4; ++j) { const int c = lane * 4 + 256 * j; const f32x4 o = z[u][j] * r2 * G2[j] + B2[j];
                *(f32x4*)(xout + (size_t)tok * D + c) = o;
                if (xb) { u32x2 w; w.x = pk(o[0], o[1]); w.y = pk(o[2], o[3]); *(u32x2*)(xb + (size_t)tok * D + c) = w; } } }
    }
}
constexpr int NPHASE = 19;
__global__ void __launch_bounds__(NTHR, 2) mega(Args args) {
    extern __shared__ __attribute__((aligned(16))) unsigned char lds_[];
#define PHASE_FRAME() Frame F; { int t_ = (int)threadIdx.x; asm volatile("" : "+v"(t_)); GAS unsigned char* wg_ = (GAS unsigned char*)args.ws; asm volatile("" : "+s"(wg_)); unsigned char* w_ = (unsigned char*)wg_; int bx_ = (int)blockIdx.x; asm volatile("" : "+s"(bx_)); \
        F.lds = (LAS unsigned char*)lds_; F.ws = w_; F.ctl = (gu32*)(w_ + WS_CTL); F.in = args.in; F.out = args.out; F.tid = t_; F.lane = t_ & 63; F.wave = __builtin_amdgcn_readfirstlane(t_ >> 6); \
        F.G = (int)gridDim.x; F.vcu = (F.G % 8 == 0) ? (bx_ % 8) * (F.G / 8) + bx_ / 8 : bx_; } unsigned char* ws = F.ws; LAS unsigned char* ring = F.lds + RING_OFF; (void)ws; (void)ring
    Frame F0; { F0.lds = (LAS unsigned char*)lds_; F0.ws = args.ws; F0.ctl = (gu32*)(args.ws + WS_CTL); F0.tid = threadIdx.x; }
    volatile LAS unsigned* MISC = (volatile LAS unsigned*)(F0.lds + LDS_MISC);
    if (F0.tid < 64) MISC[F0.tid] = 0u;
    __syncthreads();
    const int lo = args.ph_lo, hi = args.ph_hi;
    const bool one = (hi - lo) > 1;
    XcdBarrier bar; bar.bar = (unsigned*)(F0.ctl + CW_BAR); bar.x = 0; bar.st = nullptr;
    if (one) bar = xcd_barrier_post((unsigned*)(F0.ctl + CW_BAR), MISC + 8);
#ifndef PH_MASK
#define PH_MASK 0xFFFFFFFFu
#endif
#define IN(k) ((((PH_MASK) >> (k)) & 1u) && lo <= (k) && (k) < hi)
#ifndef ABL
#define ABL 0
#endif
#ifndef DUP_PHASE
#define DUP_PHASE -1
#endif
#define REP(k) for (int rep = ((k) == DUP_PHASE ? 0 : 1); rep < 2; ++rep)
#define REPSYNC() do { if (rep == 0) xcd_barrier(bar); } while (0)
#ifndef BARX
#define BARX 1
#endif
#define SEAM(k) do { if (IN(k) && IN((k) + 1)) { for (int bx_ = 0; bx_ < BARX; ++bx_) xcd_barrier(bar); } } while (0)

    if (IN(0)) REP(0) { PHASE_FRAME(); const bool dry = (rep == 0); (void)dry; p0_prologue(F); REPSYNC(); } SEAM(0);
    if (IN(1)) REP(1) { PHASE_FRAME(); const bool dry = (rep == 0); (void)dry; Gemm g{(const bf16_t*)(ws + S_XB), (const bf16_t*)(ws + WS_W0IN), T, 1536, 1024, 1024, nullptr}; pg8::StaticOrder So; So.init(T, 1536, F.G, (int)blockIdx.x);
        EpiTile E{(bf16_t*)(ws + S_H0B), 1536, 4, 0, 1.f, 0};
        pg8::gemm_phase<EpiTile, pg8::StaticOrder, true, true>(ring, g, So, E); REPSYNC(); } SEAM(1);
    if (IN(2)) REP(2) { PHASE_FRAME(); const bool dry = (rep == 0); (void)dry; for (int it = F.vcu * NWAVES + F.wave; it < 2048; it += F.G * NWAVES) mla_up_item(F, it);
        __syncthreads();
        for (int ch = F.vcu; ch < 256; ch += F.G) gmlp_chunk(F, ch, dry); REPSYNC(); } SEAM(2);
    if (IN(3)) REP(3) { PHASE_FRAME(); const bool dry = (rep == 0); (void)dry; for (int c = F.vcu; c < 256; c += F.G) { const int bh = c >> 1;
#pragma unroll 1
            for (int i = 0; i < 4; ++i) { const int qb = (c & 1) ? ((i == 0) ? 6 : (i == 1) ? 1 : (i == 2) ? 5 : 2) : ((i == 0) ? 7 : (i == 1) ? 0 : (i == 2) ? 4 : 3); mla_attn_unit(F, bh >> 3, bh & 7, qb, dry ? ABL : 0); } } REPSYNC(); } SEAM(3);
    if (IN(4)) REP(4) { PHASE_FRAME(); const bool dry = (rep == 0); (void)dry; Gemm g{(const bf16_t*)(ws + S_H0B), (const bf16_t*)(ws + WS_W0O), T, 1024, 1024, 1536, nullptr}; pg8::StaticOrder So; So.init(T, 1024, F.G, (int)blockIdx.x);
        EpiResid E{(const float*)args.in[0], (float*)(ws + WS_Z1)};
        pg8::gemm_phase<EpiResid, pg8::StaticOrder, true, true>(ring, g, So, E); REPSYNC(); } SEAM(4);
#pragma unroll
    for (int layer = 0; layer < 2; ++layer) {
        const int pb = layer ? 14 : 5;
        if (IN(pb)) REP(pb) { PHASE_FRAME(); const bool dry = (rep == 0); (void)dry; for (int c = F.vcu; c < 256; c += F.G) { Frame F2 = F; F2.vcu = c; ln_route_wg(F2, layer, dry ? 2 + layer : layer); } REPSYNC(); } SEAM(pb);
        if (IN(pb + 1)) REP(pb + 1) { PHASE_FRAME(); const bool dry = (rep == 0); (void)dry; for (int c = F.vcu; c < 256; c += F.G) { Frame F2 = F; F2.vcu = c; moe_gather_wg(F2, layer); } REPSYNC(); } SEAM(pb + 1);
        if (IN(pb + 2)) REP(pb + 2) { PHASE_FRAME(); const bool dry = (rep == 0); (void)dry; moe_tables(F, layer); const LAS int* eb = (const LAS int*)(F.lds + LDS_SCR + 4352);
            Gemm g{(const bf16_t*)(ws + S_X1B), (const bf16_t*)(ws + WS_WGU) + (size_t)layer * 32 * 512 * 1024, MOE_ROWS, 512, 1024, 1024, (const int*)(F.ctl + CW_ROWSRC) + layer * MOE_ROWS};
            MoeOrder<2> So{(const LAS int*)(F.lds + LDS_SCR + 4608), (eb[32] >> 8) * 2, F.G, F.vcu}; EpiMoeUp E{(bf16_t*)(ws + S_HP)};
            pg8::gemm_phase<EpiMoeUp, MoeOrder<2>, true, true, true>(ring, g, So, E); REPSYNC(); } SEAM(pb + 2);
        if (IN(pb + 3)) REP(pb + 3) { PHASE_FRAME(); const bool dry = (rep == 0); (void)dry; moe_tables(F, layer); const LAS int* eb = (const LAS int*)(F.lds + LDS_SCR + 4352);
            Gemm g{(const bf16_t*)(ws + S_HP), (const bf16_t*)(ws + WS_WD) + (size_t)layer * 32 * 1024 * 256, MOE_ROWS, 1024, 256, 256, nullptr};
            MoeOrder<4> So{(const LAS int*)(F.lds + LDS_SCR + 4608), (eb[32] >> 8) * 4, F.G, F.vcu}; EpiMoeDown E{(bf16_t*)(ws + S_YP)};
            pg8::gemm_phase<EpiMoeDown, MoeOrder<4>, false, true>(ring, g, So, E); REPSYNC(); } SEAM(pb + 3);
        if (IN(pb + 4)) REP(pb + 4) { PHASE_FRAME(); const bool dry = (rep == 0); (void)dry; for (int c = F.vcu; c < 256; c += F.G) { Frame F2 = F; F2.vcu = c; combine_wg(F2, layer, args.out, layer ? nullptr : (bf16_t*)(ws + S_X2B)); } REPSYNC(); }
        if (layer == 0) {
            SEAM(9);
            if (IN(10)) REP(10) { PHASE_FRAME(); const bool dry = (rep == 0); (void)dry; Gemm g{(const bf16_t*)(ws + S_X2B), (const bf16_t*)(ws + WS_W1IN), T, 2048, 1024, 1024, nullptr}; pg8::StaticOrder So; So.init(T, 2048, F.G, (int)blockIdx.x);
                EpiTile E{(bf16_t*)(ws + S_H1B), 2048, 0, 4, QS_NSA, 0};
                pg8::gemm_phase<EpiTile, pg8::StaticOrder, true, true>(ring, g, So, E); REPSYNC(); } SEAM(10);
            if (IN(11)) REP(11) { PHASE_FRAME(); const bool dry = (rep == 0); (void)dry; for (int it = F.vcu; it < 256; it += F.G) cmp_item(F, it); REPSYNC(); } SEAM(11);
            if (IN(12)) REP(12) { PHASE_FRAME(); const bool dry = (rep == 0); (void)dry; for (int c = F.vcu; c < 256; c += F.G) { const int bg = c >> 3, s = c & 7;
#pragma unroll 1
                    for (int i = 0; i < 8; ++i) { const int k = i >> 1; const int blk = (k == 0) ? 31 - s : (k == 1) ? 16 + s : (k == 2) ? 15 - s : s; nsa_unit(F, bg >> 1, bg & 1, blk * 2 + (i & 1), dry, dry ? ABL : 0); } } REPSYNC(); } SEAM(12);
            if (IN(13)) REP(13) { PHASE_FRAME(); const bool dry = (rep == 0); (void)dry; Gemm g{(const bf16_t*)(ws + S_H1B), (const bf16_t*)(ws + WS_W1O), T, 1024, 1024, 2048, nullptr}; pg8::StaticOrder So; So.init(T, 1024, F.G, (int)blockIdx.x);
                EpiResid E{(const float*)args.out, (float*)(ws + WS_Z1)};
                pg8::gemm_phase<EpiResid, pg8::StaticOrder, true, true>(ring, g, So, E); REPSYNC(); } SEAM(13);
        }
    }
#undef IN
#undef SEAM
}

#ifndef MK_SPLIT
#define MK_SPLIT 0
#endif
static void launch_all(void* const* d_in, float* out, unsigned char* ws, hipStream_t stream) {
    static int grid = 0;
    if (grid == 0) {
        int dev = 0, cus = 0, per_cu = 0;
        if (hipGetDevice(&dev) != hipSuccess || hipDeviceGetAttribute(&cus, hipDeviceAttributeMultiprocessorCount, dev) != hipSuccess) { grid = -1; return; }
        if (hipFuncSetAttribute((const void*)mega, hipFuncAttributeMaxDynamicSharedMemorySize, LDS_BYTES) != hipSuccess) { fprintf(stderr, "kernel_launch: hipFuncSetAttribute failed\n"); grid = -1; return; }
        if (hipOccupancyMaxActiveBlocksPerMultiprocessor(&per_cu, (const void*)mega, NTHR, LDS_BYTES) != hipSuccess || per_cu < 1) fprintf(stderr, "kernel_launch: occupancy query says %d\n", per_cu);
        (void)hipGetLastError();
        grid = cus < 256 ? cus : 256;
    }
    if (grid < 0) return;
    (void)hipMemsetAsync(ws + WS_CTL, 0, CTL_ZERO_BYTES, stream);
    Args a{};
    for (int i = 0; i < 32; ++i) a.in[i] = d_in[i];
    a.out = out; a.ws = ws;
#if MK_SPLIT
    for (int p = 0; p < NPHASE; ++p) { a.ph_lo = p; a.ph_hi = p + 1; hipLaunchKernelGGL(mega, dim3(grid), dim3(NTHR), LDS_BYTES, stream, a); }
#else
    a.ph_lo = 0; a.ph_hi = NPHASE; hipLaunchKernelGGL(mega, dim3(grid), dim3(NTHR), LDS_BYTES, stream, a);
#endif
}
}

extern "C" void kernel_launch(void* const* d_in, const int* in_sizes, int n_in, void* d_out, int out_size, void* d_ws, size_t ws_size, hipStream_t stream) {
    fk::launch_all(d_in, (float*)d_out, (unsigned char*)d_ws, stream);
}
```

```cpp
#include <hip/hip_runtime.h>
#include <stdint.h>
#include <math.h>
#include <cstdio>
namespace pg8 {
#define PG8_LAS __attribute__((address_space(3)))
typedef unsigned short bf16_t;
typedef short bf16x8 __attribute__((ext_vector_type(8)));
typedef float f32x4 __attribute__((ext_vector_type(4)));
typedef unsigned u32x4 __attribute__((ext_vector_type(4)));
constexpr int BM = 256, BK = 64, HALF = 128, HTB = HALF * BK * 2  , STAGE_BYTES = 8 * HTB, NXCD = 8, WGM = 8;

__host__ __device__ __forceinline__ int lds_byte(int r, int c) { const int st = (r >> 4) * 2 + (c >> 5), rr = r & 15, cc = c & 31, ob = rr * 64 + cc * 2; return st * 1024 + (ob ^ (((ob >> 9) & 1) << 5)); }
__host__ __device__ __forceinline__ void stage_rc(int b, int& R, int& C) { const int st = b / 1024, sb = b % 1024, swz = sb ^ (((sb >> 9) & 1) << 5); R = (st >> 1) * 16 + swz / 64; C = (st & 1) * 32 + (swz % 64) / 2; }
__host__ __device__ __forceinline__ int perm32(int rho) { const int n = rho >> 4, i = rho & 15; return 8 * (i >> 2) + 4 * n + (i & 3); }

struct Unit { int pm, pn; };
struct Gemm { const bf16_t* A; const bf16_t* Bt; int M, N, K, lda; const int* rowsrc; };

struct StaticOrder {
    int nM, nN, nwg, G, c;
    __host__ __device__ void init(int M, int N, int G_, int c_) { nM = M / BM; nN = N / BM; nwg = nM * nN; G = G_; c = c_; }
    __host__ __device__ bool next(int i, Unit& u) const {
        const long L = (long)i * G + c; if (L >= nwg) return false;
        int wgid = (int)L; { const int q = nwg / NXCD, r = nwg % NXCD, xcd = wgid % NXCD, off = wgid / NXCD; wgid = (xcd < r ? xcd * (q + 1) : r * (q + 1) + (xcd - r) * q) + off; }
        const int nig = WGM * nN, gid = wgid / nig, fm = gid * WGM, gsz = (nM - fm) < WGM ? (nM - fm) : WGM;
        u.pm = fm + ((wgid % nig) % gsz); u.pn = (wgid % nig) / gsz; return true;
    }
    __device__ __forceinline__ void a_ready(const Unit&) const {}
    __device__ __forceinline__ void done(const Unit&) const {}
};

__device__ __forceinline__ unsigned cvt_pk_bf16(float lo, float hi) { unsigned r; asm volatile("v_cvt_pk_bf16_f32 %0, %1, %2" : "=v"(r) : "v"(lo), "v"(hi)); return r; }
typedef float f32x2 __attribute__((ext_vector_type(2)));
template <class Epi, class Sched, bool ALIGN_EPI = false, bool SP2 = false, bool GATHER = false>
__device__ __forceinline__ void gemm_phase(PG8_LAS unsigned char* lds, const Gemm g, const Sched& S, const Epi& E) {
    int tid_l = (int)threadIdx.x; asm volatile("" : "+v"(tid_l));
    const int tid = tid_l, wid = __builtin_amdgcn_readfirstlane(tid >> 6), lane = tid & 63, wr = wid >> 2, wc = wid & 3, fr = lane & 15, fq = lane >> 4;
    const int K = g.K, nt = K / BK;
    unsigned voffA[2], voffB[2], voffA1[2] = {0u, 0u}, nvoffA[2] = {0u, 0u}, nvoffA1[2] = {0u, 0u}; int RA[2], CA[2];
#pragma unroll
    for (int i = 0; i < 2; ++i) { int R, C; stage_rc(tid * 16 + i * 8192, R, C); const int Rb = Epi::PERM ? ((R & ~31) + perm32(R & 31)) : R;
        voffA[i] = (unsigned)(R * g.lda + C) * 2u; voffB[i] = (unsigned)(Rb * K + C) * 2u; RA[i] = R; CA[i] = C; }
    const size_t kstep = (size_t)(BK * 2);
    const size_t hstepA = (size_t)HALF * g.lda * 2, hstepB = (size_t)HALF * K * 2;
    const size_t tstepA = 2 * hstepA, tstepB = 2 * hstepB;
    const unsigned ldsw = (unsigned)wid * 1024u;
    const int aoff = lds_byte(wr * 64 + fr, fq * 8), boff = lds_byte(wc * 32 + fr, fq * 8);
#define PG8_SA(b, h) (((b) * 2 + (h)) * HTB)
#define PG8_SB(b, h) ((4 + (b) * 2 + (h)) * HTB)
#define PG8_STAGE(bufoff, gbase, voff) do { _Pragma("unroll") for (int _i = 0; _i < 2; ++_i) \
        __builtin_amdgcn_global_load_lds((const unsigned*)((const char*)(gbase) + (voff)[_i]), (PG8_LAS unsigned*)(lds + (bufoff) + ldsw + _i * 8192), 16, 0, 0); } while (0)
#define PG8_GSET(u, v0, v1) do { _Pragma("unroll") for (int _i = 0; _i < 2; ++_i) { v0[_i] = (unsigned)(g.rowsrc[(u).pm * BM + RA[_i]] * g.lda + CA[_i]) * 2u; v1[_i] = (unsigned)(g.rowsrc[(u).pm * BM + HALF + RA[_i]] * g.lda + CA[_i]) * 2u; } } while (0)
#define PG8_STA0(slot, P, NX) do { if constexpr (GATHER) { if (NX) PG8_STAGE(slot, P, nvoffA); else PG8_STAGE(slot, P, voffA); } else PG8_STAGE(slot, P, voffA); } while (0)
#define PG8_STA1(slot, P, NX) do { if constexpr (GATHER) { if (NX) PG8_STAGE(slot, P, nvoffA1); else PG8_STAGE(slot, P, voffA1); } else PG8_STAGE(slot, (P) + hstepA, voffA); } while (0)
#define PG8_LDA(dst, b, h) do { _Pragma("unroll") for (int m = 0; m < 4; ++m) _Pragma("unroll") for (int k = 0; k < 2; ++k) dst[m][k] = *(const PG8_LAS bf16x8*)(lds + PG8_SA(b, h) + aoff + m * 2048 + k * 1024); } while (0)
#define PG8_LDB(dst, b, h) do { _Pragma("unroll") for (int n = 0; n < 2; ++n) _Pragma("unroll") for (int k = 0; k < 2; ++k) dst[n][k] = *(const PG8_LAS bf16x8*)(lds + PG8_SB(b, h) + boff + n * 2048 + k * 1024); } while (0)
#define PG8_MMA(ai, bj, At, Bt) do { __builtin_amdgcn_s_setprio(1); _Pragma("unroll") for (int m = 0; m < 4; ++m) _Pragma("unroll") for (int n = 0; n < 2; ++n) _Pragma("unroll") for (int k = 0; k < 2; ++k) \
        acc[ai][bj][m][n] = __builtin_amdgcn_mfma_f32_16x16x32_bf16(Bt[n][k], At[m][k], acc[ai][bj][m][n], 0, 0, 0); __builtin_amdgcn_s_setprio(0); } while (0)
#define PG8_WAIT_V(n) asm volatile("s_waitcnt vmcnt(" #n ")" ::: "memory")
#define PG8_WAIT_L(n) asm volatile("s_waitcnt lgkmcnt(" #n ")" ::: "memory")
#define PG8_BAR __builtin_amdgcn_s_barrier()
#define PG8_SCHED __builtin_amdgcn_sched_barrier(0)
    Unit cur, nxt; int ui = 0;
    if (!S.next(0, cur)) return;
    f32x4 acc[2][2][4][2];
#pragma unroll
    for (int a = 0; a < 2; ++a)
#pragma unroll
        for (int b = 0; b < 2; ++b)
#pragma unroll
            for (int m = 0; m < 4; ++m)
#pragma unroll
                for (int n = 0; n < 2; ++n) acc[a][b][m][n] = (f32x4){0.f, 0.f, 0.f, 0.f};
    bf16x8 At[4][2], B0[2][2], B1[2][2];
    const char* cA = GATHER ? (const char*)g.A : (const char*)g.A + (size_t)cur.pm * tstepA; if constexpr (GATHER) PG8_GSET(cur, voffA, voffA1);
    const char* cB = (const char*)g.Bt + (size_t)cur.pn * tstepB;
    S.a_ready(cur);
    if constexpr (SP2) {
        PG8_STAGE(PG8_SB(0, 0), cB, voffB); PG8_STAGE(PG8_SB(0, 1), cB + hstepB, voffB); PG8_STA0(PG8_SA(0, 0), cA, false); PG8_STA1(PG8_SA(0, 1), cA, false);
        if (wr == 1) PG8_BAR;
        PG8_WAIT_V(2); PG8_BAR;
        PG8_STAGE(PG8_SB(1, 0), cB + kstep, voffB); PG8_STA0(PG8_SA(1, 0), cA + kstep, false); PG8_STAGE(PG8_SB(1, 1), cB + hstepB + kstep, voffB);
        PG8_WAIT_V(6); PG8_BAR;
    } else {
        PG8_STAGE(PG8_SB(0, 0), cB, voffB); PG8_STA0(PG8_SA(0, 0), cA, false); PG8_STAGE(PG8_SB(0, 1), cB + hstepB, voffB); PG8_STA1(PG8_SA(0, 1), cA, false);
        if (wr == 1) PG8_BAR;
        PG8_WAIT_V(4); PG8_BAR;
        PG8_STAGE(PG8_SB(1, 0), cB + kstep, voffB); PG8_STA0(PG8_SA(1, 0), cA + kstep, false); PG8_STAGE(PG8_SB(1, 1), cB + hstepB + kstep, voffB);
        PG8_WAIT_V(6); PG8_BAR;
    }
    for (;;) {
        const bool has_next = S.next(ui + 1, nxt);
        const char* nA = has_next ? (GATHER ? (const char*)g.A : (const char*)g.A + (size_t)nxt.pm * tstepA) : cA; if constexpr (GATHER) { if (has_next) PG8_GSET(nxt, nvoffA, nvoffA1); } const char* nB = has_next ? (const char*)g.Bt + (size_t)nxt.pn * tstepB : cB;
        for (int t = 0; t < nt; t += 2) {
            const bool last = (t == nt - 2);
            const char* a1 = cA + (size_t)(t + 1) * kstep;
            const char* a2 = last ? nA : cA + (size_t)(t + 2) * kstep; const char* b2 = last ? nB : cB + (size_t)(t + 2) * kstep;
            const char* a3 = a2 + kstep; const char* b3 = b2 + kstep;
            if (last && has_next) S.a_ready(nxt);
            if constexpr (SP2) {
            PG8_LDB(B0, 0, 0); PG8_LDB(B1, 0, 1); PG8_SCHED; PG8_LDA(At, 0, 0); PG8_STA1(PG8_SA(1, 1), a1, false);
            PG8_WAIT_V(8); PG8_WAIT_L(0); PG8_BAR; PG8_MMA(0, 0, At, B0); PG8_MMA(0, 1, At, B1); PG8_BAR; PG8_SCHED;
            PG8_LDA(At, 0, 1); PG8_STAGE(PG8_SB(0, 0), b2, voffB); PG8_STAGE(PG8_SB(0, 1), b2 + hstepB, voffB); PG8_STA0(PG8_SA(0, 0), a2, last && has_next);
            PG8_WAIT_V(8); PG8_WAIT_L(0); PG8_BAR; PG8_MMA(1, 0, At, B0); PG8_MMA(1, 1, At, B1); PG8_BAR; PG8_SCHED;
            PG8_LDB(B0, 1, 0); PG8_LDB(B1, 1, 1); PG8_SCHED; PG8_LDA(At, 1, 0); PG8_STA1(PG8_SA(0, 1), a2, last && has_next);
            PG8_WAIT_V(8); PG8_WAIT_L(0); PG8_BAR; PG8_MMA(0, 0, At, B0); PG8_MMA(0, 1, At, B1); PG8_BAR; PG8_SCHED;
            PG8_LDA(At, 1, 1); PG8_STAGE(PG8_SB(1, 0), b3, voffB); PG8_STAGE(PG8_SB(1, 1), b3 + hstepB, voffB); PG8_STA0(PG8_SA(1, 0), a3, last && has_next);
            PG8_WAIT_V(8); PG8_WAIT_L(0); PG8_BAR; PG8_MMA(1, 0, At, B0); PG8_MMA(1, 1, At, B1); PG8_BAR; PG8_SCHED;
            } else {
            PG8_LDB(B0, 0, 0); PG8_SCHED; PG8_LDA(At, 0, 0); PG8_STA1(PG8_SA(1, 1), a1, false);
            PG8_WAIT_L(8); PG8_BAR; PG8_WAIT_L(0); PG8_MMA(0, 0, At, B0); PG8_BAR; PG8_SCHED;
            PG8_LDB(B1, 0, 1); PG8_STAGE(PG8_SB(0, 0), b2, voffB);
            PG8_BAR; PG8_WAIT_L(0); PG8_MMA(0, 1, At, B1); PG8_BAR;
            PG8_LDA(At, 0, 1); PG8_STA0(PG8_SA(0, 0), a2, last && has_next);
            PG8_BAR; PG8_WAIT_L(0); PG8_MMA(1, 0, At, B0); PG8_BAR; PG8_SCHED;
            PG8_STAGE(PG8_SB(0, 1), b2 + hstepB, voffB);
            PG8_WAIT_V(6); PG8_BAR; PG8_MMA(1, 1, At, B1); PG8_BAR;
            PG8_LDB(B0, 1, 0); PG8_SCHED; PG8_LDA(At, 1, 0); PG8_STA1(PG8_SA(0, 1), a2, last && has_next);
            PG8_WAIT_L(8); PG8_BAR; PG8_WAIT_L(0); PG8_MMA(0, 0, At, B0); PG8_BAR; PG8_SCHED;
            PG8_LDB(B1, 1, 1); PG8_STAGE(PG8_SB(1, 0), b3, voffB);
            PG8_BAR; PG8_WAIT_L(0); PG8_MMA(0, 1, At, B1); PG8_BAR;
            PG8_LDA(At, 1, 1); PG8_STA0(PG8_SA(1, 0), a3, last && has_next);
            PG8_BAR; PG8_WAIT_L(0); PG8_MMA(1, 0, At, B0); PG8_BAR; PG8_SCHED;
            PG8_STAGE(PG8_SB(1, 1), b3 + hstepB, voffB);
            PG8_WAIT_V(6); PG8_BAR; PG8_MMA(1, 1, At, B1); PG8_BAR;
            }
        }
        if constexpr (ALIGN_EPI) { if (wr == 0) PG8_BAR; }
        if constexpr (!Epi::AFTER_DRAIN) { E(acc, cur, wr, wc, fr, fq); S.done(cur); }
        if (!has_next) break;
#pragma unroll
        for (int a = 0; a < 2; ++a)
#pragma unroll
            for (int b = 0; b < 2; ++b)
#pragma unroll
                for (int m = 0; m < 4; ++m)
#pragma unroll
                    for (int n = 0; n < 2; ++n) acc[a][b][m][n] = (f32x4){0.f, 0.f, 0.f, 0.f};
        cur = nxt; cA = nA; cB = nB; ++ui;
        if constexpr (GATHER) { voffA[0] = nvoffA[0]; voffA[1] = nvoffA[1]; voffA1[0] = nvoffA1[0]; voffA1[1] = nvoffA1[1]; }
        if constexpr (ALIGN_EPI) { if (wr == 1) PG8_BAR; }
    }
    PG8_WAIT_V(0);
    if constexpr (!ALIGN_EPI) { if (wr == 0) PG8_BAR; }
    PG8_BAR;
    if constexpr (Epi::AFTER_DRAIN) { E.fused(acc, cur, wr, wc, fr, fq, lds, wid, lane); S.done(cur); }
#undef PG8_SA
#undef PG8_SB
#undef PG8_STAGE
#undef PG8_GSET
#undef PG8_STA0
#undef PG8_STA1
#undef PG8_LDA
#undef PG8_LDB
#undef PG8_MMA
#undef PG8_WAIT_V
#undef PG8_WAIT_L
#undef PG8_BAR
#undef PG8_SCHED
}
}
#define GAS __attribute__((address_space(1)))
#define LAS __attribute__((address_space(3)))
typedef unsigned short bf16;
typedef unsigned v4u __attribute__((ext_vector_type(4)));
typedef float f32x4 __attribute__((ext_vector_type(4)));
typedef short bf16x8 __attribute__((ext_vector_type(8)));
typedef GAS unsigned gu32;
typedef GAS unsigned long long gu64;
#define RLX_AGENT __ATOMIC_RELAXED, __HIP_MEMORY_SCOPE_AGENT
#define LDS_WAIT() asm volatile("s_waitcnt lgkmcnt(0)" ::: "memory")
#define VM_WAIT() asm volatile("s_waitcnt vmcnt(0)" ::: "memory")
__device__ __forceinline__ unsigned long long rt() { return __builtin_amdgcn_s_memrealtime(); }
__device__ __forceinline__ unsigned f2bf(float f) { unsigned u = __builtin_bit_cast(unsigned, f); return (u + 0x7fffu + ((u >> 16) & 1u)) >> 16; }
__device__ __forceinline__ unsigned pk2(float lo, float hi) { return f2bf(lo) | (f2bf(hi) << 16); }

#define XB_TMO      128
#define XB_XCNT(j)  (256  + 64 * (j))
#define XB_XSUB(j)  (1280 + 64 * (j))
#define XB_XGEN(j)  (2304 + 64 * (j))
#define XB_TOP      3328
#define XB_TOPGEN   3392
#define XCD_BAR_WORDS 3456
#define XB_SPIN_CAP (1u << 18)

__device__ __forceinline__ unsigned xb_ld(unsigned* p)              { return __hip_atomic_load(p, __ATOMIC_RELAXED, __HIP_MEMORY_SCOPE_AGENT); }
__device__ __forceinline__ unsigned xb_add(unsigned* p, unsigned v) { return __hip_atomic_fetch_add(p, v, __ATOMIC_RELAXED, __HIP_MEMORY_SCOPE_AGENT); }
__device__ __forceinline__ unsigned xb_xcc_id() { return (unsigned)__builtin_amdgcn_s_getreg((3 << 11) | 20) & 0xFu; }
#define XB_SPIN(cond, bar) do { unsigned _sp = 0; while (cond) { __builtin_amdgcn_s_sleep(1); \
    if ((++_sp & 255u) == 0u) { if (xb_ld(&(bar)[XB_TMO])) break; if (_sp > XB_SPIN_CAP) { atomicAdd(&(bar)[XB_TMO], 1u); break; } } } } while (0)

struct XcdBarrier {
    unsigned* bar; unsigned x;
    volatile LAS unsigned* st;
};

__device__ __forceinline__ XcdBarrier xcd_barrier_post(unsigned* bar, volatile LAS unsigned* st) {
    XcdBarrier b; b.bar = bar; b.x = xb_xcc_id(); b.st = st;
    if (threadIdx.x == 0) (void)xb_add(&bar[XB_XCNT(b.x)], 1u);
    return b;
}
__device__ __forceinline__ void xcd_barrier_complete(unsigned* bar, unsigned x, unsigned& nloc, unsigned& nx) {
    const unsigned G = gridDim.x * gridDim.y * gridDim.z;
    unsigned sum, cnt, mine, sp = 0u;
    for (;;) {
        sum = 0u; cnt = 0u; mine = 0u;
#pragma unroll
        for (unsigned j = 0; j < 16; ++j) { const unsigned c = xb_ld(&bar[XB_XCNT(j)]); sum += c; cnt += (c > 0u) ? 1u : 0u; mine = (j == x) ? c : mine; }
        if (sum == G) break;
        __builtin_amdgcn_s_sleep(1);
        if ((++sp & 255u) == 0u) { if (xb_ld(&bar[XB_TMO])) break; if (sp > XB_SPIN_CAP) { atomicAdd(&bar[XB_TMO], 1u); break; } }
    }
    nloc = mine > 0u ? mine : 1u; nx = cnt > 0u ? cnt : 1u;
}

__device__ __forceinline__ void xcd_barrier(const XcdBarrier& b) {
    asm volatile("s_waitcnt vmcnt(0)" ::: "memory");
    __syncthreads();
    if (threadIdx.x == 0) {
        unsigned* bar = b.bar;
        __builtin_amdgcn_s_waitcnt(0);
        unsigned nloc = b.st[0], nx = b.st[1];
        if (nloc == 0u) { xcd_barrier_complete(bar, b.x, nloc, nx); b.st[0] = nloc; b.st[1] = nx; }
        const unsigned old = xb_add(&bar[XB_XSUB(b.x)], 1u);
        const unsigned gen = old / nloc;
        if (old + 1u == (gen + 1u) * nloc) {
            __builtin_amdgcn_fence(__ATOMIC_RELEASE, "agent");
            asm volatile("s_waitcnt vmcnt(0)" ::: "memory");
            const unsigned og = xb_add(&bar[XB_TOP], 1u);
            const unsigned tg = og / nx;
            if (og + 1u == (tg + 1u) * nx) xb_add(&bar[XB_TOPGEN], 1u);
            else XB_SPIN(xb_ld(&bar[XB_TOPGEN]) == tg, bar);
            __builtin_amdgcn_fence(__ATOMIC_ACQUIRE, "agent");
            xb_add(&bar[XB_XGEN(b.x)], 1u);
            asm volatile("s_waitcnt vmcnt(0)" ::: "memory");
        } else {
            XB_SPIN(xb_ld(&bar[XB_XGEN(b.x)]) == gen, bar);
            __builtin_amdgcn_fence(__ATOMIC_ACQUIRE, "agent");
            asm volatile("s_waitcnt vmcnt(0)" ::: "memory");
        }
    }
    __syncthreads();
}
namespace fk {
using pg8::bf16_t; using pg8::f32x4; using pg8::u32x4; using pg8::Unit; using pg8::Gemm;
typedef float f32x16 __attribute__((ext_vector_type(16)));
typedef float f32x2 __attribute__((ext_vector_type(2)));
typedef unsigned u32x2 __attribute__((ext_vector_type(2)));
typedef short s16x4 __attribute__((ext_vector_type(4)));
constexpr int NB = 16, S = 2048, D = 1024, T = NB * S;
constexpr float ALPHA = 1.41421356237309515f, LN_EPS = 1e-5f, LOG2E = 1.4426950408889634f;
constexpr float QS_MLA = 0.10206207261596575f * LOG2E;
constexpr float QS_NSA = 0.125f * LOG2E;
constexpr int NWAVES = 8, NTHR = 512;
constexpr int MOE_ROWS = 73728, MOE_PANELS = MOE_ROWS / 256;

constexpr size_t MiB = 1u << 20;
constexpr size_t WS_CTL = 0, CTL_ZERO_BYTES = 1 * MiB;
constexpr size_t WS_W0IN = 1 * MiB, WS_WUQ = 4 * MiB, WS_WUKV = WS_WUQ + 512 * 1024, WS_W0O = 5 * MiB, WS_W1IN = 7 * MiB, WS_WCK1 = 11 * MiB, WS_WCV1 = 12 * MiB,
                 WS_WCK2 = 13 * MiB, WS_WCV2 = 13 * MiB + 64 * 1024, WS_WSB = 13 * MiB + 128 * 1024, WS_CBIAS = 13 * MiB + 512 * 1024, WS_W1O = 14 * MiB, WS_WGU = 16 * MiB, WS_WD = 80 * MiB;
constexpr size_t WS_Z1 = 113 * MiB;
constexpr size_t WS_STATS = 241 * MiB;
constexpr size_t WS_ROUTE = WS_STATS + 256 * 1024;
constexpr size_t WS_S = 242 * MiB;
constexpr size_t S_XB = WS_S, S_H0B = WS_S + 64 * MiB, S_Q96 = WS_S, S_KN = WS_S + 160 * MiB, S_V = WS_S + 192 * MiB, S_KRB = WS_S + 224 * MiB;
constexpr size_t S_X1B = WS_S, S_XP = WS_S + 64 * MiB, S_HP = WS_S + 208 * MiB, S_YP = WS_S, S_X2B = WS_S + 144 * MiB;
constexpr size_t S_H1B = WS_S, S_KCMP = WS_S + 208 * MiB, S_VCMP = S_KCMP + 1 * MiB;
constexpr size_t WS_END = WS_S + 244 * MiB;
static_assert(WS_END <= 512 * MiB, "workspace map");
constexpr int CW_BAR = 4096, CW_CNT = 16384  , CW_ROWSRC = 32768  ;
static_assert((CW_ROWSRC + 2 * 73728) * 4 <= (int)CTL_ZERO_BYTES, "control words inside the per-call memset");

constexpr int RING_OFF = 0, LDS_MISC = 139264, LDS_SCR = LDS_MISC + 256, LDS_BYTES = 163840;

struct Args { const void* in[32]; float* out; unsigned char* ws; int ph_lo, ph_hi; };

__device__ __forceinline__ float bf2f(unsigned short b) { return __uint_as_float((unsigned)b << 16); }
__device__ __forceinline__ unsigned pk(float lo, float hi) { return pg8::cvt_pk_bf16(lo, hi); }
template <int CTRL> __device__ __forceinline__ float dppf(float v) { return __builtin_bit_cast(float, __builtin_amdgcn_update_dpp(0, __builtin_bit_cast(int, v), CTRL, 0xf, 0xf, true)); }
__device__ __forceinline__ float wsum(float v) {
    v += dppf<0xB1>(v); v += dppf<0x4E>(v); v += dppf<0x141>(v); v += dppf<0x140>(v);
    const int b = __builtin_bit_cast(int, v);
    return (__builtin_bit_cast(float, __builtin_amdgcn_readlane(b, 0)) + __builtin_bit_cast(float, __builtin_amdgcn_readlane(b, 16))) + (__builtin_bit_cast(float, __builtin_amdgcn_readlane(b, 32)) + __builtin_bit_cast(float, __builtin_amdgcn_readlane(b, 48)));
}
__device__ __forceinline__ int launder(int x) { asm volatile("" : "+v"(x)); return x; }
__device__ __forceinline__ float ex2(float x) { return __builtin_amdgcn_exp2f(x); }
__device__ __forceinline__ float gelu_t(float x) {
    const float u = 0.7978845608028654f * (x + 0.044715f * x * x * x);
    return x * __builtin_amdgcn_rcpf(1.f + ex2(-2.f * LOG2E * u));
}
__device__ __forceinline__ int crow(int r, int hi) { return (r & 3) + 8 * (r >> 2) + 4 * hi; }
__device__ __forceinline__ f32x16 mfma32(bf16x8 a, bf16x8 b, f32x16 c) { return __builtin_amdgcn_mfma_f32_32x32x16_bf16(a, b, c, 0, 0, 0); }
__device__ __forceinline__ bf16x8 ld8g(const bf16_t* p) { return *(const bf16x8*)p; }
typedef short v4i16_t __attribute__((ext_vector_type(4)));
__device__ __forceinline__ s16x4 trld(const LAS unsigned char* p) { return __builtin_bit_cast(s16x4, __builtin_amdgcn_ds_read_tr16_b64_v4i16((LAS v4i16_t*)p)); }

struct Frame {
    LAS unsigned char* lds; gu32* ctl; unsigned char* ws;
    int tid, lane, wave, vcu, G;
    const void* const* in; float* out;
};

struct EpiTile {
    static constexpr bool PERM = true, AFTER_DRAIN = false;
    bf16_t* O; int ldc; int ngelu; int nscale; float scale; int pad;
    __device__ __forceinline__ void operator()(const f32x4 (&acc)[2][2][4][2], const Unit& u, int wr, int wc, int fr, int fq) const {
        const int row0 = u.pm * 256 + wr * 64 + fr, col0 = u.pn * 256 + wc * 32 + 8 * fq;
        const bool dg = u.pn < ngelu; const float sc = (u.pn < nscale) ? scale : 1.f;
#pragma unroll
        for (int ai = 0; ai < 2; ++ai)
#pragma unroll
            for (int m = 0; m < 4; ++m) { bf16_t* rowp = O + (size_t)(row0 + ai * 128 + m * 16) * ldc + col0;
#pragma unroll
                for (int bj = 0; bj < 2; ++bj) { f32x4 v0 = acc[ai][bj][m][0], v1 = acc[ai][bj][m][1];
                    if (dg) { v0 = (f32x4){gelu_t(v0[0]), gelu_t(v0[1]), gelu_t(v0[2]), gelu_t(v0[3])}; v1 = (f32x4){gelu_t(v1[0]), gelu_t(v1[1]), gelu_t(v1[2]), gelu_t(v1[3])}; }
                    v0 = v0 * sc; v1 = v1 * sc;
                    u32x4 w; w.x = pk(v0[0], v0[1]); w.y = pk(v0[2], v0[3]); w.z = pk(v1[0], v1[1]); w.w = pk(v1[2], v1[3]);
                    *(u32x4*)(rowp + bj * 128) = w; } }
    }
};
struct EpiResid {
    static constexpr bool PERM = false, AFTER_DRAIN = false;
    const float* X; float* Z;
    __device__ __forceinline__ void operator()(const f32x4 (&acc)[2][2][4][2], const Unit& u, int wr, int wc, int fr, int fq) const {
        const int col0 = u.pn * 256 + wc * 32 + 4 * fq;
#pragma unroll
        for (int ai = 0; ai < 2; ++ai)
#pragma unroll
            for (int mp = 0; mp < 2; ++mp) { f32x4 x[2][2][2];
#pragma unroll
                for (int m2 = 0; m2 < 2; ++m2) { const size_t off = (size_t)(u.pm * 256 + ai * 128 + wr * 64 + (2 * mp + m2) * 16 + fr) * D + col0;
#pragma unroll
                    for (int bj = 0; bj < 2; ++bj)
#pragma unroll
                        for (int n = 0; n < 2; ++n) x[m2][bj][n] = *(const f32x4*)(X + off + bj * 128 + n * 16); }
#pragma unroll
                for (int m2 = 0; m2 < 2; ++m2) { const size_t off = (size_t)(u.pm * 256 + ai * 128 + wr * 64 + (2 * mp + m2) * 16 + fr) * D + col0;
#pragma unroll
                    for (int bj = 0; bj < 2; ++bj)
#pragma unroll
                        for (int n = 0; n < 2; ++n) *(f32x4*)(Z + off + bj * 128 + n * 16) = x[m2][bj][n] * ALPHA + acc[ai][bj][2 * mp + m2][n]; } }
    }
};
struct EpiMoeUp {
    static constexpr bool PERM = true, AFTER_DRAIN = false;
    bf16_t* H;
    __device__ __forceinline__ void operator()(const f32x4 (&acc)[2][2][4][2], const Unit& u, int wr, int wc, int fr, int fq) const {
        const int row0 = u.pm * 256 + wr * 64 + fr, col0 = (u.pn & 1) * 128 + wc * 16 + 4 * fq;
#pragma unroll
        for (int ai = 0; ai < 2; ++ai)
#pragma unroll
            for (int m = 0; m < 4; ++m) { bf16_t* rowp = H + (size_t)(row0 + ai * 128 + m * 16) * 256 + col0;
#pragma unroll
                for (int bj = 0; bj < 2; ++bj) { const f32x4 g = acc[ai][bj][m][0], up = acc[ai][bj][m][1]; f32x4 h;
#pragma unroll
                    for (int e = 0; e < 4; ++e) h[e] = g[e] * __builtin_amdgcn_rcpf(1.f + ex2(-LOG2E * g[e])) * up[e];
                    u32x2 w; w.x = pk(h[0], h[1]); w.y = pk(h[2], h[3]); *(u32x2*)(rowp + bj * 64) = w; } }
    }
};
struct EpiMoeDown {
    static constexpr bool PERM = true, AFTER_DRAIN = false;
    bf16_t* Y;
    __device__ __forceinline__ void operator()(const f32x4 (&acc)[2][2][4][2], const Unit& u, int wr, int wc, int fr, int fq) const {
        const int row0 = u.pm * 256 + wr * 64 + fr, col0 = (u.pn & 3) * 256 + wc * 32 + 8 * fq;
#pragma unroll
        for (int ai = 0; ai < 2; ++ai)
#pragma unroll
            for (int m = 0; m < 4; ++m) { bf16_t* rowp = Y + (size_t)(row0 + ai * 128 + m * 16) * D + col0;
#pragma unroll
                for (int bj = 0; bj < 2; ++bj) { const f32x4 v0 = acc[ai][bj][m][0], v1 = acc[ai][bj][m][1];
                    u32x4 w; w.x = pk(v0[0], v0[1]); w.y = pk(v0[2], v0[3]); w.z = pk(v1[0], v1[1]); w.w = pk(v1[2], v1[3]);
                    *(u32x4*)(rowp + bj * 128) = w; } }
    }
};
template <int NC> struct MoeOrder {
    const LAS int* pe; int nunits, G, c;
    __device__ __forceinline__ bool next(int i, Unit& u) const { const int L = i * G + c; if (L >= nunits) return false; const int p = L / NC; u.pm = p; u.pn = pe[p] * NC + (L % NC); return true; }
    __device__ __forceinline__ void a_ready(const Unit&) const {}
    __device__ __forceinline__ void done(const Unit&) const {}
};

__device__ __forceinline__ void p0_load(float (&wv)[32], const float* W, int ldw, int N, int item, int lane) {
    const int nblk = (N + 31) / 32, kb = item / nblk, nb = item % nblk, k0 = 64 * kb, n0 = 32 * nb, nn = n0 + (lane & 31);
#pragma unroll
    for (int i = 0; i < 32; ++i) { const int kk = 2 * i + (lane >> 5); wv[i] = (nn < N) ? W[(size_t)(k0 + kk) * ldw + nn] : 0.f; }
}
__device__ __forceinline__ void p0_finish(const float (&wv)[32], int K, int N, bf16_t* WT, int rmode, int row_off, const float* kscale, LAS float* scr, int item, int lane) {
    const int nblk = (N + 31) / 32, kb = item / nblk, nb = item % nblk, k0 = 64 * kb, n0 = 32 * nb;
#pragma unroll
    for (int i = 0; i < 32; ++i) { const int kk = 2 * i + (lane >> 5); float v = wv[i]; if (kscale) v *= kscale[k0 + kk]; scr[kk * 33 + (lane & 31)] = v; }
    LDS_WAIT(); asm volatile("" ::: "memory");
    const int c = lane & 7;
#pragma unroll
    for (int j = 0; j < 4; ++j) { const int n = (lane >> 3) + 8 * j; const LAS float* s = scr + (8 * c) * 33 + n;
        v4u o; o.x = pk(s[0 * 33], s[1 * 33]); o.y = pk(s[2 * 33], s[3 * 33]); o.z = pk(s[4 * 33], s[5 * 33]); o.w = pk(s[6 * 33], s[7 * 33]);
        const int ng = n0 + n; const int r = (rmode == 0) ? row_off + ng : (row_off + (ng >> 2) * 8 + (rmode == 2 ? 4 : 0) + (ng & 3));
        *(GAS v4u*)(WT + (size_t)r * K + k0 + 8 * c) = o; }
    LDS_WAIT(); asm volatile("" ::: "memory");
}
__device__ __forceinline__ void p0_item(const float* W, int ldw, int K, int N, bf16_t* WT, int rmode, int row_off, const float* kscale, LAS float* scr, int item, int lane) {
    float wv[32]; p0_load(wv, W, ldw, N, item, lane); p0_finish(wv, K, N, WT, rmode, row_off, kscale, scr, item, lane);
}
struct ConvJob { const float* W; int ldw, K, N; bf16_t* WT; int rmode, row_off; const float* kscale; int nitems; };

__device__ __forceinline__ void p0_prologue(Frame& F) {
    LAS float* scr = (LAS float*)(F.lds + RING_OFF + F.wave * 16384);
    const int gw = F.vcu * NWAVES + F.wave, NGW = F.G * NWAVES;
    unsigned char* ws = F.ws;
    {
        const float* in2 = (const float*)F.in[2];
#define JOB(Wp, ldw_, K_, N_, dst, rm, ro, ks) { const int nit = ((K_) / 64) * (((N_) + 31) / 32); if (it < nit) { p0_item((const float*)(Wp), ldw_, K_, N_, (bf16_t*)(dst), rm, ro, ks, scr, it, F.lane); continue; } it -= nit; }
        constexpr int TOT = 16 * 45 + 4 * 24 + 2 * 16 + 2 * 16 + 16 * 32 + 16 * 58 + 32 * 8 * 2 + 4 * 2 * 2 + 16 * 32;
        for (int it0 = gw; it0 < TOT; it0 += NGW) { int it = it0;
            JOB(in2, 1440, 1024, 1440, ws + WS_W0IN, 0, 0, nullptr)
            JOB(F.in[9], 768, 256, 768, ws + WS_WUQ, 0, 0, (const float*)F.in[7])
            JOB(F.in[10], 512, 128, 512, ws + WS_WUKV, 0, 0, (const float*)F.in[8])
            JOB(F.in[11], 512, 128, 512, ws + WS_WUKV, 0, 512, (const float*)F.in[8])
            JOB(F.in[12], 1024, 1024, 1024, ws + WS_W0O, 0, 0, nullptr)
            JOB(F.in[13], 1840, 1024, 1840, ws + WS_W1IN, 0, 0, nullptr)
            JOB(F.in[15], 256, 2048, 256, ws + WS_WCK1, 0, 0, nullptr)
            JOB(F.in[17], 256, 2048, 256, ws + WS_WCV1, 0, 0, nullptr)
            JOB(F.in[16], 64, 256, 64, ws + WS_WCK2, 0, 0, nullptr)
            JOB(F.in[18], 64, 256, 64, ws + WS_WCV2, 0, 0, nullptr)
            JOB(F.in[20], 1024, 1024, 1024, ws + WS_W1O, 0, 0, nullptr)
        }
#undef JOB
    }
    {
        constexpr int IG = 16 * 8, ID = 4 * 32, PER = 2 * IG + ID;
        for (int it0 = gw; it0 < 64 * PER; it0 += NGW) { const int le = it0 / PER; int it = it0 % PER;
            bf16_t* gu = (bf16_t*)(ws + WS_WGU) + (size_t)le * 512 * 1024; bf16_t* wd = (bf16_t*)(ws + WS_WD) + (size_t)le * 1024 * 256;
            if (it < IG) { p0_item((const float*)F.in[25] + (size_t)le * 1024 * 256, 256, 1024, 256, gu, 1, 0, nullptr, scr, it, F.lane); continue; } it -= IG;
            if (it < IG) { p0_item((const float*)F.in[26] + (size_t)le * 1024 * 256, 256, 1024, 256, gu, 2, 0, nullptr, scr, it, F.lane); continue; } it -= IG;
            p0_item((const float*)F.in[27] + (size_t)le * 256 * 1024, 1024, 256, 1024, wd, 0, 0, nullptr, scr, it, F.lane);
        }
    }
    const int gt = F.vcu * NTHR + F.tid, NGT = F.G * NTHR;
    { v4u z = {0u, 0u, 0u, 0u};
      for (int i = gt; i < 96 * 128; i += NGT) *(GAS v4u*)((bf16_t*)(ws + WS_W0IN) + (size_t)1440 * 1024 + (size_t)i * 8) = z;
      for (int i = gt; i < 192 * 128; i += NGT) *(GAS v4u*)((bf16_t*)(ws + WS_W1IN) + (size_t)1856 * 1024 + (size_t)i * 8) = z; }
    { const float* gws = (const float*)F.in[5]; bf16_t* wsb = (bf16_t*)(ws + WS_WSB);
      for (int i = gt; i < 4 * 128 * 128; i += NGT) { const int s = i & 127, t = (i >> 7) & 127; wsb[i] = (bf16_t)(pk(s <= t ? gws[i] : 0.f, 0.f) & 0xffffu); } }
    {
      float* cb = (float*)(ws + WS_CBIAS);
      for (int o = gw; o < 512; o += NGW) { const int kv = o >> 8, h = o & 255; const float* pos = (const float*)F.in[14] + kv * 2048; const float* w1 = (const float*)F.in[kv ? 17 : 15];
          float a = 0.f; for (int k = F.lane; k < 2048; k += 64) a += pos[k] * w1[(size_t)k * 256 + h];
          a = wsum(a); if (F.lane == 0) cb[o] = a; } }
    { const float* x = (const float*)F.in[0]; bf16_t* xb = (bf16_t*)(ws + S_XB);
#pragma unroll 4
      for (int i = gt; i < T * D / 8; i += NGT) { const f32x4 a = *(const GAS f32x4*)(x + (size_t)i * 8), b = *(const GAS f32x4*)(x + (size_t)i * 8 + 4);
          v4u o; o.x = pk(a[0], a[1]); o.y = pk(a[2], a[3]); o.z = pk(b[0], b[1]); o.w = pk(b[2], b[3]); *(GAS v4u*)(xb + (size_t)i * 8) = o; } }
}

__device__ __forceinline__ void wt_load(u32x4 (&v)[4], const unsigned char* base, unsigned pitch, int lane) {
#pragma unroll
    for (int i = 0; i < 4; ++i) v[i] = *(const u32x4*)(base + (size_t)(8 * i + (lane >> 3)) * pitch + (lane & 7) * 16);
}
__device__ __forceinline__ void wt_store(LAS unsigned char* t, const u32x4 (&v)[4], int lane) {
#pragma unroll
    for (int i = 0; i < 4; ++i) { const int row = 8 * i + (lane >> 3); *(LAS u32x4*)(t + row * 128 + (((lane & 7) ^ ((row >> 1) & 7)) << 4)) = v[i]; }
}
__device__ __forceinline__ bf16x8 wt_frag(const LAS unsigned char* t, int ks, int lane) { const int r32 = lane & 31; return *(const LAS bf16x8*)(t + r32 * 128 + (((2 * ks + (lane >> 5)) ^ ((r32 >> 1) & 7)) << 4)); }

__device__ __forceinline__ void store4(bf16_t* p, float a, float b, float c, float d) { u32x2 w; w.x = pk(a, b); w.y = pk(c, d); *(u32x2*)p = w; }
__device__ __forceinline__ void mla_up_item(Frame& F, int item) {
    const int lane = F.lane, r32 = lane & 31, hi = lane >> 5, part = item & 1, tok = (item >> 1) * 32 + r32;
    const bf16_t* hrow = (const bf16_t*)(F.ws + S_H0B) + (size_t)tok * 1536;
    const float p = (float)((const int*)F.in[1])[tok];
    LAS unsigned char* wl = F.lds + RING_OFF + F.wave * 16384;
    float cs[8], sn[8];
#pragma unroll
    for (int r = 0; r < 8; ++r) { const int j = crow(r, hi); const float fr = expf(-9.210340371976184f * (float)j * (1.f / 16.f)); const float ang = p * fr; cs[r] = cosf(ang); sn[r] = sinf(ang); }
    if (part == 0) {
        bf16x8 xf[16]; float ss = 0.f;
#pragma unroll
        for (int ks = 0; ks < 16; ++ks) { xf[ks] = ld8g(hrow + 1024 + ks * 16 + hi * 8);
#pragma unroll
            for (int e = 0; e < 8; ++e) { const float v = bf2f((unsigned short)xf[ks][e]); ss += v * v; } }
        ss += __shfl_xor(ss, 32);
        const float sc = rsqrtf(ss * (1.f / 256.f) + LN_EPS) * QS_MLA;
        const unsigned char* W = (const unsigned char*)(F.ws + WS_WUQ); bf16_t* Q = (bf16_t*)(F.ws + S_Q96) + (size_t)tok * 768;
        u32x4 wv[2][4];
#pragma unroll
        for (int c = 0; c < 2; ++c) wt_load(wv[c], W + c * 128, 512u, lane);
#pragma unroll 1
        for (int nt = 0; nt < 24; ++nt) {
            f32x16 acc = {};
#pragma unroll
            for (int h = 0; h < 2; ++h) {
#pragma unroll
                for (int c = 0; c < 2; ++c) wt_store(wl + (2 * h + c) * 4096, wv[c], lane);
                { const int nn = h ? nt + 1 : nt, hh = h ^ 1; if (nn < 24) {
#pragma unroll
                    for (int c = 0; c < 2; ++c) wt_load(wv[c], W + (size_t)nn * 32 * 512 + (2 * hh + c) * 128, 512u, lane); } }
#pragma unroll
                for (int ks = 0; ks < 8; ++ks) acc = mfma32(wt_frag(wl + (2 * h + (ks >> 2)) * 4096, ks & 3, lane), xf[8 * h + ks], acc);
            }
#pragma unroll
            for (int r = 0; r < 16; ++r) acc[r] *= sc;
            if (nt % 3 == 2) {
#pragma unroll
                for (int r = 0; r < 8; ++r) { const float x1 = acc[r], x2 = acc[r + 8]; acc[r] = x1 * cs[r] - x2 * sn[r]; acc[r + 8] = x1 * sn[r] + x2 * cs[r]; } }
#pragma unroll
            for (int g4 = 0; g4 < 4; ++g4) store4(Q + nt * 32 + 8 * g4 + 4 * hi, acc[4 * g4], acc[4 * g4 + 1], acc[4 * g4 + 2], acc[4 * g4 + 3]);
        }
    } else {
        bf16x8 xf[8]; float ss = 0.f;
#pragma unroll
        for (int ks = 0; ks < 8; ++ks) { xf[ks] = ld8g(hrow + 1280 + ks * 16 + hi * 8);
#pragma unroll
            for (int e = 0; e < 8; ++e) { const float v = bf2f((unsigned short)xf[ks][e]); ss += v * v; } }
        ss += __shfl_xor(ss, 32);
        const float sc = rsqrtf(ss * (1.f / 128.f) + LN_EPS);
        const unsigned char* W = (const unsigned char*)(F.ws + WS_WUKV);
        bf16_t* KN = (bf16_t*)(F.ws + S_KN) + (size_t)tok * 512; bf16_t* V = (bf16_t*)(F.ws + S_V) + (size_t)tok * 512;
        u32x4 wv[2][4];
#pragma unroll
        for (int c = 0; c < 2; ++c) wt_load(wv[c], W + c * 128, 256u, lane);
#pragma unroll 1
        for (int nt = 0; nt < 32; ++nt) { LAS unsigned char* tl = wl + (nt & 1) * 8192;
#pragma unroll
            for (int c = 0; c < 2; ++c) wt_store(tl + c * 4096, wv[c], lane);
            if (nt + 1 < 32) {
#pragma unroll
                for (int c = 0; c < 2; ++c) wt_load(wv[c], W + (size_t)(nt + 1) * 32 * 256 + c * 128, 256u, lane); }
            f32x16 acc = {};
#pragma unroll
            for (int ks = 0; ks < 8; ++ks) acc = mfma32(wt_frag(tl + (ks >> 2) * 4096, ks & 3, lane), xf[ks], acc);
            bf16_t* o = (nt < 16) ? (KN + nt * 32) : (V + (nt - 16) * 32);
#pragma unroll
            for (int g4 = 0; g4 < 4; ++g4) store4(o + 8 * g4 + 4 * hi, acc[4 * g4] * sc, acc[4 * g4 + 1] * sc, acc[4 * g4 + 2] * sc, acc[4 * g4 + 3] * sc);
        }
        bf16_t* KR = (bf16_t*)(F.ws + S_KRB) + (size_t)tok * 32;
#pragma unroll
        for (int g2 = 0; g2 < 2; ++g2) { const int c0 = 8 * g2 + 4 * hi; const s16x4 a = *(const s16x4*)(hrow + 1408 + c0), b = *(const s16x4*)(hrow + 1408 + 16 + c0);
            float o1[4], o2[4];
#pragma unroll
            for (int e = 0; e < 4; ++e) { const float x1 = bf2f((unsigned short)a[e]), x2 = bf2f((unsigned short)b[e]); const int r = 4 * g2 + e; o1[e] = x1 * cs[r] - x2 * sn[r]; o2[e] = x1 * sn[r] + x2 * cs[r]; }
            store4(KR + c0, o1[0], o1[1], o1[2], o1[3]); store4(KR + 16 + c0, o2[0], o2[1], o2[2], o2[3]); }
    }
}

constexpr int VN_STR = 1088;
__device__ __forceinline__ void gmlp_chunk(Frame& F, int chunk, bool dry = false) {
    const int lane = F.lane, wave = F.wave, r32 = lane & 31, hi = lane >> 5;
    bf16_t* H0B = (bf16_t*)(F.ws + S_H0B);
    const float* lng = (const float*)F.in[3]; const float* lnb = (const float*)F.in[4];
    LAS unsigned char* img = F.lds + RING_OFF;
    float g8[8], b8[8];
#pragma unroll
    for (int e = 0; e < 8; ++e) { g8[e] = lng[lane * 8 + e]; b8[e] = lnb[lane * 8 + e]; }
#pragma unroll 4
    for (int i = 0; i < 16; ++i) { const int row = wave * 16 + i; const bf16x8 x = ld8g(H0B + (size_t)(chunk * 128 + row) * 1536 + 512 + lane * 8);
        float v[8]; float s = 0.f;
#pragma unroll
        for (int e = 0; e < 8; ++e) { v[e] = bf2f((unsigned short)x[e]); s += v[e]; }
        const float mean = wsum(s) * (1.f / 512.f); float q = 0.f;
#pragma unroll
        for (int e = 0; e < 8; ++e) { v[e] -= mean; q += v[e] * v[e]; }
        const float rstd = rsqrtf(wsum(q) * (1.f / 512.f) + LN_EPS);
#pragma unroll
        for (int e = 0; e < 8; ++e) v[e] = v[e] * rstd * g8[e] + b8[e];
        u32x4 w; w.x = pk(v[0], v[1]); w.y = pk(v[2], v[3]); w.z = pk(v[4], v[5]); w.w = pk(v[6], v[7]);
        *(LAS u32x4*)(img + row * VN_STR + lane * 16) = w; }
    __syncthreads();
    const int g = wave >> 1, th = wave & 1;
    const bf16_t* wsb = (const bf16_t*)(F.ws + WS_WSB) + (size_t)g * 128 * 128;
    const float* bs = (const float*)F.in[6] + g * 128;
    const int i15 = lane & 15, g1 = (lane >> 4) & 1;
#pragma unroll 1
    for (int nt = 0; nt < 2; ++nt) {
        const int t = th * 64 + nt * 32 + r32;
        const int nks = (th * 64 + nt * 32 + 31) / 16 + 1;
        bf16x8 bw[8];
#pragma unroll
        for (int ks = 0; ks < 8; ++ks) bw[ks] = ld8g(wsb + (size_t)t * 128 + ks * 16 + hi * 8);
        const float bias = bs[t];
#pragma unroll 1
        for (int ct = 0; ct < 4; ++ct) {
            const LAS unsigned char* abase = img + (8 * hi + (i15 >> 2)) * VN_STR + (g * 128 + ct * 32 + 16 * g1 + 4 * (i15 & 3)) * 2;
            f32x16 acc = {};
#pragma unroll
            for (int ks = 0; ks < 8; ++ks) { if (ks < nks) {
                const s16x4 lo = trld(abase + (16 * ks) * VN_STR), hi4 = trld(abase + (16 * ks + 4) * VN_STR);
                const bf16x8 a = {lo[0], lo[1], lo[2], lo[3], hi4[0], hi4[1], hi4[2], hi4[3]};
                acc = mfma32(a, bw[ks], acc); } }
            bf16_t* urow = H0B + (size_t)(chunk * 128 + t) * 1536 + g * 128 + ct * 32 + 4 * hi;
            bf16_t* orow = dry ? ((bf16_t*)(F.ws + WS_Z1) + (urow - H0B)) : urow;
#pragma unroll
            for (int g4 = 0; g4 < 4; ++g4) { const s16x4 uu = *(const s16x4*)(urow + 8 * g4);
                store4(orow + 8 * g4, bf2f((unsigned short)uu[0]) * (acc[4 * g4] + bias), bf2f((unsigned short)uu[1]) * (acc[4 * g4 + 1] + bias),
                       bf2f((unsigned short)uu[2]) * (acc[4 * g4 + 2] + bias), bf2f((unsigned short)uu[3]) * (acc[4 * g4 + 3] + bias)); }
        }
    }
    __syncthreads();
}

constexpr float NEGF = -1e30f;
__device__ __forceinline__ void pack_p(u32x4 (&pw)[4], const f32x16& p0, const f32x16& p1) {
    pw[0] = (u32x4){pk(p0[0], p0[1]), pk(p0[2], p0[3]), pk(p0[4], p0[5]), pk(p0[6], p0[7])}; pw[1] = (u32x4){pk(p0[8], p0[9]), pk(p0[10], p0[11]), pk(p0[12], p0[13]), pk(p0[14], p0[15])};
    pw[2] = (u32x4){pk(p1[0], p1[1]), pk(p1[2], p1[3]), pk(p1[4], p1[5]), pk(p1[6], p1[7])}; pw[3] = (u32x4){pk(p1[8], p1[9]), pk(p1[10], p1[11]), pk(p1[12], p1[13]), pk(p1[14], p1[15])};
}
struct AttnSt { f32x16 o[2]; f32x16 negm; float mref, l; int started; };
__device__ __forceinline__ void attn_reset(AttnSt& st) { st.o[0] = f32x16{}; st.o[1] = f32x16{}; st.negm = f32x16{}; st.mref = 0.f; st.l = 0.f; st.started = 0; }
constexpr int KV_ROPE = 8192;
template <bool ROPE> struct KvL { static constexpr int V = ROPE ? 12288 : 8192, SUB = ROPE ? 20480 : 16384, BUF = 2 * SUB; };
template <int NKS>
__device__ __forceinline__ void qk_tile(f32x16& p0, f32x16& p1, const LAS unsigned char* Kt, const bf16x8* qf, const f32x16& cinit, int lane) {
    const int r32 = lane & 31, hi = lane >> 5, sw = (r32 >> 1) & 7;
    const LAS unsigned char* kp = Kt + r32 * 128;
#pragma unroll
    for (int ks = 0; ks < NKS; ++ks) {
        bf16x8 a0, a1;
        if (ks < 4) { const int off = ((2 * ks + hi) ^ sw) << 4; a0 = *(const LAS bf16x8*)(kp + off); a1 = *(const LAS bf16x8*)(kp + 4096 + off); }
        else { const LAS unsigned char* rp = Kt + KV_ROPE + r32 * 64 + (((2 * (ks - 4) + hi) ^ ((r32 >> 2) & 3)) << 4); a0 = *(const LAS bf16x8*)rp; a1 = *(const LAS bf16x8*)(rp + 2048); }
        if (ks == 0) { p0 = mfma32(a0, qf[0], cinit); p1 = mfma32(a1, qf[0], cinit); } else { p0 = mfma32(a0, qf[ks], p0); p1 = mfma32(a1, qf[ks], p1); } }
}
__device__ __forceinline__ float max3(float a, float b, float c) { return fmaxf(fmaxf(a, b), c); }
constexpr float ATT_THR = 8.f;
template <class Mask>
__device__ __forceinline__ void softmax2(f32x16& p0, f32x16& p1, AttnSt& st, bool need_mask, const Mask& valid, bool lanebit, int lane, u32x4 (&pw)[4]) {
    const int hi = lane >> 5;
    if (need_mask) {
#pragma unroll
        for (int r = 0; r < 16; ++r) { const int k0 = crow(r, hi); if (!valid(k0)) p0[r] = NEGF; if (!valid(k0 + 32)) p1[r] = NEGF; } }
    float ma = max3(p0[0], p0[1], p1[0]), mb = max3(p0[2], p0[3], p1[1]); ma = max3(ma, p1[2], p1[3]);
#pragma unroll
    for (int r = 4; r < 16; r += 4) { ma = max3(ma, p0[r], p0[r + 1]); mb = max3(mb, p0[r + 2], p0[r + 3]); ma = max3(ma, p1[r], p1[r + 1]); mb = max3(mb, p1[r + 2], p1[r + 3]); }
    float mx = fmaxf(ma, mb); mx = fmaxf(mx, __shfl_xor(mx, 32));
    if (!lanebit) mx = NEGF;
    const bool has = mx > -1e29f, fresh = has && !st.started;
    if (__any((mx > ATT_THR) || fresh)) {
        const float dl = has ? (fresh ? mx : fmaxf(mx, 0.f)) : 0.f;
        st.mref += dl; const float f = ex2(-dl); st.l *= f;
#pragma unroll
        for (int r = 0; r < 16; ++r) { p0[r] -= dl; p1[r] -= dl; st.o[0][r] *= f; st.o[1][r] *= f; st.negm[r] = -st.mref; }
        st.started |= has ? 1 : 0;
    }
    float sa = 0.f, sb = 0.f;
#pragma unroll
    for (int r = 0; r < 16; ++r) { p0[r] = ex2(p0[r]); p1[r] = ex2(p1[r]); sa += p0[r]; sb += p1[r]; }
    pack_p(pw, p0, p1);
    float sum = sa + sb;
    if (!lanebit) { sum = 0.f;
#pragma unroll
        for (int i = 0; i < 4; ++i) pw[i] = (u32x4){0u, 0u, 0u, 0u}; }
    st.l += sum;
}
__device__ __forceinline__ void pv_packed(f32x16 (&o)[2], const LAS unsigned char* Vt, const u32x4 (&pw)[4], int lane) {
    const int i15 = lane & 15, g1 = (lane >> 4) & 1, hi = lane >> 5, bsw = (i15 >> 3) & 1;
    const LAS unsigned char* vrow = Vt + (4 * hi + (i15 >> 2)) * 128 + (2 * g1 + ((i15 & 3) >> 1)) * 16 + (i15 & 1) * 8;
    const LAS unsigned char* vb0 = vrow + 64 * bsw; const LAS unsigned char* vb1 = vrow + 64 * (bsw ^ 1);
#pragma unroll
    for (int db = 0; db < 2; ++db)
#pragma unroll
        for (int s = 0; s < 4; ++s) { const LAS unsigned char* vb = db ? vb1 : vb0; const s16x4 lo = trld(vb + s * 2048), h4 = trld(vb + s * 2048 + 1024);
            const bf16x8 a = {lo[0], lo[1], lo[2], lo[3], h4[0], h4[1], h4[2], h4[3]};
            o[db] = mfma32(a, __builtin_bit_cast(bf16x8, pw[s]), o[db]); }
}
#define LDS_BAR() asm volatile("s_waitcnt lgkmcnt(0)\n\ts_barrier" ::: "memory")
__device__ __forceinline__ void glds16(const void* gsrc, unsigned lds_dst) { unsigned keep;
    asm volatile("s_mov_b32 %0, m0\n\ts_mov_b32 m0, %2\n\ts_nop 0\n\tglobal_load_lds_dwordx4 %1, off\n\ts_mov_b32 m0, %0" : "=&s"(keep) : "v"(gsrc), "s"(lds_dst) : "memory"); }
template <bool ROPE, class Src>
__device__ __forceinline__ void dma_tile(const Src& src, int j, LAS unsigned char* buf, int wave, unsigned koff, unsigned voff, unsigned roff) {
    const unsigned b = (unsigned)(size_t)buf;
    glds16(src.kbase(j) + koff, (unsigned)__builtin_amdgcn_readfirstlane(b + wave * 1024));
    glds16(src.vbase(j) + voff, (unsigned)__builtin_amdgcn_readfirstlane(b + KvL<ROPE>::V + wave * 1024));
    if (ROPE) glds16(src.rbase(j) + roff, (unsigned)__builtin_amdgcn_readfirstlane(b + KV_ROPE + (wave & 3) * 1024));
}
#define VMW(n) asm volatile("s_waitcnt vmcnt(" #n ")" ::: "memory")
template <int NKS, class It, class Src, class Act, class Mask>
__device__ __forceinline__ void attn_loop(AttnSt& st, const bf16x8* qf, It it, const Src& src, const Act& active, const Mask& mask, LAS unsigned char* kv, int tid_, int lane_, int abl = 0) {
    const int tid = launder(tid_), lane = tid & 63, wave = __builtin_amdgcn_readfirstlane(tid >> 6); (void)lane_;
    constexpr bool ROPE = (NKS > 4); constexpr int SUB = KvL<ROPE>::SUB, BUF = KvL<ROPE>::BUF, VO = KvL<ROPE>::V;
    int a0 = it.next(); if (a0 < 0) return;
    int b0 = it.next();
    unsigned koff, voff, roff;
    { const int row = wave * 8 + (lane >> 3), c = lane & 7; koff = (unsigned)row * src.kpitch + (unsigned)((c ^ ((row >> 1) & 7)) << 4); voff = (unsigned)row * src.vpitch + (unsigned)((c ^ (((row >> 1) & 1) << 2)) << 4);
      const int rr = (wave & 3) * 16 + (lane >> 2), rc = lane & 3; roff = (unsigned)rr * 64u + (unsigned)((rc ^ ((rr >> 2) & 3)) << 4); }
#define DMAP(A_, B_, BUFP) do { dma_tile<ROPE>(src, (A_), (BUFP), wave, koff, voff, roff); dma_tile<ROPE>(src, ((B_) >= 0) ? (B_) : (A_), (BUFP) + SUB, wave, koff, voff, roff); } while (0)
    int a1 = (b0 >= 0) ? it.next() : -1, b1 = (a1 >= 0) ? it.next() : -1;
    DMAP(a0, b0, kv);
    if (a1 >= 0) DMAP(a1, b1, kv + BUF);
    int bc = 0;
    for (;;) {
        if (a1 >= 0) { if (ROPE) VMW(6); else VMW(4); } else VMW(0);
        if (!(abl & 16)) LDS_BAR();
        int a2 = (b1 >= 0) ? it.next() : -1, b2 = (a2 >= 0) ? it.next() : -1;
        if (a2 >= 0 && !(abl & 8)) DMAP(a2, b2, kv + ((bc + 2) % 3) * BUF);
        else if (a2 >= 0) { }
#pragma unroll
        for (int sub = 0; sub < 2; ++sub) { const int jc = sub ? b0 : a0;
            if (jc >= 0 && active(jc)) { const LAS unsigned char* kb = kv + bc * BUF + sub * SUB;
                f32x16 p0, p1; u32x4 pw[4]; __builtin_amdgcn_sched_barrier(0);
                if (!(abl & 1)) qk_tile<NKS>(p0, p1, kb, qf, st.negm, lane); else { p0 = st.negm; p1 = st.negm; } __builtin_amdgcn_sched_barrier(0);
                if (!(abl & 2)) softmax2(p0, p1, st, mask.need(jc), [&](int key) { return mask.valid(jc, key); }, mask.lanebit(jc), lane, pw); else pack_p(pw, p0, p1); __builtin_amdgcn_sched_barrier(0);
                if (!(abl & 4)) pv_packed(st.o, kb + VO, pw, lane); else st.o[0][0] += __uint_as_float(pw[0].x ^ pw[1].y ^ pw[2].z ^ pw[3].w); __builtin_amdgcn_sched_barrier(0); } }
        if (a1 < 0) break;
        a0 = a1; b0 = b1; a1 = a2; b1 = b2; bc = (bc + 1) % 3;
        if (abl & 8) { if (a1 >= 0 && false) {} }
    }
#undef DMAP
    LDS_BAR();
}
struct RangeIt { int j, end; __device__ __forceinline__ int next() { return (j < end) ? j++ : -1; } };
struct BitIt { unsigned m; __device__ __forceinline__ int next() { if (!m) return -1; const int j = __builtin_ctz(m); m &= m - 1; return j; } };

__device__ __forceinline__ void mla_attn_unit(Frame& F, int b, int h, int qb, int abl = 0) {
    const int lane = F.lane, wave = F.wave, r32 = lane & 31, hi = lane >> 5;
    const int q0 = qb * 256 + wave * 32, t = q0 + r32;
    const size_t rb = (size_t)b * S;
    const bf16_t* Q = (const bf16_t*)(F.ws + S_Q96) + (rb + t) * 768 + h * 96;
    const bf16_t* KN = (const bf16_t*)(F.ws + S_KN) + rb * 512 + h * 64; const bf16_t* KR = (const bf16_t*)(F.ws + S_KRB) + rb * 32; const bf16_t* V = (const bf16_t*)(F.ws + S_V) + rb * 512 + h * 64;
    bf16x8 qf[6];
#pragma unroll
    for (int ks = 0; ks < 6; ++ks) qf[ks] = ld8g(Q + ks * 16 + hi * 8);
    asm volatile("" : "+v"(qf[0]), "+v"(qf[1]), "+v"(qf[2]), "+v"(qf[3]), "+v"(qf[4]), "+v"(qf[5]));
    AttnSt st; attn_reset(st);
    struct Src { const unsigned char *KN, *KR, *V; unsigned kpitch, vpitch;
        __device__ __forceinline__ const unsigned char* kbase(int j) const { return KN + (size_t)j * 64 * 1024; }
        __device__ __forceinline__ const unsigned char* vbase(int j) const { return V + (size_t)j * 64 * 1024; }
        __device__ __forceinline__ const unsigned char* rbase(int j) const { return KR + (size_t)j * 64 * 64; } } src{(const unsigned char*)KN, (const unsigned char*)KR, (const unsigned char*)V, 1024u, 1024u};
    const int wlast = (q0 + 31) >> 6;
    struct MaskC { int t, tmin; __device__ __forceinline__ bool need(int j) const { return j * 64 + 63 > tmin; } __device__ __forceinline__ bool valid(int j, int key) const { return j * 64 + key <= t; }
        __device__ __forceinline__ bool lanebit(int) const { return true; } } mk{t, q0};
    if (!(abl & 32)) attn_loop<6>(st, qf, RangeIt{0, qb * 4 + 4}, src, [&](int j) { return j <= wlast; }, mk, F.lds + RING_OFF, F.tid, lane, abl); if (abl & 64) return;
    float l = st.l + __shfl_xor(st.l, 32); const float inv = 1.f / l;
    bf16_t* O = (bf16_t*)(F.ws + S_H0B) + (rb + t) * 1536 + 512 + h * 64 + 4 * hi;
#pragma unroll
    for (int db = 0; db < 2; ++db)
#pragma unroll
        for (int g4 = 0; g4 < 4; ++g4) store4(O + db * 32 + 8 * g4, st.o[db][4 * g4] * inv, st.o[db][4 * g4 + 1] * inv, st.o[db][4 * g4 + 2] * inv, st.o[db][4 * g4 + 3] * inv);
}

constexpr int NSA_IMP_OFF = 3 * KvL<false>::BUF, NSA_SEL_OFF = NSA_IMP_OFF + 8 * 32 * 33 * 4;
__device__ __forceinline__ void ob_add(u32x2 (&ob)[2][4], const f32x16 (&o)[2], float f, bool first) {
#pragma unroll
    for (int db = 0; db < 2; ++db)
#pragma unroll
        for (int g4 = 0; g4 < 4; ++g4) { float a0 = 0.f, a1 = 0.f, a2 = 0.f, a3 = 0.f;
            if (!first) { a0 = __uint_as_float(ob[db][g4].x << 16); a1 = __uint_as_float(ob[db][g4].x & 0xffff0000u); a2 = __uint_as_float(ob[db][g4].y << 16); a3 = __uint_as_float(ob[db][g4].y & 0xffff0000u); }
            ob[db][g4].x = pk(a0 + f * o[db][4 * g4], a1 + f * o[db][4 * g4 + 1]); ob[db][g4].y = pk(a2 + f * o[db][4 * g4 + 2], a3 + f * o[db][4 * g4 + 3]); }
}
__device__ __forceinline__ void nsa_unit(Frame& F, int b, int g, int tblk  , bool dry = false, int abl = 0) {
    const int lane = F.lane, wave = F.wave, tid = F.tid, r32 = lane & 31, hi = lane >> 5;
    const int t0 = tblk * 32, t = t0 + r32, tb = t0 >> 6, h = g * 8 + wave;
    const size_t rb = (size_t)b * S;
    bf16_t* H1B = (bf16_t*)(F.ws + S_H1B);
    bf16_t* qrow = H1B + (rb + t) * 2048;
    bf16x8 qf[4];
#pragma unroll
    for (int ks = 0; ks < 4; ++ks) qf[ks] = ld8g(qrow + h * 64 + ks * 16 + hi * 8);
    bf16_t* orow = (dry ? ((bf16_t*)(F.ws + WS_Z1) + (qrow - H1B)) : qrow) + h * 64 + 4 * hi;
    const float* gate_b = (const float*)F.in[19];
    float gate[3];
#pragma unroll
    for (int br = 0; br < 3; ++br) { const float x = bf2f(qrow[1792 + br * 16 + h]) + gate_b[br * 16 + h]; gate[br] = __builtin_amdgcn_rcpf(1.f + ex2(-LOG2E * x)); }
    asm volatile("" : "+v"(qf[0]), "+v"(qf[1]), "+v"(qf[2]), "+v"(qf[3]), "+v"(gate[0]), "+v"(gate[1]), "+v"(gate[2]));
    LAS unsigned char* kv = F.lds + RING_OFF;
    LAS float* impw = (LAS float*)(F.lds + NSA_IMP_OFF); LAS unsigned* selw = (LAS unsigned*)(F.lds + NSA_SEL_OFF);
    if (tid == 0) selw[32] = 0u;
    u32x2 ob[2][4];
    struct Src { const unsigned char *K, *V; unsigned kpitch, vpitch;
        __device__ __forceinline__ const unsigned char* kbase(int j) const { return K + (size_t)j * 64 * kpitch; }
        __device__ __forceinline__ const unsigned char* vbase(int j) const { return V + (size_t)j * 64 * vpitch; }
        __device__ __forceinline__ const unsigned char* rbase(int) const { return K; } };
    {
        const int tid = launder(F.tid), lane = tid & 63, r32 = lane & 31, hi = lane >> 5;
        const int nk = (t0 >> 4) + 1;
        const int ntile = (nk + 63) >> 6;
        { Src sc{(const unsigned char*)((const bf16_t*)(F.ws + S_KCMP) + (size_t)(b * 2 + g) * 128 * 64), (const unsigned char*)((const bf16_t*)(F.ws + S_VCMP) + (size_t)(b * 2 + g) * 128 * 64), 128u, 128u};
          const int row = wave * 8 + (lane >> 3), c = lane & 7; const unsigned koff = (unsigned)row * 128u + (unsigned)((c ^ ((row >> 1) & 7)) << 4), voff = (unsigned)row * 128u + (unsigned)((c ^ (((row >> 1) & 1) << 2)) << 4);
          dma_tile<false>(sc, 0, kv, wave, koff, voff, 0u); if (ntile > 1) dma_tile<false>(sc, 1, kv + KvL<false>::SUB, wave, koff, voff, 0u); }
        VMW(0); LDS_BAR();
        if (abl & 32) { f32x16 z2[2] = {f32x16{}, f32x16{}}; ob_add(ob, z2, 0.f, true); } else {
        f32x16 p[2][2]; float mx = NEGF;
#pragma unroll
        for (int tl = 0; tl < 2; ++tl) { __builtin_amdgcn_sched_barrier(0); if (tl < ntile) { qk_tile<4>(p[tl][0], p[tl][1], kv + tl * KvL<false>::SUB, qf, f32x16{}, lane);
#pragma unroll
                for (int kb = 0; kb < 2; ++kb)
#pragma unroll
                    for (int r = 0; r < 16; ++r) { const int n = tl * 64 + kb * 32 + crow(r, hi); if (t < 16 * n + 31) p[tl][kb][r] = NEGF; mx = fmaxf(mx, p[tl][kb][r]); } }
            else { p[tl][0] = f32x16{}; p[tl][1] = f32x16{};
#pragma unroll
                for (int r = 0; r < 16; ++r) { p[tl][0][r] = NEGF; p[tl][1][r] = NEGF; } } }
        mx = fmaxf(mx, __shfl_xor(mx, 32));
        const float muse = (mx < -1e29f) ? 0.f : mx; float sum = 0.f;
#pragma unroll
        for (int tl = 0; tl < 2; ++tl)
#pragma unroll
            for (int kb = 0; kb < 2; ++kb)
#pragma unroll
                for (int r = 0; r < 16; ++r) { p[tl][kb][r] = ex2(p[tl][kb][r] - muse); sum += p[tl][kb][r]; }
        sum += __shfl_xor(sum, 32);
        const float inv = (sum > 0.f) ? __builtin_amdgcn_rcpf(sum) : 0.f;
#pragma unroll
        for (int tl = 0; tl < 2; ++tl)
#pragma unroll
            for (int kb = 0; kb < 2; ++kb)
#pragma unroll
                for (int r = 0; r < 16; ++r) p[tl][kb][r] *= inv;
        { float carried = 0.f;
#pragma unroll
        for (int tl = 0; tl < 2; ++tl)
#pragma unroll
            for (int kb = 0; kb < 2; ++kb)
#pragma unroll
                for (int q4 = 0; q4 < 4; ++q4) { const int m = 8 * tl + 4 * kb + q4;
                    const float Gm = (p[tl][kb][4 * q4] + p[tl][kb][4 * q4 + 1]) + (p[tl][kb][4 * q4 + 2] + p[tl][kb][4 * q4 + 3]);
                    const float other = __shfl_xor(p[tl][kb][4 * q4 + 3], 32);
                    const float prev = hi ? other : carried; carried = other;
                    impw[(wave * 32 + r32) * 33 + 2 * m + hi] = Gm + prev; } }
        __builtin_amdgcn_sched_barrier(0);
        { f32x16 oc[2] = {f32x16{}, f32x16{}}; u32x4 pwa[4], pwb[4]; pack_p(pwa, p[0][0], p[0][1]); pack_p(pwb, p[1][0], p[1][1]); __builtin_amdgcn_sched_barrier(0);
          pv_packed(oc, kv + KvL<false>::V, pwa, lane); __builtin_amdgcn_sched_barrier(0);
          if (ntile > 1) pv_packed(oc, kv + KvL<false>::SUB + KvL<false>::V, pwb, lane); __builtin_amdgcn_sched_barrier(0);
          ob_add(ob, oc, gate[0], true); } }
        LDS_BAR();
    }
#pragma unroll 1
    for (int ps = (abl & 64) ? 2 : 0; ps < 2; ++ps) { const int lane = launder(F.tid) & 63, r32 = lane & 31, hi = lane >> 5; const int tokl = 4 * wave + 2 * ps + hi, j = r32; float a = 0.f;
#pragma unroll
        for (int w = 0; w < 8; ++w) a += impw[(w * 32 + tokl) * 33 + j];
        const bool forced = (j == 0) || (j == tb) || (j == tb - 1); const float sc = forced ? 1e4f : (j <= tb ? a : -1e4f);
        const int scb = __builtin_bit_cast(int, sc); int rank = 0;
#pragma unroll
        for (int k = 0; k < 32; ++k) { const float o0 = __builtin_bit_cast(float, __builtin_amdgcn_readlane(scb, k)), o1 = __builtin_bit_cast(float, __builtin_amdgcn_readlane(scb, 32 + k)); const float o = hi ? o1 : o0;
            rank += ((o > sc) || (o == sc && k < j)) ? 1 : 0; }
        const unsigned long long bal = __ballot(rank < 8);
        const unsigned mine = hi ? (unsigned)(bal >> 32) : (unsigned)bal;
        if (r32 == 0) { selw[tokl] = mine; __hip_atomic_fetch_or(&selw[32], mine, __ATOMIC_RELAXED, __HIP_MEMORY_SCOPE_WORKGROUP); } }
    LDS_BAR();
    const unsigned mysel = selw[r32]; const unsigned uni = selw[32] & ((tb >= 31) ? 0xffffffffu : ((2u << tb) - 1u));
    {
        AttnSt st; attn_reset(st);
        Src src{(const unsigned char*)(H1B + rb * 2048 + 1280 + g * 64), (const unsigned char*)(H1B + rb * 2048 + 1408 + g * 64), 4096u, 4096u};
        struct MaskS { int t, tb; unsigned sel; __device__ __forceinline__ bool need(int j) const { return j == tb; } __device__ __forceinline__ bool valid(int j, int key) const { return j * 64 + key <= t; }
            __device__ __forceinline__ bool lanebit(int j) const { return (sel >> j) & 1u; } } mk{t, tb, mysel};
        if (!(abl & 512)) attn_loop<4>(st, qf, BitIt{uni}, src, [&](int) { return true; }, mk, kv, tid, lane, abl);
        const float l = st.l + __shfl_xor(st.l, 32); ob_add(ob, st.o, gate[1] * __builtin_amdgcn_rcpf(l), false);
    }
    {
        AttnSt st; attn_reset(st);
        Src src{(const unsigned char*)(H1B + rb * 2048 + 1536 + g * 64), (const unsigned char*)(H1B + rb * 2048 + 1664 + g * 64), 4096u, 4096u};
        const int jlo = (t0 - 511 > 0) ? ((t0 - 511) >> 6) : 0;
        struct MaskW { int t, tb, t0; __device__ __forceinline__ bool need(int j) const { return (j == tb) || (64 * j <= t0 + 31 - 512); }
            __device__ __forceinline__ bool valid(int j, int key) const { const int k = j * 64 + key; return (k <= t) && (k > t - 512); } __device__ __forceinline__ bool lanebit(int) const { return true; } } mk{t, tb, t0};
        if (!(abl & 512)) attn_loop<4>(st, qf, RangeIt{jlo, tb + 1}, src, [&](int) { return true; }, mk, kv, tid, lane, abl);
        const float l = st.l + __shfl_xor(st.l, 32); ob_add(ob, st.o, gate[2] * __builtin_amdgcn_rcpf(l), false);
    }
#pragma unroll
    for (int db = 0; db < 2; ++db)
#pragma unroll
        for (int g4 = 0; g4 < 4; ++g4) *(u32x2*)(orow + db * 32 + 8 * g4) = ob[db][g4];
}

__device__ __forceinline__ void cmp_item(Frame& F, int item) {
    const int lane = F.lane, wave = F.wave, r32 = lane & 31, hi = lane >> 5;
    const int rblk = item & 63, gk = item >> 6, g = gk & 1, kvsel = gk >> 1;
    const int row = rblk * 32 + r32, b = row >> 7, n = row & 127;
    const bf16_t* H1B = (const bf16_t*)(F.ws + S_H1B);
    const int ncl = (n < 127) ? n : 126;
    const bf16_t* src = H1B + ((size_t)b * S + 16 * ncl) * 2048 + 1024 + kvsel * 128 + g * 64 + hi * 8;
    (void)src;
    const unsigned char* W1 = (const unsigned char*)(F.ws + (kvsel ? WS_WCV1 : WS_WCK1)) + (size_t)(wave * 32) * 4096;
    LAS unsigned char* wl = F.lds + RING_OFF + wave * 16384;
    const unsigned char* xrow[4];
#pragma unroll
    for (int i = 0; i < 4; ++i) { const int rr = rblk * 32 + 8 * i + (lane >> 3), bb = rr >> 7, nn = rr & 127, nc = (nn < 127) ? nn : 126;
        xrow[i] = (const unsigned char*)(H1B + ((size_t)bb * S + 16 * nc) * 2048 + 1024 + kvsel * 128 + g * 64) + (lane & 7) * 16; }
    f32x16 acc = {};
    u32x4 wv[2][4], xv[2][4];
#pragma unroll
    for (int c = 0; c < 2; ++c) { wt_load(wv[c], W1 + c * 128, 4096u, lane);
#pragma unroll
        for (int i = 0; i < 4; ++i) xv[c][i] = *(const u32x4*)(xrow[i] + (size_t)c * 4096); }
#pragma unroll 1
    for (int l0 = 0; l0 < 32; l0 += 2) {
#pragma unroll
        for (int c = 0; c < 2; ++c) { wt_store(wl + c * 4096, wv[c], lane); wt_store(wl + (2 + c) * 4096, xv[c], lane); }
        if (l0 + 2 < 32) {
#pragma unroll
            for (int c = 0; c < 2; ++c) { wt_load(wv[c], W1 + (size_t)(l0 + 2 + c) * 128, 4096u, lane);
#pragma unroll
                for (int i = 0; i < 4; ++i) xv[c][i] = *(const u32x4*)(xrow[i] + (size_t)(l0 + 2 + c) * 4096); } }
#pragma unroll
        for (int c = 0; c < 2; ++c)
#pragma unroll
            for (int q = 0; q < 4; ++q) acc = mfma32(wt_frag(wl + c * 4096, q, lane), wt_frag(wl + (2 + c) * 4096, q, lane), acc);
    }
    const float* cb = (const float*)(F.ws + WS_CBIAS) + kvsel * 256 + wave * 32;
    LAS unsigned char* hid = F.lds + RING_OFF;
    __syncthreads();
#pragma unroll
    for (int g4 = 0; g4 < 4; ++g4) { const int c = 8 * g4 + 4 * hi; u32x2 w; w.x = pk(gelu_t(acc[4 * g4] + cb[c]), gelu_t(acc[4 * g4 + 1] + cb[c + 1])); w.y = pk(gelu_t(acc[4 * g4 + 2] + cb[c + 2]), gelu_t(acc[4 * g4 + 3] + cb[c + 3]));
        *(LAS u32x2*)(hid + r32 * 528 + (wave * 32 + c) * 2) = w; }
    __syncthreads();
    if (wave < 2) {
        const bf16_t* W2 = (const bf16_t*)(F.ws + (kvsel ? WS_WCV2 : WS_WCK2)) + (size_t)(wave * 32 + r32) * 256 + hi * 8;
        f32x16 o = {};
#pragma unroll
        for (int ks = 0; ks < 16; ++ks) o = mfma32(ld8g(W2 + ks * 16), *(const LAS bf16x8*)(hid + r32 * 528 + ks * 32 + hi * 16), o);
        bf16_t* dst = (bf16_t*)(F.ws + (kvsel ? S_VCMP : S_KCMP)) + ((size_t)(b * 2 + g) * 128 + n) * 64 + wave * 32 + 4 * hi;
        const float z = (n < 127) ? 1.f : 0.f;
#pragma unroll
        for (int g4 = 0; g4 < 4; ++g4) store4(dst + 8 * g4, o[4 * g4] * z, o[4 * g4 + 1] * z, o[4 * g4 + 2] * z, o[4 * g4 + 3] * z);
    }
    __syncthreads();
}

__device__ __forceinline__ void ln_route_wg(Frame& F, int layer, int cset) {
    const int lane = F.lane, wave = F.wave, tid = F.tid, r32 = lane & 31, hi = lane >> 5;
    const int tok0 = F.vcu * 128;
    const float* Z = (const float*)(F.ws + WS_Z1);
    const float* g1 = (const float*)F.in[28] + layer * 1024; const float* b1 = (const float*)F.in[29] + layer * 1024;
    const float* wrg = (const float*)F.in[21] + (size_t)layer * 4096; const float* brg = (const float*)F.in[22] + layer * 4;
    const float* wre = (const float*)F.in[23] + (size_t)layer * 32768; const float* bre = (const float*)F.in[24] + layer * 32;
    LAS float* part = (LAS float*)(F.lds + RING_OFF);
    LAS float* glog = (LAS float*)(F.lds + LDS_SCR); LAS float* stl = (LAS float*)(F.lds + LDS_SCR + 2048);
    LAS int* lcnt = (LAS int*)(F.lds + LDS_SCR + 3072); LAS int* gbase = (LAS int*)(F.lds + LDS_SCR + 3200); LAS int* ent = (LAS int*)(F.lds + LDS_SCR + 3328);
    bf16_t* X1B = (bf16_t*)(F.ws + S_X1B); bf16_t* X1L = (bf16_t*)(F.ws + S_XP); float* stats = (float*)(F.ws + WS_STATS);
    if (tid < 32) lcnt[tid] = 0;
    {
        f32x4 gg[4], bb[4];
#pragma unroll
        for (int j = 0; j < 4; ++j) { gg[j] = *(const f32x4*)(g1 + lane * 4 + 256 * j); bb[j] = *(const f32x4*)(b1 + lane * 4 + 256 * j); }
#pragma unroll 1
        for (int i0 = 0; i0 < 16; i0 += 4) {
            f32x4 v[4][4]; float mean[4], rstd[4];
#pragma unroll
            for (int u = 0; u < 4; ++u) { const float* z = Z + (size_t)(tok0 + wave * 16 + i0 + u) * D;
#pragma unroll
                for (int j = 0; j < 4; ++j) v[u][j] = *(const f32x4*)(z + lane * 4 + 256 * j); }
#pragma unroll
            for (int u = 0; u < 4; ++u) { float s = 0.f;
#pragma unroll
                for (int j = 0; j < 4; ++j) s += (v[u][j][0] + v[u][j][1]) + (v[u][j][2] + v[u][j][3]);
                mean[u] = wsum(s) * (1.f / D); float q = 0.f;
#pragma unroll
                for (int j = 0; j < 4; ++j) { v[u][j] = v[u][j] - mean[u]; q += (v[u][j][0] * v[u][j][0] + v[u][j][1] * v[u][j][1]) + (v[u][j][2] * v[u][j][2] + v[u][j][3] * v[u][j][3]); }
                rstd[u] = rsqrtf(wsum(q) * (1.f / D) + LN_EPS); }
            f32x4 lg[4] = {f32x4{0.f, 0.f, 0.f, 0.f}, f32x4{0.f, 0.f, 0.f, 0.f}, f32x4{0.f, 0.f, 0.f, 0.f}, f32x4{0.f, 0.f, 0.f, 0.f}};
#pragma unroll
            for (int j = 0; j < 4; ++j) {
#pragma unroll
                for (int u = 0; u < 4; ++u) v[u][j] = v[u][j] * rstd[u] * gg[j] + bb[j];
#pragma unroll
                for (int e = 0; e < 4; ++e) { const f32x4 wv = *(const f32x4*)(wrg + (size_t)(lane * 4 + 256 * j + e) * 4);
#pragma unroll
                    for (int u = 0; u < 4; ++u) lg[u] += wv * v[u][j][e]; } }
#pragma unroll
            for (int u = 0; u < 4; ++u) { const int row = wave * 16 + i0 + u;
#pragma unroll
                for (int j = 0; j < 4; ++j) { const f32x4 x = v[u][j];
                    u32x2 w; w.x = pk(x[0], x[1]); w.y = pk(x[2], x[3]); *(u32x2*)(X1B + (size_t)(tok0 + row) * D + lane * 4 + 256 * j) = w;
                    u32x2 wl2; wl2.x = pk(x[0] - __uint_as_float(w.x << 16), x[1] - __uint_as_float(w.x & 0xffff0000u)); wl2.y = pk(x[2] - __uint_as_float(w.y << 16), x[3] - __uint_as_float(w.y & 0xffff0000u));
                    *(u32x2*)(X1L + (size_t)(tok0 + row) * D + lane * 4 + 256 * j) = wl2; }
                float l4[4];
#pragma unroll
                for (int e = 0; e < 4; ++e) l4[e] = wsum(lg[u][e]);
                if (lane == 0) { glog[row * 4 + 0] = l4[0] + brg[0]; glog[row * 4 + 1] = l4[1] + brg[1]; glog[row * 4 + 2] = l4[2] + brg[2]; glog[row * 4 + 3] = l4[3] + brg[3];
                    stl[row * 2] = mean[u]; stl[row * 2 + 1] = rstd[u]; stats[(size_t)(tok0 + row) * 2] = mean[u]; stats[(size_t)(tok0 + row) * 2 + 1] = rstd[u]; } }
        }
    }
    __syncthreads();
    { const int lane = launder(F.tid) & 63, r32 = lane & 31, hi = lane >> 5;
        bf16x8 wh[8], wl[8];
#pragma unroll
        for (int ks = 0; ks < 8; ++ks) { unsigned hh[4], ll[4];
#pragma unroll
            for (int e2 = 0; e2 < 4; ++e2) { float a[2], ah[2];
#pragma unroll
                for (int q = 0; q < 2; ++q) { const int k = wave * 128 + ks * 16 + hi * 8 + e2 * 2 + q; a[q] = wre[(size_t)k * 32 + r32]; }
                hh[e2] = pk(a[0], a[1]); ah[0] = __uint_as_float(hh[e2] << 16); ah[1] = __uint_as_float(hh[e2] & 0xffff0000u); ll[e2] = pk(a[0] - ah[0], a[1] - ah[1]); }
            wh[ks] = __builtin_bit_cast(bf16x8, (u32x4){hh[0], hh[1], hh[2], hh[3]}); wl[ks] = __builtin_bit_cast(bf16x8, (u32x4){ll[0], ll[1], ll[2], ll[3]}); asm volatile("" ::: "memory"); }
        for (int blk = 0; blk < 4; ++blk) { const int row = blk * 32 + r32; const size_t xo = (size_t)(tok0 + row) * D + wave * 128 + hi * 8;
            f32x16 acc = {};
#pragma unroll
            for (int ks = 0; ks < 8; ++ks) { const bf16x8 xh = ld8g(X1B + xo + ks * 16), xl = ld8g(X1L + xo + ks * 16);
                acc = mfma32(wh[ks], xh, acc); acc = mfma32(wh[ks], xl, acc); acc = mfma32(wl[ks], xh, acc); }
#pragma unroll
            for (int r = 0; r < 16; ++r) part[(wave * 128 + row) * 33 + crow(r, hi)] = acc[r];
        }
    }
    __syncthreads();
    const int tid2 = launder(F.tid);
    int e0 = 0, e1 = 0; float w0 = 0.f, w1 = 0.f; int rk0 = 0, rk1 = 0;
    if (tid2 < 128) {
        const float l0 = glog[tid2 * 4], l1 = glog[tid2 * 4 + 1], l2 = glog[tid2 * 4 + 2], l3 = glog[tid2 * 4 + 3];
        int gs = 0; float gm = l0; if (l1 > gm) { gm = l1; gs = 1; } if (l2 > gm) { gm = l2; gs = 2; } if (l3 > gm) { gm = l3; gs = 3; }
        const float gw = 1.f / (expf(l0 - gm) + expf(l1 - gm) + expf(l2 - gm) + expf(l3 - gm));
        float es[8];
#pragma unroll
        for (int n = 0; n < 8; ++n) { float a = bre[gs * 8 + n];
#pragma unroll
            for (int w = 0; w < 8; ++w) a += part[(w * 128 + tid2) * 33 + gs * 8 + n];
            es[n] = a; }
        int i0 = 0; float m0 = es[0];
#pragma unroll
        for (int n = 1; n < 8; ++n) if (es[n] > m0) { m0 = es[n]; i0 = n; }
        int i1 = 0; float m1 = -3e38f;
#pragma unroll
        for (int n = 0; n < 8; ++n) if (n != i0 && es[n] > m1) { m1 = es[n]; i1 = n; }
        const float r = expf(m1 - m0); w0 = gw / (1.f + r); w1 = gw * r / (1.f + r);
        e0 = gs * 8 + i0; e1 = gs * 8 + i1;
        rk0 = __hip_atomic_fetch_add(&lcnt[e0], 1, __ATOMIC_RELAXED, __HIP_MEMORY_SCOPE_WORKGROUP); rk1 = __hip_atomic_fetch_add(&lcnt[e1], 1, __ATOMIC_RELAXED, __HIP_MEMORY_SCOPE_WORKGROUP);
    }
    __syncthreads();
    if (tid2 < 32) gbase[tid2] = (int)__hip_atomic_fetch_add((int*)(F.ctl + CW_CNT + cset * 64) + tid2, lcnt[tid2], __ATOMIC_RELAXED, __HIP_MEMORY_SCOPE_AGENT);
    __syncthreads();
    if (tid2 < 128) {
        int* rt = (int*)(F.ws + WS_ROUTE); float* rw = (float*)(F.ws + WS_ROUTE + (size_t)T * 8);
        const int tok = tok0 + tid2;
        rt[tok * 2] = (e0 << 20) | (gbase[e0] + rk0); rt[tok * 2 + 1] = (e1 << 20) | (gbase[e1] + rk1);
        rw[tok * 2] = w0; rw[tok * 2 + 1] = w1;
    }
    __syncthreads();
}
__device__ __forceinline__ void moe_tables(Frame& F, int layer) {
    LAS int* ebase = (LAS int*)(F.lds + LDS_SCR + 4352); LAS int* pe = (LAS int*)(F.lds + LDS_SCR + 4608);
    if (F.tid == 0) { int a = 0; for (int e = 0; e < 32; ++e) { ebase[e] = a; const int c = (int)__hip_atomic_load((int*)(F.ctl + CW_CNT + layer * 64) + e, __ATOMIC_RELAXED, __HIP_MEMORY_SCOPE_AGENT); a += (c + 255) & ~255; } ebase[32] = a; }
    __syncthreads();
    for (int p = F.tid; p < MOE_PANELS; p += NTHR) { int e = 0; for (int k = 1; k < 32; ++k) if (p * 256 >= ebase[k]) e = k; pe[p] = e; }
    __syncthreads();
}
__device__ __forceinline__ void moe_gather_wg(Frame& F, int layer) {
    moe_tables(F, layer);
    LAS int* ebase = (LAS int*)(F.lds + LDS_SCR + 4352);
    const int tok0 = F.vcu * 128; int* rt = (int*)(F.ws + WS_ROUTE);
    int* rowsrc = (int*)(F.ctl + CW_ROWSRC) + layer * MOE_ROWS;
    if (F.tid < 256) { const int tok = tok0 + (F.tid >> 1), sl = F.tid & 1; const int v = rt[tok * 2 + sl]; const int row = ebase[v >> 20] + (v & 0xfffff);
        rowsrc[row] = tok; rt[4 * T + tok * 2 + sl] = row; }
}
__device__ __forceinline__ void combine_wg(Frame& F, int layer, float* xout, bf16_t* xb) {
    const int lane = F.lane, tok0 = F.vcu * 128;
    const float* Z = (const float*)(F.ws + WS_Z1); const float* stats = (const float*)(F.ws + WS_STATS);
    const int* rt = (const int*)(F.ws + WS_ROUTE); const float* rw = (const float*)(F.ws + WS_ROUTE + (size_t)T * 8);
    const bf16_t* YP = (const bf16_t*)(F.ws + S_YP);
    const float* g1 = (const float*)F.in[28] + layer * 1024; const float* b1 = (const float*)F.in[29] + layer * 1024;
    const float* g2 = (const float*)F.in[30] + layer * 1024; const float* b2 = (const float*)F.in[31] + layer * 1024;
    f32x4 G1[4], B1[4], G2[4], B2[4];
#pragma unroll
    for (int j = 0; j < 4; ++j) { const int c = lane * 4 + 256 * j; G1[j] = *(const f32x4*)(g1 + c); B1[j] = *(const f32x4*)(b1 + c); G2[j] = *(const f32x4*)(g2 + c); B2[j] = *(const f32x4*)(b2 + c); }
#pragma unroll 1
    for (int i0 = 0; i0 < 16; i0 += 4) {
        f32x4 z[4][4]; s16x4 ya[4][4], yb[4][4]; float mean[4], rstd[4], w0[4], w1[4];
#pragma unroll
        for (int u = 0; u < 4; ++u) { const int tok = tok0 + F.wave * 16 + i0 + u;
            mean[u] = stats[(size_t)tok * 2]; rstd[u] = stats[(size_t)tok * 2 + 1]; w0[u] = rw[tok * 2]; w1[u] = rw[tok * 2 + 1];
            const bf16_t* y0 = YP + (size_t)rt[4 * T + tok * 2] * D; const bf16_t* y1 = YP + (size_t)rt[4 * T + tok * 2 + 1] * D;
#pragma unroll
            for (int j = 0; j < 4; ++j) { const int c = lane * 4 + 256 * j; z[u][j] = *(const f32x4*)(Z + (size_t)tok * D + c); ya[u][j] = *(const s16x4*)(y0 + c); yb[u][j] = *(const s16x4*)(y1 + c); } }
        float s[4], q[4];
#pragma unroll
        for (int u = 0; u < 4; ++u) { s[u] = 0.f;
#pragma unroll
            for (int j = 0; j < 4; ++j) { const f32x4 x1 = (z[u][j] - mean[u]) * rstd[u] * G1[j] + B1[j]; f32x4 f;
#pragma unroll
                for (int e = 0; e < 4; ++e) f[e] = w0[u] * bf2f((unsigned short)ya[u][j][e]) + w1[u] * bf2f((unsigned short)yb[u][j][e]);
                z[u][j] = x1 * ALPHA + f; s[u] += (z[u][j][0] + z[u][j][1]) + (z[u][j][2] + z[u][j][3]); } }
#pragma unroll
        for (int u = 0; u < 4; ++u) { const float m2 = wsum(s[u]) * (1.f / D); q[u] = 0.f;
#pragma unroll
            for (int j = 0; j < 4; ++j) { z[u][j] = z[u][j] - m2; q[u] += (z[u][j][0] * z[u][j][0] + z[u][j][1] * z[u][j][1]) + (z[u][j][2] * z[u][j][2] + z[u][j][3] * z[u][j][3]); } }
#pragma unroll
        for (int u = 0; u < 4; ++u) { const int tok = tok0 + F.wave * 16 + i0 + u; const float r2 = rsqrtf(wsum(q[u]) * (1.f / D) + LN_EPS);
#pragma unroll
            for (int j = 0; j < 4; ++j) { const int c = lane * 4 + 256 * j; const f32x4 o = z[u][j] * r2 * G2[j] + B2[j];
                *(f32x4*)(xout + (size_t)tok * D + c) = o;
                if (xb) { u32x2 w; w.x = pk(o[0], o[1]); w.y = pk(o[2], o[3]); *(u32x2*)(xb + (size_t)tok * D + c) = w; } } }
    }
}
constexpr int NPHASE = 19;
__global__ void __launch_bounds__(NTHR, 2) mega(Args args) {
    extern __shared__ __attribute__((aligned(16))) unsigned char lds_[];
#define PHASE_FRAME() Frame F; { int t_ = (int)threadIdx.x; asm volatile("" : "+v"(t_)); GAS unsigned char* wg_ = (GAS unsigned char*)args.ws; asm volatile("" : "+s"(wg_)); unsigned char* w_ = (unsigned char*)wg_; int bx_ = (int)blockIdx.x; asm volatile("" : "+s"(bx_)); \
        F.lds = (LAS unsigned char*)lds_; F.ws = w_; F.ctl = (gu32*)(w_ + WS_CTL); F.in = args.in; F.out = args.out; F.tid = t_; F.lane = t_ & 63; F.wave = __builtin_amdgcn_readfirstlane(t_ >> 6); \
        F.G = (int)gridDim.x; F.vcu = (F.G % 8 == 0) ? (bx_ % 8) * (F.G / 8) + bx_ / 8 : bx_; } unsigned char* ws = F.ws; LAS unsigned char* ring = F.lds + RING_OFF; (void)ws; (void)ring
    Frame F0; { F0.lds = (LAS unsigned char*)lds_; F0.ws = args.ws; F0.ctl = (gu32*)(args.ws + WS_CTL); F0.tid = threadIdx.x; }
    volatile LAS unsigned* MISC = (volatile LAS unsigned*)(F0.lds + LDS_MISC);
    if (F0.tid < 64) MISC[F0.tid] = 0u;
    __syncthreads();
    const int lo = args.ph_lo, hi = args.ph_hi;
    const bool one = (hi - lo) > 1;
    XcdBarrier bar; bar.bar = (unsigned*)(F0.ctl + CW_BAR); bar.x = 0; bar.st = nullptr;
    if (one) bar = xcd_barrier_post((unsigned*)(F0.ctl + CW_BAR), MISC + 8);
#ifndef PH_MASK
#define PH_MASK 0xFFFFFFFFu
#endif
#define IN(k) ((((PH_MASK) >> (k)) & 1u) && lo <= (k) && (k) < hi)
#ifndef ABL
#define ABL 0
#endif
#ifndef DUP_PHASE
#define DUP_PHASE -1
#endif
#define REP(k) for (int rep = ((k) == DUP_PHASE ? 0 : 1); rep < 2; ++rep)
#define REPSYNC() do { if (rep == 0) xcd_barrier(bar); } while (0)
#ifndef BARX
#define BARX 1
#endif
#define SEAM(k) do { if (IN(k) && IN((k) + 1)) { for (int bx_ = 0; bx_ < BARX; ++bx_) xcd_barrier(bar); } } while (0)

    if (IN(0)) REP(0) { PHASE_FRAME(); const bool dry = (rep == 0); (void)dry; p0_prologue(F); REPSYNC(); } SEAM(0);
    if (IN(1)) REP(1) { PHASE_FRAME(); const bool dry = (rep == 0); (void)dry; Gemm g{(const bf16_t*)(ws + S_XB), (const bf16_t*)(ws + WS_W0IN), T, 1536, 1024, 1024, nullptr}; pg8::StaticOrder So; So.init(T, 1536, F.G, (int)blockIdx.x);
        EpiTile E{(bf16_t*)(ws + S_H0B), 1536, 4, 0, 1.f, 0};
        pg8::gemm_phase<EpiTile, pg8::StaticOrder, true, true>(ring, g, So, E); REPSYNC(); } SEAM(1);
    if (IN(2)) REP(2) { PHASE_FRAME(); const bool dry = (rep == 0); (void)dry; for (int it = F.vcu * NWAVES + F.wave; it < 2048; it += F.G * NWAVES) { if (!(dry && (ABL & 2048))) mla_up_item(F, it); }
        __syncthreads();
        if (!(dry && (ABL & 1024))) for (int ch = F.vcu; ch < 256; ch += F.G) gmlp_chunk(F, ch, dry); REPSYNC(); } SEAM(2);
    if (IN(3)) REP(3) { PHASE_FRAME(); const bool dry = (rep == 0); (void)dry; for (int c = F.vcu; c < 256; c += F.G) { const int bh = c >> 1;
#pragma unroll 1
            for (int i = 0; i < 4; ++i) { const int qb = (c & 1) ? ((i == 0) ? 6 : (i == 1) ? 1 : (i == 2) ? 5 : 2) : ((i == 0) ? 7 : (i == 1) ? 0 : (i == 2) ? 4 : 3); mla_attn_unit(F, bh >> 3, bh & 7, qb, dry ? ABL : 0); } } REPSYNC(); } SEAM(3);
    if (IN(4)) REP(4) { PHASE_FRAME(); const bool dry = (rep == 0); (void)dry; Gemm g{(const bf16_t*)(ws + S_H0B), (const bf16_t*)(ws + WS_W0O), T, 1024, 1024, 1536, nullptr}; pg8::StaticOrder So; So.init(T, 1024, F.G, (int)blockIdx.x);
        EpiResid E{(const float*)args.in[0], (float*)(ws + WS_Z1)};
        pg8::gemm_phase<EpiResid, pg8::StaticOrder, true, true>(ring, g, So, E); REPSYNC(); } SEAM(4);
#pragma unroll
    for (int layer = 0; layer < 2; ++layer) {
        const int pb = layer ? 14 : 5;
        if (IN(pb)) REP(pb) { PHASE_FRAME(); const bool dry = (rep == 0); (void)dry; for (int c = F.vcu; c < 256; c += F.G) { Frame F2 = F; F2.vcu = c; ln_route_wg(F2, layer, dry ? 2 + layer : layer); } REPSYNC(); } SEAM(pb);
        if (IN(pb + 1)) REP(pb + 1) { PHASE_FRAME(); const bool dry = (rep == 0); (void)dry; for (int c = F.vcu; c < 256; c += F.G) { Frame F2 = F; F2.vcu = c; moe_gather_wg(F2, layer); } REPSYNC(); } SEAM(pb + 1);
        if (IN(pb + 2)) REP(pb + 2) { PHASE_FRAME(); const bool dry = (rep == 0); (void)dry; moe_tables(F, layer); const LAS int* eb = (const LAS int*)(F.lds + LDS_SCR + 4352);
            Gemm g{(const bf16_t*)(ws + S_X1B), (const bf16_t*)(ws + WS_WGU) + (size_t)layer * 32 * 512 * 1024, MOE_ROWS, 512, 1024, 1024, (const int*)(F.ctl + CW_ROWSRC) + layer * MOE_ROWS};
            MoeOrder<2> So{(const LAS int*)(F.lds + LDS_SCR + 4608), (eb[32] >> 8) * 2, F.G, F.vcu}; EpiMoeUp E{(bf16_t*)(ws + S_HP)};
            pg8::gemm_phase<EpiMoeUp, MoeOrder<2>, true, true, true>(ring, g, So, E); REPSYNC(); } SEAM(pb + 2);
        if (IN(pb + 3)) REP(pb + 3) { PHASE_FRAME(); const bool dry = (rep == 0); (void)dry; moe_tables(F, layer); const LAS int* eb = (const LAS int*)(F.lds + LDS_SCR + 4352);
            Gemm g{(const bf16_t*)(ws + S_HP), (const bf16_t*)(ws + WS_WD) + (size_t)layer * 32 * 1024 * 256, MOE_ROWS, 1024, 256, 256, nullptr};
            MoeOrder<4> So{(const LAS int*)(F.lds + LDS_SCR + 4608), (eb[32] >> 8) * 4, F.G, F.vcu}; EpiMoeDown E{(bf16_t*)(ws + S_YP)};
            pg8::gemm_phase<EpiMoeDown, MoeOrder<4>, false, true>(ring, g, So, E); REPSYNC(); } SEAM(pb + 3);
        if (IN(pb + 4)) REP(pb + 4) { PHASE_FRAME(); const bool dry = (rep == 0); (void)dry; for (int c = F.vcu; c < 256; c += F.G) { Frame F2 = F; F2.vcu = c; combine_wg(F2, layer, args.out, layer ? nullptr : (bf16_t*)(ws + S_X2B)); } REPSYNC(); }
        if (layer == 0) {
            SEAM(9);
            if (IN(10)) REP(10) { PHASE_FRAME(); const bool dry = (rep == 0); (void)dry; Gemm g{(const bf16_t*)(ws + S_X2B), (const bf16_t*)(ws + WS_W1IN), T, 2048, 1024, 1024, nullptr}; pg8::StaticOrder So; So.init(T, 2048, F.G, (int)blockIdx.x);
                EpiTile E{(bf16_t*)(ws + S_H1B), 2048, 0, 4, QS_NSA, 0};
                pg8::gemm_phase<EpiTile, pg8::StaticOrder, true, true>(ring, g, So, E); REPSYNC(); } SEAM(10);
            if (IN(11)) REP(11) { PHASE_FRAME(); const bool dry = (rep == 0); (void)dry; for (int it = F.vcu; it < 256; it += F.G) cmp_item(F, it); REPSYNC(); } SEAM(11);
            if (IN(12)) REP(12) { PHASE_FRAME(); const bool dry = (rep == 0); (void)dry; for (int c = F.vcu; c < 256; c += F.G) { const int bg = c >> 3, s = c & 7;
#pragma unroll 1
                    for (int i = 0; i < 8; ++i) { const int k = i >> 1; const int blk = (k == 0) ? 31 - s : (k == 1) ? 16 + s : (k == 2) ? 15 - s : s; nsa_unit(F, bg >> 1, bg & 1, blk * 2 + (i & 1), dry, dry ? ABL : 0); } } REPSYNC(); } SEAM(12);
            if (IN(13)) REP(13) { PHASE_FRAME(); const bool dry = (rep == 0); (void)dry; Gemm g{(const bf16_t*)(ws + S_H1B), (const bf16_t*)(ws + WS_W1O), T, 1024, 1024, 2048, nullptr}; pg8::StaticOrder So; So.init(T, 1024, F.G, (int)blockIdx.x);
                EpiResid E{(const float*)args.out, (float*)(ws + WS_Z1)};
                pg8::gemm_phase<EpiResid, pg8::StaticOrder, true, true>(ring, g, So, E); REPSYNC(); } SEAM(13);
        }
    }
#undef IN
#undef SEAM
}

#ifndef MK_SPLIT
#define MK_SPLIT 0
#endif
static void launch_all(void* const* d_in, float* out, unsigned char* ws, hipStream_t stream) {
    static int grid = 0;
    if (grid == 0) {
        int dev = 0, cus = 0, per_cu = 0;
        if (hipGetDevice(&dev) != hipSuccess || hipDeviceGetAttribute(&cus, hipDeviceAttributeMultiprocessorCount, dev) != hipSuccess) { grid = -1; return; }
        if (hipFuncSetAttribute((const void*)mega, hipFuncAttributeMaxDynamicSharedMemorySize, LDS_BYTES) != hipSuccess) { fprintf(stderr, "kernel_launch: hipFuncSetAttribute failed\n"); grid = -1; return; }
        if (hipOccupancyMaxActiveBlocksPerMultiprocessor(&per_cu, (const void*)mega, NTHR, LDS_BYTES) != hipSuccess || per_cu < 1) fprintf(stderr, "kernel_launch: occupancy query says %d\n", per_cu);
        (void)hipGetLastError();
        grid = cus < 256 ? cus : 256;
    }
    if (grid < 0) return;
    (void)hipMemsetAsync(ws + WS_CTL, 0, CTL_ZERO_BYTES, stream);
    Args a{};
    for (int i = 0; i < 32; ++i) a.in[i] = d_in[i];
    a.out = out; a.ws = ws;
#if MK_SPLIT
    for (int p = 0; p < NPHASE; ++p) { a.ph_lo = p; a.ph_hi = p + 1; hipLaunchKernelGGL(mega, dim3(grid), dim3(NTHR), LDS_BYTES, stream, a); }
#else
    a.ph_lo = 0; a.ph_hi = NPHASE; hipLaunchKernelGGL(mega, dim3(grid), dim3(NTHR), LDS_BYTES, stream, a);
#endif
}
}

extern "C" void kernel_launch(void* const* d_in, const int* in_sizes, int n_in, void* d_out, int out_size, void* d_ws, size_t ws_size, hipStream_t stream) {
    fk::launch_all(d_in, (float*)d_out, (unsigned char*)d_ws, stream);
}
```

```cpp
#include <hip/hip_runtime.h>
#include <stdint.h>
#include <math.h>
#include <cstdio>
namespace pg8 {
#define PG8_LAS __attribute__((address_space(3)))
typedef unsigned short bf16_t;
typedef short bf16x8 __attribute__((ext_vector_type(8)));
typedef float f32x4 __attribute__((ext_vector_type(4)));
typedef unsigned u32x4 __attribute__((ext_vector_type(4)));
constexpr int BM = 256, BK = 64, HALF = 128, HTB = HALF * BK * 2  , STAGE_BYTES = 8 * HTB, NXCD = 8, WGM = 8;

__host__ __device__ __forceinline__ int lds_byte(int r, int c) { const int st = (r >> 4) * 2 + (c >> 5), rr = r & 15, cc = c & 31, ob = rr * 64 + cc * 2; return st * 1024 + (ob ^ (((ob >> 9) & 1) << 5)); }
__host__ __device__ __forceinline__ void stage_rc(int b, int& R, int& C) { const int st = b / 1024, sb = b % 1024, swz = sb ^ (((sb >> 9) & 1) << 5); R = (st >> 1) * 16 + swz / 64; C = (st & 1) * 32 + (swz % 64) / 2; }
__host__ __device__ __forceinline__ int perm32(int rho) { const int n = rho >> 4, i = rho & 15; return 8 * (i >> 2) + 4 * n + (i & 3); }

struct Unit { int pm, pn; };
struct Gemm { const bf16_t* A; const bf16_t* Bt; int M, N, K, lda; const int* rowsrc; };

struct StaticOrder {
    int nM, nN, nwg, G, c;
    __host__ __device__ void init(int M, int N, int G_, int c_) { nM = M / BM; nN = N / BM; nwg = nM * nN; G = G_; c = c_; }
    __host__ __device__ bool next(int i, Unit& u) const {
        const long L = (long)i * G + c; if (L >= nwg) return false;
        int wgid = (int)L; { const int q = nwg / NXCD, r = nwg % NXCD, xcd = wgid % NXCD, off = wgid / NXCD; wgid = (xcd < r ? xcd * (q + 1) : r * (q + 1) + (xcd - r) * q) + off; }
        const int nig = WGM * nN, gid = wgid / nig, fm = gid * WGM, gsz = (nM - fm) < WGM ? (nM - fm) : WGM;
        u.pm = fm + ((wgid % nig) % gsz); u.pn = (wgid % nig) / gsz; return true;
    }
    __device__ __forceinline__ void a_ready(const Unit&) const {}
    __device__ __forceinline__ void done(const Unit&) const {}
};

__device__ __forceinline__ unsigned cvt_pk_bf16(float lo, float hi) { unsigned r; asm volatile("v_cvt_pk_bf16_f32 %0, %1, %2" : "=v"(r) : "v"(lo), "v"(hi)); return r; }
typedef float f32x2 __attribute__((ext_vector_type(2)));
template <class Epi, class Sched, bool ALIGN_EPI = false, bool SP2 = false, bool GATHER = false>
__device__ __forceinline__ void gemm_phase(PG8_LAS unsigned char* lds, const Gemm g, const Sched& S, const Epi& E) {
    int tid_l = (int)threadIdx.x; asm volatile("" : "+v"(tid_l));
    const int tid = tid_l, wid = __builtin_amdgcn_readfirstlane(tid >> 6), lane = tid & 63, wr = wid >> 2, wc = wid & 3, fr = lane & 15, fq = lane >> 4;
    const int K = g.K, nt = K / BK;
    unsigned voffA[2], voffB[2], voffA1[2] = {0u, 0u}, nvoffA[2] = {0u, 0u}, nvoffA1[2] = {0u, 0u}; int RA[2], CA[2];
#pragma unroll
    for (int i = 0; i < 2; ++i) { int R, C; stage_rc(tid * 16 + i * 8192, R, C); const int Rb = Epi::PERM ? ((R & ~31) + perm32(R & 31)) : R;
        voffA[i] = (unsigned)(R * g.lda + C) * 2u; voffB[i] = (unsigned)(Rb * K + C) * 2u; RA[i] = R; CA[i] = C; }
    const size_t kstep = (size_t)(BK * 2);
    const size_t hstepA = (size_t)HALF * g.lda * 2, hstepB = (size_t)HALF * K * 2;
    const size_t tstepA = 2 * hstepA, tstepB = 2 * hstepB;
    const unsigned ldsw = (unsigned)wid * 1024u;
    const int aoff = lds_byte(wr * 64 + fr, fq * 8), boff = lds_byte(wc * 32 + fr, fq * 8);
#define PG8_SA(b, h) (((b) * 2 + (h)) * HTB)
#define PG8_SB(b, h) ((4 + (b) * 2 + (h)) * HTB)
#define PG8_STAGE(bufoff, gbase, voff) do { _Pragma("unroll") for (int _i = 0; _i < 2; ++_i) \
        __builtin_amdgcn_global_load_lds((const unsigned*)((const char*)(gbase) + (voff)[_i]), (PG8_LAS unsigned*)(lds + (bufoff) + ldsw + _i * 8192), 16, 0, 0); } while (0)
#define PG8_GSET(u, v0, v1) do { _Pragma("unroll") for (int _i = 0; _i < 2; ++_i) { v0[_i] = (unsigned)(S.arow((u), RA[_i]) * g.lda + CA[_i]) * 2u; v1[_i] = (unsigned)(S.arow((u), HALF + RA[_i]) * g.lda + CA[_i]) * 2u; } } while (0)
#define PG8_STA0(slot, P, NX) do { if constexpr (GATHER) { if (NX) PG8_STAGE(slot, P, nvoffA); else PG8_STAGE(slot, P, voffA); } else PG8_STAGE(slot, P, voffA); } while (0)
#define PG8_STA1(slot, P, NX) do { if constexpr (GATHER) { if (NX) PG8_STAGE(slot, P, nvoffA1); else PG8_STAGE(slot, P, voffA1); } else PG8_STAGE(slot, (P) + hstepA, voffA); } while (0)
#define PG8_LDA(dst, b, h) do { _Pragma("unroll") for (int m = 0; m < 4; ++m) _Pragma("unroll") for (int k = 0; k < 2; ++k) dst[m][k] = *(const PG8_LAS bf16x8*)(lds + PG8_SA(b, h) + aoff + m * 2048 + k * 1024); } while (0)
#define PG8_LDB(dst, b, h) do { _Pragma("unroll") for (int n = 0; n < 2; ++n) _Pragma("unroll") for (int k = 0; k < 2; ++k) dst[n][k] = *(const PG8_LAS bf16x8*)(lds + PG8_SB(b, h) + boff + n * 2048 + k * 1024); } while (0)
#define PG8_MMA(ai, bj, At, Bt) do { __builtin_amdgcn_s_setprio(1); _Pragma("unroll") for (int m = 0; m < 4; ++m) _Pragma("unroll") for (int n = 0; n < 2; ++n) _Pragma("unroll") for (int k = 0; k < 2; ++k) \
        acc[ai][bj][m][n] = __builtin_amdgcn_mfma_f32_16x16x32_bf16(Bt[n][k], At[m][k], acc[ai][bj][m][n], 0, 0, 0); __builtin_amdgcn_s_setprio(0); } while (0)
#define PG8_WAIT_V(n) asm volatile("s_waitcnt vmcnt(" #n ")" ::: "memory")
#define PG8_WAIT_L(n) asm volatile("s_waitcnt lgkmcnt(" #n ")" ::: "memory")
#define PG8_BAR __builtin_amdgcn_s_barrier()
#define PG8_SCHED __builtin_amdgcn_sched_barrier(0)
    Unit cur, nxt; int ui = 0;
    if (!S.next(0, cur)) return;
    f32x4 acc[2][2][4][2];
#pragma unroll
    for (int a = 0; a < 2; ++a)
#pragma unroll
        for (int b = 0; b < 2; ++b)
#pragma unroll
            for (int m = 0; m < 4; ++m)
#pragma unroll
                for (int n = 0; n < 2; ++n) acc[a][b][m][n] = (f32x4){0.f, 0.f, 0.f, 0.f};
    bf16x8 At[4][2], B0[2][2], B1[2][2];
    const char* cA = GATHER ? (const char*)g.A : (const char*)g.A + (size_t)cur.pm * tstepA; if constexpr (GATHER) PG8_GSET(cur, voffA, voffA1);
    const char* cB = (const char*)g.Bt + (size_t)cur.pn * tstepB;
    S.a_ready(cur);
    if constexpr (SP2) {
        PG8_STAGE(PG8_SB(0, 0), cB, voffB); PG8_STAGE(PG8_SB(0, 1), cB + hstepB, voffB); PG8_STA0(PG8_SA(0, 0), cA, false); PG8_STA1(PG8_SA(0, 1), cA, false);
        if (wr == 1) PG8_BAR;
        PG8_WAIT_V(2); PG8_BAR;
        PG8_STAGE(PG8_SB(1, 0), cB + kstep, voffB); PG8_STA0(PG8_SA(1, 0), cA + kstep, false); PG8_STAGE(PG8_SB(1, 1), cB + hstepB + kstep, voffB);
        PG8_WAIT_V(6); PG8_BAR;
    } else {
        PG8_STAGE(PG8_SB(0, 0), cB, voffB); PG8_STA0(PG8_SA(0, 0), cA, false); PG8_STAGE(PG8_SB(0, 1), cB + hstepB, voffB); PG8_STA1(PG8_SA(0, 1), cA, false);
        if (wr == 1) PG8_BAR;
        PG8_WAIT_V(4); PG8_BAR;
        PG8_STAGE(PG8_SB(1, 0), cB + kstep, voffB); PG8_STA0(PG8_SA(1, 0), cA + kstep, false); PG8_STAGE(PG8_SB(1, 1), cB + hstepB + kstep, voffB);
        PG8_WAIT_V(6); PG8_BAR;
    }
    for (;;) {
        const bool has_next = S.next(ui + 1, nxt);
        const char* nA = has_next ? (GATHER ? (const char*)g.A : (const char*)g.A + (size_t)nxt.pm * tstepA) : cA; if constexpr (GATHER) { if (has_next) PG8_GSET(nxt, nvoffA, nvoffA1); } const char* nB = has_next ? (const char*)g.Bt + (size_t)nxt.pn * tstepB : cB;
        for (int t = 0; t < nt; t += 2) {
            const bool last = (t == nt - 2);
            const char* a1 = cA + (size_t)(t + 1) * kstep;
            const char* a2 = last ? nA : cA + (size_t)(t + 2) * kstep; const char* b2 = last ? nB : cB + (size_t)(t + 2) * kstep;
            const char* a3 = a2 + kstep; const char* b3 = b2 + kstep;
            if (last && has_next) S.a_ready(nxt);
            if constexpr (SP2) {
            PG8_LDB(B0, 0, 0); PG8_LDB(B1, 0, 1); PG8_SCHED; PG8_LDA(At, 0, 0); PG8_STA1(PG8_SA(1, 1), a1, false);
            PG8_WAIT_V(8); PG8_WAIT_L(0); PG8_BAR; PG8_MMA(0, 0, At, B0); PG8_MMA(0, 1, At, B1); PG8_BAR; PG8_SCHED;
            PG8_LDA(At, 0, 1); PG8_STAGE(PG8_SB(0, 0), b2, voffB); PG8_STAGE(PG8_SB(0, 1), b2 + hstepB, voffB); PG8_STA0(PG8_SA(0, 0), a2, last && has_next);
            PG8_WAIT_V(8); PG8_WAIT_L(0); PG8_BAR; PG8_MMA(1, 0, At, B0); PG8_MMA(1, 1, At, B1); PG8_BAR; PG8_SCHED;
            PG8_LDB(B0, 1, 0); PG8_LDB(B1, 1, 1); PG8_SCHED; PG8_LDA(At, 1, 0); PG8_STA1(PG8_SA(0, 1), a2, last && has_next);
            PG8_WAIT_V(8); PG8_WAIT_L(0); PG8_BAR; PG8_MMA(0, 0, At, B0); PG8_MMA(0, 1, At, B1); PG8_BAR; PG8_SCHED;
            PG8_LDA(At, 1, 1); PG8_STAGE(PG8_SB(1, 0), b3, voffB); PG8_STAGE(PG8_SB(1, 1), b3 + hstepB, voffB); PG8_STA0(PG8_SA(1, 0), a3, last && has_next);
            PG8_WAIT_V(8); PG8_WAIT_L(0); PG8_BAR; PG8_MMA(1, 0, At, B0); PG8_MMA(1, 1, At, B1); PG8_BAR; PG8_SCHED;
            } else {
            PG8_LDB(B0, 0, 0); PG8_SCHED; PG8_LDA(At, 0, 0); PG8_STA1(PG8_SA(1, 1), a1, false);
            PG8_WAIT_L(8); PG8_BAR; PG8_WAIT_L(0); PG8_MMA(0, 0, At, B0); PG8_BAR; PG8_SCHED;
            PG8_LDB(B1, 0, 1); PG8_STAGE(PG8_SB(0, 0), b2, voffB);
            PG8_BAR; PG8_WAIT_L(0); PG8_MMA(0, 1, At, B1); PG8_BAR;
            PG8_LDA(At, 0, 1); PG8_STA0(PG8_SA(0, 0), a2, last && has_next);
            PG8_BAR; PG8_WAIT_L(0); PG8_MMA(1, 0, At, B0); PG8_BAR; PG8_SCHED;
            PG8_STAGE(PG8_SB(0, 1), b2 + hstepB, voffB);
            PG8_WAIT_V(6); PG8_BAR; PG8_MMA(1, 1, At, B1); PG8_BAR;
            PG8_LDB(B0, 1, 0); PG8_SCHED; PG8_LDA(At, 1, 0); PG8_STA1(PG8_SA(0, 1), a2, last && has_next);
            PG8_WAIT_L(8); PG8_BAR; PG8_WAIT_L(0); PG8_MMA(0, 0, At, B0); PG8_BAR; PG8_SCHED;
            PG8_LDB(B1, 1, 1); PG8_STAGE(PG8_SB(1, 0), b3, voffB);
            PG8_BAR; PG8_WAIT_L(0); PG8_MMA(0, 1, At, B1); PG8_BAR;
            PG8_LDA(At, 1, 1); PG8_STA0(PG8_SA(1, 0), a3, last && has_next);
            PG8_BAR; PG8_WAIT_L(0); PG8_MMA(1, 0, At, B0); PG8_BAR; PG8_SCHED;
            PG8_STAGE(PG8_SB(1, 1), b3 + hstepB, voffB);
            PG8_WAIT_V(6); PG8_BAR; PG8_MMA(1, 1, At, B1); PG8_BAR;
            }
        }
        if constexpr (ALIGN_EPI) { if (wr == 0) PG8_BAR; }
        if constexpr (!Epi::AFTER_DRAIN) { E(acc, cur, wr, wc, fr, fq); S.done(cur); }
        if (!has_next) break;
#pragma unroll
        for (int a = 0; a < 2; ++a)
#pragma unroll
            for (int b = 0; b < 2; ++b)
#pragma unroll
                for (int m = 0; m < 4; ++m)
#pragma unroll
                    for (int n = 0; n < 2; ++n) acc[a][b][m][n] = (f32x4){0.f, 0.f, 0.f, 0.f};
        cur = nxt; cA = nA; cB = nB; ++ui;
        if constexpr (GATHER) { voffA[0] = nvoffA[0]; voffA[1] = nvoffA[1]; voffA1[0] = nvoffA1[0]; voffA1[1] = nvoffA1[1]; }
        if constexpr (ALIGN_EPI) { if (wr == 1) PG8_BAR; }
    }
    PG8_WAIT_V(0);
    if constexpr (!ALIGN_EPI) { if (wr == 0) PG8_BAR; }
    PG8_BAR;
    if constexpr (Epi::AFTER_DRAIN) { E.fused(acc, cur, wr, wc, fr, fq, lds, wid, lane); S.done(cur); }
#undef PG8_SA
#undef PG8_SB
#undef PG8_STAGE
#undef PG8_GSET
#undef PG8_STA0
#undef PG8_STA1
#undef PG8_LDA
#undef PG8_LDB
#undef PG8_MMA
#undef PG8_WAIT_V
#undef PG8_WAIT_L
#undef PG8_BAR
#undef PG8_SCHED
}
}
#define GAS __attribute__((address_space(1)))
#define LAS __attribute__((address_space(3)))
typedef unsigned short bf16;
typedef unsigned v4u __attribute__((ext_vector_type(4)));
typedef float f32x4 __attribute__((ext_vector_type(4)));
typedef short bf16x8 __attribute__((ext_vector_type(8)));
typedef GAS unsigned gu32;
typedef GAS unsigned long long gu64;
#define RLX_AGENT __ATOMIC_RELAXED, __HIP_MEMORY_SCOPE_AGENT
#define LDS_WAIT() asm volatile("s_waitcnt lgkmcnt(0)" ::: "memory")
#define VM_WAIT() asm volatile("s_waitcnt vmcnt(0)" ::: "memory")
__device__ __forceinline__ unsigned long long rt() { return __builtin_amdgcn_s_memrealtime(); }
__device__ __forceinline__ unsigned f2bf(float f) { unsigned u = __builtin_bit_cast(unsigned, f); return (u + 0x7fffu + ((u >> 16) & 1u)) >> 16; }
__device__ __forceinline__ unsigned pk2(float lo, float hi) { return f2bf(lo) | (f2bf(hi) << 16); }

#define XB_TMO      128
#define XB_XCNT(j)  (256  + 64 * (j))
#define XB_XSUB(j)  (1280 + 64 * (j))
#define XB_XGEN(j)  (2304 + 64 * (j))
#define XB_TOP      3328
#define XB_TOPGEN   3392
#define XCD_BAR_WORDS 3456
#define XB_SPIN_CAP (1u << 18)

__device__ __forceinline__ unsigned xb_ld(unsigned* p)              { return __hip_atomic_load(p, __ATOMIC_RELAXED, __HIP_MEMORY_SCOPE_AGENT); }
__device__ __forceinline__ unsigned xb_add(unsigned* p, unsigned v) { return __hip_atomic_fetch_add(p, v, __ATOMIC_RELAXED, __HIP_MEMORY_SCOPE_AGENT); }
__device__ __forceinline__ unsigned xb_xcc_id() { return (unsigned)__builtin_amdgcn_s_getreg((3 << 11) | 20) & 0xFu; }
#define XB_SPIN(cond, bar) do { unsigned _sp = 0; while (cond) { __builtin_amdgcn_s_sleep(1); \
    if ((++_sp & 255u) == 0u) { if (xb_ld(&(bar)[XB_TMO])) break; if (_sp > XB_SPIN_CAP) { atomicAdd(&(bar)[XB_TMO], 1u); break; } } } } while (0)

struct XcdBarrier {
    unsigned* bar; unsigned x;
    volatile LAS unsigned* st;
};

__device__ __forceinline__ XcdBarrier xcd_barrier_post(unsigned* bar, volatile LAS unsigned* st) {
    XcdBarrier b; b.bar = bar; b.x = xb_xcc_id(); b.st = st;
    if (threadIdx.x == 0) (void)xb_add(&bar[XB_XCNT(b.x)], 1u);
    return b;
}
__device__ __forceinline__ void xcd_barrier_complete(unsigned* bar, unsigned x, unsigned& nloc, unsigned& nx) {
    const unsigned G = gridDim.x * gridDim.y * gridDim.z;
    unsigned sum, cnt, mine, sp = 0u;
    for (;;) {
        sum = 0u; cnt = 0u; mine = 0u;
#pragma unroll
        for (unsigned j = 0; j < 16; ++j) { const unsigned c = xb_ld(&bar[XB_XCNT(j)]); sum += c; cnt += (c > 0u) ? 1u : 0u; mine = (j == x) ? c : mine; }
        if (sum == G) break;
        __builtin_amdgcn_s_sleep(1);
        if ((++sp & 255u) == 0u) { if (xb_ld(&bar[XB_TMO])) break; if (sp > XB_SPIN_CAP) { atomicAdd(&bar[XB_TMO], 1u); break; } }
    }
    nloc = mine > 0u ? mine : 1u; nx = cnt > 0u ? cnt : 1u;
}

__device__ __forceinline__ void xcd_barrier(const XcdBarrier& b) {
    asm volatile("s_waitcnt vmcnt(0)" ::: "memory");
    __syncthreads();
    if (threadIdx.x == 0) {
        unsigned* bar = b.bar;
        __builtin_amdgcn_s_waitcnt(0);
        unsigned nloc = b.st[0], nx = b.st[1];
        if (nloc == 0u) { xcd_barrier_complete(bar, b.x, nloc, nx); b.st[0] = nloc; b.st[1] = nx; }
        const unsigned old = xb_add(&bar[XB_XSUB(b.x)], 1u);
        const unsigned gen = old / nloc;
        if (old + 1u == (gen + 1u) * nloc) {
            __builtin_amdgcn_fence(__ATOMIC_RELEASE, "agent");
            asm volatile("s_waitcnt vmcnt(0)" ::: "memory");
            const unsigned og = xb_add(&bar[XB_TOP], 1u);
            const unsigned tg = og / nx;
            if (og + 1u == (tg + 1u) * nx) xb_add(&bar[XB_TOPGEN], 1u);
            else XB_SPIN(xb_ld(&bar[XB_TOPGEN]) == tg, bar);
            __builtin_amdgcn_fence(__ATOMIC_ACQUIRE, "agent");
            xb_add(&bar[XB_XGEN(b.x)], 1u);
            asm volatile("s_waitcnt vmcnt(0)" ::: "memory");
        } else {
            XB_SPIN(xb_ld(&bar[XB_XGEN(b.x)]) == gen, bar);
            __builtin_amdgcn_fence(__ATOMIC_ACQUIRE, "agent");
            asm volatile("s_waitcnt vmcnt(0)" ::: "memory");
        }
    }
    __syncthreads();
}
namespace fk {
using pg8::bf16_t; using pg8::f32x4; using pg8::u32x4; using pg8::Unit; using pg8::Gemm;
typedef float f32x16 __attribute__((ext_vector_type(16)));
typedef float f32x2 __attribute__((ext_vector_type(2)));
typedef unsigned u32x2 __attribute__((ext_vector_type(2)));
typedef short s16x4 __attribute__((ext_vector_type(4)));
constexpr int NB = 16, S = 2048, D = 1024, T = NB * S;
constexpr float ALPHA = 1.41421356237309515f, LN_EPS = 1e-5f, LOG2E = 1.4426950408889634f;
constexpr float QS_MLA = 0.10206207261596575f * LOG2E;
constexpr float QS_NSA = 0.125f * LOG2E;
constexpr int NWAVES = 8, NTHR = 512;
constexpr int MOE_ROWS = 73728, MOE_PANELS = MOE_ROWS / 256;

constexpr size_t MiB = 1u << 20;
constexpr size_t WS_CTL = 0, CTL_ZERO_BYTES = 1 * MiB;
constexpr size_t WS_W0IN = 1 * MiB, WS_WUQ = 4 * MiB, WS_WUKV = WS_WUQ + 512 * 1024, WS_W0O = 5 * MiB, WS_W1IN = 7 * MiB, WS_WCK1 = 11 * MiB, WS_WCV1 = 12 * MiB,
                 WS_WCK2 = 13 * MiB, WS_WCV2 = 13 * MiB + 64 * 1024, WS_WSB = 13 * MiB + 128 * 1024, WS_CBIAS = 13 * MiB + 512 * 1024, WS_W1O = 14 * MiB, WS_WGU = 16 * MiB, WS_WD = 80 * MiB;
constexpr size_t WS_Z1 = 113 * MiB;
constexpr size_t WS_STATS = 241 * MiB;
constexpr size_t WS_ROUTE = WS_STATS + 256 * 1024;
constexpr size_t WS_S = 242 * MiB;
constexpr size_t S_XB = WS_S, S_H0B = WS_S + 64 * MiB, S_Q96 = WS_S, S_KN = WS_S + 160 * MiB, S_V = WS_S + 192 * MiB, S_KRB = WS_S + 224 * MiB;
constexpr size_t S_X1B = WS_S, S_XP = WS_S + 64 * MiB, S_HP = WS_S + 208 * MiB, S_YP = WS_S, S_X2B = WS_S + 144 * MiB;
constexpr size_t S_H1B = WS_S, S_KCMP = WS_S + 208 * MiB, S_VCMP = S_KCMP + 1 * MiB;
constexpr size_t WS_END = WS_S + 244 * MiB;
constexpr size_t WS_EXPL = 488 * MiB;
static_assert(WS_END <= 512 * MiB, "workspace map");
constexpr int CW_BAR = 4096, CW_CNT = 16384  , CW_ROWSRC = 32768  ;
static_assert((CW_ROWSRC + 2 * 73728) * 4 <= (int)CTL_ZERO_BYTES, "control words inside the per-call memset");

constexpr int RING_OFF = 0, LDS_MISC = 139264, LDS_SCR = LDS_MISC + 256, LDS_BYTES = 163840;

struct Args { const void* in[32]; float* out; unsigned char* ws; int ph_lo, ph_hi; };

__device__ __forceinline__ float bf2f(unsigned short b) { return __uint_as_float((unsigned)b << 16); }
__device__ __forceinline__ unsigned pk(float lo, float hi) { return pg8::cvt_pk_bf16(lo, hi); }
template <int CTRL> __device__ __forceinline__ float dppf(float v) { return __builtin_bit_cast(float, __builtin_amdgcn_update_dpp(0, __builtin_bit_cast(int, v), CTRL, 0xf, 0xf, true)); }
__device__ __forceinline__ float wsum(float v) {
    v += dppf<0xB1>(v); v += dppf<0x4E>(v); v += dppf<0x141>(v); v += dppf<0x140>(v);
    const int b = __builtin_bit_cast(int, v);
    return (__builtin_bit_cast(float, __builtin_amdgcn_readlane(b, 0)) + __builtin_bit_cast(float, __builtin_amdgcn_readlane(b, 16))) + (__builtin_bit_cast(float, __builtin_amdgcn_readlane(b, 32)) + __builtin_bit_cast(float, __builtin_amdgcn_readlane(b, 48)));
}
__device__ __forceinline__ int launder(int x) { asm volatile("" : "+v"(x)); return x; }
__device__ __forceinline__ float ex2(float x) { return __builtin_amdgcn_exp2f(x); }
__device__ __forceinline__ float gelu_t(float x) {
    const float u = 0.7978845608028654f * (x + 0.044715f * x * x * x);
    return x * __builtin_amdgcn_rcpf(1.f + ex2(-2.f * LOG2E * u));
}
__device__ __forceinline__ int crow(int r, int hi) { return (r & 3) + 8 * (r >> 2) + 4 * hi; }
__device__ __forceinline__ f32x16 mfma32(bf16x8 a, bf16x8 b, f32x16 c) { return __builtin_amdgcn_mfma_f32_32x32x16_bf16(a, b, c, 0, 0, 0); }
__device__ __forceinline__ bf16x8 ld8g(const bf16_t* p) { return *(const bf16x8*)p; }
typedef short v4i16_t __attribute__((ext_vector_type(4)));
__device__ __forceinline__ s16x4 trld(const LAS unsigned char* p) { return __builtin_bit_cast(s16x4, __builtin_amdgcn_ds_read_tr16_b64_v4i16((LAS v4i16_t*)p)); }

struct Frame {
    LAS unsigned char* lds; gu32* ctl; unsigned char* ws;
    int tid, lane, wave, vcu, G;
    const void* const* in; float* out;
};

struct EpiTile {
    static constexpr bool PERM = true, AFTER_DRAIN = false;
    bf16_t* O; int ldc; int ngelu; int nscale; float scale; int pad;
    __device__ __forceinline__ void operator()(const f32x4 (&acc)[2][2][4][2], const Unit& u, int wr, int wc, int fr, int fq) const {
        const int row0 = u.pm * 256 + wr * 64 + fr, col0 = u.pn * 256 + wc * 32 + 8 * fq;
        const bool dg = u.pn < ngelu; const float sc = (u.pn < nscale) ? scale : 1.f;
#pragma unroll
        for (int ai = 0; ai < 2; ++ai)
#pragma unroll
            for (int m = 0; m < 4; ++m) { bf16_t* rowp = O + (size_t)(row0 + ai * 128 + m * 16) * ldc + col0;
#pragma unroll
                for (int bj = 0; bj < 2; ++bj) { f32x4 v0 = acc[ai][bj][m][0], v1 = acc[ai][bj][m][1];
                    if (dg) { v0 = (f32x4){gelu_t(v0[0]), gelu_t(v0[1]), gelu_t(v0[2]), gelu_t(v0[3])}; v1 = (f32x4){gelu_t(v1[0]), gelu_t(v1[1]), gelu_t(v1[2]), gelu_t(v1[3])}; }
                    v0 = v0 * sc; v1 = v1 * sc;
                    u32x4 w; w.x = pk(v0[0], v0[1]); w.y = pk(v0[2], v0[3]); w.z = pk(v1[0], v1[1]); w.w = pk(v1[2], v1[3]);
                    *(u32x4*)(rowp + bj * 128) = w; } }
    }
};
struct EpiResid {
    static constexpr bool PERM = false, AFTER_DRAIN = false;
    const float* X; float* Z;
    __device__ __forceinline__ void operator()(const f32x4 (&acc)[2][2][4][2], const Unit& u, int wr, int wc, int fr, int fq) const {
        const int col0 = u.pn * 256 + wc * 32 + 4 * fq;
#pragma unroll
        for (int ai = 0; ai < 2; ++ai)
#pragma unroll
            for (int mp = 0; mp < 2; ++mp) { f32x4 x[2][2][2];
#pragma unroll
                for (int m2 = 0; m2 < 2; ++m2) { const size_t off = (size_t)(u.pm * 256 + ai * 128 + wr * 64 + (2 * mp + m2) * 16 + fr) * D + col0;
#pragma unroll
                    for (int bj = 0; bj < 2; ++bj)
#pragma unroll
                        for (int n = 0; n < 2; ++n) x[m2][bj][n] = *(const f32x4*)(X + off + bj * 128 + n * 16); }
#pragma unroll
                for (int m2 = 0; m2 < 2; ++m2) { const size_t off = (size_t)(u.pm * 256 + ai * 128 + wr * 64 + (2 * mp + m2) * 16 + fr) * D + col0;
#pragma unroll
                    for (int bj = 0; bj < 2; ++bj)
#pragma unroll
                        for (int n = 0; n < 2; ++n) *(f32x4*)(Z + off + bj * 128 + n * 16) = x[m2][bj][n] * ALPHA + acc[ai][bj][2 * mp + m2][n]; } }
    }
};
struct EpiMoeUp {
    static constexpr bool PERM = true, AFTER_DRAIN = false;
    bf16_t* H;
    __device__ __forceinline__ void operator()(const f32x4 (&acc)[2][2][4][2], const Unit& u, int wr, int wc, int fr, int fq) const {
        const int row0 = u.pm * 256 + wr * 64 + fr, col0 = (u.pn & 1) * 128 + wc * 16 + 4 * fq;
#pragma unroll
        for (int ai = 0; ai < 2; ++ai)
#pragma unroll
            for (int m = 0; m < 4; ++m) { bf16_t* rowp = H + (size_t)(row0 + ai * 128 + m * 16) * 256 + col0;
#pragma unroll
                for (int bj = 0; bj < 2; ++bj) { const f32x4 g = acc[ai][bj][m][0], up = acc[ai][bj][m][1]; f32x4 h;
#pragma unroll
                    for (int e = 0; e < 4; ++e) h[e] = g[e] * __builtin_amdgcn_rcpf(1.f + ex2(-LOG2E * g[e])) * up[e];
                    u32x2 w; w.x = pk(h[0], h[1]); w.y = pk(h[2], h[3]); *(u32x2*)(rowp + bj * 64) = w; } }
    }
};
struct EpiMoeDown {
    static constexpr bool PERM = true, AFTER_DRAIN = false;
    bf16_t* Y;
    __device__ __forceinline__ void operator()(const f32x4 (&acc)[2][2][4][2], const Unit& u, int wr, int wc, int fr, int fq) const {
        const int row0 = u.pm * 256 + wr * 64 + fr, col0 = (u.pn & 3) * 256 + wc * 32 + 8 * fq;
#pragma unroll
        for (int ai = 0; ai < 2; ++ai)
#pragma unroll
            for (int m = 0; m < 4; ++m) { bf16_t* rowp = Y + (size_t)(row0 + ai * 128 + m * 16) * D + col0;
#pragma unroll
                for (int bj = 0; bj < 2; ++bj) { const f32x4 v0 = acc[ai][bj][m][0], v1 = acc[ai][bj][m][1];
                    u32x4 w; w.x = pk(v0[0], v0[1]); w.y = pk(v0[2], v0[3]); w.z = pk(v1[0], v1[1]); w.w = pk(v1[2], v1[3]);
                    *(u32x4*)(rowp + bj * 128) = w; } }
    }
};
template <int NC> struct MoeOrder {
    const LAS int* pe; int nunits, G, c;
    const LAS int* ebase; const int* expl;
    __device__ __forceinline__ int arow(const Unit& u, int r) const { const int e = u.pn / NC; return expl[(size_t)e * T + (u.pm * 256 + r - ebase[e])] & (T - 1); }
    __device__ __forceinline__ bool next(int i, Unit& u) const { const int L = i * G + c; if (L >= nunits) return false; const int p = L / NC; u.pm = p; u.pn = pe[p] * NC + (L % NC); return true; }
    __device__ __forceinline__ void a_ready(const Unit&) const {}
    __device__ __forceinline__ void done(const Unit&) const {}
};

__device__ __forceinline__ void p0_load(float (&wv)[32], const float* W, int ldw, int N, int item, int lane) {
    const int nblk = (N + 31) / 32, kb = item / nblk, nb = item % nblk, k0 = 64 * kb, n0 = 32 * nb, nn = n0 + (lane & 31);
#pragma unroll
    for (int i = 0; i < 32; ++i) { const int kk = 2 * i + (lane >> 5); wv[i] = (nn < N) ? W[(size_t)(k0 + kk) * ldw + nn] : 0.f; }
}
__device__ __forceinline__ void p0_finish(const float (&wv)[32], int K, int N, bf16_t* WT, int rmode, int row_off, const float* kscale, LAS float* scr, int item, int lane) {
    const int nblk = (N + 31) / 32, kb = item / nblk, nb = item % nblk, k0 = 64 * kb, n0 = 32 * nb;
#pragma unroll
    for (int i = 0; i < 32; ++i) { const int kk = 2 * i + (lane >> 5); float v = wv[i]; if (kscale) v *= kscale[k0 + kk]; scr[kk * 33 + (lane & 31)] = v; }
    LDS_WAIT(); asm volatile("" ::: "memory");
    const int c = lane & 7;
#pragma unroll
    for (int j = 0; j < 4; ++j) { const int n = (lane >> 3) + 8 * j; const LAS float* s = scr + (8 * c) * 33 + n;
        v4u o; o.x = pk(s[0 * 33], s[1 * 33]); o.y = pk(s[2 * 33], s[3 * 33]); o.z = pk(s[4 * 33], s[5 * 33]); o.w = pk(s[6 * 33], s[7 * 33]);
        const int ng = n0 + n; const int r = (rmode == 0) ? row_off + ng : (row_off + (ng >> 2) * 8 + (rmode == 2 ? 4 : 0) + (ng & 3));
        *(GAS v4u*)(WT + (size_t)r * K + k0 + 8 * c) = o; }
    LDS_WAIT(); asm volatile("" ::: "memory");
}
__device__ __forceinline__ void p0_item(const float* W, int ldw, int K, int N, bf16_t* WT, int rmode, int row_off, const float* kscale, LAS float* scr, int item, int lane) {
    float wv[32]; p0_load(wv, W, ldw, N, item, lane); p0_finish(wv, K, N, WT, rmode, row_off, kscale, scr, item, lane);
}
struct ConvJob { const float* W; int ldw, K, N; bf16_t* WT; int rmode, row_off; const float* kscale; int nitems; };

__device__ __forceinline__ void p0_prologue(Frame& F) {
    LAS float* scr = (LAS float*)(F.lds + RING_OFF + F.wave * 16384);
    const int gw = F.vcu * NWAVES + F.wave, NGW = F.G * NWAVES;
    unsigned char* ws = F.ws;
    {
        const float* in2 = (const float*)F.in[2];
#define JOB(Wp, ldw_, K_, N_, dst, rm, ro, ks) { const int nit = ((K_) / 64) * (((N_) + 31) / 32); if (it < nit) { p0_item((const float*)(Wp), ldw_, K_, N_, (bf16_t*)(dst), rm, ro, ks, scr, it, F.lane); continue; } it -= nit; }
        constexpr int TOT = 16 * 45 + 4 * 24 + 2 * 16 + 2 * 16 + 16 * 32 + 16 * 58 + 32 * 8 * 2 + 4 * 2 * 2 + 16 * 32;
        for (int it0 = gw; it0 < TOT; it0 += NGW) { int it = it0;
            JOB(in2, 1440, 1024, 1440, ws + WS_W0IN, 0, 0, nullptr)
            JOB(F.in[9], 768, 256, 768, ws + WS_WUQ, 0, 0, (const float*)F.in[7])
            JOB(F.in[10], 512, 128, 512, ws + WS_WUKV, 0, 0, (const float*)F.in[8])
            JOB(F.in[11], 512, 128, 512, ws + WS_WUKV, 0, 512, (const float*)F.in[8])
            JOB(F.in[12], 1024, 1024, 1024, ws + WS_W0O, 0, 0, nullptr)
            JOB(F.in[13], 1840, 1024, 1840, ws + WS_W1IN, 0, 0, nullptr)
            JOB(F.in[15], 256, 2048, 256, ws + WS_WCK1, 0, 0, nullptr)
            JOB(F.in[17], 256, 2048, 256, ws + WS_WCV1, 0, 0, nullptr)
            JOB(F.in[16], 64, 256, 64, ws + WS_WCK2, 0, 0, nullptr)
            JOB(F.in[18], 64, 256, 64, ws + WS_WCV2, 0, 0, nullptr)
            JOB(F.in[20], 1024, 1024, 1024, ws + WS_W1O, 0, 0, nullptr)
        }
#undef JOB
    }
    {
        constexpr int IG = 16 * 8, ID = 4 * 32, PER = 2 * IG + ID;
        for (int it0 = gw; it0 < 64 * PER; it0 += NGW) { const int le = it0 / PER; int it = it0 % PER;
            bf16_t* gu = (bf16_t*)(ws + WS_WGU) + (size_t)le * 512 * 1024; bf16_t* wd = (bf16_t*)(ws + WS_WD) + (size_t)le * 1024 * 256;
            if (it < IG) { p0_item((const float*)F.in[25] + (size_t)le * 1024 * 256, 256, 1024, 256, gu, 1, 0, nullptr, scr, it, F.lane); continue; } it -= IG;
            if (it < IG) { p0_item((const float*)F.in[26] + (size_t)le * 1024 * 256, 256, 1024, 256, gu, 2, 0, nullptr, scr, it, F.lane); continue; } it -= IG;
            p0_item((const float*)F.in[27] + (size_t)le * 256 * 1024, 1024, 256, 1024, wd, 0, 0, nullptr, scr, it, F.lane);
        }
    }
    const int gt = F.vcu * NTHR + F.tid, NGT = F.G * NTHR;
    { v4u z = {0u, 0u, 0u, 0u};
      for (int i = gt; i < 96 * 128; i += NGT) *(GAS v4u*)((bf16_t*)(ws + WS_W0IN) + (size_t)1440 * 1024 + (size_t)i * 8) = z;
      for (int i = gt; i < 192 * 128; i += NGT) *(GAS v4u*)((bf16_t*)(ws + WS_W1IN) + (size_t)1856 * 1024 + (size_t)i * 8) = z; }
    { const float* gws = (const float*)F.in[5]; bf16_t* wsb = (bf16_t*)(ws + WS_WSB);
      for (int i = gt; i < 4 * 128 * 128; i += NGT) { const int s = i & 127, t = (i >> 7) & 127; wsb[i] = (bf16_t)(pk(s <= t ? gws[i] : 0.f, 0.f) & 0xffffu); } }
    {
      float* cb = (float*)(ws + WS_CBIAS);
      for (int o = gw; o < 512; o += NGW) { const int kv = o >> 8, h = o & 255; const float* pos = (const float*)F.in[14] + kv * 2048; const float* w1 = (const float*)F.in[kv ? 17 : 15];
          float a = 0.f; for (int k = F.lane; k < 2048; k += 64) a += pos[k] * w1[(size_t)k * 256 + h];
          a = wsum(a); if (F.lane == 0) cb[o] = a; } }
    { const float* x = (const float*)F.in[0]; bf16_t* xb = (bf16_t*)(ws + S_XB);
#pragma unroll 4
      for (int i = gt; i < T * D / 8; i += NGT) { const f32x4 a = *(const GAS f32x4*)(x + (size_t)i * 8), b = *(const GAS f32x4*)(x + (size_t)i * 8 + 4);
          v4u o; o.x = pk(a[0], a[1]); o.y = pk(a[2], a[3]); o.z = pk(b[0], b[1]); o.w = pk(b[2], b[3]); *(GAS v4u*)(xb + (size_t)i * 8) = o; } }
}

__device__ __forceinline__ void wt_load(u32x4 (&v)[4], const unsigned char* base, unsigned pitch, int lane) {
#pragma unroll
    for (int i = 0; i < 4; ++i) v[i] = *(const u32x4*)(base + (size_t)(8 * i + (lane >> 3)) * pitch + (lane & 7) * 16);
}
__device__ __forceinline__ void wt_store(LAS unsigned char* t, const u32x4 (&v)[4], int lane) {
#pragma unroll
    for (int i = 0; i < 4; ++i) { const int row = 8 * i + (lane >> 3); *(LAS u32x4*)(t + row * 128 + (((lane & 7) ^ ((row >> 1) & 7)) << 4)) = v[i]; }
}
__device__ __forceinline__ bf16x8 wt_frag(const LAS unsigned char* t, int ks, int lane) { const int r32 = lane & 31; return *(const LAS bf16x8*)(t + r32 * 128 + (((2 * ks + (lane >> 5)) ^ ((r32 >> 1) & 7)) << 4)); }

__device__ __forceinline__ void store4(bf16_t* p, float a, float b, float c, float d) { u32x2 w; w.x = pk(a, b); w.y = pk(c, d); *(u32x2*)p = w; }
__device__ __forceinline__ void mla_up_item(Frame& F, int item) {
    const int lane = F.lane, r32 = lane & 31, hi = lane >> 5, part = item & 1, tok = (item >> 1) * 32 + r32;
    const bf16_t* hrow = (const bf16_t*)(F.ws + S_H0B) + (size_t)tok * 1536;
    const float p = (float)((const int*)F.in[1])[tok];
    LAS unsigned char* wl = F.lds + RING_OFF + F.wave * 16384;
    float cs[8], sn[8];
#pragma unroll
    for (int r = 0; r < 8; ++r) { const int j = crow(r, hi); const float fr = expf(-9.210340371976184f * (float)j * (1.f / 16.f)); const float ang = p * fr; cs[r] = cosf(ang); sn[r] = sinf(ang); }
    if (part == 0) {
        bf16x8 xf[16]; float ss = 0.f;
#pragma unroll
        for (int ks = 0; ks < 16; ++ks) { xf[ks] = ld8g(hrow + 1024 + ks * 16 + hi * 8);
#pragma unroll
            for (int e = 0; e < 8; ++e) { const float v = bf2f((unsigned short)xf[ks][e]); ss += v * v; } }
        ss += __shfl_xor(ss, 32);
        const float sc = rsqrtf(ss * (1.f / 256.f) + LN_EPS) * QS_MLA;
        const unsigned char* W = (const unsigned char*)(F.ws + WS_WUQ); bf16_t* Q = (bf16_t*)(F.ws + S_Q96) + (size_t)tok * 768;
        u32x4 wv[2][4];
#pragma unroll
        for (int c = 0; c < 2; ++c) wt_load(wv[c], W + c * 128, 512u, lane);
#pragma unroll 1
        for (int nt = 0; nt < 24; ++nt) {
            f32x16 acc = {};
#pragma unroll
            for (int h = 0; h < 2; ++h) {
#pragma unroll
                for (int c = 0; c < 2; ++c) wt_store(wl + (2 * h + c) * 4096, wv[c], lane);
                { const int nn = h ? nt + 1 : nt, hh = h ^ 1; if (nn < 24) {
#pragma unroll
                    for (int c = 0; c < 2; ++c) wt_load(wv[c], W + (size_t)nn * 32 * 512 + (2 * hh + c) * 128, 512u, lane); } }
#pragma unroll
                for (int ks = 0; ks < 8; ++ks) acc = mfma32(wt_frag(wl + (2 * h + (ks >> 2)) * 4096, ks & 3, lane), xf[8 * h + ks], acc);
            }
#pragma unroll
            for (int r = 0; r < 16; ++r) acc[r] *= sc;
            if (nt % 3 == 2) {
#pragma unroll
                for (int r = 0; r < 8; ++r) { const float x1 = acc[r], x2 = acc[r + 8]; acc[r] = x1 * cs[r] - x2 * sn[r]; acc[r + 8] = x1 * sn[r] + x2 * cs[r]; } }
#pragma unroll
            for (int g4 = 0; g4 < 4; ++g4) store4(Q + nt * 32 + 8 * g4 + 4 * hi, acc[4 * g4], acc[4 * g4 + 1], acc[4 * g4 + 2], acc[4 * g4 + 3]);
        }
    } else {
        bf16x8 xf[8]; float ss = 0.f;
#pragma unroll
        for (int ks = 0; ks < 8; ++ks) { xf[ks] = ld8g(hrow + 1280 + ks * 16 + hi * 8);
#pragma unroll
            for (int e = 0; e < 8; ++e) { const float v = bf2f((unsigned short)xf[ks][e]); ss += v * v; } }
        ss += __shfl_xor(ss, 32);
        const float sc = rsqrtf(ss * (1.f / 128.f) + LN_EPS);
        const unsigned char* W = (const unsigned char*)(F.ws + WS_WUKV);
        bf16_t* KN = (bf16_t*)(F.ws + S_KN) + (size_t)tok * 512; bf16_t* V = (bf16_t*)(F.ws + S_V) + (size_t)tok * 512;
        u32x4 wv[2][4];
#pragma unroll
        for (int c = 0; c < 2; ++c) wt_load(wv[c], W + c * 128, 256u, lane);
#pragma unroll 1
        for (int nt = 0; nt < 32; ++nt) { LAS unsigned char* tl = wl + (nt & 1) * 8192;
#pragma unroll
            for (int c = 0; c < 2; ++c) wt_store(tl + c * 4096, wv[c], lane);
            if (nt + 1 < 32) {
#pragma unroll
                for (int c = 0; c < 2; ++c) wt_load(wv[c], W + (size_t)(nt + 1) * 32 * 256 + c * 128, 256u, lane); }
            f32x16 acc = {};
#pragma unroll
            for (int ks = 0; ks < 8; ++ks) acc = mfma32(wt_frag(tl + (ks >> 2) * 4096, ks & 3, lane), xf[ks], acc);
            bf16_t* o = (nt < 16) ? (KN + nt * 32) : (V + (nt - 16) * 32);
#pragma unroll
            for (int g4 = 0; g4 < 4; ++g4) store4(o + 8 * g4 + 4 * hi, acc[4 * g4] * sc, acc[4 * g4 + 1] * sc, acc[4 * g4 + 2] * sc, acc[4 * g4 + 3] * sc);
        }
        bf16_t* KR = (bf16_t*)(F.ws + S_KRB) + (size_t)tok * 32;
#pragma unroll
        for (int g2 = 0; g2 < 2; ++g2) { const int c0 = 8 * g2 + 4 * hi; const s16x4 a = *(const s16x4*)(hrow + 1408 + c0), b = *(const s16x4*)(hrow + 1408 + 16 + c0);
            float o1[4], o2[4];
#pragma unroll
            for (int e = 0; e < 4; ++e) { const float x1 = bf2f((unsigned short)a[e]), x2 = bf2f((unsigned short)b[e]); const int r = 4 * g2 + e; o1[e] = x1 * cs[r] - x2 * sn[r]; o2[e] = x1 * sn[r] + x2 * cs[r]; }
            store4(KR + c0, o1[0], o1[1], o1[2], o1[3]); store4(KR + 16 + c0, o2[0], o2[1], o2[2], o2[3]); }
    }
}

constexpr int VN_STR = 1088;
__device__ __forceinline__ void gmlp_chunk(Frame& F, int chunk, bool dry = false) {
    const int lane = F.lane, wave = F.wave, r32 = lane & 31, hi = lane >> 5;
    bf16_t* H0B = (bf16_t*)(F.ws + S_H0B);
    const float* lng = (const float*)F.in[3]; const float* lnb = (const float*)F.in[4];
    LAS unsigned char* img = F.lds + RING_OFF;
    float g8[8], b8[8];
#pragma unroll
    for (int e = 0; e < 8; ++e) { g8[e] = lng[lane * 8 + e]; b8[e] = lnb[lane * 8 + e]; }
#pragma unroll 4
    for (int i = 0; i < 16; ++i) { const int row = wave * 16 + i; const bf16x8 x = ld8g(H0B + (size_t)(chunk * 128 + row) * 1536 + 512 + lane * 8);
        float v[8]; float s = 0.f;
#pragma unroll
        for (int e = 0; e < 8; ++e) { v[e] = bf2f((unsigned short)x[e]); s += v[e]; }
        const float mean = wsum(s) * (1.f / 512.f); float q = 0.f;
#pragma unroll
        for (int e = 0; e < 8; ++e) { v[e] -= mean; q += v[e] * v[e]; }
        const float rstd = rsqrtf(wsum(q) * (1.f / 512.f) + LN_EPS);
#pragma unroll
        for (int e = 0; e < 8; ++e) v[e] = v[e] * rstd * g8[e] + b8[e];
        u32x4 w; w.x = pk(v[0], v[1]); w.y = pk(v[2], v[3]); w.z = pk(v[4], v[5]); w.w = pk(v[6], v[7]);
        *(LAS u32x4*)(img + row * VN_STR + lane * 16) = w; }
    __syncthreads();
    const int g = wave >> 1, th = wave & 1;
    const bf16_t* wsb = (const bf16_t*)(F.ws + WS_WSB) + (size_t)g * 128 * 128;
    const float* bs = (const float*)F.in[6] + g * 128;
    const int i15 = lane & 15, g1 = (lane >> 4) & 1;
#pragma unroll 1
    for (int nt = 0; nt < 2; ++nt) {
        const int t = th * 64 + nt * 32 + r32;
        const int nks = (th * 64 + nt * 32 + 31) / 16 + 1;
        bf16x8 bw[8];
#pragma unroll
        for (int ks = 0; ks < 8; ++ks) bw[ks] = ld8g(wsb + (size_t)t * 128 + ks * 16 + hi * 8);
        const float bias = bs[t];
#pragma unroll 1
        for (int ct = 0; ct < 4; ++ct) {
            const LAS unsigned char* abase = img + (8 * hi + (i15 >> 2)) * VN_STR + (g * 128 + ct * 32 + 16 * g1 + 4 * (i15 & 3)) * 2;
            f32x16 acc = {};
#pragma unroll
            for (int ks = 0; ks < 8; ++ks) { if (ks < nks) {
                const s16x4 lo = trld(abase + (16 * ks) * VN_STR), hi4 = trld(abase + (16 * ks + 4) * VN_STR);
                const bf16x8 a = {lo[0], lo[1], lo[2], lo[3], hi4[0], hi4[1], hi4[2], hi4[3]};
                acc = mfma32(a, bw[ks], acc); } }
            bf16_t* urow = H0B + (size_t)(chunk * 128 + t) * 1536 + g * 128 + ct * 32 + 4 * hi;
            bf16_t* orow = dry ? ((bf16_t*)(F.ws + WS_Z1) + (urow - H0B)) : urow;
#pragma unroll
            for (int g4 = 0; g4 < 4; ++g4) { const s16x4 uu = *(const s16x4*)(urow + 8 * g4);
                store4(orow + 8 * g4, bf2f((unsigned short)uu[0]) * (acc[4 * g4] + bias), bf2f((unsigned short)uu[1]) * (acc[4 * g4 + 1] + bias),
                       bf2f((unsigned short)uu[2]) * (acc[4 * g4 + 2] + bias), bf2f((unsigned short)uu[3]) * (acc[4 * g4 + 3] + bias)); }
        }
    }
    __syncthreads();
}

constexpr float NEGF = -1e30f;
__device__ __forceinline__ void pack_p(u32x4 (&pw)[4], const f32x16& p0, const f32x16& p1) {
    pw[0] = (u32x4){pk(p0[0], p0[1]), pk(p0[2], p0[3]), pk(p0[4], p0[5]), pk(p0[6], p0[7])}; pw[1] = (u32x4){pk(p0[8], p0[9]), pk(p0[10], p0[11]), pk(p0[12], p0[13]), pk(p0[14], p0[15])};
    pw[2] = (u32x4){pk(p1[0], p1[1]), pk(p1[2], p1[3]), pk(p1[4], p1[5]), pk(p1[6], p1[7])}; pw[3] = (u32x4){pk(p1[8], p1[9]), pk(p1[10], p1[11]), pk(p1[12], p1[13]), pk(p1[14], p1[15])};
}
struct AttnSt { f32x16 o[2]; f32x16 negm; float mref, l; int started; };
__device__ __forceinline__ void attn_reset(AttnSt& st) { st.o[0] = f32x16{}; st.o[1] = f32x16{}; st.negm = f32x16{}; st.mref = 0.f; st.l = 0.f; st.started = 0; }
constexpr int KV_ROPE = 8192;
template <bool ROPE> struct KvL { static constexpr int V = ROPE ? 12288 : 8192, SUB = ROPE ? 20480 : 16384, BUF = 2 * SUB; };
template <int NKS>
__device__ __forceinline__ void qk_tile(f32x16& p0, f32x16& p1, const LAS unsigned char* Kt, const bf16x8* qf, const f32x16& cinit, int lane) {
    const int r32 = lane & 31, hi = lane >> 5, sw = (r32 >> 1) & 7;
    const LAS unsigned char* kp = Kt + r32 * 128;
#pragma unroll
    for (int ks = 0; ks < NKS; ++ks) {
        bf16x8 a0, a1;
        if (ks < 4) { const int off = ((2 * ks + hi) ^ sw) << 4; a0 = *(const LAS bf16x8*)(kp + off); a1 = *(const LAS bf16x8*)(kp + 4096 + off); }
        else { const LAS unsigned char* rp = Kt + KV_ROPE + r32 * 64 + (((2 * (ks - 4) + hi) ^ ((r32 >> 2) & 3)) << 4); a0 = *(const LAS bf16x8*)rp; a1 = *(const LAS bf16x8*)(rp + 2048); }
        if (ks == 0) { p0 = mfma32(a0, qf[0], cinit); p1 = mfma32(a1, qf[0], cinit); } else { p0 = mfma32(a0, qf[ks], p0); p1 = mfma32(a1, qf[ks], p1); } }
}
__device__ __forceinline__ float max3(float a, float b, float c) { return fmaxf(fmaxf(a, b), c); }
constexpr float ATT_THR = 8.f;
template <class Mask>
__device__ __forceinline__ void softmax2(f32x16& p0, f32x16& p1, AttnSt& st, bool need_mask, const Mask& valid, bool lanebit, int lane, u32x4 (&pw)[4]) {
    const int hi = lane >> 5;
    if (need_mask) {
#pragma unroll
        for (int r = 0; r < 16; ++r) { const int k0 = crow(r, hi); if (!valid(k0)) p0[r] = NEGF; if (!valid(k0 + 32)) p1[r] = NEGF; } }
    float ma = max3(p0[0], p0[1], p1[0]), mb = max3(p0[2], p0[3], p1[1]); ma = max3(ma, p1[2], p1[3]);
#pragma unroll
    for (int r = 4; r < 16; r += 4) { ma = max3(ma, p0[r], p0[r + 1]); mb = max3(mb, p0[r + 2], p0[r + 3]); ma = max3(ma, p1[r], p1[r + 1]); mb = max3(mb, p1[r + 2], p1[r + 3]); }
    float mx = fmaxf(ma, mb); mx = fmaxf(mx, __shfl_xor(mx, 32));
    if (!lanebit) mx = NEGF;
    const bool has = mx > -1e29f, fresh = has && !st.started;
    if (__any((mx > ATT_THR) || fresh)) {
        const float dl = has ? (fresh ? mx : fmaxf(mx, 0.f)) : 0.f;
        st.mref += dl; const float f = ex2(-dl); st.l *= f;
#pragma unroll
        for (int r = 0; r < 16; ++r) { p0[r] -= dl; p1[r] -= dl; st.o[0][r] *= f; st.o[1][r] *= f; st.negm[r] = -st.mref; }
        st.started |= has ? 1 : 0;
    }
    float sa = 0.f, sb = 0.f;
#pragma unroll
    for (int r = 0; r < 16; ++r) { p0[r] = ex2(p0[r]); p1[r] = ex2(p1[r]); sa += p0[r]; sb += p1[r]; }
    pack_p(pw, p0, p1);
    float sum = sa + sb;
    if (!lanebit) { sum = 0.f;
#pragma unroll
        for (int i = 0; i < 4; ++i) pw[i] = (u32x4){0u, 0u, 0u, 0u}; }
    st.l += sum;
}
__device__ __forceinline__ void pv_packed(f32x16 (&o)[2], const LAS unsigned char* Vt, const u32x4 (&pw)[4], int lane) {
    const int i15 = lane & 15, g1 = (lane >> 4) & 1, hi = lane >> 5, bsw = (i15 >> 3) & 1;
    const LAS unsigned char* vrow = Vt + (4 * hi + (i15 >> 2)) * 128 + (2 * g1 + ((i15 & 3) >> 1)) * 16 + (i15 & 1) * 8;
    const LAS unsigned char* vb0 = vrow + 64 * bsw; const LAS unsigned char* vb1 = vrow + 64 * (bsw ^ 1);
#pragma unroll
    for (int db = 0; db < 2; ++db)
#pragma unroll
        for (int s = 0; s < 4; ++s) { const LAS unsigned char* vb = db ? vb1 : vb0; const s16x4 lo = trld(vb + s * 2048), h4 = trld(vb + s * 2048 + 1024);
            const bf16x8 a = {lo[0], lo[1], lo[2], lo[3], h4[0], h4[1], h4[2], h4[3]};
            o[db] = mfma32(a, __builtin_bit_cast(bf16x8, pw[s]), o[db]); }
}
#define LDS_BAR() asm volatile("s_waitcnt lgkmcnt(0)\n\ts_barrier" ::: "memory")
__device__ __forceinline__ void glds16(const void* gsrc, unsigned lds_dst) { unsigned keep;
    asm volatile("s_mov_b32 %0, m0\n\ts_mov_b32 m0, %2\n\ts_nop 0\n\tglobal_load_lds_dwordx4 %1, off\n\ts_mov_b32 m0, %0" : "=&s"(keep) : "v"(gsrc), "s"(lds_dst) : "memory"); }
template <bool ROPE, class Src>
__device__ __forceinline__ void dma_tile(const Src& src, int j, LAS unsigned char* buf, int wave, unsigned koff, unsigned voff, unsigned roff) {
    const unsigned b = (unsigned)(size_t)buf;
    glds16(src.kbase(j) + koff, (unsigned)__builtin_amdgcn_readfirstlane(b + wave * 1024));
    glds16(src.vbase(j) + voff, (unsigned)__builtin_amdgcn_readfirstlane(b + KvL<ROPE>::V + wave * 1024));
    if (ROPE) glds16(src.rbase(j) + roff, (unsigned)__builtin_amdgcn_readfirstlane(b + KV_ROPE + (wave & 3) * 1024));
}
#define VMW(n) asm volatile("s_waitcnt vmcnt(" #n ")" ::: "memory")
struct NoHook { __device__ __forceinline__ void operator()(int) const {} };
template <int NKS, class It, class Src, class Act, class Mask, class Hook = NoHook>
__device__ __forceinline__ void attn_loop(AttnSt& st, const bf16x8* qf, It it, const Src& src, const Act& active, const Mask& mask, LAS unsigned char* kv, int tid_, int lane_, int abl = 0, const Hook& hook = Hook()) {
    const int tid = launder(tid_), lane = tid & 63, wave = __builtin_amdgcn_readfirstlane(tid >> 6); (void)lane_;
    constexpr bool ROPE = (NKS > 4); constexpr int SUB = KvL<ROPE>::SUB, BUF = KvL<ROPE>::BUF, VO = KvL<ROPE>::V;
    int a0 = it.next(); if (a0 < 0) return;
    int b0 = it.next();
    unsigned koff, voff, roff;
    { const int row = wave * 8 + (lane >> 3), c = lane & 7; koff = (unsigned)row * src.kpitch + (unsigned)((c ^ ((row >> 1) & 7)) << 4); voff = (unsigned)row * src.vpitch + (unsigned)((c ^ (((row >> 1) & 1) << 2)) << 4);
      const int rr = (wave & 3) * 16 + (lane >> 2), rc = lane & 3; roff = (unsigned)rr * 64u + (unsigned)((rc ^ ((rr >> 2) & 3)) << 4); }
#define DMAP(A_, B_, BUFP) do { dma_tile<ROPE>(src, (A_), (BUFP), wave, koff, voff, roff); dma_tile<ROPE>(src, ((B_) >= 0) ? (B_) : (A_), (BUFP) + SUB, wave, koff, voff, roff); } while (0)
    int a1 = (b0 >= 0) ? it.next() : -1, b1 = (a1 >= 0) ? it.next() : -1;
    DMAP(a0, b0, kv);
    if (a1 >= 0) DMAP(a1, b1, kv + BUF);
    int bc = 0;
    for (;;) {
        if (a1 >= 0) { if (ROPE) VMW(6); else VMW(4); } else VMW(0);
        if (!(abl & 16)) LDS_BAR();
        int a2 = (b1 >= 0) ? it.next() : -1, b2 = (a2 >= 0) ? it.next() : -1;
        if (a2 >= 0 && !(abl & 8)) DMAP(a2, b2, kv + ((bc + 2) % 3) * BUF);
        else if (a2 >= 0) { }
#pragma unroll
        for (int sub = 0; sub < 2; ++sub) { const int jc = sub ? b0 : a0;
            if (jc >= 0 && active(jc)) { const LAS unsigned char* kb = kv + bc * BUF + sub * SUB;
                hook(jc);
                f32x16 p0, p1; u32x4 pw[4];
                if (!(abl & 1)) qk_tile<NKS>(p0, p1, kb, qf, st.negm, lane); else { p0 = st.negm; p1 = st.negm; }
                if (!(abl & 2)) softmax2(p0, p1, st, mask.need(jc), [&](int key) { return mask.valid(jc, key); }, mask.lanebit(jc), lane, pw); else pack_p(pw, p0, p1);
                if (!(abl & 4)) pv_packed(st.o, kb + VO, pw, lane); else st.o[0][0] += __uint_as_float(pw[0].x ^ pw[1].y ^ pw[2].z ^ pw[3].w); } }
        if (a1 < 0) break;
        a0 = a1; b0 = b1; a1 = a2; b1 = b2; bc = (bc + 1) % 3;
        if (abl & 8) { if (a1 >= 0 && false) {} }
    }
#undef DMAP
    LDS_BAR();
}
struct RangeIt { int j, end; __device__ __forceinline__ int next() { return (j < end) ? j++ : -1; } };
struct BitIt { unsigned m; __device__ __forceinline__ int next() { if (!m) return -1; const int j = __builtin_ctz(m); m &= m - 1; return j; } };

__device__ __forceinline__ void mla_attn_unit(Frame& F, int b, int h, int qb, int abl = 0) {
    const int lane = F.lane, wave = F.wave, r32 = lane & 31, hi = lane >> 5;
    const int q0 = qb * 256 + wave * 32, t = q0 + r32;
    const size_t rb = (size_t)b * S;
    const bf16_t* Q = (const bf16_t*)(F.ws + S_Q96) + (rb + t) * 768 + h * 96;
    const bf16_t* KN = (const bf16_t*)(F.ws + S_KN) + rb * 512 + h * 64; const bf16_t* KR = (const bf16_t*)(F.ws + S_KRB) + rb * 32; const bf16_t* V = (const bf16_t*)(F.ws + S_V) + rb * 512 + h * 64;
    bf16x8 qf[6];
#pragma unroll
    for (int ks = 0; ks < 6; ++ks) qf[ks] = ld8g(Q + ks * 16 + hi * 8);
    asm volatile("" : "+v"(qf[0]), "+v"(qf[1]), "+v"(qf[2]), "+v"(qf[3]), "+v"(qf[4]), "+v"(qf[5]));
    AttnSt st; attn_reset(st);
    struct Src { const unsigned char *KN, *KR, *V; unsigned kpitch, vpitch;
        __device__ __forceinline__ const unsigned char* kbase(int j) const { return KN + (size_t)j * 64 * 1024; }
        __device__ __forceinline__ const unsigned char* vbase(int j) const { return V + (size_t)j * 64 * 1024; }
        __device__ __forceinline__ const unsigned char* rbase(int j) const { return KR + (size_t)j * 64 * 64; } } src{(const unsigned char*)KN, (const unsigned char*)KR, (const unsigned char*)V, 1024u, 1024u};
    const int wlast = (q0 + 31) >> 6;
    struct MaskC { int t, tmin; __device__ __forceinline__ bool need(int j) const { return j * 64 + 63 > tmin; } __device__ __forceinline__ bool valid(int j, int key) const { return j * 64 + key <= t; }
        __device__ __forceinline__ bool lanebit(int) const { return true; } } mk{t, q0};
    if (!(abl & 32)) attn_loop<6>(st, qf, RangeIt{0, qb * 4 + 4}, src, [&](int j) { return j <= wlast; }, mk, F.lds + RING_OFF, F.tid, lane, abl); if (abl & 64) return;
    float l = st.l + __shfl_xor(st.l, 32); const float inv = 1.f / l;
    bf16_t* O = (bf16_t*)(F.ws + S_H0B) + (rb + t) * 1536 + 512 + h * 64 + 4 * hi;
#pragma unroll
    for (int db = 0; db < 2; ++db)
#pragma unroll
        for (int g4 = 0; g4 < 4; ++g4) store4(O + db * 32 + 8 * g4, st.o[db][4 * g4] * inv, st.o[db][4 * g4 + 1] * inv, st.o[db][4 * g4 + 2] * inv, st.o[db][4 * g4 + 3] * inv);
}

constexpr int NSA_IMP_OFF = 3 * KvL<false>::BUF, NSA_SEL_OFF = NSA_IMP_OFF + 8 * 32 * 33 * 4;
__device__ __forceinline__ void ob_add(u32x2 (&ob)[2][4], const f32x16 (&o)[2], float f, bool first) {
#pragma unroll
    for (int db = 0; db < 2; ++db)
#pragma unroll
        for (int g4 = 0; g4 < 4; ++g4) { float a0 = 0.f, a1 = 0.f, a2 = 0.f, a3 = 0.f;
            if (!first) { a0 = __uint_as_float(ob[db][g4].x << 16); a1 = __uint_as_float(ob[db][g4].x & 0xffff0000u); a2 = __uint_as_float(ob[db][g4].y << 16); a3 = __uint_as_float(ob[db][g4].y & 0xffff0000u); }
            ob[db][g4].x = pk(a0 + f * o[db][4 * g4], a1 + f * o[db][4 * g4 + 1]); ob[db][g4].y = pk(a2 + f * o[db][4 * g4 + 2], a3 + f * o[db][4 * g4 + 3]); }
}
__device__ __forceinline__ void nsa_unit(Frame& F, int b, int g, int tblk  , bool dry = false, int abl = 0) {
    const int lane = F.lane, wave = F.wave, tid = F.tid, r32 = lane & 31, hi = lane >> 5;
    const int t0 = tblk * 32, t = t0 + r32, tb = t0 >> 6, h = g * 8 + wave;
    const size_t rb = (size_t)b * S;
    bf16_t* H1B = (bf16_t*)(F.ws + S_H1B);
    bf16_t* qrow = H1B + (rb + t) * 2048;
    LAS unsigned char* kv = F.lds + RING_OFF;
    LAS float* impw = (LAS float*)(F.lds + NSA_IMP_OFF); LAS unsigned* selw = (LAS unsigned*)(F.lds + NSA_SEL_OFF);
    struct Src { const unsigned char *K, *V; unsigned kpitch, vpitch;
        __device__ __forceinline__ const unsigned char* kbase(int j) const { return K + (size_t)j * 64 * kpitch; }
        __device__ __forceinline__ const unsigned char* vbase(int j) const { return V + (size_t)j * 64 * vpitch; }
        __device__ __forceinline__ const unsigned char* rbase(int) const { return K; } };
    const int nk = (t0 >> 4) + 1;
    const int ntile = (nk + 63) >> 6;
    { Src sc{(const unsigned char*)((const bf16_t*)(F.ws + S_KCMP) + (size_t)(b * 2 + g) * 128 * 64), (const unsigned char*)((const bf16_t*)(F.ws + S_VCMP) + (size_t)(b * 2 + g) * 128 * 64), 128u, 128u};
      const int row = wave * 8 + (lane >> 3), c = lane & 7; const unsigned koff = (unsigned)row * 128u + (unsigned)((c ^ ((row >> 1) & 7)) << 4), voff = (unsigned)row * 128u + (unsigned)((c ^ (((row >> 1) & 1) << 2)) << 4);
      dma_tile<false>(sc, 0, kv, wave, koff, voff, 0u); if (ntile > 1) dma_tile<false>(sc, 1, kv + KvL<false>::SUB, wave, koff, voff, 0u); }
    bf16x8 qf[4];
#pragma unroll
    for (int ks = 0; ks < 4; ++ks) qf[ks] = ld8g(qrow + h * 64 + ks * 16 + hi * 8);
    bf16_t* orow = (dry ? ((bf16_t*)(F.ws + WS_Z1) + (qrow - H1B)) : qrow) + h * 64 + 4 * hi;
    const float* gate_b = (const float*)F.in[19];
    float gate[3];
#pragma unroll
    for (int br = 0; br < 3; ++br) { const float x = bf2f(qrow[1792 + br * 16 + h]) + gate_b[br * 16 + h]; gate[br] = __builtin_amdgcn_rcpf(1.f + ex2(-LOG2E * x)); }
    asm volatile("" : "+v"(qf[0]), "+v"(qf[1]), "+v"(qf[2]), "+v"(qf[3]), "+v"(gate[0]), "+v"(gate[1]), "+v"(gate[2]));
    if (tid == 0) selw[32] = 0u;
    u32x2 ob[2][4];
    {
        const int tid = launder(F.tid), lane = tid & 63, r32 = lane & 31, hi = lane >> 5;
        VMW(0); LDS_BAR();
        if (abl & 32) { f32x16 z2[2] = {f32x16{}, f32x16{}}; ob_add(ob, z2, 0.f, true); } else {
        f32x16 p[2][2]; float mx = NEGF;
#pragma unroll
        for (int tl = 0; tl < 2; ++tl) { __builtin_amdgcn_sched_barrier(0); if (tl < ntile) { qk_tile<4>(p[tl][0], p[tl][1], kv + tl * KvL<false>::SUB, qf, f32x16{}, lane);
#pragma unroll
                for (int kb = 0; kb < 2; ++kb)
#pragma unroll
                    for (int r = 0; r < 16; ++r) { const int n = tl * 64 + kb * 32 + crow(r, hi); if (t < 16 * n + 31) p[tl][kb][r] = NEGF; mx = fmaxf(mx, p[tl][kb][r]); } }
            else { p[tl][0] = f32x16{}; p[tl][1] = f32x16{};
#pragma unroll
                for (int r = 0; r < 16; ++r) { p[tl][0][r] = NEGF; p[tl][1][r] = NEGF; } } }
        mx = fmaxf(mx, __shfl_xor(mx, 32));
        const float muse = (mx < -1e29f) ? 0.f : mx; float sum = 0.f;
#pragma unroll
        for (int tl = 0; tl < 2; ++tl)
#pragma unroll
            for (int kb = 0; kb < 2; ++kb)
#pragma unroll
                for (int r = 0; r < 16; ++r) { p[tl][kb][r] = ex2(p[tl][kb][r] - muse); sum += p[tl][kb][r]; }
        sum += __shfl_xor(sum, 32);
        const float inv = (sum > 0.f) ? __builtin_amdgcn_rcpf(sum) : 0.f;
#pragma unroll
        for (int tl = 0; tl < 2; ++tl)
#pragma unroll
            for (int kb = 0; kb < 2; ++kb)
#pragma unroll
                for (int r = 0; r < 16; ++r) p[tl][kb][r] *= inv;
        { float carried = 0.f;
#pragma unroll
        for (int tl = 0; tl < 2; ++tl)
#pragma unroll
            for (int kb = 0; kb < 2; ++kb)
#pragma unroll
                for (int q4 = 0; q4 < 4; ++q4) { const int m = 8 * tl + 4 * kb + q4;
                    const float Gm = (p[tl][kb][4 * q4] + p[tl][kb][4 * q4 + 1]) + (p[tl][kb][4 * q4 + 2] + p[tl][kb][4 * q4 + 3]);
                    const float other = __shfl_xor(p[tl][kb][4 * q4 + 3], 32);
                    const float prev = hi ? other : carried; carried = other;
                    impw[(wave * 32 + r32) * 33 + 2 * m + hi] = Gm + prev; } }
        __builtin_amdgcn_sched_barrier(0);
        { f32x16 oc[2] = {f32x16{}, f32x16{}}; u32x4 pwa[4], pwb[4]; pack_p(pwa, p[0][0], p[0][1]); pack_p(pwb, p[1][0], p[1][1]); __builtin_amdgcn_sched_barrier(0);
          pv_packed(oc, kv + KvL<false>::V, pwa, lane); __builtin_amdgcn_sched_barrier(0);
          if (ntile > 1) pv_packed(oc, kv + KvL<false>::SUB + KvL<false>::V, pwb, lane); __builtin_amdgcn_sched_barrier(0);
          ob_add(ob, oc, gate[0], true); } }
        LDS_BAR();
    }
#pragma unroll 1
    for (int ps = (abl & 64) ? 2 : 0; ps < 2; ++ps) { const int lane = launder(F.tid) & 63, r32 = lane & 31, hi = lane >> 5; const int tokl = 4 * wave + 2 * ps + hi, j = r32; float a = 0.f;
#pragma unroll
        for (int w = 0; w < 8; ++w) a += impw[(w * 32 + tokl) * 33 + j];
        const bool forced = (j == 0) || (j == tb) || (j == tb - 1); const float sc = forced ? 1e4f : (j <= tb ? a : -1e4f);
        const int scb = __builtin_bit_cast(int, sc); int rank = 0;
#pragma unroll
        for (int k = 0; k < 32; ++k) { const float o0 = __builtin_bit_cast(float, __builtin_amdgcn_readlane(scb, k)), o1 = __builtin_bit_cast(float, __builtin_amdgcn_readlane(scb, 32 + k)); const float o = hi ? o1 : o0;
            rank += ((o > sc) || (o == sc && k < j)) ? 1 : 0; }
        const unsigned long long bal = __ballot(rank < 8);
        const unsigned mine = hi ? (unsigned)(bal >> 32) : (unsigned)bal;
        if (r32 == 0) { selw[tokl] = mine; __hip_atomic_fetch_or(&selw[32], mine, __ATOMIC_RELAXED, __HIP_MEMORY_SCOPE_WORKGROUP); } }
    LDS_BAR();
    const unsigned mysel = selw[r32]; const unsigned uni = selw[32] & ((tb >= 31) ? 0xffffffffu : ((2u << tb) - 1u));
    {
        AttnSt st; attn_reset(st);
        Src src{(const unsigned char*)(H1B + rb * 2048 + 1280 + g * 64), (const unsigned char*)(H1B + rb * 2048 + 1408 + g * 64), 4096u, 4096u};
        struct MaskS { int t, tb; unsigned sel; __device__ __forceinline__ bool need(int j) const { return j == tb; } __device__ __forceinline__ bool valid(int j, int key) const { return j * 64 + key <= t; }
            __device__ __forceinline__ bool lanebit(int j) const { return (sel >> j) & 1u; } } mk{t, tb, mysel};
        if (!(abl & 512)) attn_loop<4>(st, qf, BitIt{uni}, src, [&](int) { return true; }, mk, kv, tid, lane, abl);
        const float l = st.l + __shfl_xor(st.l, 32); ob_add(ob, st.o, gate[1] * __builtin_amdgcn_rcpf(l), false);
    }
    {
        AttnSt st; attn_reset(st);
        Src src{(const unsigned char*)(H1B + rb * 2048 + 1536 + g * 64), (const unsigned char*)(H1B + rb * 2048 + 1664 + g * 64), 4096u, 4096u};
        const int jlo = (t0 - 511 > 0) ? ((t0 - 511) >> 6) : 0;
        struct MaskW { int t, tb, t0; __device__ __forceinline__ bool need(int j) const { return (j == tb) || (64 * j <= t0 + 31 - 512); }
            __device__ __forceinline__ bool valid(int j, int key) const { const int k = j * 64 + key; return (k <= t) && (k > t - 512); } __device__ __forceinline__ bool lanebit(int) const { return true; } } mk{t, tb, t0};
        if (!(abl & 512)) attn_loop<4>(st, qf, RangeIt{jlo, tb + 1}, src, [&](int) { return true; }, mk, kv, tid, lane, abl);
        const float l = st.l + __shfl_xor(st.l, 32); ob_add(ob, st.o, gate[2] * __builtin_amdgcn_rcpf(l), false);
    }
#pragma unroll
    for (int db = 0; db < 2; ++db)
#pragma unroll
        for (int g4 = 0; g4 < 4; ++g4) *(u32x2*)(orow + db * 32 + 8 * g4) = ob[db][g4];
}

__device__ __forceinline__ void cmp_item(Frame& F, int item) {
    const int lane = F.lane, wave = F.wave, r32 = lane & 31, hi = lane >> 5;
    const int rblk = item & 63, gk = item >> 6, g = gk & 1, kvsel = gk >> 1;
    const int row = rblk * 32 + r32, b = row >> 7, n = row & 127;
    const bf16_t* H1B = (const bf16_t*)(F.ws + S_H1B);
    const int ncl = (n < 127) ? n : 126;
    const bf16_t* src = H1B + ((size_t)b * S + 16 * ncl) * 2048 + 1024 + kvsel * 128 + g * 64 + hi * 8;
    (void)src;
    const unsigned char* W1 = (const unsigned char*)(F.ws + (kvsel ? WS_WCV1 : WS_WCK1)) + (size_t)(wave * 32) * 4096;
    LAS unsigned char* wl = F.lds + RING_OFF + wave * 16384;
    const unsigned char* xrow[4];
#pragma unroll
    for (int i = 0; i < 4; ++i) { const int rr = rblk * 32 + 8 * i + (lane >> 3), bb = rr >> 7, nn = rr & 127, nc = (nn < 127) ? nn : 126;
        xrow[i] = (const unsigned char*)(H1B + ((size_t)bb * S + 16 * nc) * 2048 + 1024 + kvsel * 128 + g * 64) + (lane & 7) * 16; }
    f32x16 acc = {};
    u32x4 wv[2][4], xv[2][4];
#pragma unroll
    for (int c = 0; c < 2; ++c) { wt_load(wv[c], W1 + c * 128, 4096u, lane);
#pragma unroll
        for (int i = 0; i < 4; ++i) xv[c][i] = *(const u32x4*)(xrow[i] + (size_t)c * 4096); }
#pragma unroll 1
    for (int l0 = 0; l0 < 32; l0 += 2) {
#pragma unroll
        for (int c = 0; c < 2; ++c) { wt_store(wl + c * 4096, wv[c], lane); wt_store(wl + (2 + c) * 4096, xv[c], lane); }
        if (l0 + 2 < 32) {
#pragma unroll
            for (int c = 0; c < 2; ++c) { wt_load(wv[c], W1 + (size_t)(l0 + 2 + c) * 128, 4096u, lane);
#pragma unroll
                for (int i = 0; i < 4; ++i) xv[c][i] = *(const u32x4*)(xrow[i] + (size_t)(l0 + 2 + c) * 4096); } }
#pragma unroll
        for (int c = 0; c < 2; ++c)
#pragma unroll
            for (int q = 0; q < 4; ++q) acc = mfma32(wt_frag(wl + c * 4096, q, lane), wt_frag(wl + (2 + c) * 4096, q, lane), acc);
    }
    const float* cb = (const float*)(F.ws + WS_CBIAS) + kvsel * 256 + wave * 32;
    LAS unsigned char* hid = F.lds + RING_OFF;
    __syncthreads();
#pragma unroll
    for (int g4 = 0; g4 < 4; ++g4) { const int c = 8 * g4 + 4 * hi; u32x2 w; w.x = pk(gelu_t(acc[4 * g4] + cb[c]), gelu_t(acc[4 * g4 + 1] + cb[c + 1])); w.y = pk(gelu_t(acc[4 * g4 + 2] + cb[c + 2]), gelu_t(acc[4 * g4 + 3] + cb[c + 3]));
        *(LAS u32x2*)(hid + r32 * 528 + (wave * 32 + c) * 2) = w; }
    __syncthreads();
    if (wave < 2) {
        const bf16_t* W2 = (const bf16_t*)(F.ws + (kvsel ? WS_WCV2 : WS_WCK2)) + (size_t)(wave * 32 + r32) * 256 + hi * 8;
        f32x16 o = {};
#pragma unroll
        for (int ks = 0; ks < 16; ++ks) o = mfma32(ld8g(W2 + ks * 16), *(const LAS bf16x8*)(hid + r32 * 528 + ks * 32 + hi * 16), o);
        bf16_t* dst = (bf16_t*)(F.ws + (kvsel ? S_VCMP : S_KCMP)) + ((size_t)(b * 2 + g) * 128 + n) * 64 + wave * 32 + 4 * hi;
        const float z = (n < 127) ? 1.f : 0.f;
#pragma unroll
        for (int g4 = 0; g4 < 4; ++g4) store4(dst + 8 * g4, o[4 * g4] * z, o[4 * g4 + 1] * z, o[4 * g4 + 2] * z, o[4 * g4 + 3] * z);
    }
    __syncthreads();
}

__device__ __forceinline__ void ln_route_wg(Frame& F, int layer, int cset) {
    const int lane = F.lane, wave = F.wave, tid = F.tid, r32 = lane & 31, hi = lane >> 5;
    const int tok0 = F.vcu * 128;
    const float* Z = (const float*)(F.ws + WS_Z1);
    const float* g1 = (const float*)F.in[28] + layer * 1024; const float* b1 = (const float*)F.in[29] + layer * 1024;
    const float* wrg = (const float*)F.in[21] + (size_t)layer * 4096; const float* brg = (const float*)F.in[22] + layer * 4;
    const float* wre = (const float*)F.in[23] + (size_t)layer * 32768; const float* bre = (const float*)F.in[24] + layer * 32;
    LAS float* part = (LAS float*)(F.lds + RING_OFF);
    LAS float* glog = (LAS float*)(F.lds + LDS_SCR); LAS float* stl = (LAS float*)(F.lds + LDS_SCR + 2048);
    LAS int* lcnt = (LAS int*)(F.lds + LDS_SCR + 3072); LAS int* gbase = (LAS int*)(F.lds + LDS_SCR + 3200); LAS int* ent = (LAS int*)(F.lds + LDS_SCR + 3328);
    bf16_t* X1B = (bf16_t*)(F.ws + S_X1B); bf16_t* X1L = (bf16_t*)(F.ws + S_XP); float* stats = (float*)(F.ws + WS_STATS);
    if (tid < 32) lcnt[tid] = 0;
    {
        f32x4 gg[4], bb[4];
#pragma unroll
        for (int j = 0; j < 4; ++j) { gg[j] = *(const f32x4*)(g1 + lane * 4 + 256 * j); bb[j] = *(const f32x4*)(b1 + lane * 4 + 256 * j); }
#pragma unroll 1
        for (int i0 = 0; i0 < 16; i0 += 4) {
            f32x4 v[4][4]; float mean[4], rstd[4];
#pragma unroll
            for (int u = 0; u < 4; ++u) { const float* z = Z + (size_t)(tok0 + wave * 16 + i0 + u) * D;
#pragma unroll
                for (int j = 0; j < 4; ++j) v[u][j] = *(const f32x4*)(z + lane * 4 + 256 * j); }
#pragma unroll
            for (int u = 0; u < 4; ++u) { float s = 0.f;
#pragma unroll
                for (int j = 0; j < 4; ++j) s += (v[u][j][0] + v[u][j][1]) + (v[u][j][2] + v[u][j][3]);
                mean[u] = wsum(s) * (1.f / D); float q = 0.f;
#pragma unroll
                for (int j = 0; j < 4; ++j) { v[u][j] = v[u][j] - mean[u]; q += (v[u][j][0] * v[u][j][0] + v[u][j][1] * v[u][j][1]) + (v[u][j][2] * v[u][j][2] + v[u][j][3] * v[u][j][3]); }
                rstd[u] = rsqrtf(wsum(q) * (1.f / D) + LN_EPS); }
            f32x4 lg[4] = {f32x4{0.f, 0.f, 0.f, 0.f}, f32x4{0.f, 0.f, 0.f, 0.f}, f32x4{0.f, 0.f, 0.f, 0.f}, f32x4{0.f, 0.f, 0.f, 0.f}};
#pragma unroll
            for (int j = 0; j < 4; ++j) {
#pragma unroll
                for (int u = 0; u < 4; ++u) v[u][j] = v[u][j] * rstd[u] * gg[j] + bb[j];
#pragma unroll
                for (int e = 0; e < 4; ++e) { const f32x4 wv = *(const f32x4*)(wrg + (size_t)(lane * 4 + 256 * j + e) * 4);
#pragma unroll
                    for (int u = 0; u < 4; ++u) lg[u] += wv * v[u][j][e]; } }
#pragma unroll
            for (int u = 0; u < 4; ++u) { const int row = wave * 16 + i0 + u;
#pragma unroll
                for (int j = 0; j < 4; ++j) { const f32x4 x = v[u][j];
                    u32x2 w; w.x = pk(x[0], x[1]); w.y = pk(x[2], x[3]); *(u32x2*)(X1B + (size_t)(tok0 + row) * D + lane * 4 + 256 * j) = w;
                    u32x2 wl2; wl2.x = pk(x[0] - __uint_as_float(w.x << 16), x[1] - __uint_as_float(w.x & 0xffff0000u)); wl2.y = pk(x[2] - __uint_as_float(w.y << 16), x[3] - __uint_as_float(w.y & 0xffff0000u));
                    *(u32x2*)(X1L + (size_t)(tok0 + row) * D + lane * 4 + 256 * j) = wl2; }
                float l4[4];
#pragma unroll
                for (int e = 0; e < 4; ++e) l4[e] = wsum(lg[u][e]);
                if (lane == 0) { glog[row * 4 + 0] = l4[0] + brg[0]; glog[row * 4 + 1] = l4[1] + brg[1]; glog[row * 4 + 2] = l4[2] + brg[2]; glog[row * 4 + 3] = l4[3] + brg[3];
                    stl[row * 2] = mean[u]; stl[row * 2 + 1] = rstd[u]; stats[(size_t)(tok0 + row) * 2] = mean[u]; stats[(size_t)(tok0 + row) * 2 + 1] = rstd[u]; } }
        }
    }
    __syncthreads();
    { const int lane = launder(F.tid) & 63, r32 = lane & 31, hi = lane >> 5;
        bf16x8 wh[8], wl[8];
#pragma unroll
        for (int ks = 0; ks < 8; ++ks) { unsigned hh[4], ll[4];
#pragma unroll
            for (int e2 = 0; e2 < 4; ++e2) { float a[2], ah[2];
#pragma unroll
                for (int q = 0; q < 2; ++q) { const int k = wave * 128 + ks * 16 + hi * 8 + e2 * 2 + q; a[q] = wre[(size_t)k * 32 + r32]; }
                hh[e2] = pk(a[0], a[1]); ah[0] = __uint_as_float(hh[e2] << 16); ah[1] = __uint_as_float(hh[e2] & 0xffff0000u); ll[e2] = pk(a[0] - ah[0], a[1] - ah[1]); }
            wh[ks] = __builtin_bit_cast(bf16x8, (u32x4){hh[0], hh[1], hh[2], hh[3]}); wl[ks] = __builtin_bit_cast(bf16x8, (u32x4){ll[0], ll[1], ll[2], ll[3]}); asm volatile("" ::: "memory"); }
        for (int blk = 0; blk < 4; ++blk) { const int row = blk * 32 + r32; const size_t xo = (size_t)(tok0 + row) * D + wave * 128 + hi * 8;
            f32x16 acc = {};
#pragma unroll
            for (int ks = 0; ks < 8; ++ks) { const bf16x8 xh = ld8g(X1B + xo + ks * 16), xl = ld8g(X1L + xo + ks * 16);
                acc = mfma32(wh[ks], xh, acc); acc = mfma32(wh[ks], xl, acc); acc = mfma32(wl[ks], xh, acc); }
#pragma unroll
            for (int r = 0; r < 16; ++r) part[(wave * 128 + row) * 33 + crow(r, hi)] = acc[r];
        }
    }
    __syncthreads();
    const int tid2 = launder(F.tid);
    int e0 = 0, e1 = 0; float w0 = 0.f, w1 = 0.f; int rk0 = 0, rk1 = 0;
    if (tid2 < 128) {
        const float l0 = glog[tid2 * 4], l1 = glog[tid2 * 4 + 1], l2 = glog[tid2 * 4 + 2], l3 = glog[tid2 * 4 + 3];
        int gs = 0; float gm = l0; if (l1 > gm) { gm = l1; gs = 1; } if (l2 > gm) { gm = l2; gs = 2; } if (l3 > gm) { gm = l3; gs = 3; }
        const float gw = 1.f / (expf(l0 - gm) + expf(l1 - gm) + expf(l2 - gm) + expf(l3 - gm));
        float es[8];
#pragma unroll
        for (int n = 0; n < 8; ++n) { float a = bre[gs * 8 + n];
#pragma unroll
            for (int w = 0; w < 8; ++w) a += part[(w * 128 + tid2) * 33 + gs * 8 + n];
            es[n] = a; }
        int i0 = 0; float m0 = es[0];
#pragma unroll
        for (int n = 1; n < 8; ++n) if (es[n] > m0) { m0 = es[n]; i0 = n; }
        int i1 = 0; float m1 = -3e38f;
#pragma unroll
        for (int n = 0; n < 8; ++n) if (n != i0 && es[n] > m1) { m1 = es[n]; i1 = n; }
        const float r = expf(m1 - m0); w0 = gw / (1.f + r); w1 = gw * r / (1.f + r);
        e0 = gs * 8 + i0; e1 = gs * 8 + i1;
        rk0 = __hip_atomic_fetch_add(&lcnt[e0], 1, __ATOMIC_RELAXED, __HIP_MEMORY_SCOPE_WORKGROUP); rk1 = __hip_atomic_fetch_add(&lcnt[e1], 1, __ATOMIC_RELAXED, __HIP_MEMORY_SCOPE_WORKGROUP);
    }
    __syncthreads();
    if (tid2 < 32) gbase[tid2] = (int)__hip_atomic_fetch_add((int*)(F.ctl + CW_CNT + cset * 64) + tid2, lcnt[tid2], __ATOMIC_RELAXED, __HIP_MEMORY_SCOPE_AGENT);
    __syncthreads();
    if (tid2 < 128) {
        int* rt = (int*)(F.ws + WS_ROUTE); float* rw = (float*)(F.ws + WS_ROUTE + (size_t)T * 8);
        const int tok = tok0 + tid2;
        rt[tok * 2] = (e0 << 20) | (gbase[e0] + rk0); rt[tok * 2 + 1] = (e1 << 20) | (gbase[e1] + rk1);
        int* expl = (int*)(F.ws + WS_EXPL); expl[(size_t)e0 * T + gbase[e0] + rk0] = tok; expl[(size_t)e1 * T + gbase[e1] + rk1] = tok;
        rw[tok * 2] = w0; rw[tok * 2 + 1] = w1;
    }
    __syncthreads();
}
__device__ __forceinline__ void moe_tables(Frame& F, int layer) {
    LAS int* ebase = (LAS int*)(F.lds + LDS_SCR + 4352); LAS int* pe = (LAS int*)(F.lds + LDS_SCR + 4608);
    if (F.tid == 0) { int a = 0; for (int e = 0; e < 32; ++e) { ebase[e] = a; const int c = (int)__hip_atomic_load((int*)(F.ctl + CW_CNT + layer * 64) + e, __ATOMIC_RELAXED, __HIP_MEMORY_SCOPE_AGENT); a += (c + 255) & ~255; } ebase[32] = a; }
    __syncthreads();
    for (int p = F.tid; p < MOE_PANELS; p += NTHR) { int e = 0; for (int k = 1; k < 32; ++k) if (p * 256 >= ebase[k]) e = k; pe[p] = e; }
    __syncthreads();
}
__device__ __forceinline__ void moe_gather_wg(Frame& F, int layer) {
    moe_tables(F, layer);
    LAS int* ebase = (LAS int*)(F.lds + LDS_SCR + 4352);
    const int tok0 = F.vcu * 128; int* rt = (int*)(F.ws + WS_ROUTE);
    int* rowsrc = (int*)(F.ctl + CW_ROWSRC) + layer * MOE_ROWS;
    if (F.tid < 256) { const int tok = tok0 + (F.tid >> 1), sl = F.tid & 1; const int v = rt[tok * 2 + sl]; const int row = ebase[v >> 20] + (v & 0xfffff);
        rowsrc[row] = tok; rt[4 * T + tok * 2 + sl] = row; }
}
__device__ __forceinline__ void combine_wg(Frame& F, int layer, float* xout, bf16_t* xb) {
    const int lane = F.lane, tok0 = F.vcu * 128;
    const LAS int* ebase = (const LAS int*)(F.lds + LDS_SCR + 4352);
    const float* Z = (const float*)(F.ws + WS_Z1); const float* stats = (const float*)(F.ws + WS_STATS);
    const int* rt = (const int*)(F.ws + WS_ROUTE); const float* rw = (const float*)(F.ws + WS_ROUTE + (size_t)T * 8);
    const bf16_t* YP = (const bf16_t*)(F.ws + S_YP);
    const float* g1 = (const float*)F.in[28] + layer * 1024; const float* b1 = (const float*)F.in[29] + layer * 1024;
    const float* g2 = (const float*)F.in[30] + layer * 1024; const float* b2 = (const float*)F.in[31] + layer * 1024;
    f32x4 G1[4], B1[4], G2[4], B2[4];
#pragma unroll
    for (int j = 0; j < 4; ++j) { const int c = lane * 4 + 256 * j; G1[j] = *(const f32x4*)(g1 + c); B1[j] = *(const f32x4*)(b1 + c); G2[j] = *(const f32x4*)(g2 + c); B2[j] = *(const f32x4*)(b2 + c); }
#pragma unroll 1
    for (int i0 = 0; i0 < 16; i0 += 4) {
        f32x4 z[4][4]; s16x4 ya[4][4], yb[4][4]; float mean[4], rstd[4], w0[4], w1[4];
#pragma unroll
        for (int u = 0; u < 4; ++u) { const int tok = tok0 + F.wave * 16 + i0 + u;
            mean[u] = stats[(size_t)tok * 2]; rstd[u] = stats[(size_t)tok * 2 + 1]; w0[u] = rw[tok * 2]; w1[u] = rw[tok * 2 + 1];
            const int v0 = rt[tok * 2], v1 = rt[tok * 2 + 1];
            const bf16_t* y0 = YP + (size_t)(ebase[v0 >> 20] + (v0 & 0xfffff)) * D; const bf16_t* y1 = YP + (size_t)(ebase[v1 >> 20] + (v1 & 0xfffff)) * D;
#pragma unroll
            for (int j = 0; j < 4; ++j) { const int c = lane * 4 + 256 * j; z[u][j] = *(const f32x4*)(Z + (size_t)tok * D + c); ya[u][j] = *(const s16x4*)(y0 + c); yb[u][j] = *(const s16x4*)(y1 + c); } }
        float s[4], q[4];
#pragma unroll
        for (int u = 0; u < 4; ++u) { s[u] = 0.f;
#pragma unroll
            for (int j = 0; j < 4; ++j) { const f32x4 x1 = (z[u][j] - mean[u]) * rstd[u] * G1[j] + B1[j]; f32x4 f;
#pragma unroll
                for (int e = 0; e < 4; ++e) f[e] = w0[u] * bf2f((unsigned short)ya[u][j][e]) + w1[u] * bf2f((unsigned short)yb[u][j][e]);
                z[u][j] = x1 * ALPHA + f; s[u] += (z[u][j][0] + z[u][j][1]) + (z[u][j][2] + z[u][j][3]); } }
#pragma unroll
        for (int u = 0; u < 4; ++u) { const float m2 = wsum(s[u]) * (1.f / D); q[u] = 0.f;
#pragma unroll
            for (int j = 0; j < 4; ++j) { z[u][j] = z[u][j] - m2; q[u] += (z[u][j][0] * z[u][j][0] + z[u][j][1] * z[u][j][1]) + (z[u][j][2] * z[u][j][2] + z[u][j][3] * z[u][j][3]); } }
#pragma unroll
        for (int u = 0; u < 4; ++u) { const int tok = tok0 + F.wave * 16 + i0 + u; const float r2 = rsqrtf(wsum(q[u]) * (1.f / D) + LN_EPS);
#pragma unroll
            for (int j = 0; j < 4; ++j) { const int c = lane * 4 + 256 * j; const f32x4 o = z[u][j] * r2 * G2[j] + B2[j];
                *(f32x4*)(xout + (size_t)tok * D + c) = o;
                if (xb) { u32x2 w; w.x = pk(o[0], o[1]); w.y = pk(o[2], o[3]); *(u32x2*)(xb + (size_t)tok * D + c) = w; } } }
    }
}
constexpr int NPHASE = 19;
__global__ void __launch_bounds__(NTHR, 2) mega(Args args) {
    extern __shared__ __attribute__((aligned(16))) unsigned char lds_[];
#define PHASE_FRAME() Frame F; { int t_ = (int)threadIdx.x; asm volatile("" : "+v"(t_)); GAS unsigned char* wg_ = (GAS unsigned char*)args.ws; asm volatile("" : "+s"(wg_)); unsigned char* w_ = (unsigned char*)wg_; int bx_ = (int)blockIdx.x; asm volatile("" : "+s"(bx_)); \
        F.lds = (LAS unsigned char*)lds_; F.ws = w_; F.ctl = (gu32*)(w_ + WS_CTL); F.in = args.in; F.out = args.out; F.tid = t_; F.lane = t_ & 63; F.wave = __builtin_amdgcn_readfirstlane(t_ >> 6); \
        F.G = (int)gridDim.x; F.vcu = (F.G % 8 == 0) ? (bx_ % 8) * (F.G / 8) + bx_ / 8 : bx_; } unsigned char* ws = F.ws; LAS unsigned char* ring = F.lds + RING_OFF; (void)ws; (void)ring
    Frame F0; { F0.lds = (LAS unsigned char*)lds_; F0.ws = args.ws; F0.ctl = (gu32*)(args.ws + WS_CTL); F0.tid = threadIdx.x; }
    volatile LAS unsigned* MISC = (volatile LAS unsigned*)(F0.lds + LDS_MISC);
    if (F0.tid < 64) MISC[F0.tid] = 0u;
    __syncthreads();
    const int lo = args.ph_lo, hi = args.ph_hi;
    const bool one = (hi - lo) > 1;
    XcdBarrier bar; bar.bar = (unsigned*)(F0.ctl + CW_BAR); bar.x = 0; bar.st = nullptr;
    if (one) bar = xcd_barrier_post((unsigned*)(F0.ctl + CW_BAR), MISC + 8);
#ifndef PH_MASK
#define PH_MASK 0xFFFFFFFFu
#endif
#define IN(k) ((((PH_MASK) >> (k)) & 1u) && lo <= (k) && (k) < hi)
#ifndef ABL
#define ABL 0
#endif
#ifndef DUP_PHASE
#define DUP_PHASE -1
#endif
#define REP(k) for (int rep = ((k) == DUP_PHASE ? 0 : 1); rep < 2; ++rep)
#define REPSYNC() do { if (rep == 0) xcd_barrier(bar); } while (0)
#ifndef BARX
#define BARX 1
#endif
#define SEAM(k) do { if (IN(k) && IN((k) + 1)) { for (int bx_ = 0; bx_ < BARX; ++bx_) xcd_barrier(bar); } } while (0)

    if (IN(0)) REP(0) { PHASE_FRAME(); const bool dry = (rep == 0); (void)dry; p0_prologue(F); REPSYNC(); } SEAM(0);
    if (IN(1)) REP(1) { PHASE_FRAME(); const bool dry = (rep == 0); (void)dry; Gemm g{(const bf16_t*)(ws + S_XB), (const bf16_t*)(ws + WS_W0IN), T, 1536, 1024, 1024, nullptr}; pg8::StaticOrder So; So.init(T, 1536, F.G, (int)blockIdx.x);
        EpiTile E{(bf16_t*)(ws + S_H0B), 1536, 4, 0, 1.f, 0};
        pg8::gemm_phase<EpiTile, pg8::StaticOrder, true, true>(ring, g, So, E); REPSYNC(); } SEAM(1);
    if (IN(2)) REP(2) { PHASE_FRAME(); const bool dry = (rep == 0); (void)dry; for (int it = F.vcu * NWAVES + F.wave; it < 2048; it += F.G * NWAVES) { if (!(dry && (ABL & 2048))) mla_up_item(F, it); }
        __syncthreads();
        if (!(dry && (ABL & 1024))) for (int ch = F.vcu; ch < 256; ch += F.G) gmlp_chunk(F, ch, dry); REPSYNC(); } SEAM(2);
    if (IN(3)) REP(3) { PHASE_FRAME(); const bool dry = (rep == 0); (void)dry; for (int c = F.vcu; c < 256; c += F.G) { const int bh = c >> 1;
#pragma unroll 1
            for (int i = 0; i < 4; ++i) { const int qb = (c & 1) ? ((i == 0) ? 6 : (i == 1) ? 1 : (i == 2) ? 5 : 2) : ((i == 0) ? 7 : (i == 1) ? 0 : (i == 2) ? 4 : 3); mla_attn_unit(F, bh >> 3, bh & 7, qb, dry ? ABL : 0); } } REPSYNC(); } SEAM(3);
    if (IN(4)) REP(4) { PHASE_FRAME(); const bool dry = (rep == 0); (void)dry; Gemm g{(const bf16_t*)(ws + S_H0B), (const bf16_t*)(ws + WS_W0O), T, 1024, 1024, 1536, nullptr}; pg8::StaticOrder So; So.init(T, 1024, F.G, (int)blockIdx.x);
        EpiResid E{(const float*)args.in[0], (float*)(ws + WS_Z1)};
        pg8::gemm_phase<EpiResid, pg8::StaticOrder, true, true>(ring, g, So, E); REPSYNC(); } SEAM(4);
#pragma unroll
    for (int layer = 0; layer < 2; ++layer) {
        const int pb = layer ? 14 : 5;
        if (IN(pb)) REP(pb) { PHASE_FRAME(); const bool dry = (rep == 0); (void)dry; for (int c = F.vcu; c < 256; c += F.G) { Frame F2 = F; F2.vcu = c; ln_route_wg(F2, layer, dry ? 2 + layer : layer); } REPSYNC(); } SEAM(pb);
        if (IN(pb + 2)) REP(pb + 2) { PHASE_FRAME(); const bool dry = (rep == 0); (void)dry; moe_tables(F, layer); const LAS int* eb = (const LAS int*)(F.lds + LDS_SCR + 4352);
            Gemm g{(const bf16_t*)(ws + S_X1B), (const bf16_t*)(ws + WS_WGU) + (size_t)layer * 32 * 512 * 1024, MOE_ROWS, 512, 1024, 1024, nullptr};
            MoeOrder<2> So{(const LAS int*)(F.lds + LDS_SCR + 4608), (eb[32] >> 8) * 2, F.G, F.vcu, eb, (const int*)(ws + WS_EXPL)}; EpiMoeUp E{(bf16_t*)(ws + S_HP)};
            pg8::gemm_phase<EpiMoeUp, MoeOrder<2>, true, true, true>(ring, g, So, E); REPSYNC(); } SEAM(pb + 2);
        if (IN(pb + 3)) REP(pb + 3) { PHASE_FRAME(); const bool dry = (rep == 0); (void)dry; moe_tables(F, layer); const LAS int* eb = (const LAS int*)(F.lds + LDS_SCR + 4352);
            Gemm g{(const bf16_t*)(ws + S_HP), (const bf16_t*)(ws + WS_WD) + (size_t)layer * 32 * 1024 * 256, MOE_ROWS, 1024, 256, 256, nullptr};
            MoeOrder<4> So{(const LAS int*)(F.lds + LDS_SCR + 4608), (eb[32] >> 8) * 4, F.G, F.vcu, eb, (const int*)(ws + WS_EXPL)}; EpiMoeDown E{(bf16_t*)(ws + S_YP)};
            pg8::gemm_phase<EpiMoeDown, MoeOrder<4>, false, true>(ring, g, So, E); REPSYNC(); } SEAM(pb + 3);
        if (IN(pb + 4)) REP(pb + 4) { PHASE_FRAME(); const bool dry = (rep == 0); (void)dry; moe_tables(F, layer); for (int c = F.vcu; c < 256; c += F.G) { Frame F2 = F; F2.vcu = c; combine_wg(F2, layer, args.out, layer ? nullptr : (bf16_t*)(ws + S_X2B)); } REPSYNC(); }
        if (layer == 0) {
            SEAM(9);
            if (IN(10)) REP(10) { PHASE_FRAME(); const bool dry = (rep == 0); (void)dry; Gemm g{(const bf16_t*)(ws + S_X2B), (const bf16_t*)(ws + WS_W1IN), T, 2048, 1024, 1024, nullptr}; pg8::StaticOrder So; So.init(T, 2048, F.G, (int)blockIdx.x);
                EpiTile E{(bf16_t*)(ws + S_H1B), 2048, 0, 4, QS_NSA, 0};
                pg8::gemm_phase<EpiTile, pg8::StaticOrder, true, true>(ring, g, So, E); REPSYNC(); } SEAM(10);
            if (IN(11)) REP(11) { PHASE_FRAME(); const bool dry = (rep == 0); (void)dry; for (int it = F.vcu; it < 256; it += F.G) cmp_item(F, it); REPSYNC(); } SEAM(11);
            if (IN(12)) REP(12) { PHASE_FRAME(); const bool dry = (rep == 0); (void)dry; for (int c = F.vcu; c < 256; c += F.G) { const int bg = c >> 3, s = c & 7;
#pragma unroll 1
                    for (int i = 0; i < 8; ++i) { const int k = i >> 1; const int blk = (k == 0) ? 31 - s : (k == 1) ? 16 + s : (k == 2) ? 15 - s : s; nsa_unit(F, bg >> 1, bg & 1, blk * 2 + (i & 1), dry, dry ? ABL : 0); } } REPSYNC(); } SEAM(12);
            if (IN(13)) REP(13) { PHASE_FRAME(); const bool dry = (rep == 0); (void)dry; Gemm g{(const bf16_t*)(ws + S_H1B), (const bf16_t*)(ws + WS_W1O), T, 1024, 1024, 2048, nullptr}; pg8::StaticOrder So; So.init(T, 1024, F.G, (int)blockIdx.x);
                EpiResid E{(const float*)args.out, (float*)(ws + WS_Z1)};
                pg8::gemm_phase<EpiResid, pg8::StaticOrder, true, true>(ring, g, So, E); REPSYNC(); } SEAM(13);
        }
    }
#undef IN
#undef SEAM
}

#ifndef MK_SPLIT
#define MK_SPLIT 0
#endif
static void launch_all(void* const* d_in, float* out, unsigned char* ws, hipStream_t stream) {
    static int grid = 0;
    if (grid == 0) {
        int dev = 0, cus = 0, per_cu = 0;
        if (hipGetDevice(&dev) != hipSuccess || hipDeviceGetAttribute(&cus, hipDeviceAttributeMultiprocessorCount, dev) != hipSuccess) { grid = -1; return; }
        if (hipFuncSetAttribute((const void*)mega, hipFuncAttributeMaxDynamicSharedMemorySize, LDS_BYTES) != hipSuccess) { fprintf(stderr, "kernel_launch: hipFuncSetAttribute failed\n"); grid = -1; return; }
        if (hipOccupancyMaxActiveBlocksPerMultiprocessor(&per_cu, (const void*)mega, NTHR, LDS_BYTES) != hipSuccess || per_cu < 1) fprintf(stderr, "kernel_launch: occupancy query says %d\n", per_cu);
        (void)hipGetLastError();
        grid = cus < 256 ? cus : 256;
    }
    if (grid < 0) return;
    (void)hipMemsetAsync(ws + WS_CTL, 0, CTL_ZERO_BYTES, stream);
    Args a{};
    for (int i = 0; i < 32; ++i) a.in[i] = d_in[i];
    a.out = out; a.ws = ws;
#if MK_SPLIT
    for (int p = 0; p < NPHASE; ++p) { a.ph_lo = p; a.ph_hi = p + 1; hipLaunchKernelGGL(mega, dim3(grid), dim3(NTHR), LDS_BYTES, stream, a); }
#else
    a.ph_lo = 0; a.ph_hi = NPHASE; hipLaunchKernelGGL(mega, dim3(grid), dim3(NTHR), LDS_BYTES, stream, a);
#endif
}
}

extern "C" void kernel_launch(void* const* d_in, const int* in_sizes, int n_in, void* d_out, int out_size, void* d_ws, size_t ws_size, hipStream_t stream) {
    fk::launch_all(d_in, (float*)d_out, (unsigned char*)d_ws, stream);
}
```

```cpp
#include <hip/hip_runtime.h>
#include <stdint.h>
#include <math.h>
#include <cstdio>
namespace pg8 {
#define PG8_LAS __attribute__((address_space(3)))
typedef unsigned short bf16_t;
typedef short bf16x8 __attribute__((ext_vector_type(8)));
typedef float f32x4 __attribute__((ext_vector_type(4)));
typedef unsigned u32x4 __attribute__((ext_vector_type(4)));
constexpr int BM = 256, BK = 64, HALF = 128, HTB = HALF * BK * 2  , STAGE_BYTES = 8 * HTB, NXCD = 8, WGM = 8;

__host__ __device__ __forceinline__ int lds_byte(int r, int c) { const int st = (r >> 4) * 2 + (c >> 5), rr = r & 15, cc = c & 31, ob = rr * 64 + cc * 2; return st * 1024 + (ob ^ (((ob >> 9) & 1) << 5)); }
__host__ __device__ __forceinline__ void stage_rc(int b, int& R, int& C) { const int st = b / 1024, sb = b % 1024, swz = sb ^ (((sb >> 9) & 1) << 5); R = (st >> 1) * 16 + swz / 64; C = (st & 1) * 32 + (swz % 64) / 2; }
__host__ __device__ __forceinline__ int perm32(int rho) { const int n = rho >> 4, i = rho & 15; return 8 * (i >> 2) + 4 * n + (i & 3); }

struct Unit { int pm, pn; };
struct Gemm { const bf16_t* A; const bf16_t* Bt; int M, N, K, lda; const int* rowsrc; };

struct StaticOrder {
    int nM, nN, nwg, G, c;
    __host__ __device__ void init(int M, int N, int G_, int c_) { nM = M / BM; nN = N / BM; nwg = nM * nN; G = G_; c = c_; }
    __host__ __device__ bool next(int i, Unit& u) const {
        const long L = (long)i * G + c; if (L >= nwg) return false;
        int wgid = (int)L; { const int q = nwg / NXCD, r = nwg % NXCD, xcd = wgid % NXCD, off = wgid / NXCD; wgid = (xcd < r ? xcd * (q + 1) : r * (q + 1) + (xcd - r) * q) + off; }
        const int nig = WGM * nN, gid = wgid / nig, fm = gid * WGM, gsz = (nM - fm) < WGM ? (nM - fm) : WGM;
        u.pm = fm + ((wgid % nig) % gsz); u.pn = (wgid % nig) / gsz; return true;
    }
    __device__ __forceinline__ void a_ready(const Unit&) const {}
    __device__ __forceinline__ void done(const Unit&) const {}
};

__device__ __forceinline__ unsigned cvt_pk_bf16(float lo, float hi) { unsigned r; asm volatile("v_cvt_pk_bf16_f32 %0, %1, %2" : "=v"(r) : "v"(lo), "v"(hi)); return r; }
typedef float f32x2 __attribute__((ext_vector_type(2)));
template <class Epi, class Sched, bool ALIGN_EPI = false, bool SP2 = false, bool GATHER = false>
__device__ __forceinline__ void gemm_phase(PG8_LAS unsigned char* lds, const Gemm g, const Sched& S, const Epi& E) {
    int tid_l = (int)threadIdx.x; asm volatile("" : "+v"(tid_l));
    const int tid = tid_l, wid = __builtin_amdgcn_readfirstlane(tid >> 6), lane = tid & 63, wr = wid >> 2, wc = wid & 3, fr = lane & 15, fq = lane >> 4;
    const int K = g.K, nt = K / BK;
    unsigned voffA[2], voffB[2], voffA1[2] = {0u, 0u}, nvoffA[2] = {0u, 0u}, nvoffA1[2] = {0u, 0u}; int RA[2], CA[2];
#pragma unroll
    for (int i = 0; i < 2; ++i) { int R, C; stage_rc(tid * 16 + i * 8192, R, C); const int Rb = Epi::PERM ? ((R & ~31) + perm32(R & 31)) : R;
        voffA[i] = (unsigned)(R * g.lda + C) * 2u; voffB[i] = (unsigned)(Rb * K + C) * 2u; RA[i] = R; CA[i] = C; }
    const size_t kstep = (size_t)(BK * 2);
    const size_t hstepA = (size_t)HALF * g.lda * 2, hstepB = (size_t)HALF * K * 2;
    const size_t tstepA = 2 * hstepA, tstepB = 2 * hstepB;
    const unsigned ldsw = (unsigned)wid * 1024u;
    const int aoff = lds_byte(wr * 64 + fr, fq * 8), boff = lds_byte(wc * 32 + fr, fq * 8);
#define PG8_SA(b, h) (((b) * 2 + (h)) * HTB)
#define PG8_SB(b, h) ((4 + (b) * 2 + (h)) * HTB)
#define PG8_STAGE(bufoff, gbase, voff) do { _Pragma("unroll") for (int _i = 0; _i < 2; ++_i) \
        __builtin_amdgcn_global_load_lds((const unsigned*)((const char*)(gbase) + (voff)[_i]), (PG8_LAS unsigned*)(lds + (bufoff) + ldsw + _i * 8192), 16, 0, 0); } while (0)
#define PG8_GSET(u, v0, v1) do { _Pragma("unroll") for (int _i = 0; _i < 2; ++_i) { v0[_i] = (unsigned)(S.arow((u), RA[_i]) * g.lda + CA[_i]) * 2u; v1[_i] = (unsigned)(S.arow((u), HALF + RA[_i]) * g.lda + CA[_i]) * 2u; } } while (0)
#define PG8_STA0(slot, P, NX) do { if constexpr (GATHER) { if (NX) PG8_STAGE(slot, P, nvoffA); else PG8_STAGE(slot, P, voffA); } else PG8_STAGE(slot, P, voffA); } while (0)
#define PG8_STA1(slot, P, NX) do { if constexpr (GATHER) { if (NX) PG8_STAGE(slot, P, nvoffA1); else PG8_STAGE(slot, P, voffA1); } else PG8_STAGE(slot, (P) + hstepA, voffA); } while (0)
#define PG8_LDA(dst, b, h) do { _Pragma("unroll") for (int m = 0; m < 4; ++m) _Pragma("unroll") for (int k = 0; k < 2; ++k) dst[m][k] = *(const PG8_LAS bf16x8*)(lds + PG8_SA(b, h) + aoff + m * 2048 + k * 1024); } while (0)
#define PG8_LDB(dst, b, h) do { _Pragma("unroll") for (int n = 0; n < 2; ++n) _Pragma("unroll") for (int k = 0; k < 2; ++k) dst[n][k] = *(const PG8_LAS bf16x8*)(lds + PG8_SB(b, h) + boff + n * 2048 + k * 1024); } while (0)
#define PG8_MMA(ai, bj, At, Bt) do { __builtin_amdgcn_s_setprio(1); _Pragma("unroll") for (int m = 0; m < 4; ++m) _Pragma("unroll") for (int n = 0; n < 2; ++n) _Pragma("unroll") for (int k = 0; k < 2; ++k) \
        acc[ai][bj][m][n] = __builtin_amdgcn_mfma_f32_16x16x32_bf16(Bt[n][k], At[m][k], acc[ai][bj][m][n], 0, 0, 0); __builtin_amdgcn_s_setprio(0); } while (0)
#define PG8_WAIT_V(n) asm volatile("s_waitcnt vmcnt(" #n ")" ::: "memory")
#define PG8_WAIT_L(n) asm volatile("s_waitcnt lgkmcnt(" #n ")" ::: "memory")
#define PG8_BAR __builtin_amdgcn_s_barrier()
#define PG8_SCHED __builtin_amdgcn_sched_barrier(0)
    Unit cur, nxt; int ui = 0;
    if (!S.next(0, cur)) return;
    f32x4 acc[2][2][4][2];
#pragma unroll
    for (int a = 0; a < 2; ++a)
#pragma unroll
        for (int b = 0; b < 2; ++b)
#pragma unroll
            for (int m = 0; m < 4; ++m)
#pragma unroll
                for (int n = 0; n < 2; ++n) acc[a][b][m][n] = (f32x4){0.f, 0.f, 0.f, 0.f};
    bf16x8 At[4][2], B0[2][2], B1[2][2];
    const char* cA = GATHER ? (const char*)g.A : (const char*)g.A + (size_t)cur.pm * tstepA; if constexpr (GATHER) PG8_GSET(cur, voffA, voffA1);
    const char* cB = (const char*)g.Bt + (size_t)cur.pn * tstepB;
    S.a_ready(cur);
    if constexpr (SP2) {
        PG8_STAGE(PG8_SB(0, 0), cB, voffB); PG8_STAGE(PG8_SB(0, 1), cB + hstepB, voffB); PG8_STA0(PG8_SA(0, 0), cA, false); PG8_STA1(PG8_SA(0, 1), cA, false);
        if (wr == 1) PG8_BAR;
        PG8_WAIT_V(2); PG8_BAR;
        PG8_STAGE(PG8_SB(1, 0), cB + kstep, voffB); PG8_STA0(PG8_SA(1, 0), cA + kstep, false); PG8_STAGE(PG8_SB(1, 1), cB + hstepB + kstep, voffB);
        PG8_WAIT_V(6); PG8_BAR;
    } else {
        PG8_STAGE(PG8_SB(0, 0), cB, voffB); PG8_STA0(PG8_SA(0, 0), cA, false); PG8_STAGE(PG8_SB(0, 1), cB + hstepB, voffB); PG8_STA1(PG8_SA(0, 1), cA, false);
        if (wr == 1) PG8_BAR;
        PG8_WAIT_V(4); PG8_BAR;
        PG8_STAGE(PG8_SB(1, 0), cB + kstep, voffB); PG8_STA0(PG8_SA(1, 0), cA + kstep, false); PG8_STAGE(PG8_SB(1, 1), cB + hstepB + kstep, voffB);
        PG8_WAIT_V(6); PG8_BAR;
    }
    for (;;) {
        const bool has_next = S.next(ui + 1, nxt);
        const char* nA = has_next ? (GATHER ? (const char*)g.A : (const char*)g.A + (size_t)nxt.pm * tstepA) : cA; if constexpr (GATHER) { if (has_next) PG8_GSET(nxt, nvoffA, nvoffA1); } const char* nB = has_next ? (const char*)g.Bt + (size_t)nxt.pn * tstepB : cB;
#pragma unroll 1
        for (int t = 0; t < nt; t += 2) {
            const bool last = (t == nt - 2);
            const char* a1 = cA + (size_t)(t + 1) * kstep;
            const char* a2 = last ? nA : cA + (size_t)(t + 2) * kstep; const char* b2 = last ? nB : cB + (size_t)(t + 2) * kstep;
            const char* a3 = a2 + kstep; const char* b3 = b2 + kstep;
            if (last && has_next) S.a_ready(nxt);
            if constexpr (SP2) {
            PG8_LDB(B0, 0, 0); PG8_LDB(B1, 0, 1); PG8_SCHED; PG8_LDA(At, 0, 0); PG8_STA1(PG8_SA(1, 1), a1, false);
            PG8_WAIT_V(8); PG8_WAIT_L(0); PG8_BAR; PG8_MMA(0, 0, At, B0); PG8_MMA(0, 1, At, B1); PG8_BAR; PG8_SCHED;
            PG8_LDA(At, 0, 1); PG8_STAGE(PG8_SB(0, 0), b2, voffB); PG8_STAGE(PG8_SB(0, 1), b2 + hstepB, voffB); PG8_STA0(PG8_SA(0, 0), a2, last && has_next);
            PG8_WAIT_V(8); PG8_WAIT_L(0); PG8_BAR; PG8_MMA(1, 0, At, B0); PG8_MMA(1, 1, At, B1); PG8_BAR; PG8_SCHED;
            PG8_LDB(B0, 1, 0); PG8_LDB(B1, 1, 1); PG8_SCHED; PG8_LDA(At, 1, 0); PG8_STA1(PG8_SA(0, 1), a2, last && has_next);
            PG8_WAIT_V(8); PG8_WAIT_L(0); PG8_BAR; PG8_MMA(0, 0, At, B0); PG8_MMA(0, 1, At, B1); PG8_BAR; PG8_SCHED;
            PG8_LDA(At, 1, 1); PG8_STAGE(PG8_SB(1, 0), b3, voffB); PG8_STAGE(PG8_SB(1, 1), b3 + hstepB, voffB); PG8_STA0(PG8_SA(1, 0), a3, last && has_next);
            PG8_WAIT_V(8); PG8_WAIT_L(0); PG8_BAR; PG8_MMA(1, 0, At, B0); PG8_MMA(1, 1, At, B1); PG8_BAR; PG8_SCHED;
            } else {
            PG8_LDB(B0, 0, 0); PG8_SCHED; PG8_LDA(At, 0, 0); PG8_STA1(PG8_SA(1, 1), a1, false);
            PG8_WAIT_L(8); PG8_BAR; PG8_WAIT_L(0); PG8_MMA(0, 0, At, B0); PG8_BAR; PG8_SCHED;
            PG8_LDB(B1, 0, 1); PG8_STAGE(PG8_SB(0, 0), b2, voffB);
            PG8_BAR; PG8_WAIT_L(0); PG8_MMA(0, 1, At, B1); PG8_BAR;
            PG8_LDA(At, 0, 1); PG8_STA0(PG8_SA(0, 0), a2, last && has_next);
            PG8_BAR; PG8_WAIT_L(0); PG8_MMA(1, 0, At, B0); PG8_BAR; PG8_SCHED;
            PG8_STAGE(PG8_SB(0, 1), b2 + hstepB, voffB);
            PG8_WAIT_V(6); PG8_BAR; PG8_MMA(1, 1, At, B1); PG8_BAR;
            PG8_LDB(B0, 1, 0); PG8_SCHED; PG8_LDA(At, 1, 0); PG8_STA1(PG8_SA(0, 1), a2, last && has_next);
            PG8_WAIT_L(8); PG8_BAR; PG8_WAIT_L(0); PG8_MMA(0, 0, At, B0); PG8_BAR; PG8_SCHED;
            PG8_LDB(B1, 1, 1); PG8_STAGE(PG8_SB(1, 0), b3, voffB);
            PG8_BAR; PG8_WAIT_L(0); PG8_MMA(0, 1, At, B1); PG8_BAR;
            PG8_LDA(At, 1, 1); PG8_STA0(PG8_SA(1, 0), a3, last && has_next);
            PG8_BAR; PG8_WAIT_L(0); PG8_MMA(1, 0, At, B0); PG8_BAR; PG8_SCHED;
            PG8_STAGE(PG8_SB(1, 1), b3 + hstepB, voffB);
            PG8_WAIT_V(6); PG8_BAR; PG8_MMA(1, 1, At, B1); PG8_BAR;
            }
        }
        if constexpr (ALIGN_EPI) { if (wr == 0) PG8_BAR; }
        if constexpr (!Epi::AFTER_DRAIN) { E(acc, cur, wr, wc, fr, fq); S.done(cur); }
        if (!has_next) break;
#pragma unroll
        for (int a = 0; a < 2; ++a)
#pragma unroll
            for (int b = 0; b < 2; ++b)
#pragma unroll
                for (int m = 0; m < 4; ++m)
#pragma unroll
                    for (int n = 0; n < 2; ++n) acc[a][b][m][n] = (f32x4){0.f, 0.f, 0.f, 0.f};
        cur = nxt; cA = nA; cB = nB; ++ui;
        if constexpr (GATHER) { voffA[0] = nvoffA[0]; voffA[1] = nvoffA[1]; voffA1[0] = nvoffA1[0]; voffA1[1] = nvoffA1[1]; }
        if constexpr (ALIGN_EPI) { if (wr == 1) PG8_BAR; }
    }
    PG8_WAIT_V(0);
    if constexpr (!ALIGN_EPI) { if (wr == 0) PG8_BAR; }
    PG8_BAR;
    if constexpr (Epi::AFTER_DRAIN) { E.fused(acc, cur, wr, wc, fr, fq, lds, wid, lane); S.done(cur); }
#undef PG8_SA
#undef PG8_SB
#undef PG8_STAGE
#undef PG8_GSET
#undef PG8_STA0
#undef PG8_STA1
#undef PG8_LDA
#undef PG8_LDB
#undef PG8_MMA
#undef PG8_WAIT_V
#undef PG8_WAIT_L
#undef PG8_BAR
#undef PG8_SCHED
}
}
#define GAS __attribute__((address_space(1)))
#define LAS __attribute__((address_space(3)))
typedef unsigned short bf16;
typedef unsigned v4u __attribute__((ext_vector_type(4)));
typedef float f32x4 __attribute__((ext_vector_type(4)));
typedef short bf16x8 __attribute__((ext_vector_type(8)));
typedef GAS unsigned gu32;
typedef GAS unsigned long long gu64;
#define RLX_AGENT __ATOMIC_RELAXED, __HIP_MEMORY_SCOPE_AGENT
#define LDS_WAIT() asm volatile("s_waitcnt lgkmcnt(0)" ::: "memory")
#define VM_WAIT() asm volatile("s_waitcnt vmcnt(0)" ::: "memory")
__device__ __forceinline__ unsigned long long rt() { return __builtin_amdgcn_s_memrealtime(); }
__device__ __forceinline__ unsigned f2bf(float f) { unsigned u = __builtin_bit_cast(unsigned, f); return (u + 0x7fffu + ((u >> 16) & 1u)) >> 16; }
__device__ __forceinline__ unsigned pk2(float lo, float hi) { return f2bf(lo) | (f2bf(hi) << 16); }

#define XB_TMO      128
#define XB_XCNT(j)  (256  + 64 * (j))
#define XB_XSUB(j)  (1280 + 64 * (j))
#define XB_XGEN(j)  (2304 + 64 * (j))
#define XB_TOP      3328
#define XB_TOPGEN   3392
#define XCD_BAR_WORDS 3456
#define XB_SPIN_CAP (1u << 18)

__device__ __forceinline__ unsigned xb_ld(unsigned* p)              { return __hip_atomic_load(p, __ATOMIC_RELAXED, __HIP_MEMORY_SCOPE_AGENT); }
__device__ __forceinline__ unsigned xb_add(unsigned* p, unsigned v) { return __hip_atomic_fetch_add(p, v, __ATOMIC_RELAXED, __HIP_MEMORY_SCOPE_AGENT); }
__device__ __forceinline__ unsigned xb_xcc_id() { return (unsigned)__builtin_amdgcn_s_getreg((3 << 11) | 20) & 0xFu; }
#define XB_SPIN(cond, bar) do { unsigned _sp = 0; while (cond) { __builtin_amdgcn_s_sleep(1); \
    if ((++_sp & 255u) == 0u) { if (xb_ld(&(bar)[XB_TMO])) break; if (_sp > XB_SPIN_CAP) { atomicAdd(&(bar)[XB_TMO], 1u); break; } } } } while (0)

struct XcdBarrier {
    unsigned* bar; unsigned x;
    volatile LAS unsigned* st;
};

__device__ __forceinline__ XcdBarrier xcd_barrier_post(unsigned* bar, volatile LAS unsigned* st) {
    XcdBarrier b; b.bar = bar; b.x = xb_xcc_id(); b.st = st;
    if (threadIdx.x == 0) (void)xb_add(&bar[XB_XCNT(b.x)], 1u);
    return b;
}
__device__ __forceinline__ void xcd_barrier_complete(unsigned* bar, unsigned x, unsigned& nloc, unsigned& nx) {
    const unsigned G = gridDim.x * gridDim.y * gridDim.z;
    unsigned sum, cnt, mine, sp = 0u;
    for (;;) {
        sum = 0u; cnt = 0u; mine = 0u;
#pragma unroll
        for (unsigned j = 0; j < 16; ++j) { const unsigned c = xb_ld(&bar[XB_XCNT(j)]); sum += c; cnt += (c > 0u) ? 1u : 0u; mine = (j == x) ? c : mine; }
        if (sum == G) break;
        __builtin_amdgcn_s_sleep(1);
        if ((++sp & 255u) == 0u) { if (xb_ld(&bar[XB_TMO])) break; if (sp > XB_SPIN_CAP) { atomicAdd(&bar[XB_TMO], 1u); break; } }
    }
    nloc = mine > 0u ? mine : 1u; nx = cnt > 0u ? cnt : 1u;
}

__device__ __forceinline__ void xcd_barrier(const XcdBarrier& b) {
    asm volatile("s_waitcnt vmcnt(0)" ::: "memory");
    __syncthreads();
    if (threadIdx.x == 0) {
        unsigned* bar = b.bar;
        __builtin_amdgcn_s_waitcnt(0);
        unsigned nloc = b.st[0], nx = b.st[1];
        if (nloc == 0u) { xcd_barrier_complete(bar, b.x, nloc, nx); b.st[0] = nloc; b.st[1] = nx; }
        const unsigned old = xb_add(&bar[XB_XSUB(b.x)], 1u);
        const unsigned gen = old / nloc;
        if (old + 1u == (gen + 1u) * nloc) {
            __builtin_amdgcn_fence(__ATOMIC_RELEASE, "agent");
            asm volatile("s_waitcnt vmcnt(0)" ::: "memory");
            const unsigned og = xb_add(&bar[XB_TOP], 1u);
            const unsigned tg = og / nx;
            if (og + 1u == (tg + 1u) * nx) xb_add(&bar[XB_TOPGEN], 1u);
            else XB_SPIN(xb_ld(&bar[XB_TOPGEN]) == tg, bar);
            __builtin_amdgcn_fence(__ATOMIC_ACQUIRE, "agent");
            xb_add(&bar[XB_XGEN(b.x)], 1u);
            asm volatile("s_waitcnt vmcnt(0)" ::: "memory");
        } else {
            XB_SPIN(xb_ld(&bar[XB_XGEN(b.x)]) == gen, bar);
            __builtin_amdgcn_fence(__ATOMIC_ACQUIRE, "agent");
            asm volatile("s_waitcnt vmcnt(0)" ::: "memory");
        }
    }
    __syncthreads();
}
namespace fk {
using pg8::bf16_t; using pg8::f32x4; using pg8::u32x4; using pg8::Unit; using pg8::Gemm;
typedef float f32x16 __attribute__((ext_vector_type(16)));
typedef float f32x2 __attribute__((ext_vector_type(2)));
typedef unsigned u32x2 __attribute__((ext_vector_type(2)));
typedef short s16x4 __attribute__((ext_vector_type(4)));
constexpr int NB = 16, S = 2048, D = 1024, T = NB * S;
constexpr float ALPHA = 1.41421356237309515f, LN_EPS = 1e-5f, LOG2E = 1.4426950408889634f;
constexpr float QS_MLA = 0.10206207261596575f * LOG2E;
constexpr float QS_NSA = 0.125f * LOG2E;
constexpr int NWAVES = 8, NTHR = 512;
constexpr int MOE_ROWS = 73728, MOE_PANELS = MOE_ROWS / 256;

constexpr size_t MiB = 1u << 20;
constexpr size_t WS_CTL = 0, CTL_ZERO_BYTES = 1 * MiB;
constexpr size_t WS_W0IN = 1 * MiB, WS_WUQ = 4 * MiB, WS_WUKV = WS_WUQ + 512 * 1024, WS_W0O = 5 * MiB, WS_W1IN = 7 * MiB, WS_WCK1 = 11 * MiB, WS_WCV1 = 12 * MiB,
                 WS_WCK2 = 13 * MiB, WS_WCV2 = 13 * MiB + 64 * 1024, WS_WSB = 13 * MiB + 128 * 1024, WS_CBIAS = 13 * MiB + 512 * 1024, WS_W1O = 14 * MiB, WS_WGU = 16 * MiB, WS_WD = 80 * MiB;
constexpr size_t WS_Z1 = 113 * MiB;
constexpr size_t WS_STATS = 241 * MiB;
constexpr size_t WS_ROUTE = WS_STATS + 256 * 1024;
constexpr size_t WS_S = 242 * MiB;
constexpr size_t S_XB = WS_S, S_H0B = WS_S + 64 * MiB, S_Q96 = WS_S, S_KN = WS_S + 160 * MiB, S_V = WS_S + 192 * MiB, S_KRB = WS_S + 224 * MiB;
constexpr size_t S_X1B = WS_S, S_XP = WS_S + 64 * MiB, S_HP = WS_S + 208 * MiB, S_YP = WS_S, S_X2B = WS_S + 144 * MiB;
constexpr size_t S_H1B = WS_S, S_KCMP = WS_S + 208 * MiB, S_VCMP = S_KCMP + 1 * MiB;
constexpr size_t WS_END = WS_S + 244 * MiB;
constexpr size_t WS_EXPL = 488 * MiB;
constexpr size_t WS_ROPE = 492 * MiB;
constexpr size_t WS_RINV = 496 * MiB;
static_assert(WS_END <= 512 * MiB, "workspace map");
constexpr int CW_BAR = 4096, CW_CNT = 16384  , CW_ROWSRC = 32768  ;
static_assert((CW_ROWSRC + 2 * 73728) * 4 <= (int)CTL_ZERO_BYTES, "control words inside the per-call memset");

constexpr int RING_OFF = 0, LDS_MISC = 139264, LDS_SCR = LDS_MISC + 256, LDS_BYTES = 163840;

struct Args { const void* in[32]; float* out; unsigned char* ws; int ph_lo, ph_hi; };

__device__ __forceinline__ float bf2f(unsigned short b) { return __uint_as_float((unsigned)b << 16); }
__device__ __forceinline__ unsigned pk(float lo, float hi) { return pg8::cvt_pk_bf16(lo, hi); }
template <int CTRL> __device__ __forceinline__ float dppf(float v) { return __builtin_bit_cast(float, __builtin_amdgcn_update_dpp(0, __builtin_bit_cast(int, v), CTRL, 0xf, 0xf, true)); }
__device__ __forceinline__ float wsum(float v) {
    v += dppf<0xB1>(v); v += dppf<0x4E>(v); v += dppf<0x141>(v); v += dppf<0x140>(v);
    const int b = __builtin_bit_cast(int, v);
    return (__builtin_bit_cast(float, __builtin_amdgcn_readlane(b, 0)) + __builtin_bit_cast(float, __builtin_amdgcn_readlane(b, 16))) + (__builtin_bit_cast(float, __builtin_amdgcn_readlane(b, 32)) + __builtin_bit_cast(float, __builtin_amdgcn_readlane(b, 48)));
}
__device__ __forceinline__ int launder(int x) { asm volatile("" : "+v"(x)); return x; }
__device__ __forceinline__ float ex2(float x) { return __builtin_amdgcn_exp2f(x); }
__device__ __forceinline__ float gelu_t(float x) {
    const float u = 0.7978845608028654f * (x + 0.044715f * x * x * x);
    return x * __builtin_amdgcn_rcpf(1.f + ex2(-2.f * LOG2E * u));
}
__device__ __forceinline__ int crow(int r, int hi) { return (r & 3) + 8 * (r >> 2) + 4 * hi; }
__device__ __forceinline__ f32x16 mfma32(bf16x8 a, bf16x8 b, f32x16 c) { return __builtin_amdgcn_mfma_f32_32x32x16_bf16(a, b, c, 0, 0, 0); }
__device__ __forceinline__ bf16x8 ld8g(const bf16_t* p) { return *(const bf16x8*)p; }
typedef short v4i16_t __attribute__((ext_vector_type(4)));
__device__ __forceinline__ s16x4 trld(const LAS unsigned char* p) { return __builtin_bit_cast(s16x4, __builtin_amdgcn_ds_read_tr16_b64_v4i16((LAS v4i16_t*)p)); }

struct Frame {
    LAS unsigned char* lds; gu32* ctl; unsigned char* ws;
    int tid, lane, wave, vcu, G;
    const void* const* in; float* out;
};

struct EpiTile {
    static constexpr bool PERM = true, AFTER_DRAIN = false;
    bf16_t* O; int ldc; int ngelu; int nscale; float scale; int pad;
    __device__ __forceinline__ void operator()(const f32x4 (&acc)[2][2][4][2], const Unit& u, int wr, int wc, int fr, int fq) const {
        const int row0 = u.pm * 256 + wr * 64 + fr, col0 = u.pn * 256 + wc * 32 + 8 * fq;
        const bool dg = u.pn < ngelu; const float sc = (u.pn < nscale) ? scale : 1.f;
#pragma unroll
        for (int ai = 0; ai < 2; ++ai)
#pragma unroll
            for (int m = 0; m < 4; ++m) { bf16_t* rowp = O + (size_t)(row0 + ai * 128 + m * 16) * ldc + col0;
#pragma unroll
                for (int bj = 0; bj < 2; ++bj) { f32x4 v0 = acc[ai][bj][m][0], v1 = acc[ai][bj][m][1];
                    if (dg) { v0 = (f32x4){gelu_t(v0[0]), gelu_t(v0[1]), gelu_t(v0[2]), gelu_t(v0[3])}; v1 = (f32x4){gelu_t(v1[0]), gelu_t(v1[1]), gelu_t(v1[2]), gelu_t(v1[3])}; }
                    v0 = v0 * sc; v1 = v1 * sc;
                    u32x4 w; w.x = pk(v0[0], v0[1]); w.y = pk(v0[2], v0[3]); w.z = pk(v1[0], v1[1]); w.w = pk(v1[2], v1[3]);
                    *(u32x4*)(rowp + bj * 128) = w; } }
    }
};
struct EpiResid {
    static constexpr bool PERM = false, AFTER_DRAIN = false;
    const float* X; float* Z;
    __device__ __forceinline__ void operator()(const f32x4 (&acc)[2][2][4][2], const Unit& u, int wr, int wc, int fr, int fq) const {
        const int col0 = u.pn * 256 + wc * 32 + 4 * fq;
#pragma unroll
        for (int ai = 0; ai < 2; ++ai)
#pragma unroll
            for (int mp = 0; mp < 2; ++mp) { f32x4 x[2][2][2];
#pragma unroll
                for (int m2 = 0; m2 < 2; ++m2) { const size_t off = (size_t)(u.pm * 256 + ai * 128 + wr * 64 + (2 * mp + m2) * 16 + fr) * D + col0;
#pragma unroll
                    for (int bj = 0; bj < 2; ++bj)
#pragma unroll
                        for (int n = 0; n < 2; ++n) x[m2][bj][n] = *(const f32x4*)(X + off + bj * 128 + n * 16); }
#pragma unroll
                for (int m2 = 0; m2 < 2; ++m2) { const size_t off = (size_t)(u.pm * 256 + ai * 128 + wr * 64 + (2 * mp + m2) * 16 + fr) * D + col0;
#pragma unroll
                    for (int bj = 0; bj < 2; ++bj)
#pragma unroll
                        for (int n = 0; n < 2; ++n) *(f32x4*)(Z + off + bj * 128 + n * 16) = x[m2][bj][n] * ALPHA + acc[ai][bj][2 * mp + m2][n]; } }
    }
};
struct EpiQ {
    static constexpr bool PERM = false, AFTER_DRAIN = false;
    unsigned char* ws;
    __device__ __forceinline__ void operator()(const f32x4 (&acc)[2][2][4][2], const Unit& u, int wr, int wc, int fr, int fq) const {
        bf16_t* Q = (bf16_t*)(ws + S_Q96); const float* rinv = (const float*)(ws + WS_RINV); const float* rope = (const float*)(ws + WS_ROPE);
#pragma unroll
        for (int ai = 0; ai < 2; ++ai)
#pragma unroll
            for (int m = 0; m < 4; ++m) { const int row = u.pm * 256 + ai * 128 + wr * 64 + m * 16 + fr; const float sc = rinv[row * 2];
#pragma unroll
                for (int bj = 0; bj < 2; ++bj) { const int blk = u.pn * 8 + bj * 4 + wc; f32x4 x1 = acc[ai][bj][m][0] * sc, x2 = acc[ai][bj][m][1] * sc;
                    if (blk % 3 == 2) { const f32x4 c = *(const f32x4*)(rope + (size_t)row * 32 + 4 * fq), sn = *(const f32x4*)(rope + (size_t)row * 32 + 16 + 4 * fq);
                        const f32x4 y1 = x1 * c - x2 * sn, y2 = x1 * sn + x2 * c; x1 = y1; x2 = y2; }
                    bf16_t* o = Q + (size_t)row * 768 + blk * 32 + 4 * fq;
                    u32x2 w; w.x = pk(x1[0], x1[1]); w.y = pk(x1[2], x1[3]); *(u32x2*)o = w; w.x = pk(x2[0], x2[1]); w.y = pk(x2[2], x2[3]); *(u32x2*)(o + 16) = w; }
                asm volatile("" ::: "memory"); }
    }
};
struct EpiKV {
    static constexpr bool PERM = true, AFTER_DRAIN = false;
    unsigned char* ws;
    __device__ __forceinline__ void operator()(const f32x4 (&acc)[2][2][4][2], const Unit& u, int wr, int wc, int fr, int fq) const {
        const float* rinv = (const float*)(ws + WS_RINV);
        bf16_t* O = (bf16_t*)(ws + ((u.pn < 2) ? S_KN : S_V)); const int col0 = (u.pn & 1) * 256 + wc * 32 + 8 * fq;
#pragma unroll
        for (int ai = 0; ai < 2; ++ai)
#pragma unroll
            for (int m = 0; m < 4; ++m) { const int row = u.pm * 256 + ai * 128 + wr * 64 + m * 16 + fr; const float sc = rinv[row * 2 + 1];
#pragma unroll
                for (int bj = 0; bj < 2; ++bj) { const f32x4 v0 = acc[ai][bj][m][0] * sc, v1 = acc[ai][bj][m][1] * sc;
                    u32x4 w; w.x = pk(v0[0], v0[1]); w.y = pk(v0[2], v0[3]); w.z = pk(v1[0], v1[1]); w.w = pk(v1[2], v1[3]);
                    *(u32x4*)(O + (size_t)row * 512 + col0 + bj * 128) = w; }
                asm volatile("" ::: "memory"); }
    }
};
struct EpiMoeUp {
    static constexpr bool PERM = true, AFTER_DRAIN = false;
    bf16_t* H;
    __device__ __forceinline__ void operator()(const f32x4 (&acc)[2][2][4][2], const Unit& u, int wr, int wc, int fr, int fq) const {
        const int row0 = u.pm * 256 + wr * 64 + fr, col0 = (u.pn & 1) * 128 + wc * 16 + 4 * fq;
#pragma unroll
        for (int ai = 0; ai < 2; ++ai)
#pragma unroll
            for (int m = 0; m < 4; ++m) { bf16_t* rowp = H + (size_t)(row0 + ai * 128 + m * 16) * 256 + col0;
#pragma unroll
                for (int bj = 0; bj < 2; ++bj) { const f32x4 g = acc[ai][bj][m][0], up = acc[ai][bj][m][1]; f32x4 h;
#pragma unroll
                    for (int e = 0; e < 4; ++e) h[e] = g[e] * __builtin_amdgcn_rcpf(1.f + ex2(-LOG2E * g[e])) * up[e];
                    u32x2 w; w.x = pk(h[0], h[1]); w.y = pk(h[2], h[3]); *(u32x2*)(rowp + bj * 64) = w; } }
    }
};
struct EpiMoeDown {
    static constexpr bool PERM = true, AFTER_DRAIN = false;
    bf16_t* Y;
    __device__ __forceinline__ void operator()(const f32x4 (&acc)[2][2][4][2], const Unit& u, int wr, int wc, int fr, int fq) const {
        const int row0 = u.pm * 256 + wr * 64 + fr, col0 = (u.pn & 3) * 256 + wc * 32 + 8 * fq;
#pragma unroll
        for (int ai = 0; ai < 2; ++ai)
#pragma unroll
            for (int m = 0; m < 4; ++m) { bf16_t* rowp = Y + (size_t)(row0 + ai * 128 + m * 16) * D + col0;
#pragma unroll
                for (int bj = 0; bj < 2; ++bj) { const f32x4 v0 = acc[ai][bj][m][0], v1 = acc[ai][bj][m][1];
                    u32x4 w; w.x = pk(v0[0], v0[1]); w.y = pk(v0[2], v0[3]); w.z = pk(v1[0], v1[1]); w.w = pk(v1[2], v1[3]);
                    *(u32x4*)(rowp + bj * 128) = w; } }
    }
};
template <int NC> struct MoeOrder {
    const LAS int* pe; int nunits, G, c;
    const LAS int* ebase; const int* expl;
    __device__ __forceinline__ int arow(const Unit& u, int r) const { const int e = u.pn / NC; return expl[(size_t)e * T + (u.pm * 256 + r - ebase[e])] & (T - 1); }
    __device__ __forceinline__ bool next(int i, Unit& u) const { const int L = i * G + c; if (L >= nunits) return false; const int p = L / NC; u.pm = p; u.pn = pe[p] * NC + (L % NC); return true; }
    __device__ __forceinline__ void a_ready(const Unit&) const {}
    __device__ __forceinline__ void done(const Unit&) const {}
};

__device__ __forceinline__ void p0_load(float (&wv)[32], const float* W, int ldw, int N, int item, int lane) {
    const int nblk = (N + 31) / 32, kb = item / nblk, nb = item % nblk, k0 = 64 * kb, n0 = 32 * nb, nn = n0 + (lane & 31);
#pragma unroll
    for (int i = 0; i < 32; ++i) { const int kk = 2 * i + (lane >> 5); wv[i] = (nn < N) ? W[(size_t)(k0 + kk) * ldw + nn] : 0.f; }
}
__device__ __forceinline__ void p0_finish(const float (&wv)[32], int K, int N, bf16_t* WT, int rmode, int row_off, const float* kscale, LAS float* scr, int item, int lane) {
    const int nblk = (N + 31) / 32, kb = item / nblk, nb = item % nblk, k0 = 64 * kb, n0 = 32 * nb;
#pragma unroll
    for (int i = 0; i < 32; ++i) { const int kk = 2 * i + (lane >> 5); float v = wv[i]; if (kscale) v *= kscale[k0 + kk]; scr[kk * 33 + (lane & 31)] = v; }
    LDS_WAIT(); asm volatile("" ::: "memory");
    const int c = lane & 7;
#pragma unroll
    for (int j = 0; j < 4; ++j) { const int n = (lane >> 3) + 8 * j; const LAS float* s = scr + (8 * c) * 33 + n;
        v4u o; o.x = pk(s[0 * 33], s[1 * 33]); o.y = pk(s[2 * 33], s[3 * 33]); o.z = pk(s[4 * 33], s[5 * 33]); o.w = pk(s[6 * 33], s[7 * 33]);
        const int ng = n0 + n; const int r = (rmode == 0) ? row_off + ng : (row_off + (ng >> 2) * 8 + (rmode == 2 ? 4 : 0) + (ng & 3));
        *(GAS v4u*)(WT + (size_t)r * K + k0 + 8 * c) = o; }
    LDS_WAIT(); asm volatile("" ::: "memory");
}
__device__ __forceinline__ void p0_item(const float* W, int ldw, int K, int N, bf16_t* WT, int rmode, int row_off, const float* kscale, LAS float* scr, int item, int lane) {
    float wv[32]; p0_load(wv, W, ldw, N, item, lane); p0_finish(wv, K, N, WT, rmode, row_off, kscale, scr, item, lane);
}
__device__ __forceinline__ void p0_item_k(const float* W, int ldw, int K, int KP, int N, bf16_t* WT, int rmode, int row_off, const float* kscale, LAS float* scr, int item, int lane) {
    (void)K; float wv[32]; p0_load(wv, W, ldw, N, item, lane); p0_finish(wv, KP, N, WT, rmode, row_off, kscale, scr, item, lane);
}
struct ConvJob { const float* W; int ldw, K, N; bf16_t* WT; int rmode, row_off; const float* kscale; int nitems; };

__device__ __forceinline__ void p0_prologue(Frame& F) {
    LAS float* scr = (LAS float*)(F.lds + RING_OFF + F.wave * 16384);
    const int gw = F.vcu * NWAVES + F.wave, NGW = F.G * NWAVES;
    unsigned char* ws = F.ws;
    {
        const float* in2 = (const float*)F.in[2];
#define JOB2(Wp, ldw_, K_, N_, dst, rm, ro, ks) { const int nit = ((K_) / 64) * (((N_) + 31) / 32); if (it < nit) { p0_item_k((const float*)(Wp), ldw_, K_, 256, N_, (bf16_t*)(dst), rm, ro, ks, scr, it, F.lane); continue; } it -= nit; }
#define JOB(Wp, ldw_, K_, N_, dst, rm, ro, ks) { const int nit = ((K_) / 64) * (((N_) + 31) / 32); if (it < nit) { p0_item((const float*)(Wp), ldw_, K_, N_, (bf16_t*)(dst), rm, ro, ks, scr, it, F.lane); continue; } it -= nit; }
        constexpr int TOT = 16 * 45 + 4 * 24 + 2 * 16 + 2 * 16 + 16 * 32 + 16 * 58 + 32 * 8 * 2 + 4 * 2 * 2 + 16 * 32;
        for (int it0 = gw; it0 < TOT; it0 += NGW) { int it = it0;
            JOB(in2, 1440, 1024, 1440, ws + WS_W0IN, 0, 0, nullptr)
            JOB(F.in[9], 768, 256, 768, ws + WS_WUQ, 0, 0, (const float*)F.in[7])
            JOB2(F.in[10], 512, 128, 512, ws + WS_WUKV, 0, 0, (const float*)F.in[8])
            JOB2(F.in[11], 512, 128, 512, ws + WS_WUKV, 0, 512, (const float*)F.in[8])
            JOB(F.in[12], 1024, 1024, 1024, ws + WS_W0O, 0, 0, nullptr)
            JOB(F.in[13], 1840, 1024, 1840, ws + WS_W1IN, 0, 0, nullptr)
            JOB(F.in[15], 256, 2048, 256, ws + WS_WCK1, 0, 0, nullptr)
            JOB(F.in[17], 256, 2048, 256, ws + WS_WCV1, 0, 0, nullptr)
            JOB(F.in[16], 64, 256, 64, ws + WS_WCK2, 0, 0, nullptr)
            JOB(F.in[18], 64, 256, 64, ws + WS_WCV2, 0, 0, nullptr)
            JOB(F.in[20], 1024, 1024, 1024, ws + WS_W1O, 0, 0, nullptr)
        }
#undef JOB
#undef JOB2
    }
    {
        constexpr int IG = 16 * 8, ID = 4 * 32, PER = 2 * IG + ID;
        for (int it0 = gw; it0 < 64 * PER; it0 += NGW) { const int le = it0 / PER; int it = it0 % PER;
            bf16_t* gu = (bf16_t*)(ws + WS_WGU) + (size_t)le * 512 * 1024; bf16_t* wd = (bf16_t*)(ws + WS_WD) + (size_t)le * 1024 * 256;
            if (it < IG) { p0_item((const float*)F.in[25] + (size_t)le * 1024 * 256, 256, 1024, 256, gu, 1, 0, nullptr, scr, it, F.lane); continue; } it -= IG;
            if (it < IG) { p0_item((const float*)F.in[26] + (size_t)le * 1024 * 256, 256, 1024, 256, gu, 2, 0, nullptr, scr, it, F.lane); continue; } it -= IG;
            p0_item((const float*)F.in[27] + (size_t)le * 256 * 1024, 1024, 256, 1024, wd, 0, 0, nullptr, scr, it, F.lane);
        }
    }
    const int gt = F.vcu * NTHR + F.tid, NGT = F.G * NTHR;
    { v4u z = {0u, 0u, 0u, 0u};
      for (int i = gt; i < 96 * 128; i += NGT) *(GAS v4u*)((bf16_t*)(ws + WS_W0IN) + (size_t)1440 * 1024 + (size_t)i * 8) = z;
      for (int i = gt; i < 192 * 128; i += NGT) *(GAS v4u*)((bf16_t*)(ws + WS_W1IN) + (size_t)1856 * 1024 + (size_t)i * 8) = z; }
    { float* rope = (float*)(ws + WS_ROPE); const int* pos = (const int*)F.in[1];
      for (int i = gt; i < T * 16; i += NGT) { const int tok = i >> 4, j = i & 15; const float ang = (float)pos[tok] * expf(-9.210340371976184f * (float)j * (1.f / 16.f)); rope[tok * 32 + j] = cosf(ang); rope[tok * 32 + 16 + j] = sinf(ang); }
      v4u z = {0u, 0u, 0u, 0u};
      for (int i = gt; i < 1024 * 16; i += NGT) *(GAS v4u*)((bf16_t*)(ws + WS_WUKV) + (size_t)(i >> 4) * 256 + 128 + (i & 15) * 8) = z; }
    { const float* gws = (const float*)F.in[5]; bf16_t* wsb = (bf16_t*)(ws + WS_WSB);
      for (int i = gt; i < 4 * 128 * 128; i += NGT) { const int s = i & 127, t = (i >> 7) & 127; wsb[i] = (bf16_t)(pk(s <= t ? gws[i] : 0.f, 0.f) & 0xffffu); } }
    {
      float* cb = (float*)(ws + WS_CBIAS);
      for (int o = gw; o < 512; o += NGW) { const int kv = o >> 8, h = o & 255; const float* pos = (const float*)F.in[14] + kv * 2048; const float* w1 = (const float*)F.in[kv ? 17 : 15];
          float a = 0.f; for (int k = F.lane; k < 2048; k += 64) a += pos[k] * w1[(size_t)k * 256 + h];
          a = wsum(a); if (F.lane == 0) cb[o] = a; } }
    { const float* x = (const float*)F.in[0]; bf16_t* xb = (bf16_t*)(ws + S_XB);
#pragma unroll 4
      for (int i = gt; i < T * D / 8; i += NGT) { const f32x4 a = *(const GAS f32x4*)(x + (size_t)i * 8), b = *(const GAS f32x4*)(x + (size_t)i * 8 + 4);
          v4u o; o.x = pk(a[0], a[1]); o.y = pk(a[2], a[3]); o.z = pk(b[0], b[1]); o.w = pk(b[2], b[3]); *(GAS v4u*)(xb + (size_t)i * 8) = o; } }
}

__device__ __forceinline__ void wt_load(u32x4 (&v)[4], const unsigned char* base, unsigned pitch, int lane) {
#pragma unroll
    for (int i = 0; i < 4; ++i) v[i] = *(const u32x4*)(base + (size_t)(8 * i + (lane >> 3)) * pitch + (lane & 7) * 16);
}
__device__ __forceinline__ void wt_store(LAS unsigned char* t, const u32x4 (&v)[4], int lane) {
#pragma unroll
    for (int i = 0; i < 4; ++i) { const int row = 8 * i + (lane >> 3); *(LAS u32x4*)(t + row * 128 + (((lane & 7) ^ ((row >> 1) & 7)) << 4)) = v[i]; }
}
__device__ __forceinline__ bf16x8 wt_frag(const LAS unsigned char* t, int ks, int lane) { const int r32 = lane & 31; return *(const LAS bf16x8*)(t + r32 * 128 + (((2 * ks + (lane >> 5)) ^ ((r32 >> 1) & 7)) << 4)); }

__device__ __forceinline__ void store4(bf16_t* p, float a, float b, float c, float d) { u32x2 w; w.x = pk(a, b); w.y = pk(c, d); *(u32x2*)p = w; }
__device__ __forceinline__ void mla_prep_rows(Frame& F) {
    const int lane = F.lane; const bf16_t* H0B = (const bf16_t*)(F.ws + S_H0B);
    float* rinv = (float*)(F.ws + WS_RINV); const float* rope = (const float*)(F.ws + WS_ROPE); bf16_t* KRB = (bf16_t*)(F.ws + S_KRB);
    const int gw = F.vcu * NWAVES + F.wave, NGW = F.G * NWAVES;
    for (int t0 = gw * 4; t0 < T; t0 += NGW * 4) {
        s16x4 cq[4]; unsigned ck[4]; float x1[4], x2[4], cc[4], ss[4];
#pragma unroll
        for (int u = 0; u < 4; ++u) { const bf16_t* h = H0B + (size_t)(t0 + u) * 1536; cq[u] = *(const s16x4*)(h + 1024 + lane * 4); ck[u] = *(const unsigned*)(h + 1280 + lane * 2);
            x1[u] = bf2f(h[1408 + (lane & 15)]); x2[u] = bf2f(h[1408 + 16 + (lane & 15)]); cc[u] = rope[(size_t)(t0 + u) * 32 + (lane & 15)]; ss[u] = rope[(size_t)(t0 + u) * 32 + 16 + (lane & 15)]; }
#pragma unroll
        for (int u = 0; u < 4; ++u) { float q = 0.f;
#pragma unroll
            for (int e = 0; e < 4; ++e) { const float v = bf2f((unsigned short)cq[u][e]); q += v * v; }
            const float a = __uint_as_float(ck[u] << 16), b = __uint_as_float(ck[u] & 0xffff0000u); const float k = a * a + b * b;
            const float sq = wsum(q), sk = wsum(k);
            if (lane == 0) { rinv[(size_t)(t0 + u) * 2] = rsqrtf(sq * (1.f / 256.f) + LN_EPS) * QS_MLA; rinv[(size_t)(t0 + u) * 2 + 1] = rsqrtf(sk * (1.f / 128.f) + LN_EPS); }
            if (lane < 16) { KRB[(size_t)(t0 + u) * 32 + lane] = (bf16_t)(pk(x1[u] * cc[u] - x2[u] * ss[u], 0.f) & 0xffffu); KRB[(size_t)(t0 + u) * 32 + 16 + lane] = (bf16_t)(pk(x1[u] * ss[u] + x2[u] * cc[u], 0.f) & 0xffffu); } }
    }
}

constexpr int VN_STR = 1088;
__device__ __forceinline__ void gmlp_chunk(Frame& F, int chunk, bool dry = false) {
    const int lane = F.lane, wave = F.wave, r32 = lane & 31, hi = lane >> 5;
    bf16_t* H0B = (bf16_t*)(F.ws + S_H0B);
    const float* lng = (const float*)F.in[3]; const float* lnb = (const float*)F.in[4];
    LAS unsigned char* img = F.lds + RING_OFF;
    float g8[8], b8[8];
#pragma unroll
    for (int e = 0; e < 8; ++e) { g8[e] = lng[lane * 8 + e]; b8[e] = lnb[lane * 8 + e]; }
#pragma unroll 4
    for (int i = 0; i < 16; ++i) { const int row = wave * 16 + i; const bf16x8 x = ld8g(H0B + (size_t)(chunk * 128 + row) * 1536 + 512 + lane * 8);
        float v[8]; float s = 0.f;
#pragma unroll
        for (int e = 0; e < 8; ++e) { v[e] = bf2f((unsigned short)x[e]); s += v[e]; }
        const float mean = wsum(s) * (1.f / 512.f); float q = 0.f;
#pragma unroll
        for (int e = 0; e < 8; ++e) { v[e] -= mean; q += v[e] * v[e]; }
        const float rstd = rsqrtf(wsum(q) * (1.f / 512.f) + LN_EPS);
#pragma unroll
        for (int e = 0; e < 8; ++e) v[e] = v[e] * rstd * g8[e] + b8[e];
        u32x4 w; w.x = pk(v[0], v[1]); w.y = pk(v[2], v[3]); w.z = pk(v[4], v[5]); w.w = pk(v[6], v[7]);
        *(LAS u32x4*)(img + row * VN_STR + lane * 16) = w; }
    __syncthreads();
    const int g = wave >> 1, th = wave & 1;
    const bf16_t* wsb = (const bf16_t*)(F.ws + WS_WSB) + (size_t)g * 128 * 128;
    const float* bs = (const float*)F.in[6] + g * 128;
    const int i15 = lane & 15, g1 = (lane >> 4) & 1;
#pragma unroll 1
    for (int nt = 0; nt < 2; ++nt) {
        const int t = th * 64 + nt * 32 + r32;
        const int nks = (th * 64 + nt * 32 + 31) / 16 + 1;
        bf16x8 bw[8];
#pragma unroll
        for (int ks = 0; ks < 8; ++ks) bw[ks] = ld8g(wsb + (size_t)t * 128 + ks * 16 + hi * 8);
        const float bias = bs[t];
#pragma unroll 1
        for (int ct = 0; ct < 4; ++ct) {
            const LAS unsigned char* abase = img + (8 * hi + (i15 >> 2)) * VN_STR + (g * 128 + ct * 32 + 16 * g1 + 4 * (i15 & 3)) * 2;
            f32x16 acc = {};
#pragma unroll
            for (int ks = 0; ks < 8; ++ks) { if (ks < nks) {
                const s16x4 lo = trld(abase + (16 * ks) * VN_STR), hi4 = trld(abase + (16 * ks + 4) * VN_STR);
                const bf16x8 a = {lo[0], lo[1], lo[2], lo[3], hi4[0], hi4[1], hi4[2], hi4[3]};
                acc = mfma32(a, bw[ks], acc); } }
            bf16_t* urow = H0B + (size_t)(chunk * 128 + t) * 1536 + g * 128 + ct * 32 + 4 * hi;
            bf16_t* orow = dry ? ((bf16_t*)(F.ws + WS_Z1) + (urow - H0B)) : urow;
#pragma unroll
            for (int g4 = 0; g4 < 4; ++g4) { const s16x4 uu = *(const s16x4*)(urow + 8 * g4);
                store4(orow + 8 * g4, bf2f((unsigned short)uu[0]) * (acc[4 * g4] + bias), bf2f((unsigned short)uu[1]) * (acc[4 * g4 + 1] + bias),
                       bf2f((unsigned short)uu[2]) * (acc[4 * g4 + 2] + bias), bf2f((unsigned short)uu[3]) * (acc[4 * g4 + 3] + bias)); }
        }
    }
    __syncthreads();
}

constexpr float NEGF = -1e30f;
__device__ __forceinline__ void pack_p(u32x4 (&pw)[4], const f32x16& p0, const f32x16& p1) {
    pw[0] = (u32x4){pk(p0[0], p0[1]), pk(p0[2], p0[3]), pk(p0[4], p0[5]), pk(p0[6], p0[7])}; pw[1] = (u32x4){pk(p0[8], p0[9]), pk(p0[10], p0[11]), pk(p0[12], p0[13]), pk(p0[14], p0[15])};
    pw[2] = (u32x4){pk(p1[0], p1[1]), pk(p1[2], p1[3]), pk(p1[4], p1[5]), pk(p1[6], p1[7])}; pw[3] = (u32x4){pk(p1[8], p1[9]), pk(p1[10], p1[11]), pk(p1[12], p1[13]), pk(p1[14], p1[15])};
}
struct AttnSt { f32x16 o[2]; f32x16 negm; float mref, l; int started; };
__device__ __forceinline__ void attn_reset(AttnSt& st) { st.o[0] = f32x16{}; st.o[1] = f32x16{}; st.negm = f32x16{}; st.mref = 0.f; st.l = 0.f; st.started = 0; }
constexpr int KV_ROPE = 8192;
template <bool ROPE> struct KvL { static constexpr int V = ROPE ? 12288 : 8192, SUB = ROPE ? 20480 : 16384, BUF = 2 * SUB; };
template <int NKS>
__device__ __forceinline__ void qk_tile(f32x16& p0, f32x16& p1, const LAS unsigned char* Kt, const bf16x8* qf, const f32x16& cinit, int lane) {
    const int r32 = lane & 31, hi = lane >> 5, sw = (r32 >> 1) & 7;
    const LAS unsigned char* kp = Kt + r32 * 128;
#pragma unroll
    for (int ks = 0; ks < NKS; ++ks) {
        bf16x8 a0, a1;
        if (ks < 4) { const int off = ((2 * ks + hi) ^ sw) << 4; a0 = *(const LAS bf16x8*)(kp + off); a1 = *(const LAS bf16x8*)(kp + 4096 + off); }
        else { const LAS unsigned char* rp = Kt + KV_ROPE + r32 * 64 + (((2 * (ks - 4) + hi) ^ ((r32 >> 2) & 3)) << 4); a0 = *(const LAS bf16x8*)rp; a1 = *(const LAS bf16x8*)(rp + 2048); }
        if (ks == 0) { p0 = mfma32(a0, qf[0], cinit); p1 = mfma32(a1, qf[0], cinit); } else { p0 = mfma32(a0, qf[ks], p0); p1 = mfma32(a1, qf[ks], p1); } }
}
__device__ __forceinline__ float max3(float a, float b, float c) { return fmaxf(fmaxf(a, b), c); }
constexpr float ATT_THR = 8.f;
template <class Mask>
__device__ __forceinline__ void softmax2(f32x16& p0, f32x16& p1, AttnSt& st, bool need_mask, const Mask& valid, bool lanebit, int lane, u32x4 (&pw)[4]) {
    const int hi = lane >> 5;
    if (need_mask) {
#pragma unroll
        for (int r = 0; r < 16; ++r) { const int k0 = crow(r, hi); if (!valid(k0)) p0[r] = NEGF; if (!valid(k0 + 32)) p1[r] = NEGF; } }
    float ma = max3(p0[0], p0[1], p1[0]), mb = max3(p0[2], p0[3], p1[1]); ma = max3(ma, p1[2], p1[3]);
#pragma unroll
    for (int r = 4; r < 16; r += 4) { ma = max3(ma, p0[r], p0[r + 1]); mb = max3(mb, p0[r + 2], p0[r + 3]); ma = max3(ma, p1[r], p1[r + 1]); mb = max3(mb, p1[r + 2], p1[r + 3]); }
    float mx = fmaxf(ma, mb); mx = fmaxf(mx, __shfl_xor(mx, 32));
    if (!lanebit) mx = NEGF;
    const bool has = mx > -1e29f, fresh = has && !st.started;
    if (__any((mx > ATT_THR) || fresh)) {
        const float dl = has ? (fresh ? mx : fmaxf(mx, 0.f)) : 0.f;
        st.mref += dl; const float f = ex2(-dl); st.l *= f;
#pragma unroll
        for (int r = 0; r < 16; ++r) { p0[r] -= dl; p1[r] -= dl; st.o[0][r] *= f; st.o[1][r] *= f; st.negm[r] = -st.mref; }
        st.started |= has ? 1 : 0;
    }
    float sa = 0.f, sb = 0.f;
#pragma unroll
    for (int r = 0; r < 16; ++r) { p0[r] = ex2(p0[r]); p1[r] = ex2(p1[r]); sa += p0[r]; sb += p1[r]; }
    pack_p(pw, p0, p1);
    float sum = sa + sb;
    if (!lanebit) { sum = 0.f;
#pragma unroll
        for (int i = 0; i < 4; ++i) pw[i] = (u32x4){0u, 0u, 0u, 0u}; }
    st.l += sum;
}
__device__ __forceinline__ void pv_packed(f32x16 (&o)[2], const LAS unsigned char* Vt, const u32x4 (&pw)[4], int lane) {
    const int i15 = lane & 15, g1 = (lane >> 4) & 1, hi = lane >> 5, bsw = (i15 >> 3) & 1;
    const LAS unsigned char* vrow = Vt + (4 * hi + (i15 >> 2)) * 128 + (2 * g1 + ((i15 & 3) >> 1)) * 16 + (i15 & 1) * 8;
    const LAS unsigned char* vb0 = vrow + 64 * bsw; const LAS unsigned char* vb1 = vrow + 64 * (bsw ^ 1);
#pragma unroll
    for (int db = 0; db < 2; ++db)
#pragma unroll
        for (int s = 0; s < 4; ++s) { const LAS unsigned char* vb = db ? vb1 : vb0; const s16x4 lo = trld(vb + s * 2048), h4 = trld(vb + s * 2048 + 1024);
            const bf16x8 a = {lo[0], lo[1], lo[2], lo[3], h4[0], h4[1], h4[2], h4[3]};
            o[db] = mfma32(a, __builtin_bit_cast(bf16x8, pw[s]), o[db]); }
}
#define LDS_BAR() asm volatile("s_waitcnt lgkmcnt(0)\n\ts_barrier" ::: "memory")
__device__ __forceinline__ void glds16(const void* gsrc, unsigned lds_dst) { unsigned keep;
    asm volatile("s_mov_b32 %0, m0\n\ts_mov_b32 m0, %2\n\ts_nop 0\n\tglobal_load_lds_dwordx4 %1, off\n\ts_mov_b32 m0, %0" : "=&s"(keep) : "v"(gsrc), "s"(lds_dst) : "memory"); }
template <bool ROPE, class Src>
__device__ __forceinline__ void dma_tile(const Src& src, int j, LAS unsigned char* buf, int wave, unsigned koff, unsigned voff, unsigned roff) {
    const unsigned b = (unsigned)(size_t)buf;
    glds16(src.kbase(j) + koff, (unsigned)__builtin_amdgcn_readfirstlane(b + wave * 1024));
    glds16(src.vbase(j) + voff, (unsigned)__builtin_amdgcn_readfirstlane(b + KvL<ROPE>::V + wave * 1024));
    if (ROPE) glds16(src.rbase(j) + roff, (unsigned)__builtin_amdgcn_readfirstlane(b + KV_ROPE + (wave & 3) * 1024));
}
#define VMW(n) asm volatile("s_waitcnt vmcnt(" #n ")" ::: "memory")
struct NoHook { __device__ __forceinline__ void operator()(int) const {} };
template <int NKS, class It, class Src, class Act, class Mask, class Hook = NoHook>
__device__ __forceinline__ void attn_loop(AttnSt& st, const bf16x8* qf, It it, const Src& src, const Act& active, const Mask& mask, LAS unsigned char* kv, int tid_, int lane_, int abl = 0, const Hook& hook = Hook()) {
    const int tid = launder(tid_), lane = tid & 63, wave = __builtin_amdgcn_readfirstlane(tid >> 6); (void)lane_;
    constexpr bool ROPE = (NKS > 4); constexpr int SUB = KvL<ROPE>::SUB, BUF = KvL<ROPE>::BUF, VO = KvL<ROPE>::V;
    int a0 = it.next(); if (a0 < 0) return;
    int b0 = it.next();
    unsigned koff, voff, roff;
    { const int row = wave * 8 + (lane >> 3), c = lane & 7; koff = (unsigned)row * src.kpitch + (unsigned)((c ^ ((row >> 1) & 7)) << 4); voff = (unsigned)row * src.vpitch + (unsigned)((c ^ (((row >> 1) & 1) << 2)) << 4);
      const int rr = (wave & 3) * 16 + (lane >> 2), rc = lane & 3; roff = (unsigned)rr * 64u + (unsigned)((rc ^ ((rr >> 2) & 3)) << 4); }
#define DMAP(A_, B_, BUFP) do { dma_tile<ROPE>(src, (A_), (BUFP), wave, koff, voff, roff); dma_tile<ROPE>(src, ((B_) >= 0) ? (B_) : (A_), (BUFP) + SUB, wave, koff, voff, roff); } while (0)
    int a1 = (b0 >= 0) ? it.next() : -1, b1 = (a1 >= 0) ? it.next() : -1;
    DMAP(a0, b0, kv);
    if (a1 >= 0) DMAP(a1, b1, kv + BUF);
    int bc = 0;
    for (;;) {
        if (a1 >= 0) { if (ROPE) VMW(6); else VMW(4); } else VMW(0);
        if (!(abl & 16)) LDS_BAR();
        int a2 = (b1 >= 0) ? it.next() : -1, b2 = (a2 >= 0) ? it.next() : -1;
        if (a2 >= 0 && !(abl & 8)) DMAP(a2, b2, kv + ((bc + 2) % 3) * BUF);
        else if (a2 >= 0) { }
#pragma unroll
        for (int sub = 0; sub < 2; ++sub) { const int jc = sub ? b0 : a0;
            if (jc >= 0 && active(jc)) { const LAS unsigned char* kb = kv + bc * BUF + sub * SUB;
                hook(jc);
                f32x16 p0, p1; u32x4 pw[4];
                if (!(abl & 1)) qk_tile<NKS>(p0, p1, kb, qf, st.negm, lane); else { p0 = st.negm; p1 = st.negm; }
                if (!(abl & 2)) softmax2(p0, p1, st, mask.need(jc), [&](int key) { return mask.valid(jc, key); }, mask.lanebit(jc), lane, pw); else pack_p(pw, p0, p1);
                if (!(abl & 4)) pv_packed(st.o, kb + VO, pw, lane); else st.o[0][0] += __uint_as_float(pw[0].x ^ pw[1].y ^ pw[2].z ^ pw[3].w); } }
        if (a1 < 0) break;
        a0 = a1; b0 = b1; a1 = a2; b1 = b2; bc = (bc + 1) % 3;
        if (abl & 8) { if (a1 >= 0 && false) {} }
    }
#undef DMAP
    LDS_BAR();
}
struct RangeIt { int j, end; __device__ __forceinline__ int next() { return (j < end) ? j++ : -1; } };
struct BitIt { unsigned m; __device__ __forceinline__ int next() { if (!m) return -1; const int j = __builtin_ctz(m); m &= m - 1; return j; } };

__device__ __forceinline__ void mla_attn_unit(Frame& F, int b, int h, int qb, int abl = 0) {
    const int lane = F.lane, wave = F.wave, r32 = lane & 31, hi = lane >> 5;
    const int q0 = qb * 256 + wave * 32, t = q0 + r32;
    const size_t rb = (size_t)b * S;
    const bf16_t* Q = (const bf16_t*)(F.ws + S_Q96) + (rb + t) * 768 + h * 96;
    const bf16_t* KN = (const bf16_t*)(F.ws + S_KN) + rb * 512 + h * 64; const bf16_t* KR = (const bf16_t*)(F.ws + S_KRB) + rb * 32; const bf16_t* V = (const bf16_t*)(F.ws + S_V) + rb * 512 + h * 64;
    bf16x8 qf[6];
#pragma unroll
    for (int ks = 0; ks < 6; ++ks) qf[ks] = ld8g(Q + ks * 16 + hi * 8);
    asm volatile("" : "+v"(qf[0]), "+v"(qf[1]), "+v"(qf[2]), "+v"(qf[3]), "+v"(qf[4]), "+v"(qf[5]));
    AttnSt st; attn_reset(st);
    struct Src { const unsigned char *KN, *KR, *V; unsigned kpitch, vpitch;
        __device__ __forceinline__ const unsigned char* kbase(int j) const { return KN + (size_t)j * 64 * 1024; }
        __device__ __forceinline__ const unsigned char* vbase(int j) const { return V + (size_t)j * 64 * 1024; }
        __device__ __forceinline__ const unsigned char* rbase(int j) const { return KR + (size_t)j * 64 * 64; } } src{(const unsigned char*)KN, (const unsigned char*)KR, (const unsigned char*)V, 1024u, 1024u};
    const int wlast = (q0 + 31) >> 6;
    struct MaskC { int t, tmin; __device__ __forceinline__ bool need(int j) const { return j * 64 + 63 > tmin; } __device__ __forceinline__ bool valid(int j, int key) const { return j * 64 + key <= t; }
        __device__ __forceinline__ bool lanebit(int) const { return true; } } mk{t, q0};
    if (!(abl & 32)) attn_loop<6>(st, qf, RangeIt{0, qb * 4 + 4}, src, [&](int j) { return j <= wlast; }, mk, F.lds + RING_OFF, F.tid, lane, abl); if (abl & 64) return;
    float l = st.l + __shfl_xor(st.l, 32); const float inv = 1.f / l;
    bf16_t* O = (bf16_t*)(F.ws + S_H0B) + (rb + t) * 1536 + 512 + h * 64 + 4 * hi;
#pragma unroll
    for (int db = 0; db < 2; ++db)
#pragma unroll
        for (int g4 = 0; g4 < 4; ++g4) store4(O + db * 32 + 8 * g4, st.o[db][4 * g4] * inv, st.o[db][4 * g4 + 1] * inv, st.o[db][4 * g4 + 2] * inv, st.o[db][4 * g4 + 3] * inv);
}

constexpr int NSA_IMP_OFF = 3 * KvL<false>::BUF, NSA_SEL_OFF = NSA_IMP_OFF + 8 * 32 * 33 * 4;
__device__ __forceinline__ void ob_add(u32x2 (&ob)[2][4], const f32x16 (&o)[2], float f, bool first) {
#pragma unroll
    for (int db = 0; db < 2; ++db)
#pragma unroll
        for (int g4 = 0; g4 < 4; ++g4) { float a0 = 0.f, a1 = 0.f, a2 = 0.f, a3 = 0.f;
            if (!first) { a0 = __uint_as_float(ob[db][g4].x << 16); a1 = __uint_as_float(ob[db][g4].x & 0xffff0000u); a2 = __uint_as_float(ob[db][g4].y << 16); a3 = __uint_as_float(ob[db][g4].y & 0xffff0000u); }
            ob[db][g4].x = pk(a0 + f * o[db][4 * g4], a1 + f * o[db][4 * g4 + 1]); ob[db][g4].y = pk(a2 + f * o[db][4 * g4 + 2], a3 + f * o[db][4 * g4 + 3]); }
}
__device__ __forceinline__ void nsa_unit(Frame& F, int b, int g, int tblk  , bool dry = false, int abl = 0) {
    const int lane = F.lane, wave = F.wave, tid = F.tid, r32 = lane & 31, hi = lane >> 5;
    const int t0 = tblk * 32, t = t0 + r32, tb = t0 >> 6, h = g * 8 + wave;
    const size_t rb = (size_t)b * S;
    bf16_t* H1B = (bf16_t*)(F.ws + S_H1B);
    bf16_t* qrow = H1B + (rb + t) * 2048;
    LAS unsigned char* kv = F.lds + RING_OFF;
    LAS float* impw = (LAS float*)(F.lds + NSA_IMP_OFF); LAS unsigned* selw = (LAS unsigned*)(F.lds + NSA_SEL_OFF);
    struct Src { const unsigned char *K, *V; unsigned kpitch, vpitch;
        __device__ __forceinline__ const unsigned char* kbase(int j) const { return K + (size_t)j * 64 * kpitch; }
        __device__ __forceinline__ const unsigned char* vbase(int j) const { return V + (size_t)j * 64 * vpitch; }
        __device__ __forceinline__ const unsigned char* rbase(int) const { return K; } };
    const int nk = (t0 >> 4) + 1;
    const int ntile = (nk + 63) >> 6;
    { Src sc{(const unsigned char*)((const bf16_t*)(F.ws + S_KCMP) + (size_t)(b * 2 + g) * 128 * 64), (const unsigned char*)((const bf16_t*)(F.ws + S_VCMP) + (size_t)(b * 2 + g) * 128 * 64), 128u, 128u};
      const int row = wave * 8 + (lane >> 3), c = lane & 7; const unsigned koff = (unsigned)row * 128u + (unsigned)((c ^ ((row >> 1) & 7)) << 4), voff = (unsigned)row * 128u + (unsigned)((c ^ (((row >> 1) & 1) << 2)) << 4);
      dma_tile<false>(sc, 0, kv, wave, koff, voff, 0u); if (ntile > 1) dma_tile<false>(sc, 1, kv + KvL<false>::SUB, wave, koff, voff, 0u); }
    bf16x8 qf[4];
#pragma unroll
    for (int ks = 0; ks < 4; ++ks) qf[ks] = ld8g(qrow + h * 64 + ks * 16 + hi * 8);
    bf16_t* orow = (dry ? ((bf16_t*)(F.ws + WS_Z1) + (qrow - H1B)) : qrow) + h * 64 + 4 * hi;
    const float* gate_b = (const float*)F.in[19];
    float gate[3];
#pragma unroll
    for (int br = 0; br < 3; ++br) { const float x = bf2f(qrow[1792 + br * 16 + h]) + gate_b[br * 16 + h]; gate[br] = __builtin_amdgcn_rcpf(1.f + ex2(-LOG2E * x)); }
    asm volatile("" : "+v"(qf[0]), "+v"(qf[1]), "+v"(qf[2]), "+v"(qf[3]), "+v"(gate[0]), "+v"(gate[1]), "+v"(gate[2]));
    if (tid == 0) selw[32] = 0u;
    u32x2 ob[2][4];
    {
        const int tid = launder(F.tid), lane = tid & 63, r32 = lane & 31, hi = lane >> 5;
        VMW(0); LDS_BAR();
        if (abl & 32) { f32x16 z2[2] = {f32x16{}, f32x16{}}; ob_add(ob, z2, 0.f, true); } else {
        f32x16 p[2][2]; float mx = NEGF;
#pragma unroll
        for (int tl = 0; tl < 2; ++tl) { __builtin_amdgcn_sched_barrier(0); if (tl < ntile) { qk_tile<4>(p[tl][0], p[tl][1], kv + tl * KvL<false>::SUB, qf, f32x16{}, lane);
#pragma unroll
                for (int kb = 0; kb < 2; ++kb)
#pragma unroll
                    for (int r = 0; r < 16; ++r) { const int n = tl * 64 + kb * 32 + crow(r, hi); if (t < 16 * n + 31) p[tl][kb][r] = NEGF; mx = fmaxf(mx, p[tl][kb][r]); } }
            else { p[tl][0] = f32x16{}; p[tl][1] = f32x16{};
#pragma unroll
                for (int r = 0; r < 16; ++r) { p[tl][0][r] = NEGF; p[tl][1][r] = NEGF; } } }
        mx = fmaxf(mx, __shfl_xor(mx, 32));
        const float muse = (mx < -1e29f) ? 0.f : mx; float sum = 0.f;
#pragma unroll
        for (int tl = 0; tl < 2; ++tl)
#pragma unroll
            for (int kb = 0; kb < 2; ++kb)
#pragma unroll
                for (int r = 0; r < 16; ++r) { p[tl][kb][r] = ex2(p[tl][kb][r] - muse); sum += p[tl][kb][r]; }
        sum += __shfl_xor(sum, 32);
        const float inv = (sum > 0.f) ? __builtin_amdgcn_rcpf(sum) : 0.f;
#pragma unroll
        for (int tl = 0; tl < 2; ++tl)
#pragma unroll
            for (int kb = 0; kb < 2; ++kb)
#pragma unroll
                for (int r = 0; r < 16; ++r) p[tl][kb][r] *= inv;
        { float carried = 0.f;
#pragma unroll
        for (int tl = 0; tl < 2; ++tl)
#pragma unroll
            for (int kb = 0; kb < 2; ++kb)
#pragma unroll
                for (int q4 = 0; q4 < 4; ++q4) { const int m = 8 * tl + 4 * kb + q4;
                    const float Gm = (p[tl][kb][4 * q4] + p[tl][kb][4 * q4 + 1]) + (p[tl][kb][4 * q4 + 2] + p[tl][kb][4 * q4 + 3]);
                    const float other = __shfl_xor(p[tl][kb][4 * q4 + 3], 32);
                    const float prev = hi ? other : carried; carried = other;
                    impw[(wave * 32 + r32) * 33 + 2 * m + hi] = Gm + prev; } }
        __builtin_amdgcn_sched_barrier(0);
        { f32x16 oc[2] = {f32x16{}, f32x16{}}; u32x4 pwa[4], pwb[4]; pack_p(pwa, p[0][0], p[0][1]); pack_p(pwb, p[1][0], p[1][1]); __builtin_amdgcn_sched_barrier(0);
          pv_packed(oc, kv + KvL<false>::V, pwa, lane); __builtin_amdgcn_sched_barrier(0);
          if (ntile > 1) pv_packed(oc, kv + KvL<false>::SUB + KvL<false>::V, pwb, lane); __builtin_amdgcn_sched_barrier(0);
          ob_add(ob, oc, gate[0], true); } }
        LDS_BAR();
    }
#pragma unroll 1
    for (int ps = (abl & 64) ? 2 : 0; ps < 2; ++ps) { const int lane = launder(F.tid) & 63, r32 = lane & 31, hi = lane >> 5; const int tokl = 4 * wave + 2 * ps + hi, j = r32; float a = 0.f;
#pragma unroll
        for (int w = 0; w < 8; ++w) a += impw[(w * 32 + tokl) * 33 + j];
        const bool forced = (j == 0) || (j == tb) || (j == tb - 1); const float sc = forced ? 1e4f : (j <= tb ? a : -1e4f);
        const int scb = __builtin_bit_cast(int, sc); int rank = 0;
#pragma unroll
        for (int k = 0; k < 32; ++k) { const float o0 = __builtin_bit_cast(float, __builtin_amdgcn_readlane(scb, k)), o1 = __builtin_bit_cast(float, __builtin_amdgcn_readlane(scb, 32 + k)); const float o = hi ? o1 : o0;
            rank += ((o > sc) || (o == sc && k < j)) ? 1 : 0; }
        const unsigned long long bal = __ballot(rank < 8);
        const unsigned mine = hi ? (unsigned)(bal >> 32) : (unsigned)bal;
        if (r32 == 0) { selw[tokl] = mine; __hip_atomic_fetch_or(&selw[32], mine, __ATOMIC_RELAXED, __HIP_MEMORY_SCOPE_WORKGROUP); } }
    LDS_BAR();
    const unsigned mysel = selw[r32]; const unsigned uni = selw[32] & ((tb >= 31) ? 0xffffffffu : ((2u << tb) - 1u));
    {
        AttnSt st; attn_reset(st);
        Src src{(const unsigned char*)(H1B + rb * 2048 + 1280 + g * 64), (const unsigned char*)(H1B + rb * 2048 + 1408 + g * 64), 4096u, 4096u};
        struct MaskS { int t, tb; unsigned sel; __device__ __forceinline__ bool need(int j) const { return j == tb; } __device__ __forceinline__ bool valid(int j, int key) const { return j * 64 + key <= t; }
            __device__ __forceinline__ bool lanebit(int j) const { return (sel >> j) & 1u; } } mk{t, tb, mysel};
        if (!(abl & 512)) attn_loop<4>(st, qf, BitIt{uni}, src, [&](int) { return true; }, mk, kv, tid, lane, abl);
        const float l = st.l + __shfl_xor(st.l, 32); ob_add(ob, st.o, gate[1] * __builtin_amdgcn_rcpf(l), false);
    }
    {
        AttnSt st; attn_reset(st);
        Src src{(const unsigned char*)(H1B + rb * 2048 + 1536 + g * 64), (const unsigned char*)(H1B + rb * 2048 + 1664 + g * 64), 4096u, 4096u};
        const int jlo = (t0 - 511 > 0) ? ((t0 - 511) >> 6) : 0;
        struct MaskW { int t, tb, t0; __device__ __forceinline__ bool need(int j) const { return (j == tb) || (64 * j <= t0 + 31 - 512); }
            __device__ __forceinline__ bool valid(int j, int key) const { const int k = j * 64 + key; return (k <= t) && (k > t - 512); } __device__ __forceinline__ bool lanebit(int) const { return true; } } mk{t, tb, t0};
        if (!(abl & 512)) attn_loop<4>(st, qf, RangeIt{jlo, tb + 1}, src, [&](int) { return true; }, mk, kv, tid, lane, abl);
        const float l = st.l + __shfl_xor(st.l, 32); ob_add(ob, st.o, gate[2] * __builtin_amdgcn_rcpf(l), false);
    }
#pragma unroll
    for (int db = 0; db < 2; ++db)
#pragma unroll
        for (int g4 = 0; g4 < 4; ++g4) *(u32x2*)(orow + db * 32 + 8 * g4) = ob[db][g4];
}

__device__ __forceinline__ void cmp_item(Frame& F, int item) {
    const int lane = F.lane, wave = F.wave, r32 = lane & 31, hi = lane >> 5;
    const int rblk = item & 63, gk = item >> 6, g = gk & 1, kvsel = gk >> 1;
    const int row = rblk * 32 + r32, b = row >> 7, n = row & 127;
    const bf16_t* H1B = (const bf16_t*)(F.ws + S_H1B);
    const int ncl = (n < 127) ? n : 126;
    const bf16_t* src = H1B + ((size_t)b * S + 16 * ncl) * 2048 + 1024 + kvsel * 128 + g * 64 + hi * 8;
    (void)src;
    const unsigned char* W1 = (const unsigned char*)(F.ws + (kvsel ? WS_WCV1 : WS_WCK1)) + (size_t)(wave * 32) * 4096;
    LAS unsigned char* wl = F.lds + RING_OFF + wave * 16384;
    const unsigned char* xrow[4];
#pragma unroll
    for (int i = 0; i < 4; ++i) { const int rr = rblk * 32 + 8 * i + (lane >> 3), bb = rr >> 7, nn = rr & 127, nc = (nn < 127) ? nn : 126;
        xrow[i] = (const unsigned char*)(H1B + ((size_t)bb * S + 16 * nc) * 2048 + 1024 + kvsel * 128 + g * 64) + (lane & 7) * 16; }
    f32x16 acc = {};
    u32x4 wv[2][4], xv[2][4];
#pragma unroll
    for (int c = 0; c < 2; ++c) { wt_load(wv[c], W1 + c * 128, 4096u, lane);
#pragma unroll
        for (int i = 0; i < 4; ++i) xv[c][i] = *(const u32x4*)(xrow[i] + (size_t)c * 4096); }
#pragma unroll 1
    for (int l0 = 0; l0 < 32; l0 += 2) {
#pragma unroll
        for (int c = 0; c < 2; ++c) { wt_store(wl + c * 4096, wv[c], lane); wt_store(wl + (2 + c) * 4096, xv[c], lane); }
        if (l0 + 2 < 32) {
#pragma unroll
            for (int c = 0; c < 2; ++c) { wt_load(wv[c], W1 + (size_t)(l0 + 2 + c) * 128, 4096u, lane);
#pragma unroll
                for (int i = 0; i < 4; ++i) xv[c][i] = *(const u32x4*)(xrow[i] + (size_t)(l0 + 2 + c) * 4096); } }
#pragma unroll
        for (int c = 0; c < 2; ++c)
#pragma unroll
            for (int q = 0; q < 4; ++q) acc = mfma32(wt_frag(wl + c * 4096, q, lane), wt_frag(wl + (2 + c) * 4096, q, lane), acc);
    }
    const float* cb = (const float*)(F.ws + WS_CBIAS) + kvsel * 256 + wave * 32;
    LAS unsigned char* hid = F.lds + RING_OFF;
    __syncthreads();
#pragma unroll
    for (int g4 = 0; g4 < 4; ++g4) { const int c = 8 * g4 + 4 * hi; u32x2 w; w.x = pk(gelu_t(acc[4 * g4] + cb[c]), gelu_t(acc[4 * g4 + 1] + cb[c + 1])); w.y = pk(gelu_t(acc[4 * g4 + 2] + cb[c + 2]), gelu_t(acc[4 * g4 + 3] + cb[c + 3]));
        *(LAS u32x2*)(hid + r32 * 528 + (wave * 32 + c) * 2) = w; }
    __syncthreads();
    if (wave < 2) {
        const bf16_t* W2 = (const bf16_t*)(F.ws + (kvsel ? WS_WCV2 : WS_WCK2)) + (size_t)(wave * 32 + r32) * 256 + hi * 8;
        f32x16 o = {};
#pragma unroll
        for (int ks = 0; ks < 16; ++ks) o = mfma32(ld8g(W2 + ks * 16), *(const LAS bf16x8*)(hid + r32 * 528 + ks * 32 + hi * 16), o);
        bf16_t* dst = (bf16_t*)(F.ws + (kvsel ? S_VCMP : S_KCMP)) + ((size_t)(b * 2 + g) * 128 + n) * 64 + wave * 32 + 4 * hi;
        const float z = (n < 127) ? 1.f : 0.f;
#pragma unroll
        for (int g4 = 0; g4 < 4; ++g4) store4(dst + 8 * g4, o[4 * g4] * z, o[4 * g4 + 1] * z, o[4 * g4 + 2] * z, o[4 * g4 + 3] * z);
    }
    __syncthreads();
}

__device__ __forceinline__ void ln_route_wg(Frame& F, int layer, int cset) {
    const int lane = F.lane, wave = F.wave, tid = F.tid, r32 = lane & 31, hi = lane >> 5;
    const int tok0 = F.vcu * 128;
    const float* Z = (const float*)(F.ws + WS_Z1);
    const float* g1 = (const float*)F.in[28] + layer * 1024; const float* b1 = (const float*)F.in[29] + layer * 1024;
    const float* wrg = (const float*)F.in[21] + (size_t)layer * 4096; const float* brg = (const float*)F.in[22] + layer * 4;
    const float* wre = (const float*)F.in[23] + (size_t)layer * 32768; const float* bre = (const float*)F.in[24] + layer * 32;
    LAS float* part = (LAS float*)(F.lds + RING_OFF);
    LAS float* glog = (LAS float*)(F.lds + LDS_SCR); LAS float* stl = (LAS float*)(F.lds + LDS_SCR + 2048);
    LAS int* lcnt = (LAS int*)(F.lds + LDS_SCR + 3072); LAS int* gbase = (LAS int*)(F.lds + LDS_SCR + 3200); LAS int* ent = (LAS int*)(F.lds + LDS_SCR + 3328);
    bf16_t* X1B = (bf16_t*)(F.ws + S_X1B); bf16_t* X1L = (bf16_t*)(F.ws + S_XP); float* stats = (float*)(F.ws + WS_STATS);
    if (tid < 32) lcnt[tid] = 0;
    {
        f32x4 gg[4], bb[4];
#pragma unroll
        for (int j = 0; j < 4; ++j) { gg[j] = *(const f32x4*)(g1 + lane * 4 + 256 * j); bb[j] = *(const f32x4*)(b1 + lane * 4 + 256 * j); }
#pragma unroll 1
        for (int i0 = 0; i0 < 16; i0 += 4) {
            f32x4 v[4][4]; float mean[4], rstd[4];
#pragma unroll
            for (int u = 0; u < 4; ++u) { const float* z = Z + (size_t)(tok0 + wave * 16 + i0 + u) * D;
#pragma unroll
                for (int j = 0; j < 4; ++j) v[u][j] = *(const f32x4*)(z + lane * 4 + 256 * j); }
#pragma unroll
            for (int u = 0; u < 4; ++u) { float s = 0.f;
#pragma unroll
                for (int j = 0; j < 4; ++j) s += (v[u][j][0] + v[u][j][1]) + (v[u][j][2] + v[u][j][3]);
                mean[u] = wsum(s) * (1.f / D); float q = 0.f;
#pragma unroll
                for (int j = 0; j < 4; ++j) { v[u][j] = v[u][j] - mean[u]; q += (v[u][j][0] * v[u][j][0] + v[u][j][1] * v[u][j][1]) + (v[u][j][2] * v[u][j][2] + v[u][j][3] * v[u][j][3]); }
                rstd[u] = rsqrtf(wsum(q) * (1.f / D) + LN_EPS); }
            f32x4 lg[4] = {f32x4{0.f, 0.f, 0.f, 0.f}, f32x4{0.f, 0.f, 0.f, 0.f}, f32x4{0.f, 0.f, 0.f, 0.f}, f32x4{0.f, 0.f, 0.f, 0.f}};
#pragma unroll
            for (int j = 0; j < 4; ++j) {
#pragma unroll
                for (int u = 0; u < 4; ++u) v[u][j] = v[u][j] * rstd[u] * gg[j] + bb[j];
#pragma unroll
                for (int e = 0; e < 4; ++e) { const f32x4 wv = *(const f32x4*)(wrg + (size_t)(lane * 4 + 256 * j + e) * 4);
#pragma unroll
                    for (int u = 0; u < 4; ++u) lg[u] += wv * v[u][j][e]; } }
#pragma unroll
            for (int u = 0; u < 4; ++u) { const int row = wave * 16 + i0 + u;
#pragma unroll
                for (int j = 0; j < 4; ++j) { const f32x4 x = v[u][j];
                    u32x2 w; w.x = pk(x[0], x[1]); w.y = pk(x[2], x[3]); *(u32x2*)(X1B + (size_t)(tok0 + row) * D + lane * 4 + 256 * j) = w;
                    u32x2 wl2; wl2.x = pk(x[0] - __uint_as_float(w.x << 16), x[1] - __uint_as_float(w.x & 0xffff0000u)); wl2.y = pk(x[2] - __uint_as_float(w.y << 16), x[3] - __uint_as_float(w.y & 0xffff0000u));
                    *(u32x2*)(X1L + (size_t)(tok0 + row) * D + lane * 4 + 256 * j) = wl2; }
                float l4[4];
#pragma unroll
                for (int e = 0; e < 4; ++e) l4[e] = wsum(lg[u][e]);
                if (lane == 0) { glog[row * 4 + 0] = l4[0] + brg[0]; glog[row * 4 + 1] = l4[1] + brg[1]; glog[row * 4 + 2] = l4[2] + brg[2]; glog[row * 4 + 3] = l4[3] + brg[3];
                    stl[row * 2] = mean[u]; stl[row * 2 + 1] = rstd[u]; stats[(size_t)(tok0 + row) * 2] = mean[u]; stats[(size_t)(tok0 + row) * 2 + 1] = rstd[u]; } }
        }
    }
    __syncthreads();
    { const int lane = launder(F.tid) & 63, r32 = lane & 31, hi = lane >> 5;
        bf16x8 wh[8], wl[8];
#pragma unroll
        for (int ks = 0; ks < 8; ++ks) { unsigned hh[4], ll[4];
#pragma unroll
            for (int e2 = 0; e2 < 4; ++e2) { float a[2], ah[2];
#pragma unroll
                for (int q = 0; q < 2; ++q) { const int k = wave * 128 + ks * 16 + hi * 8 + e2 * 2 + q; a[q] = wre[(size_t)k * 32 + r32]; }
                hh[e2] = pk(a[0], a[1]); ah[0] = __uint_as_float(hh[e2] << 16); ah[1] = __uint_as_float(hh[e2] & 0xffff0000u); ll[e2] = pk(a[0] - ah[0], a[1] - ah[1]); }
            wh[ks] = __builtin_bit_cast(bf16x8, (u32x4){hh[0], hh[1], hh[2], hh[3]}); wl[ks] = __builtin_bit_cast(bf16x8, (u32x4){ll[0], ll[1], ll[2], ll[3]}); asm volatile("" ::: "memory"); }
        for (int blk = 0; blk < 4; ++blk) { const int row = blk * 32 + r32; const size_t xo = (size_t)(tok0 + row) * D + wave * 128 + hi * 8;
            f32x16 acc = {};
#pragma unroll
            for (int ks = 0; ks < 8; ++ks) { const bf16x8 xh = ld8g(X1B + xo + ks * 16), xl = ld8g(X1L + xo + ks * 16);
                acc = mfma32(wh[ks], xh, acc); acc = mfma32(wh[ks], xl, acc); acc = mfma32(wl[ks], xh, acc); }
#pragma unroll
            for (int r = 0; r < 16; ++r) part[(wave * 128 + row) * 33 + crow(r, hi)] = acc[r];
        }
    }
    __syncthreads();
    const int tid2 = launder(F.tid);
    int e0 = 0, e1 = 0; float w0 = 0.f, w1 = 0.f; int rk0 = 0, rk1 = 0;
    if (tid2 < 128) {
        const float l0 = glog[tid2 * 4], l1 = glog[tid2 * 4 + 1], l2 = glog[tid2 * 4 + 2], l3 = glog[tid2 * 4 + 3];
        int gs = 0; float gm = l0; if (l1 > gm) { gm = l1; gs = 1; } if (l2 > gm) { gm = l2; gs = 2; } if (l3 > gm) { gm = l3; gs = 3; }
        const float gw = 1.f / (expf(l0 - gm) + expf(l1 - gm) + expf(l2 - gm) + expf(l3 - gm));
        float es[8];
#pragma unroll
        for (int n = 0; n < 8; ++n) { float a = bre[gs * 8 + n];
#pragma unroll
            for (int w = 0; w < 8; ++w) a += part[(w * 128 + tid2) * 33 + gs * 8 + n];
            es[n] = a; }
        int i0 = 0; float m0 = es[0];
#pragma unroll
        for (int n = 1; n < 8; ++n) if (es[n] > m0) { m0 = es[n]; i0 = n; }
        int i1 = 0; float m1 = -3e38f;
#pragma unroll
        for (int n = 0; n < 8; ++n) if (n != i0 && es[n] > m1) { m1 = es[n]; i1 = n; }
        const float r = expf(m1 - m0); w0 = gw / (1.f + r); w1 = gw * r / (1.f + r);
        e0 = gs * 8 + i0; e1 = gs * 8 + i1;
        rk0 = __hip_atomic_fetch_add(&lcnt[e0], 1, __ATOMIC_RELAXED, __HIP_MEMORY_SCOPE_WORKGROUP); rk1 = __hip_atomic_fetch_add(&lcnt[e1], 1, __ATOMIC_RELAXED, __HIP_MEMORY_SCOPE_WORKGROUP);
    }
    __syncthreads();
    if (tid2 < 32) gbase[tid2] = (int)__hip_atomic_fetch_add((int*)(F.ctl + CW_CNT + cset * 64) + tid2, lcnt[tid2], __ATOMIC_RELAXED, __HIP_MEMORY_SCOPE_AGENT);
    __syncthreads();
    if (tid2 < 128) {
        int* rt = (int*)(F.ws + WS_ROUTE); float* rw = (float*)(F.ws + WS_ROUTE + (size_t)T * 8);
        const int tok = tok0 + tid2;
        rt[tok * 2] = (e0 << 20) | (gbase[e0] + rk0); rt[tok * 2 + 1] = (e1 << 20) | (gbase[e1] + rk1);
        int* expl = (int*)(F.ws + WS_EXPL); expl[(size_t)e0 * T + gbase[e0] + rk0] = tok; expl[(size_t)e1 * T + gbase[e1] + rk1] = tok;
        rw[tok * 2] = w0; rw[tok * 2 + 1] = w1;
    }
    __syncthreads();
}
__device__ __forceinline__ void moe_tables(Frame& F, int layer) {
    LAS int* ebase = (LAS int*)(F.lds + LDS_SCR + 4352); LAS int* pe = (LAS int*)(F.lds + LDS_SCR + 4608);
    if (F.tid == 0) { int a = 0; for (int e = 0; e < 32; ++e) { ebase[e] = a; const int c = (int)__hip_atomic_load((int*)(F.ctl + CW_CNT + layer * 64) + e, __ATOMIC_RELAXED, __HIP_MEMORY_SCOPE_AGENT); a += (c + 255) & ~255; } ebase[32] = a; }
    __syncthreads();
    for (int p = F.tid; p < MOE_PANELS; p += NTHR) { int e = 0; for (int k = 1; k < 32; ++k) if (p * 256 >= ebase[k]) e = k; pe[p] = e; }
    __syncthreads();
}
__device__ __forceinline__ void moe_gather_wg(Frame& F, int layer) {
    moe_tables(F, layer);
    LAS int* ebase = (LAS int*)(F.lds + LDS_SCR + 4352);
    const int tok0 = F.vcu * 128; int* rt = (int*)(F.ws + WS_ROUTE);
    int* rowsrc = (int*)(F.ctl + CW_ROWSRC) + layer * MOE_ROWS;
    if (F.tid < 256) { const int tok = tok0 + (F.tid >> 1), sl = F.tid & 1; const int v = rt[tok * 2 + sl]; const int row = ebase[v >> 20] + (v & 0xfffff);
        rowsrc[row] = tok; rt[4 * T + tok * 2 + sl] = row; }
}
__device__ __forceinline__ void combine_wg(Frame& F, int layer, float* xout, bf16_t* xb) {
    const int lane = F.lane, tok0 = F.vcu * 128;
    const LAS int* ebase = (const LAS int*)(F.lds + LDS_SCR + 4352);
    const float* Z = (const float*)(F.ws + WS_Z1); const float* stats = (const float*)(F.ws + WS_STATS);
    const int* rt = (const int*)(F.ws + WS_ROUTE); const float* rw = (const float*)(F.ws + WS_ROUTE + (size_t)T * 8);
    const bf16_t* YP = (const bf16_t*)(F.ws + S_YP);
    const float* g1 = (const float*)F.in[28] + layer * 1024; const float* b1 = (const float*)F.in[29] + layer * 1024;
    const float* g2 = (const float*)F.in[30] + layer * 1024; const float* b2 = (const float*)F.in[31] + layer * 1024;
    f32x4 G1[4], B1[4], G2[4], B2[4];
#pragma unroll
    for (int j = 0; j < 4; ++j) { const int c = lane * 4 + 256 * j; G1[j] = *(const f32x4*)(g1 + c); B1[j] = *(const f32x4*)(b1 + c); G2[j] = *(const f32x4*)(g2 + c); B2[j] = *(const f32x4*)(b2 + c); }
#pragma unroll 1
    for (int i0 = 0; i0 < 16; i0 += 4) {
        f32x4 z[4][4]; s16x4 ya[4][4], yb[4][4]; float mean[4], rstd[4], w0[4], w1[4];
#pragma unroll
        for (int u = 0; u < 4; ++u) { const int tok = tok0 + F.wave * 16 + i0 + u;
            mean[u] = stats[(size_t)tok * 2]; rstd[u] = stats[(size_t)tok * 2 + 1]; w0[u] = rw[tok * 2]; w1[u] = rw[tok * 2 + 1];
            const int v0 = rt[tok * 2], v1 = rt[tok * 2 + 1];
            const bf16_t* y0 = YP + (size_t)(ebase[v0 >> 20] + (v0 & 0xfffff)) * D; const bf16_t* y1 = YP + (size_t)(ebase[v1 >> 20] + (v1 & 0xfffff)) * D;
#pragma unroll
            for (int j = 0; j < 4; ++j) { const int c = lane * 4 + 256 * j; z[u][j] = *(const f32x4*)(Z + (size_t)tok * D + c); ya[u][j] = *(const s16x4*)(y0 + c); yb[u][j] = *(const s16x4*)(y1 + c); } }
        float s[4], q[4];
#pragma unroll
        for (int u = 0; u < 4; ++u) { s[u] = 0.f;
#pragma unroll
            for (int j = 0; j < 4; ++j) { const f32x4 x1 = (z[u][j] - mean[u]) * rstd[u] * G1[j] + B1[j]; f32x4 f;
#pragma unroll
                for (int e = 0; e < 4; ++e) f[e] = w0[u] * bf2f((unsigned short)ya[u][j][e]) + w1[u] * bf2f((unsigned short)yb[u][j][e]);
                z[u][j] = x1 * ALPHA + f; s[u] += (z[u][j][0] + z[u][j][1]) + (z[u][j][2] + z[u][j][3]); } }
#pragma unroll
        for (int u = 0; u < 4; ++u) { const float m2 = wsum(s[u]) * (1.f / D); q[u] = 0.f;
#pragma unroll
            for (int j = 0; j < 4; ++j) { z[u][j] = z[u][j] - m2; q[u] += (z[u][j][0] * z[u][j][0] + z[u][j][1] * z[u][j][1]) + (z[u][j][2] * z[u][j][2] + z[u][j][3] * z[u][j][3]); } }
#pragma unroll
        for (int u = 0; u < 4; ++u) { const int tok = tok0 + F.wave * 16 + i0 + u; const float r2 = rsqrtf(wsum(q[u]) * (1.f / D) + LN_EPS);
#pragma unroll
            for (int j = 0; j < 4; ++j) { const int c = lane * 4 + 256 * j; const f32x4 o = z[u][j] * r2 * G2[j] + B2[j];
                *(f32x4*)(xout + (size_t)tok * D + c) = o;
                if (xb) { u32x2 w; w.x = pk(o[0], o[1]); w.y = pk(o[2], o[3]); *(u32x2*)(xb + (size_t)tok * D + c) = w; } } }
    }
}
constexpr int NPHASE = 20;
__global__ void __launch_bounds__(NTHR, 2) mega(Args args) {
    extern __shared__ __attribute__((aligned(16))) unsigned char lds_[];
#define PHASE_FRAME() Frame F; { int t_ = (int)threadIdx.x; asm volatile("" : "+v"(t_)); GAS unsigned char* wg_ = (GAS unsigned char*)args.ws; asm volatile("" : "+s"(wg_)); unsigned char* w_ = (unsigned char*)wg_; int bx_ = (int)blockIdx.x; asm volatile("" : "+s"(bx_)); \
        F.lds = (LAS unsigned char*)lds_; F.ws = w_; F.ctl = (gu32*)(w_ + WS_CTL); F.in = args.in; F.out = args.out; F.tid = t_; F.lane = t_ & 63; F.wave = __builtin_amdgcn_readfirstlane(t_ >> 6); \
        F.G = (int)gridDim.x; F.vcu = (F.G % 8 == 0) ? (bx_ % 8) * (F.G / 8) + bx_ / 8 : bx_; } unsigned char* ws = F.ws; LAS unsigned char* ring = F.lds + RING_OFF; (void)ws; (void)ring
    Frame F0; { F0.lds = (LAS unsigned char*)lds_; F0.ws = args.ws; F0.ctl = (gu32*)(args.ws + WS_CTL); F0.tid = threadIdx.x; }
    volatile LAS unsigned* MISC = (volatile LAS unsigned*)(F0.lds + LDS_MISC);
    if (F0.tid < 64) MISC[F0.tid] = 0u;
    __syncthreads();
    const int lo = args.ph_lo, hi = args.ph_hi;
    const bool one = (hi - lo) > 1;
    XcdBarrier bar; bar.bar = (unsigned*)(F0.ctl + CW_BAR); bar.x = 0; bar.st = nullptr;
    if (one) bar = xcd_barrier_post((unsigned*)(F0.ctl + CW_BAR), MISC + 8);
#ifndef PH_MASK
#define PH_MASK 0xFFFFFFFFu
#endif
#define IN(k) ((((PH_MASK) >> (k)) & 1u) && lo <= (k) && (k) < hi)
#ifndef ABL
#define ABL 0
#endif
#ifndef DUP_PHASE
#define DUP_PHASE -1
#endif
#define REP(k) for (int rep = ((k) == DUP_PHASE ? 0 : 1); rep < 2; ++rep)
#define REPSYNC() do { if (rep == 0) xcd_barrier(bar); } while (0)
#ifndef BARX
#define BARX 1
#endif
#define SEAM(k) do { if (IN(k) && IN((k) + 1)) { for (int bx_ = 0; bx_ < BARX; ++bx_) xcd_barrier(bar); } } while (0)

    if (IN(0)) REP(0) { PHASE_FRAME(); const bool dry = (rep == 0); (void)dry; p0_prologue(F); REPSYNC(); } SEAM(0);
    if (IN(1)) REP(1) { PHASE_FRAME(); const bool dry = (rep == 0); (void)dry; Gemm g{(const bf16_t*)(ws + S_XB), (const bf16_t*)(ws + WS_W0IN), T, 1536, 1024, 1024, nullptr}; pg8::StaticOrder So; So.init(T, 1536, F.G, (int)blockIdx.x);
        EpiTile E{(bf16_t*)(ws + S_H0B), 1536, 4, 0, 1.f, 0};
        pg8::gemm_phase<EpiTile, pg8::StaticOrder, true, true>(ring, g, So, E); REPSYNC(); } SEAM(1);
    if (IN(2)) REP(2) { PHASE_FRAME(); const bool dry = (rep == 0); (void)dry; mla_prep_rows(F);
        for (int ch = F.vcu; ch < 256; ch += F.G) gmlp_chunk(F, ch, dry); REPSYNC(); } SEAM(2);
    if (IN(3)) REP(3) { PHASE_FRAME(); const bool dry = (rep == 0); (void)dry;
        { Gemm g{(const bf16_t*)(ws + S_H0B) + 1024, (const bf16_t*)(ws + WS_WUQ), T, 768, 256, 1536, nullptr}; pg8::StaticOrder So; So.init(T, 768, F.G, (int)blockIdx.x);
          EpiQ E{ws};
#ifndef NO_Q
          pg8::gemm_phase<EpiQ, pg8::StaticOrder, true, true>(ring, g, So, E);
#endif
        }
        { Gemm g{(const bf16_t*)(ws + S_H0B) + 1280, (const bf16_t*)(ws + WS_WUKV), T, 1024, 256, 1536, nullptr}; pg8::StaticOrder So; So.init(T, 1024, F.G, (int)blockIdx.x);
          EpiKV E{ws};
#ifndef NO_KV
          pg8::gemm_phase<EpiKV, pg8::StaticOrder, true, true>(ring, g, So, E);
#endif
        }
        REPSYNC(); } SEAM(3);
    if (IN(4)) REP(4) { PHASE_FRAME(); const bool dry = (rep == 0); (void)dry; for (int c = F.vcu; c < 256; c += F.G) { const int bh = c >> 1;
#pragma unroll 1
            for (int i = 0; i < 4; ++i) { const int qb = (c & 1) ? ((i == 0) ? 6 : (i == 1) ? 1 : (i == 2) ? 5 : 2) : ((i == 0) ? 7 : (i == 1) ? 0 : (i == 2) ? 4 : 3); mla_attn_unit(F, bh >> 3, bh & 7, qb, dry ? ABL : 0); } } REPSYNC(); } SEAM(4);
    if (IN(5)) REP(5) { PHASE_FRAME(); const bool dry = (rep == 0); (void)dry; Gemm g{(const bf16_t*)(ws + S_H0B), (const bf16_t*)(ws + WS_W0O), T, 1024, 1024, 1536, nullptr}; pg8::StaticOrder So; So.init(T, 1024, F.G, (int)blockIdx.x);
        EpiResid E{(const float*)args.in[0], (float*)(ws + WS_Z1)};
        pg8::gemm_phase<EpiResid, pg8::StaticOrder, true, true>(ring, g, So, E); REPSYNC(); } SEAM(5);
#pragma unroll
    for (int layer = 0; layer < 2; ++layer) {
        const int pb = layer ? 15 : 6;
        if (IN(pb)) REP(pb) { PHASE_FRAME(); const bool dry = (rep == 0); (void)dry; for (int c = F.vcu; c < 256; c += F.G) { Frame F2 = F; F2.vcu = c; ln_route_wg(F2, layer, dry ? 2 + layer : layer); } REPSYNC(); } SEAM(pb);
        if (IN(pb + 2)) REP(pb + 2) { PHASE_FRAME(); const bool dry = (rep == 0); (void)dry; moe_tables(F, layer); const LAS int* eb = (const LAS int*)(F.lds + LDS_SCR + 4352);
            Gemm g{(const bf16_t*)(ws + S_X1B), (const bf16_t*)(ws + WS_WGU) + (size_t)layer * 32 * 512 * 1024, MOE_ROWS, 512, 1024, 1024, nullptr};
            MoeOrder<2> So{(const LAS int*)(F.lds + LDS_SCR + 4608), (eb[32] >> 8) * 2, F.G, F.vcu, eb, (const int*)(ws + WS_EXPL)}; EpiMoeUp E{(bf16_t*)(ws + S_HP)};
            pg8::gemm_phase<EpiMoeUp, MoeOrder<2>, true, true, true>(ring, g, So, E); REPSYNC(); } SEAM(pb + 2);
        if (IN(pb + 3)) REP(pb + 3) { PHASE_FRAME(); const bool dry = (rep == 0); (void)dry; moe_tables(F, layer); const LAS int* eb = (const LAS int*)(F.lds + LDS_SCR + 4352);
            Gemm g{(const bf16_t*)(ws + S_HP), (const bf16_t*)(ws + WS_WD) + (size_t)layer * 32 * 1024 * 256, MOE_ROWS, 1024, 256, 256, nullptr};
            MoeOrder<4> So{(const LAS int*)(F.lds + LDS_SCR + 4608), (eb[32] >> 8) * 4, F.G, F.vcu, eb, (const int*)(ws + WS_EXPL)}; EpiMoeDown E{(bf16_t*)(ws + S_YP)};
            pg8::gemm_phase<EpiMoeDown, MoeOrder<4>, true, true>(ring, g, So, E); REPSYNC(); } SEAM(pb + 3);
        if (IN(pb + 4)) REP(pb + 4) { PHASE_FRAME(); const bool dry = (rep == 0); (void)dry; moe_tables(F, layer); for (int c = F.vcu; c < 256; c += F.G) { Frame F2 = F; F2.vcu = c; combine_wg(F2, layer, args.out, layer ? nullptr : (bf16_t*)(ws + S_X2B)); } REPSYNC(); }
        if (layer == 0) {
            SEAM(10);
            if (IN(11)) REP(11) { PHASE_FRAME(); const bool dry = (rep == 0); (void)dry; Gemm g{(const bf16_t*)(ws + S_X2B), (const bf16_t*)(ws + WS_W1IN), T, 2048, 1024, 1024, nullptr}; pg8::StaticOrder So; So.init(T, 2048, F.G, (int)blockIdx.x);
                EpiTile E{(bf16_t*)(ws + S_H1B), 2048, 0, 4, QS_NSA, 0};
                pg8::gemm_phase<EpiTile, pg8::StaticOrder, true, true>(ring, g, So, E); REPSYNC(); } SEAM(11);
            if (IN(12)) REP(12) { PHASE_FRAME(); const bool dry = (rep == 0); (void)dry; for (int it = F.vcu; it < 256; it += F.G) cmp_item(F, it); REPSYNC(); } SEAM(12);
            if (IN(13)) REP(13) { PHASE_FRAME(); const bool dry = (rep == 0); (void)dry; for (int c = F.vcu; c < 256; c += F.G) { const int bg = c >> 3, s = c & 7;
#pragma unroll 1
                    for (int i = 0; i < 8; ++i) { const int k = i >> 1; const int blk = (k == 0) ? 31 - s : (k == 1) ? 16 + s : (k == 2) ? 15 - s : s; nsa_unit(F, bg >> 1, bg & 1, blk * 2 + (i & 1), dry, dry ? ABL : 0); } } REPSYNC(); } SEAM(13);
            if (IN(14)) REP(14) { PHASE_FRAME(); const bool dry = (rep == 0); (void)dry; Gemm g{(const bf16_t*)(ws + S_H1B), (const bf16_t*)(ws + WS_W1O), T, 1024, 1024, 2048, nullptr}; pg8::StaticOrder So; So.init(T, 1024, F.G, (int)blockIdx.x);
                EpiResid E{(const float*)args.out, (float*)(ws + WS_Z1)};
                pg8::gemm_phase<EpiResid, pg8::StaticOrder, true, true>(ring, g, So, E); REPSYNC(); } SEAM(14);
        }
    }
#undef IN
#undef SEAM
}

#ifndef MK_SPLIT
#define MK_SPLIT 0
#endif
static void launch_all(void* const* d_in, float* out, unsigned char* ws, hipStream_t stream) {
    static int grid = 0;
    if (grid == 0) {
        int dev = 0, cus = 0, per_cu = 0;
        if (hipGetDevice(&dev) != hipSuccess || hipDeviceGetAttribute(&cus, hipDeviceAttributeMultiprocessorCount, dev) != hipSuccess) { grid = -1; return; }
        if (hipFuncSetAttribute((const void*)mega, hipFuncAttributeMaxDynamicSharedMemorySize, LDS_BYTES) != hipSuccess) { fprintf(stderr, "kernel_launch: hipFuncSetAttribute failed\n"); grid = -1; return; }
        if (hipOccupancyMaxActiveBlocksPerMultiprocessor(&per_cu, (const void*)mega, NTHR, LDS_BYTES) != hipSuccess || per_cu < 1) fprintf(stderr, "kernel_launch: occupancy query says %d\n", per_cu);
        (void)hipGetLastError();
        grid = cus < 256 ? cus : 256;
    }
    if (grid < 0) return;
    (void)hipMemsetAsync(ws + WS_CTL, 0, CTL_ZERO_BYTES, stream);
    Args a{};
    for (int i = 0; i < 32; ++i) a.in[i] = d_in[i];
    a.out = out; a.ws = ws;
#if MK_SPLIT
    for (int p = 0; p < NPHASE; ++p) { a.ph_lo = p; a.ph_hi = p + 1; hipLaunchKernelGGL(mega, dim3(grid), dim3(NTHR), LDS_BYTES, stream, a); }
#else
    a.ph_lo = 0; a.ph_hi = NPHASE; hipLaunchKernelGGL(mega, dim3(grid), dim3(NTHR), LDS_BYTES, stream, a);
#endif
}
}

extern "C" void kernel_launch(void* const* d_in, const int* in_sizes, int n_in, void* d_out, int out_size, void* d_ws, size_t ws_size, hipStream_t stream) {
    fk::launch_all(d_in, (float*)d_out, (unsigned char*)d_ws, stream);
}
```

```cpp
#include <hip/hip_runtime.h>
#include <stdint.h>
#include <math.h>
#include <cstdio>
namespace pg8 {
#define PG8_LAS __attribute__((address_space(3)))
typedef unsigned short bf16_t;
typedef short bf16x8 __attribute__((ext_vector_type(8)));
typedef float f32x4 __attribute__((ext_vector_type(4)));
typedef unsigned u32x4 __attribute__((ext_vector_type(4)));
constexpr int BM = 256, BK = 64, HALF = 128, HTB = HALF * BK * 2  , STAGE_BYTES = 8 * HTB, NXCD = 8, WGM = 8;

__host__ __device__ __forceinline__ int lds_byte(int r, int c) { const int st = (r >> 4) * 2 + (c >> 5), rr = r & 15, cc = c & 31, ob = rr * 64 + cc * 2; return st * 1024 + (ob ^ (((ob >> 9) & 1) << 5)); }
__host__ __device__ __forceinline__ void stage_rc(int b, int& R, int& C) { const int st = b / 1024, sb = b % 1024, swz = sb ^ (((sb >> 9) & 1) << 5); R = (st >> 1) * 16 + swz / 64; C = (st & 1) * 32 + (swz % 64) / 2; }
__host__ __device__ __forceinline__ int perm32(int rho) { const int n = rho >> 4, i = rho & 15; return 8 * (i >> 2) + 4 * n + (i & 3); }

struct Unit { int pm, pn; };
struct Gemm { const bf16_t* A; const bf16_t* Bt; int M, N, K, lda; const int* rowsrc; };

struct StaticOrder {
    int nM, nN, nwg, G, c;
    __host__ __device__ void init(int M, int N, int G_, int c_) { nM = M / BM; nN = N / BM; nwg = nM * nN; G = G_; c = c_; }
    __host__ __device__ bool next(int i, Unit& u) const {
        const long L = (long)i * G + c; if (L >= nwg) return false;
        int wgid = (int)L; { const int q = nwg / NXCD, r = nwg % NXCD, xcd = wgid % NXCD, off = wgid / NXCD; wgid = (xcd < r ? xcd * (q + 1) : r * (q + 1) + (xcd - r) * q) + off; }
        const int nig = WGM * nN, gid = wgid / nig, fm = gid * WGM, gsz = (nM - fm) < WGM ? (nM - fm) : WGM;
        u.pm = fm + ((wgid % nig) % gsz); u.pn = (wgid % nig) / gsz; return true;
    }
    __device__ __forceinline__ void a_ready(const Unit&) const {}
    __device__ __forceinline__ void done(const Unit&) const {}
};

__device__ __forceinline__ unsigned cvt_pk_bf16(float lo, float hi) { unsigned r; asm volatile("v_cvt_pk_bf16_f32 %0, %1, %2" : "=v"(r) : "v"(lo), "v"(hi)); return r; }
typedef float f32x2 __attribute__((ext_vector_type(2)));
template <class Epi, class Sched, bool ALIGN_EPI = false, bool SP2 = false, bool GATHER = false>
__device__ __forceinline__ void gemm_phase(PG8_LAS unsigned char* lds, const Gemm g, const Sched& S, const Epi& E) {
    int tid_l = (int)threadIdx.x; asm volatile("" : "+v"(tid_l));
    const int tid = tid_l, wid = __builtin_amdgcn_readfirstlane(tid >> 6), lane = tid & 63, wr = wid >> 2, wc = wid & 3, fr = lane & 15, fq = lane >> 4;
    const int K = g.K, nt = K / BK;
    unsigned voffA[2], voffB[2], voffA1[2] = {0u, 0u}, nvoffA[2] = {0u, 0u}, nvoffA1[2] = {0u, 0u}; int RA[2], CA[2];
#pragma unroll
    for (int i = 0; i < 2; ++i) { int R, C; stage_rc(tid * 16 + i * 8192, R, C); const int Rb = Epi::PERM ? ((R & ~31) + perm32(R & 31)) : R;
        voffA[i] = (unsigned)(R * g.lda + C) * 2u; voffB[i] = (unsigned)(Rb * K + C) * 2u; RA[i] = R; CA[i] = C; }
    const size_t kstep = (size_t)(BK * 2);
    const size_t hstepA = (size_t)HALF * g.lda * 2, hstepB = (size_t)HALF * K * 2;
    const size_t tstepA = 2 * hstepA, tstepB = 2 * hstepB;
    const unsigned ldsw = (unsigned)wid * 1024u;
    const int aoff = lds_byte(wr * 64 + fr, fq * 8), boff = lds_byte(wc * 32 + fr, fq * 8);
#define PG8_SA(b, h) (((b) * 2 + (h)) * HTB)
#define PG8_SB(b, h) ((4 + (b) * 2 + (h)) * HTB)
#define PG8_STAGE(bufoff, gbase, voff) do { _Pragma("unroll") for (int _i = 0; _i < 2; ++_i) \
        __builtin_amdgcn_global_load_lds((const unsigned*)((const char*)(gbase) + (voff)[_i]), (PG8_LAS unsigned*)(lds + (bufoff) + ldsw + _i * 8192), 16, 0, 0); } while (0)
#define PG8_GSET(u, v0, v1) do { _Pragma("unroll") for (int _i = 0; _i < 2; ++_i) { v0[_i] = (unsigned)(S.arow((u), RA[_i]) * g.lda + CA[_i]) * 2u; v1[_i] = (unsigned)(S.arow((u), HALF + RA[_i]) * g.lda + CA[_i]) * 2u; } } while (0)
#define PG8_STA0(slot, P, NX) do { if constexpr (GATHER) { if (NX) PG8_STAGE(slot, P, nvoffA); else PG8_STAGE(slot, P, voffA); } else PG8_STAGE(slot, P, voffA); } while (0)
#define PG8_STA1(slot, P, NX) do { if constexpr (GATHER) { if (NX) PG8_STAGE(slot, P, nvoffA1); else PG8_STAGE(slot, P, voffA1); } else PG8_STAGE(slot, (P) + hstepA, voffA); } while (0)
#define PG8_LDA(dst, b, h) do { _Pragma("unroll") for (int m = 0; m < 4; ++m) _Pragma("unroll") for (int k = 0; k < 2; ++k) dst[m][k] = *(const PG8_LAS bf16x8*)(lds + PG8_SA(b, h) + aoff + m * 2048 + k * 1024); } while (0)
#define PG8_LDB(dst, b, h) do { _Pragma("unroll") for (int n = 0; n < 2; ++n) _Pragma("unroll") for (int k = 0; k < 2; ++k) dst[n][k] = *(const PG8_LAS bf16x8*)(lds + PG8_SB(b, h) + boff + n * 2048 + k * 1024); } while (0)
#define PG8_MMA(ai, bj, At, Bt) do { __builtin_amdgcn_s_setprio(1); _Pragma("unroll") for (int m = 0; m < 4; ++m) _Pragma("unroll") for (int n = 0; n < 2; ++n) _Pragma("unroll") for (int k = 0; k < 2; ++k) \
        acc[ai][bj][m][n] = __builtin_amdgcn_mfma_f32_16x16x32_bf16(Bt[n][k], At[m][k], acc[ai][bj][m][n], 0, 0, 0); __builtin_amdgcn_s_setprio(0); } while (0)
#define PG8_WAIT_V(n) asm volatile("s_waitcnt vmcnt(" #n ")" ::: "memory")
#define PG8_WAIT_L(n) asm volatile("s_waitcnt lgkmcnt(" #n ")" ::: "memory")
#define PG8_BAR __builtin_amdgcn_s_barrier()
#define PG8_SCHED __builtin_amdgcn_sched_barrier(0)
    Unit cur, nxt; int ui = 0;
    if (!S.next(0, cur)) return;
    f32x4 acc[2][2][4][2];
#pragma unroll
    for (int a = 0; a < 2; ++a)
#pragma unroll
        for (int b = 0; b < 2; ++b)
#pragma unroll
            for (int m = 0; m < 4; ++m)
#pragma unroll
                for (int n = 0; n < 2; ++n) acc[a][b][m][n] = (f32x4){0.f, 0.f, 0.f, 0.f};
    bf16x8 At[4][2], B0[2][2], B1[2][2];
    const char* cA = GATHER ? (const char*)g.A : (const char*)g.A + (size_t)cur.pm * tstepA; if constexpr (GATHER) PG8_GSET(cur, voffA, voffA1);
    const char* cB = (const char*)g.Bt + (size_t)cur.pn * tstepB;
    S.a_ready(cur);
    if constexpr (SP2) {
        PG8_STAGE(PG8_SB(0, 0), cB, voffB); PG8_STAGE(PG8_SB(0, 1), cB + hstepB, voffB); PG8_STA0(PG8_SA(0, 0), cA, false); PG8_STA1(PG8_SA(0, 1), cA, false);
        if (wr == 1) PG8_BAR;
        PG8_WAIT_V(2); PG8_BAR;
        PG8_STAGE(PG8_SB(1, 0), cB + kstep, voffB); PG8_STA0(PG8_SA(1, 0), cA + kstep, false); PG8_STAGE(PG8_SB(1, 1), cB + hstepB + kstep, voffB);
        PG8_WAIT_V(6); PG8_BAR;
    } else {
        PG8_STAGE(PG8_SB(0, 0), cB, voffB); PG8_STA0(PG8_SA(0, 0), cA, false); PG8_STAGE(PG8_SB(0, 1), cB + hstepB, voffB); PG8_STA1(PG8_SA(0, 1), cA, false);
        if (wr == 1) PG8_BAR;
        PG8_WAIT_V(4); PG8_BAR;
        PG8_STAGE(PG8_SB(1, 0), cB + kstep, voffB); PG8_STA0(PG8_SA(1, 0), cA + kstep, false); PG8_STAGE(PG8_SB(1, 1), cB + hstepB + kstep, voffB);
        PG8_WAIT_V(6); PG8_BAR;
    }
    for (;;) {
        const bool has_next = S.next(ui + 1, nxt);
        const char* nA = has_next ? (GATHER ? (const char*)g.A : (const char*)g.A + (size_t)nxt.pm * tstepA) : cA; if constexpr (GATHER) { if (has_next) PG8_GSET(nxt, nvoffA, nvoffA1); } const char* nB = has_next ? (const char*)g.Bt + (size_t)nxt.pn * tstepB : cB;
#pragma unroll 1
        for (int t = 0; t < nt; t += 2) {
            const bool last = (t == nt - 2);
            const char* a1 = cA + (size_t)(t + 1) * kstep;
            const char* a2 = last ? nA : cA + (size_t)(t + 2) * kstep; const char* b2 = last ? nB : cB + (size_t)(t + 2) * kstep;
            const char* a3 = a2 + kstep; const char* b3 = b2 + kstep;
            if (last && has_next) S.a_ready(nxt);
            if constexpr (SP2) {
            PG8_LDB(B0, 0, 0); PG8_LDB(B1, 0, 1); PG8_SCHED; PG8_LDA(At, 0, 0); PG8_STA1(PG8_SA(1, 1), a1, false);
            PG8_WAIT_V(8); PG8_WAIT_L(0); PG8_BAR; PG8_MMA(0, 0, At, B0); PG8_MMA(0, 1, At, B1); PG8_BAR; PG8_SCHED;
            PG8_LDA(At, 0, 1); PG8_STAGE(PG8_SB(0, 0), b2, voffB); PG8_STAGE(PG8_SB(0, 1), b2 + hstepB, voffB); PG8_STA0(PG8_SA(0, 0), a2, last && has_next);
            PG8_WAIT_V(8); PG8_WAIT_L(0); PG8_BAR; PG8_MMA(1, 0, At, B0); PG8_MMA(1, 1, At, B1); PG8_BAR; PG8_SCHED;
            PG8_LDB(B0, 1, 0); PG8_LDB(B1, 1, 1); PG8_SCHED; PG8_LDA(At, 1, 0); PG8_STA1(PG8_SA(0, 1), a2, last && has_next);
            PG8_WAIT_V(8); PG8_WAIT_L(0); PG8_BAR; PG8_MMA(0, 0, At, B0); PG8_MMA(0, 1, At, B1); PG8_BAR; PG8_SCHED;
            PG8_LDA(At, 1, 1); PG8_STAGE(PG8_SB(1, 0), b3, voffB); PG8_STAGE(PG8_SB(1, 1), b3 + hstepB, voffB); PG8_STA0(PG8_SA(1, 0), a3, last && has_next);
            PG8_WAIT_V(8); PG8_WAIT_L(0); PG8_BAR; PG8_MMA(1, 0, At, B0); PG8_MMA(1, 1, At, B1); PG8_BAR; PG8_SCHED;
            } else {
            PG8_LDB(B0, 0, 0); PG8_SCHED; PG8_LDA(At, 0, 0); PG8_STA1(PG8_SA(1, 1), a1, false);
            PG8_WAIT_L(8); PG8_BAR; PG8_WAIT_L(0); PG8_MMA(0, 0, At, B0); PG8_BAR; PG8_SCHED;
            PG8_LDB(B1, 0, 1); PG8_STAGE(PG8_SB(0, 0), b2, voffB);
            PG8_BAR; PG8_WAIT_L(0); PG8_MMA(0, 1, At, B1); PG8_BAR;
            PG8_LDA(At, 0, 1); PG8_STA0(PG8_SA(0, 0), a2, last && has_next);
            PG8_BAR; PG8_WAIT_L(0); PG8_MMA(1, 0, At, B0); PG8_BAR; PG8_SCHED;
            PG8_STAGE(PG8_SB(0, 1), b2 + hstepB, voffB);
            PG8_WAIT_V(6); PG8_BAR; PG8_MMA(1, 1, At, B1); PG8_BAR;
            PG8_LDB(B0, 1, 0); PG8_SCHED; PG8_LDA(At, 1, 0); PG8_STA1(PG8_SA(0, 1), a2, last && has_next);
            PG8_WAIT_L(8); PG8_BAR; PG8_WAIT_L(0); PG8_MMA(0, 0, At, B0); PG8_BAR; PG8_SCHED;
            PG8_LDB(B1, 1, 1); PG8_STAGE(PG8_SB(1, 0), b3, voffB);
            PG8_BAR; PG8_WAIT_L(0); PG8_MMA(0, 1, At, B1); PG8_BAR;
            PG8_LDA(At, 1, 1); PG8_STA0(PG8_SA(1, 0), a3, last && has_next);
            PG8_BAR; PG8_WAIT_L(0); PG8_MMA(1, 0, At, B0); PG8_BAR; PG8_SCHED;
            PG8_STAGE(PG8_SB(1, 1), b3 + hstepB, voffB);
            PG8_WAIT_V(6); PG8_BAR; PG8_MMA(1, 1, At, B1); PG8_BAR;
            }
        }
        if constexpr (ALIGN_EPI) { if (wr == 0) PG8_BAR; }
        if constexpr (!Epi::AFTER_DRAIN) { E(acc, cur, wr, wc, fr, fq); S.done(cur); }
        if (!has_next) break;
#pragma unroll
        for (int a = 0; a < 2; ++a)
#pragma unroll
            for (int b = 0; b < 2; ++b)
#pragma unroll
                for (int m = 0; m < 4; ++m)
#pragma unroll
                    for (int n = 0; n < 2; ++n) acc[a][b][m][n] = (f32x4){0.f, 0.f, 0.f, 0.f};
        cur = nxt; cA = nA; cB = nB; ++ui;
        if constexpr (GATHER) { voffA[0] = nvoffA[0]; voffA[1] = nvoffA[1]; voffA1[0] = nvoffA1[0]; voffA1[1] = nvoffA1[1]; }
        if constexpr (ALIGN_EPI) { if (wr == 1) PG8_BAR; }
    }
    PG8_WAIT_V(0);
    if constexpr (!ALIGN_EPI) { if (wr == 0) PG8_BAR; }
    PG8_BAR;
    if constexpr (Epi::AFTER_DRAIN) { E.fused(acc, cur, wr, wc, fr, fq, lds, wid, lane); S.done(cur); }
#undef PG8_SA
#undef PG8_SB
#undef PG8_STAGE
#undef PG8_GSET
#undef PG8_STA0
#undef PG8_STA1
#undef PG8_LDA
#undef PG8_LDB
#undef PG8_MMA
#undef PG8_WAIT_V
#undef PG8_WAIT_L
#undef PG8_BAR
#undef PG8_SCHED
}
}
#define GAS __attribute__((address_space(1)))
#define LAS __attribute__((address_space(3)))
typedef unsigned short bf16;
typedef unsigned v4u __attribute__((ext_vector_type(4)));
typedef float f32x4 __attribute__((ext_vector_type(4)));
typedef short bf16x8 __attribute__((ext_vector_type(8)));
typedef GAS unsigned gu32;
typedef GAS unsigned long long gu64;
#define RLX_AGENT __ATOMIC_RELAXED, __HIP_MEMORY_SCOPE_AGENT
#define LDS_WAIT() asm volatile("s_waitcnt lgkmcnt(0)" ::: "memory")
#define VM_WAIT() asm volatile("s_waitcnt vmcnt(0)" ::: "memory")
__device__ __forceinline__ unsigned long long rt() { return __builtin_amdgcn_s_memrealtime(); }
__device__ __forceinline__ unsigned f2bf(float f) { unsigned u = __builtin_bit_cast(unsigned, f); return (u + 0x7fffu + ((u >> 16) & 1u)) >> 16; }
__device__ __forceinline__ unsigned pk2(float lo, float hi) { return f2bf(lo) | (f2bf(hi) << 16); }

#define XB_TMO      128
#define XB_XCNT(j)  (256  + 64 * (j))
#define XB_XSUB(j)  (1280 + 64 * (j))
#define XB_XGEN(j)  (2304 + 64 * (j))
#define XB_TOP      3328
#define XB_TOPGEN   3392
#define XCD_BAR_WORDS 3456
#define XB_SPIN_CAP (1u << 18)

__device__ __forceinline__ unsigned xb_ld(unsigned* p)              { return __hip_atomic_load(p, __ATOMIC_RELAXED, __HIP_MEMORY_SCOPE_AGENT); }
__device__ __forceinline__ unsigned xb_add(unsigned* p, unsigned v) { return __hip_atomic_fetch_add(p, v, __ATOMIC_RELAXED, __HIP_MEMORY_SCOPE_AGENT); }
__device__ __forceinline__ unsigned xb_xcc_id() { return (unsigned)__builtin_amdgcn_s_getreg((3 << 11) | 20) & 0xFu; }
#define XB_SPIN(cond, bar) do { unsigned _sp = 0; while (cond) { __builtin_amdgcn_s_sleep(1); \
    if ((++_sp & 255u) == 0u) { if (xb_ld(&(bar)[XB_TMO])) break; if (_sp > XB_SPIN_CAP) { atomicAdd(&(bar)[XB_TMO], 1u); break; } } } } while (0)

struct XcdBarrier {
    unsigned* bar; unsigned x;
    volatile LAS unsigned* st;
};

__device__ __forceinline__ XcdBarrier xcd_barrier_post(unsigned* bar, volatile LAS unsigned* st) {
    XcdBarrier b; b.bar = bar; b.x = xb_xcc_id(); b.st = st;
    if (threadIdx.x == 0) (void)xb_add(&bar[XB_XCNT(b.x)], 1u);
    return b;
}
__device__ __forceinline__ void xcd_barrier_complete(unsigned* bar, unsigned x, unsigned& nloc, unsigned& nx) {
    const unsigned G = gridDim.x * gridDim.y * gridDim.z;
    unsigned sum, cnt, mine, sp = 0u;
    for (;;) {
        sum = 0u; cnt = 0u; mine = 0u;
#pragma unroll
        for (unsigned j = 0; j < 16; ++j) { const unsigned c = xb_ld(&bar[XB_XCNT(j)]); sum += c; cnt += (c > 0u) ? 1u : 0u; mine = (j == x) ? c : mine; }
        if (sum == G) break;
        __builtin_amdgcn_s_sleep(1);
        if ((++sp & 255u) == 0u) { if (xb_ld(&bar[XB_TMO])) break; if (sp > XB_SPIN_CAP) { atomicAdd(&bar[XB_TMO], 1u); break; } }
    }
    nloc = mine > 0u ? mine : 1u; nx = cnt > 0u ? cnt : 1u;
}

__device__ __forceinline__ void xcd_barrier(const XcdBarrier& b) {
    asm volatile("s_waitcnt vmcnt(0)" ::: "memory");
    __syncthreads();
    if (threadIdx.x == 0) {
        unsigned* bar = b.bar;
        __builtin_amdgcn_s_waitcnt(0);
        unsigned nloc = b.st[0], nx = b.st[1];
        if (nloc == 0u) { xcd_barrier_complete(bar, b.x, nloc, nx); b.st[0] = nloc; b.st[1] = nx; }
        const unsigned old = xb_add(&bar[XB_XSUB(b.x)], 1u);
        const unsigned gen = old / nloc;
        if (old + 1u == (gen + 1u) * nloc) {
            __builtin_amdgcn_fence(__ATOMIC_RELEASE, "agent");
            asm volatile("s_waitcnt vmcnt(0)" ::: "memory");
            const unsigned og = xb_add(&bar[XB_TOP], 1u);
            const unsigned tg = og / nx;
            if (og + 1u == (tg + 1u) * nx) xb_add(&bar[XB_TOPGEN], 1u);
            else XB_SPIN(xb_ld(&bar[XB_TOPGEN]) == tg, bar);
            __builtin_amdgcn_fence(__ATOMIC_ACQUIRE, "agent");
            xb_add(&bar[XB_XGEN(b.x)], 1u);
            asm volatile("s_waitcnt vmcnt(0)" ::: "memory");
        } else {
            XB_SPIN(xb_ld(&bar[XB_XGEN(b.x)]) == gen, bar);
            __builtin_amdgcn_fence(__ATOMIC_ACQUIRE, "agent");
            asm volatile("s_waitcnt vmcnt(0)" ::: "memory");
        }
    }
    __syncthreads();
}
namespace fk {
using pg8::bf16_t; using pg8::f32x4; using pg8::u32x4; using pg8::Unit; using pg8::Gemm;
typedef float f32x16 __attribute__((ext_vector_type(16)));
typedef float f32x2 __attribute__((ext_vector_type(2)));
typedef unsigned u32x2 __attribute__((ext_vector_type(2)));
typedef short s16x4 __attribute__((ext_vector_type(4)));
constexpr int NB = 16, S = 2048, D = 1024, T = NB * S;
constexpr float ALPHA = 1.41421356237309515f, LN_EPS = 1e-5f, LOG2E = 1.4426950408889634f;
constexpr float QS_MLA = 0.10206207261596575f * LOG2E;
constexpr float QS_NSA = 0.125f * LOG2E;
constexpr int NWAVES = 8, NTHR = 512;
constexpr int MOE_ROWS = 73728, MOE_PANELS = MOE_ROWS / 256;

constexpr size_t MiB = 1u << 20;
constexpr size_t WS_CTL = 0, CTL_ZERO_BYTES = 1 * MiB;
constexpr size_t WS_W0IN = 1 * MiB, WS_WUQ = 4 * MiB, WS_WUKV = WS_WUQ + 512 * 1024, WS_W0O = 5 * MiB, WS_W1IN = 7 * MiB, WS_WCK1 = 11 * MiB, WS_WCV1 = 12 * MiB,
                 WS_WCK2 = 13 * MiB, WS_WCV2 = 13 * MiB + 64 * 1024, WS_WSB = 13 * MiB + 128 * 1024, WS_CBIAS = 13 * MiB + 512 * 1024, WS_W1O = 14 * MiB, WS_WGU = 16 * MiB, WS_WD = 80 * MiB;
constexpr size_t WS_Z1 = 113 * MiB;
constexpr size_t WS_STATS = 241 * MiB;
constexpr size_t WS_ROUTE = WS_STATS + 256 * 1024;
constexpr size_t WS_S = 242 * MiB;
constexpr size_t S_XB = WS_S, S_H0B = WS_S + 64 * MiB, S_Q96 = WS_S, S_KN = WS_S + 160 * MiB, S_V = WS_S + 192 * MiB, S_KRB = WS_S + 224 * MiB;
constexpr size_t S_X1B = WS_S, S_XP = WS_S + 64 * MiB, S_HP = WS_S + 208 * MiB, S_YP = WS_S, S_X2B = WS_S + 144 * MiB;
constexpr size_t S_H1B = WS_S, S_KCMP = WS_S + 208 * MiB, S_VCMP = S_KCMP + 1 * MiB;
constexpr size_t WS_END = WS_S + 244 * MiB;
constexpr size_t WS_EXPL = 488 * MiB;
constexpr size_t WS_ROPE = 492 * MiB;
constexpr size_t WS_RINV = 496 * MiB;
static_assert(WS_END <= 512 * MiB, "workspace map");
constexpr int CW_BAR = 4096, CW_CNT = 16384  , CW_ROWSRC = 32768  ;
static_assert((CW_ROWSRC + 2 * 73728) * 4 <= (int)CTL_ZERO_BYTES, "control words inside the per-call memset");

constexpr int RING_OFF = 0, LDS_MISC = 139264, LDS_SCR = LDS_MISC + 256, LDS_BYTES = 163840;

struct Args { const void* in[32]; float* out; unsigned char* ws; int ph_lo, ph_hi; };

__device__ __forceinline__ float bf2f(unsigned short b) { return __uint_as_float((unsigned)b << 16); }
__device__ __forceinline__ unsigned pk(float lo, float hi) { return pg8::cvt_pk_bf16(lo, hi); }
template <int CTRL> __device__ __forceinline__ float dppf(float v) { return __builtin_bit_cast(float, __builtin_amdgcn_update_dpp(0, __builtin_bit_cast(int, v), CTRL, 0xf, 0xf, true)); }
__device__ __forceinline__ float wsum(float v) {
    v += dppf<0xB1>(v); v += dppf<0x4E>(v); v += dppf<0x141>(v); v += dppf<0x140>(v);
    const int b = __builtin_bit_cast(int, v);
    return (__builtin_bit_cast(float, __builtin_amdgcn_readlane(b, 0)) + __builtin_bit_cast(float, __builtin_amdgcn_readlane(b, 16))) + (__builtin_bit_cast(float, __builtin_amdgcn_readlane(b, 32)) + __builtin_bit_cast(float, __builtin_amdgcn_readlane(b, 48)));
}
__device__ __forceinline__ int launder(int x) { asm volatile("" : "+v"(x)); return x; }
__device__ __forceinline__ float ex2(float x) { return __builtin_amdgcn_exp2f(x); }
__device__ __forceinline__ float gelu_t(float x) {
    const float u = 0.7978845608028654f * (x + 0.044715f * x * x * x);
    return x * __builtin_amdgcn_rcpf(1.f + ex2(-2.f * LOG2E * u));
}
__device__ __forceinline__ int crow(int r, int hi) { return (r & 3) + 8 * (r >> 2) + 4 * hi; }
__device__ __forceinline__ f32x16 mfma32(bf16x8 a, bf16x8 b, f32x16 c) { return __builtin_amdgcn_mfma_f32_32x32x16_bf16(a, b, c, 0, 0, 0); }
__device__ __forceinline__ bf16x8 ld8g(const bf16_t* p) { return *(const bf16x8*)p; }
typedef short v4i16_t __attribute__((ext_vector_type(4)));
__device__ __forceinline__ s16x4 trld(const LAS unsigned char* p) { return __builtin_bit_cast(s16x4, __builtin_amdgcn_ds_read_tr16_b64_v4i16((LAS v4i16_t*)p)); }

struct Frame {
    LAS unsigned char* lds; gu32* ctl; unsigned char* ws;
    int tid, lane, wave, vcu, G;
    const void* const* in; float* out;
};

struct EpiTile {
    static constexpr bool PERM = true, AFTER_DRAIN = false;
    bf16_t* O; int ldc; int ngelu; int nscale; float scale; int pad;
    __device__ __forceinline__ void operator()(const f32x4 (&acc)[2][2][4][2], const Unit& u, int wr, int wc, int fr, int fq) const {
        const int row0 = u.pm * 256 + wr * 64 + fr, col0 = u.pn * 256 + wc * 32 + 8 * fq;
        const bool dg = u.pn < ngelu; const float sc = (u.pn < nscale) ? scale : 1.f;
#pragma unroll
        for (int ai = 0; ai < 2; ++ai)
#pragma unroll
            for (int m = 0; m < 4; ++m) { bf16_t* rowp = O + (size_t)(row0 + ai * 128 + m * 16) * ldc + col0;
#pragma unroll
                for (int bj = 0; bj < 2; ++bj) { f32x4 v0 = acc[ai][bj][m][0], v1 = acc[ai][bj][m][1];
                    if (dg) { v0 = (f32x4){gelu_t(v0[0]), gelu_t(v0[1]), gelu_t(v0[2]), gelu_t(v0[3])}; v1 = (f32x4){gelu_t(v1[0]), gelu_t(v1[1]), gelu_t(v1[2]), gelu_t(v1[3])}; }
                    v0 = v0 * sc; v1 = v1 * sc;
                    u32x4 w; w.x = pk(v0[0], v0[1]); w.y = pk(v0[2], v0[3]); w.z = pk(v1[0], v1[1]); w.w = pk(v1[2], v1[3]);
                    *(u32x4*)(rowp + bj * 128) = w; } }
    }
};
struct EpiResid {
    static constexpr bool PERM = false, AFTER_DRAIN = false;
    const float* X; float* Z;
    __device__ __forceinline__ void operator()(const f32x4 (&acc)[2][2][4][2], const Unit& u, int wr, int wc, int fr, int fq) const {
        const int col0 = u.pn * 256 + wc * 32 + 4 * fq;
#pragma unroll
        for (int ai = 0; ai < 2; ++ai)
#pragma unroll
            for (int mp = 0; mp < 2; ++mp) { f32x4 x[2][2][2];
#pragma unroll
                for (int m2 = 0; m2 < 2; ++m2) { const size_t off = (size_t)(u.pm * 256 + ai * 128 + wr * 64 + (2 * mp + m2) * 16 + fr) * D + col0;
#pragma unroll
                    for (int bj = 0; bj < 2; ++bj)
#pragma unroll
                        for (int n = 0; n < 2; ++n) x[m2][bj][n] = *(const f32x4*)(X + off + bj * 128 + n * 16); }
#pragma unroll
                for (int m2 = 0; m2 < 2; ++m2) { const size_t off = (size_t)(u.pm * 256 + ai * 128 + wr * 64 + (2 * mp + m2) * 16 + fr) * D + col0;
#pragma unroll
                    for (int bj = 0; bj < 2; ++bj)
#pragma unroll
                        for (int n = 0; n < 2; ++n) *(f32x4*)(Z + off + bj * 128 + n * 16) = x[m2][bj][n] * ALPHA + acc[ai][bj][2 * mp + m2][n]; } }
    }
};
struct EpiQ {
    static constexpr bool PERM = false, AFTER_DRAIN = false;
    unsigned char* ws;
    __device__ __forceinline__ void operator()(const f32x4 (&acc)[2][2][4][2], const Unit& u, int wr, int wc, int fr, int fq) const {
        bf16_t* Q = (bf16_t*)(ws + S_Q96); const float* rinv = (const float*)(ws + WS_RINV); const float* rope = (const float*)(ws + WS_ROPE);
#pragma unroll
        for (int ai = 0; ai < 2; ++ai)
#pragma unroll
            for (int m = 0; m < 4; ++m) { const int row = u.pm * 256 + ai * 128 + wr * 64 + m * 16 + fr; const float sc = rinv[row * 2];
#pragma unroll
                for (int bj = 0; bj < 2; ++bj) { const int blk = u.pn * 8 + bj * 4 + wc; f32x4 x1 = acc[ai][bj][m][0] * sc, x2 = acc[ai][bj][m][1] * sc;
                    if (blk % 3 == 2) { const f32x4 c = *(const f32x4*)(rope + (size_t)row * 32 + 4 * fq), sn = *(const f32x4*)(rope + (size_t)row * 32 + 16 + 4 * fq);
                        const f32x4 y1 = x1 * c - x2 * sn, y2 = x1 * sn + x2 * c; x1 = y1; x2 = y2; }
                    bf16_t* o = Q + (size_t)row * 768 + blk * 32 + 4 * fq;
                    u32x2 w; w.x = pk(x1[0], x1[1]); w.y = pk(x1[2], x1[3]); *(u32x2*)o = w; w.x = pk(x2[0], x2[1]); w.y = pk(x2[2], x2[3]); *(u32x2*)(o + 16) = w; }
                asm volatile("" ::: "memory"); }
    }
};
struct EpiKV {
    static constexpr bool PERM = true, AFTER_DRAIN = false;
    unsigned char* ws;
    __device__ __forceinline__ void operator()(const f32x4 (&acc)[2][2][4][2], const Unit& u, int wr, int wc, int fr, int fq) const {
        const float* rinv = (const float*)(ws + WS_RINV);
        bf16_t* O = (bf16_t*)(ws + ((u.pn < 2) ? S_KN : S_V)); const int col0 = (u.pn & 1) * 256 + wc * 32 + 8 * fq;
#pragma unroll
        for (int ai = 0; ai < 2; ++ai)
#pragma unroll
            for (int m = 0; m < 4; ++m) { const int row = u.pm * 256 + ai * 128 + wr * 64 + m * 16 + fr; const float sc = rinv[row * 2 + 1];
#pragma unroll
                for (int bj = 0; bj < 2; ++bj) { const f32x4 v0 = acc[ai][bj][m][0] * sc, v1 = acc[ai][bj][m][1] * sc;
                    u32x4 w; w.x = pk(v0[0], v0[1]); w.y = pk(v0[2], v0[3]); w.z = pk(v1[0], v1[1]); w.w = pk(v1[2], v1[3]);
                    *(u32x4*)(O + (size_t)row * 512 + col0 + bj * 128) = w; }
                asm volatile("" ::: "memory"); }
    }
};
struct EpiMoeUp {
    static constexpr bool PERM = true, AFTER_DRAIN = false;
    bf16_t* H;
    __device__ __forceinline__ void operator()(const f32x4 (&acc)[2][2][4][2], const Unit& u, int wr, int wc, int fr, int fq) const {
        const int row0 = u.pm * 256 + wr * 64 + fr, col0 = (u.pn & 1) * 128 + wc * 16 + 4 * fq;
#pragma unroll
        for (int ai = 0; ai < 2; ++ai)
#pragma unroll
            for (int m = 0; m < 4; ++m) { bf16_t* rowp = H + (size_t)(row0 + ai * 128 + m * 16) * 256 + col0;
#pragma unroll
                for (int bj = 0; bj < 2; ++bj) { const f32x4 g = acc[ai][bj][m][0], up = acc[ai][bj][m][1]; f32x4 h;
#pragma unroll
                    for (int e = 0; e < 4; ++e) h[e] = g[e] * __builtin_amdgcn_rcpf(1.f + ex2(-LOG2E * g[e])) * up[e];
                    u32x2 w; w.x = pk(h[0], h[1]); w.y = pk(h[2], h[3]); *(u32x2*)(rowp + bj * 64) = w; } }
    }
};
struct EpiMoeDown {
    static constexpr bool PERM = true, AFTER_DRAIN = false;
    bf16_t* Y;
    __device__ __forceinline__ void operator()(const f32x4 (&acc)[2][2][4][2], const Unit& u, int wr, int wc, int fr, int fq) const {
        const int row0 = u.pm * 256 + wr * 64 + fr, col0 = (u.pn & 3) * 256 + wc * 32 + 8 * fq;
#pragma unroll
        for (int ai = 0; ai < 2; ++ai)
#pragma unroll
            for (int m = 0; m < 4; ++m) { bf16_t* rowp = Y + (size_t)(row0 + ai * 128 + m * 16) * D + col0;
#pragma unroll
                for (int bj = 0; bj < 2; ++bj) { const f32x4 v0 = acc[ai][bj][m][0], v1 = acc[ai][bj][m][1];
                    u32x4 w; w.x = pk(v0[0], v0[1]); w.y = pk(v0[2], v0[3]); w.z = pk(v1[0], v1[1]); w.w = pk(v1[2], v1[3]);
                    *(u32x4*)(rowp + bj * 128) = w; } }
    }
};
template <int NC> struct MoeOrder {
    const LAS int* pe; int nunits, G, c;
    const LAS int* ebase; const int* expl;
    __device__ __forceinline__ int arow(const Unit& u, int r) const { const int e = u.pn / NC; return expl[(size_t)e * T + (u.pm * 256 + r - ebase[e])] & (T - 1); }
    __device__ __forceinline__ bool next(int i, Unit& u) const { const int L = i * G + c; if (L >= nunits) return false; const int p = L / NC; u.pm = p; u.pn = pe[p] * NC + (L % NC); return true; }
    __device__ __forceinline__ void a_ready(const Unit&) const {}
    __device__ __forceinline__ void done(const Unit&) const {}
};

__device__ __forceinline__ void p0_load(float (&wv)[32], const float* W, int ldw, int N, int item, int lane) {
    const int nblk = (N + 31) / 32, kb = item / nblk, nb = item % nblk, k0 = 64 * kb, n0 = 32 * nb, nn = n0 + (lane & 31);
#pragma unroll
    for (int i = 0; i < 32; ++i) { const int kk = 2 * i + (lane >> 5); wv[i] = (nn < N) ? W[(size_t)(k0 + kk) * ldw + nn] : 0.f; }
}
__device__ __forceinline__ void p0_finish(const float (&wv)[32], int K, int N, bf16_t* WT, int rmode, int row_off, const float* kscale, LAS float* scr, int item, int lane) {
    const int nblk = (N + 31) / 32, kb = item / nblk, nb = item % nblk, k0 = 64 * kb, n0 = 32 * nb;
#pragma unroll
    for (int i = 0; i < 32; ++i) { const int kk = 2 * i + (lane >> 5); float v = wv[i]; if (kscale) v *= kscale[k0 + kk]; scr[kk * 33 + (lane & 31)] = v; }
    LDS_WAIT(); asm volatile("" ::: "memory");
    const int c = lane & 7;
#pragma unroll
    for (int j = 0; j < 4; ++j) { const int n = (lane >> 3) + 8 * j; const LAS float* s = scr + (8 * c) * 33 + n;
        v4u o; o.x = pk(s[0 * 33], s[1 * 33]); o.y = pk(s[2 * 33], s[3 * 33]); o.z = pk(s[4 * 33], s[5 * 33]); o.w = pk(s[6 * 33], s[7 * 33]);
        const int ng = n0 + n; const int r = (rmode == 0) ? row_off + ng : (row_off + (ng >> 2) * 8 + (rmode == 2 ? 4 : 0) + (ng & 3));
        *(GAS v4u*)(WT + (size_t)r * K + k0 + 8 * c) = o; }
    LDS_WAIT(); asm volatile("" ::: "memory");
}
__device__ __forceinline__ void p0_item(const float* W, int ldw, int K, int N, bf16_t* WT, int rmode, int row_off, const float* kscale, LAS float* scr, int item, int lane) {
    float wv[32]; p0_load(wv, W, ldw, N, item, lane); p0_finish(wv, K, N, WT, rmode, row_off, kscale, scr, item, lane);
}
__device__ __forceinline__ void p0_item_k(const float* W, int ldw, int K, int KP, int N, bf16_t* WT, int rmode, int row_off, const float* kscale, LAS float* scr, int item, int lane) {
    (void)K; float wv[32]; p0_load(wv, W, ldw, N, item, lane); p0_finish(wv, KP, N, WT, rmode, row_off, kscale, scr, item, lane);
}
struct ConvJob { const float* W; int ldw, K, N; bf16_t* WT; int rmode, row_off; const float* kscale; int nitems; };

__device__ __forceinline__ void p0_prologue(Frame& F) {
    LAS float* scr = (LAS float*)(F.lds + RING_OFF + F.wave * 16384);
    const int gw = F.vcu * NWAVES + F.wave, NGW = F.G * NWAVES;
    unsigned char* ws = F.ws;
    {
        const float* in2 = (const float*)F.in[2];
#define JOB2(Wp, ldw_, K_, N_, dst, rm, ro, ks) { const int nit = ((K_) / 64) * (((N_) + 31) / 32); if (it < nit) { p0_item_k((const float*)(Wp), ldw_, K_, 256, N_, (bf16_t*)(dst), rm, ro, ks, scr, it, F.lane); continue; } it -= nit; }
#define JOB(Wp, ldw_, K_, N_, dst, rm, ro, ks) { const int nit = ((K_) / 64) * (((N_) + 31) / 32); if (it < nit) { p0_item((const float*)(Wp), ldw_, K_, N_, (bf16_t*)(dst), rm, ro, ks, scr, it, F.lane); continue; } it -= nit; }
        constexpr int TOT = 16 * 45 + 4 * 24 + 2 * 16 + 2 * 16 + 16 * 32 + 16 * 58 + 32 * 8 * 2 + 4 * 2 * 2 + 16 * 32;
        for (int it0 = gw; it0 < TOT; it0 += NGW) { int it = it0;
            JOB(in2, 1440, 1024, 1440, ws + WS_W0IN, 0, 0, nullptr)
            JOB(F.in[9], 768, 256, 768, ws + WS_WUQ, 0, 0, (const float*)F.in[7])
            JOB2(F.in[10], 512, 128, 512, ws + WS_WUKV, 0, 0, (const float*)F.in[8])
            JOB2(F.in[11], 512, 128, 512, ws + WS_WUKV, 0, 512, (const float*)F.in[8])
            JOB(F.in[12], 1024, 1024, 1024, ws + WS_W0O, 0, 0, nullptr)
            JOB(F.in[13], 1840, 1024, 1840, ws + WS_W1IN, 0, 0, nullptr)
            JOB(F.in[15], 256, 2048, 256, ws + WS_WCK1, 0, 0, nullptr)
            JOB(F.in[17], 256, 2048, 256, ws + WS_WCV1, 0, 0, nullptr)
            JOB(F.in[16], 64, 256, 64, ws + WS_WCK2, 0, 0, nullptr)
            JOB(F.in[18], 64, 256, 64, ws + WS_WCV2, 0, 0, nullptr)
            JOB(F.in[20], 1024, 1024, 1024, ws + WS_W1O, 0, 0, nullptr)
        }
#undef JOB
#undef JOB2
    }
    {
        constexpr int IG = 16 * 8, ID = 4 * 32, PER = 2 * IG + ID;
        for (int it0 = gw; it0 < 64 * PER; it0 += NGW) { const int le = it0 / PER; int it = it0 % PER;
            bf16_t* gu = (bf16_t*)(ws + WS_WGU) + (size_t)le * 512 * 1024; bf16_t* wd = (bf16_t*)(ws + WS_WD) + (size_t)le * 1024 * 256;
            if (it < IG) { p0_item((const float*)F.in[25] + (size_t)le * 1024 * 256, 256, 1024, 256, gu, 1, 0, nullptr, scr, it, F.lane); continue; } it -= IG;
            if (it < IG) { p0_item((const float*)F.in[26] + (size_t)le * 1024 * 256, 256, 1024, 256, gu, 2, 0, nullptr, scr, it, F.lane); continue; } it -= IG;
            p0_item((const float*)F.in[27] + (size_t)le * 256 * 1024, 1024, 256, 1024, wd, 0, 0, nullptr, scr, it, F.lane);
        }
    }
    const int gt = F.vcu * NTHR + F.tid, NGT = F.G * NTHR;
    { v4u z = {0u, 0u, 0u, 0u};
      for (int i = gt; i < 96 * 128; i += NGT) *(GAS v4u*)((bf16_t*)(ws + WS_W0IN) + (size_t)1440 * 1024 + (size_t)i * 8) = z;
      for (int i = gt; i < 192 * 128; i += NGT) *(GAS v4u*)((bf16_t*)(ws + WS_W1IN) + (size_t)1856 * 1024 + (size_t)i * 8) = z; }
    { float* rope = (float*)(ws + WS_ROPE); const int* pos = (const int*)F.in[1];
      for (int i = gt; i < T * 16; i += NGT) { const int tok = i >> 4, j = i & 15; const float ang = (float)pos[tok] * expf(-9.210340371976184f * (float)j * (1.f / 16.f));
          double a = (double)ang; a -= 6.283185307179586 * rint(a * 0.15915494309189535); const float r = (float)a;
          rope[tok * 32 + j] = cosf(r); rope[tok * 32 + 16 + j] = sinf(r); }
      v4u z = {0u, 0u, 0u, 0u};
      for (int i = gt; i < 1024 * 16; i += NGT) *(GAS v4u*)((bf16_t*)(ws + WS_WUKV) + (size_t)(i >> 4) * 256 + 128 + (i & 15) * 8) = z; }
    { const float* gws = (const float*)F.in[5]; bf16_t* wsb = (bf16_t*)(ws + WS_WSB);
      for (int i = gt; i < 4 * 128 * 128; i += NGT) { const int s = i & 127, t = (i >> 7) & 127; wsb[i] = (bf16_t)(pk(s <= t ? gws[i] : 0.f, 0.f) & 0xffffu); } }
    {
      float* cb = (float*)(ws + WS_CBIAS);
      for (int o = gw; o < 512; o += NGW) { const int kv = o >> 8, h = o & 255; const float* pos = (const float*)F.in[14] + kv * 2048; const float* w1 = (const float*)F.in[kv ? 17 : 15];
          float a = 0.f; for (int k = F.lane; k < 2048; k += 64) a += pos[k] * w1[(size_t)k * 256 + h];
          a = wsum(a); if (F.lane == 0) cb[o] = a; } }
    { const float* x = (const float*)F.in[0]; bf16_t* xb = (bf16_t*)(ws + S_XB);
#pragma unroll 4
      for (int i = gt; i < T * D / 8; i += NGT) { const f32x4 a = *(const GAS f32x4*)(x + (size_t)i * 8), b = *(const GAS f32x4*)(x + (size_t)i * 8 + 4);
          v4u o; o.x = pk(a[0], a[1]); o.y = pk(a[2], a[3]); o.z = pk(b[0], b[1]); o.w = pk(b[2], b[3]); *(GAS v4u*)(xb + (size_t)i * 8) = o; } }
}

__device__ __forceinline__ void wt_load(u32x4 (&v)[4], const unsigned char* base, unsigned pitch, int lane) {
#pragma unroll
    for (int i = 0; i < 4; ++i) v[i] = *(const u32x4*)(base + (size_t)(8 * i + (lane >> 3)) * pitch + (lane & 7) * 16);
}
__device__ __forceinline__ void wt_store(LAS unsigned char* t, const u32x4 (&v)[4], int lane) {
#pragma unroll
    for (int i = 0; i < 4; ++i) { const int row = 8 * i + (lane >> 3); *(LAS u32x4*)(t + row * 128 + (((lane & 7) ^ ((row >> 1) & 7)) << 4)) = v[i]; }
}
__device__ __forceinline__ bf16x8 wt_frag(const LAS unsigned char* t, int ks, int lane) { const int r32 = lane & 31; return *(const LAS bf16x8*)(t + r32 * 128 + (((2 * ks + (lane >> 5)) ^ ((r32 >> 1) & 7)) << 4)); }

__device__ __forceinline__ void store4(bf16_t* p, float a, float b, float c, float d) { u32x2 w; w.x = pk(a, b); w.y = pk(c, d); *(u32x2*)p = w; }
__device__ __forceinline__ void mla_prep_rows(Frame& F) {
    const int lane = F.lane; const bf16_t* H0B = (const bf16_t*)(F.ws + S_H0B);
    float* rinv = (float*)(F.ws + WS_RINV); const float* rope = (const float*)(F.ws + WS_ROPE); bf16_t* KRB = (bf16_t*)(F.ws + S_KRB);
    const int gw = F.vcu * NWAVES + F.wave, NGW = F.G * NWAVES;
    for (int t0 = gw * 4; t0 < T; t0 += NGW * 4) {
        s16x4 cq[4]; unsigned ck[4]; float x1[4], x2[4], cc[4], ss[4];
#pragma unroll
        for (int u = 0; u < 4; ++u) { const bf16_t* h = H0B + (size_t)(t0 + u) * 1536; cq[u] = *(const s16x4*)(h + 1024 + lane * 4); ck[u] = *(const unsigned*)(h + 1280 + lane * 2);
            x1[u] = bf2f(h[1408 + (lane & 15)]); x2[u] = bf2f(h[1408 + 16 + (lane & 15)]); cc[u] = rope[(size_t)(t0 + u) * 32 + (lane & 15)]; ss[u] = rope[(size_t)(t0 + u) * 32 + 16 + (lane & 15)]; }
#pragma unroll
        for (int u = 0; u < 4; ++u) { float q = 0.f;
#pragma unroll
            for (int e = 0; e < 4; ++e) { const float v = bf2f((unsigned short)cq[u][e]); q += v * v; }
            const float a = __uint_as_float(ck[u] << 16), b = __uint_as_float(ck[u] & 0xffff0000u); const float k = a * a + b * b;
            const float sq = wsum(q), sk = wsum(k);
            if (lane == 0) { rinv[(size_t)(t0 + u) * 2] = rsqrtf(sq * (1.f / 256.f) + LN_EPS) * QS_MLA; rinv[(size_t)(t0 + u) * 2 + 1] = rsqrtf(sk * (1.f / 128.f) + LN_EPS); }
            if (lane < 16) { KRB[(size_t)(t0 + u) * 32 + lane] = (bf16_t)(pk(x1[u] * cc[u] - x2[u] * ss[u], 0.f) & 0xffffu); KRB[(size_t)(t0 + u) * 32 + 16 + lane] = (bf16_t)(pk(x1[u] * ss[u] + x2[u] * cc[u], 0.f) & 0xffffu); } }
    }
}

constexpr int VN_STR = 1088;
__device__ __forceinline__ void gmlp_chunk(Frame& F, int chunk, bool dry = false) {
    const int lane = F.lane, wave = F.wave, r32 = lane & 31, hi = lane >> 5;
    bf16_t* H0B = (bf16_t*)(F.ws + S_H0B);
    const float* lng = (const float*)F.in[3]; const float* lnb = (const float*)F.in[4];
    LAS unsigned char* img = F.lds + RING_OFF;
    float g8[8], b8[8];
#pragma unroll
    for (int e = 0; e < 8; ++e) { g8[e] = lng[lane * 8 + e]; b8[e] = lnb[lane * 8 + e]; }
#pragma unroll 4
    for (int i = 0; i < 16; ++i) { const int row = wave * 16 + i; const bf16x8 x = ld8g(H0B + (size_t)(chunk * 128 + row) * 1536 + 512 + lane * 8);
        float v[8]; float s = 0.f;
#pragma unroll
        for (int e = 0; e < 8; ++e) { v[e] = bf2f((unsigned short)x[e]); s += v[e]; }
        const float mean = wsum(s) * (1.f / 512.f); float q = 0.f;
#pragma unroll
        for (int e = 0; e < 8; ++e) { v[e] -= mean; q += v[e] * v[e]; }
        const float rstd = rsqrtf(wsum(q) * (1.f / 512.f) + LN_EPS);
#pragma unroll
        for (int e = 0; e < 8; ++e) v[e] = v[e] * rstd * g8[e] + b8[e];
        u32x4 w; w.x = pk(v[0], v[1]); w.y = pk(v[2], v[3]); w.z = pk(v[4], v[5]); w.w = pk(v[6], v[7]);
        *(LAS u32x4*)(img + row * VN_STR + lane * 16) = w; }
    __syncthreads();
    const int g = wave >> 1, th = wave & 1;
    const bf16_t* wsb = (const bf16_t*)(F.ws + WS_WSB) + (size_t)g * 128 * 128;
    const float* bs = (const float*)F.in[6] + g * 128;
    const int i15 = lane & 15, g1 = (lane >> 4) & 1;
#pragma unroll 1
    for (int nt = 0; nt < 2; ++nt) {
        const int t = th * 64 + nt * 32 + r32;
        const int nks = (th * 64 + nt * 32 + 31) / 16 + 1;
        bf16x8 bw[8];
#pragma unroll
        for (int ks = 0; ks < 8; ++ks) bw[ks] = ld8g(wsb + (size_t)t * 128 + ks * 16 + hi * 8);
        const float bias = bs[t];
#pragma unroll 1
        for (int ct = 0; ct < 4; ++ct) {
            const LAS unsigned char* abase = img + (8 * hi + (i15 >> 2)) * VN_STR + (g * 128 + ct * 32 + 16 * g1 + 4 * (i15 & 3)) * 2;
            f32x16 acc = {};
#pragma unroll
            for (int ks = 0; ks < 8; ++ks) { if (ks < nks) {
                const s16x4 lo = trld(abase + (16 * ks) * VN_STR), hi4 = trld(abase + (16 * ks + 4) * VN_STR);
                const bf16x8 a = {lo[0], lo[1], lo[2], lo[3], hi4[0], hi4[1], hi4[2], hi4[3]};
                acc = mfma32(a, bw[ks], acc); } }
            bf16_t* urow = H0B + (size_t)(chunk * 128 + t) * 1536 + g * 128 + ct * 32 + 4 * hi;
            bf16_t* orow = dry ? ((bf16_t*)(F.ws + WS_Z1) + (urow - H0B)) : urow;
#pragma unroll
            for (int g4 = 0; g4 < 4; ++g4) { const s16x4 uu = *(const s16x4*)(urow + 8 * g4);
                store4(orow + 8 * g4, bf2f((unsigned short)uu[0]) * (acc[4 * g4] + bias), bf2f((unsigned short)uu[1]) * (acc[4 * g4 + 1] + bias),
                       bf2f((unsigned short)uu[2]) * (acc[4 * g4 + 2] + bias), bf2f((unsigned short)uu[3]) * (acc[4 * g4 + 3] + bias)); }
        }
    }
    __syncthreads();
}

constexpr float NEGF = -1e30f;
__device__ __forceinline__ void pack_p(u32x4 (&pw)[4], const f32x16& p0, const f32x16& p1) {
    pw[0] = (u32x4){pk(p0[0], p0[1]), pk(p0[2], p0[3]), pk(p0[4], p0[5]), pk(p0[6], p0[7])}; pw[1] = (u32x4){pk(p0[8], p0[9]), pk(p0[10], p0[11]), pk(p0[12], p0[13]), pk(p0[14], p0[15])};
    pw[2] = (u32x4){pk(p1[0], p1[1]), pk(p1[2], p1[3]), pk(p1[4], p1[5]), pk(p1[6], p1[7])}; pw[3] = (u32x4){pk(p1[8], p1[9]), pk(p1[10], p1[11]), pk(p1[12], p1[13]), pk(p1[14], p1[15])};
}
struct AttnSt { f32x16 o[2]; f32x16 negm; float mref, l; int started; };
__device__ __forceinline__ void attn_reset(AttnSt& st) { st.o[0] = f32x16{}; st.o[1] = f32x16{}; st.negm = f32x16{}; st.mref = 0.f; st.l = 0.f; st.started = 0; }
constexpr int KV_ROPE = 8192;
template <bool ROPE> struct KvL { static constexpr int V = ROPE ? 12288 : 8192, SUB = ROPE ? 20480 : 16384, BUF = 2 * SUB; };
template <int NKS>
__device__ __forceinline__ void qk_tile(f32x16& p0, f32x16& p1, const LAS unsigned char* Kt, const bf16x8* qf, const f32x16& cinit, int lane) {
    const int r32 = lane & 31, hi = lane >> 5, sw = (r32 >> 1) & 7;
    const LAS unsigned char* kp = Kt + r32 * 128;
#pragma unroll
    for (int ks = 0; ks < NKS; ++ks) {
        bf16x8 a0, a1;
        if (ks < 4) { const int off = ((2 * ks + hi) ^ sw) << 4; a0 = *(const LAS bf16x8*)(kp + off); a1 = *(const LAS bf16x8*)(kp + 4096 + off); }
        else { const LAS unsigned char* rp = Kt + KV_ROPE + r32 * 64 + (((2 * (ks - 4) + hi) ^ ((r32 >> 2) & 3)) << 4); a0 = *(const LAS bf16x8*)rp; a1 = *(const LAS bf16x8*)(rp + 2048); }
        if (ks == 0) { p0 = mfma32(a0, qf[0], cinit); p1 = mfma32(a1, qf[0], cinit); } else { p0 = mfma32(a0, qf[ks], p0); p1 = mfma32(a1, qf[ks], p1); } }
}
__device__ __forceinline__ float max3(float a, float b, float c) { return fmaxf(fmaxf(a, b), c); }
constexpr float ATT_THR = 8.f;
template <class Mask>
__device__ __forceinline__ void softmax2(f32x16& p0, f32x16& p1, AttnSt& st, bool need_mask, const Mask& valid, bool lanebit, int lane, u32x4 (&pw)[4]) {
    const int hi = lane >> 5;
    if (need_mask) {
#pragma unroll
        for (int r = 0; r < 16; ++r) { const int k0 = crow(r, hi); if (!valid(k0)) p0[r] = NEGF; if (!valid(k0 + 32)) p1[r] = NEGF; } }
    float ma = max3(p0[0], p0[1], p1[0]), mb = max3(p0[2], p0[3], p1[1]); ma = max3(ma, p1[2], p1[3]);
#pragma unroll
    for (int r = 4; r < 16; r += 4) { ma = max3(ma, p0[r], p0[r + 1]); mb = max3(mb, p0[r + 2], p0[r + 3]); ma = max3(ma, p1[r], p1[r + 1]); mb = max3(mb, p1[r + 2], p1[r + 3]); }
    float mx = fmaxf(ma, mb); mx = fmaxf(mx, __shfl_xor(mx, 32));
    if (!lanebit) mx = NEGF;
    const bool has = mx > -1e29f, fresh = has && !st.started;
    if (__any((mx > ATT_THR) || fresh)) {
        const float dl = has ? (fresh ? mx : fmaxf(mx, 0.f)) : 0.f;
        st.mref += dl; const float f = ex2(-dl); st.l *= f;
#pragma unroll
        for (int r = 0; r < 16; ++r) { p0[r] -= dl; p1[r] -= dl; st.o[0][r] *= f; st.o[1][r] *= f; st.negm[r] = -st.mref; }
        st.started |= has ? 1 : 0;
    }
    float sa = 0.f, sb = 0.f;
#pragma unroll
    for (int r = 0; r < 16; ++r) { p0[r] = ex2(p0[r]); p1[r] = ex2(p1[r]); sa += p0[r]; sb += p1[r]; }
    pack_p(pw, p0, p1);
    float sum = sa + sb;
    if (!lanebit) { sum = 0.f;
#pragma unroll
        for (int i = 0; i < 4; ++i) pw[i] = (u32x4){0u, 0u, 0u, 0u}; }
    st.l += sum;
}
__device__ __forceinline__ void pv_packed(f32x16 (&o)[2], const LAS unsigned char* Vt, const u32x4 (&pw)[4], int lane) {
    const int i15 = lane & 15, g1 = (lane >> 4) & 1, hi = lane >> 5, bsw = (i15 >> 3) & 1;
    const LAS unsigned char* vrow = Vt + (4 * hi + (i15 >> 2)) * 128 + (2 * g1 + ((i15 & 3) >> 1)) * 16 + (i15 & 1) * 8;
    const LAS unsigned char* vb0 = vrow + 64 * bsw; const LAS unsigned char* vb1 = vrow + 64 * (bsw ^ 1);
#pragma unroll
    for (int db = 0; db < 2; ++db)
#pragma unroll
        for (int s = 0; s < 4; ++s) { const LAS unsigned char* vb = db ? vb1 : vb0; const s16x4 lo = trld(vb + s * 2048), h4 = trld(vb + s * 2048 + 1024);
            const bf16x8 a = {lo[0], lo[1], lo[2], lo[3], h4[0], h4[1], h4[2], h4[3]};
            o[db] = mfma32(a, __builtin_bit_cast(bf16x8, pw[s]), o[db]); }
}
#define LDS_BAR() asm volatile("s_waitcnt lgkmcnt(0)\n\ts_barrier" ::: "memory")
__device__ __forceinline__ void glds16(const void* gsrc, unsigned lds_dst) { unsigned keep;
    asm volatile("s_mov_b32 %0, m0\n\ts_mov_b32 m0, %2\n\ts_nop 0\n\tglobal_load_lds_dwordx4 %1, off\n\ts_mov_b32 m0, %0" : "=&s"(keep) : "v"(gsrc), "s"(lds_dst) : "memory"); }
template <bool ROPE, class Src>
__device__ __forceinline__ void dma_tile(const Src& src, int j, LAS unsigned char* buf, int wave, unsigned koff, unsigned voff, unsigned roff) {
    const unsigned b = (unsigned)(size_t)buf;
    glds16(src.kbase(j) + koff, (unsigned)__builtin_amdgcn_readfirstlane(b + wave * 1024));
    glds16(src.vbase(j) + voff, (unsigned)__builtin_amdgcn_readfirstlane(b + KvL<ROPE>::V + wave * 1024));
    if (ROPE) glds16(src.rbase(j) + roff, (unsigned)__builtin_amdgcn_readfirstlane(b + KV_ROPE + (wave & 3) * 1024));
}
#define VMW(n) asm volatile("s_waitcnt vmcnt(" #n ")" ::: "memory")
struct NoHook { __device__ __forceinline__ void operator()(int) const {} };
template <int NKS, class It, class Src, class Act, class Mask, class Hook = NoHook>
__device__ __forceinline__ void attn_loop(AttnSt& st, const bf16x8* qf, It it, const Src& src, const Act& active, const Mask& mask, LAS unsigned char* kv, int tid_, int lane_, int abl = 0, const Hook& hook = Hook()) {
    const int tid = launder(tid_), lane = tid & 63, wave = __builtin_amdgcn_readfirstlane(tid >> 6); (void)lane_;
    constexpr bool ROPE = (NKS > 4); constexpr int SUB = KvL<ROPE>::SUB, BUF = KvL<ROPE>::BUF, VO = KvL<ROPE>::V;
    int a0 = it.next(); if (a0 < 0) return;
    int b0 = it.next();
    unsigned koff, voff, roff;
    { const int row = wave * 8 + (lane >> 3), c = lane & 7; koff = (unsigned)row * src.kpitch + (unsigned)((c ^ ((row >> 1) & 7)) << 4); voff = (unsigned)row * src.vpitch + (unsigned)((c ^ (((row >> 1) & 1) << 2)) << 4);
      const int rr = (wave & 3) * 16 + (lane >> 2), rc = lane & 3; roff = (unsigned)rr * 64u + (unsigned)((rc ^ ((rr >> 2) & 3)) << 4); }
#define DMAP(A_, B_, BUFP) do { dma_tile<ROPE>(src, (A_), (BUFP), wave, koff, voff, roff); dma_tile<ROPE>(src, ((B_) >= 0) ? (B_) : (A_), (BUFP) + SUB, wave, koff, voff, roff); } while (0)
    int a1 = (b0 >= 0) ? it.next() : -1, b1 = (a1 >= 0) ? it.next() : -1;
    DMAP(a0, b0, kv);
    if (a1 >= 0) DMAP(a1, b1, kv + BUF);
    int bc = 0;
    for (;;) {
        if (a1 >= 0) { if (ROPE) VMW(6); else VMW(4); } else VMW(0);
        if (!(abl & 16)) LDS_BAR();
        int a2 = (b1 >= 0) ? it.next() : -1, b2 = (a2 >= 0) ? it.next() : -1;
        if (a2 >= 0 && !(abl & 8)) DMAP(a2, b2, kv + ((bc + 2) % 3) * BUF);
        else if (a2 >= 0) { }
#pragma unroll
        for (int sub = 0; sub < 2; ++sub) { const int jc = sub ? b0 : a0;
            if (jc >= 0 && active(jc)) { const LAS unsigned char* kb = kv + bc * BUF + sub * SUB;
                hook(jc);
                f32x16 p0, p1; u32x4 pw[4];
                if (!(abl & 1)) qk_tile<NKS>(p0, p1, kb, qf, st.negm, lane); else { p0 = st.negm; p1 = st.negm; }
                if (!(abl & 2)) softmax2(p0, p1, st, mask.need(jc), [&](int key) { return mask.valid(jc, key); }, mask.lanebit(jc), lane, pw); else pack_p(pw, p0, p1);
                if (!(abl & 4)) pv_packed(st.o, kb + VO, pw, lane); else st.o[0][0] += __uint_as_float(pw[0].x ^ pw[1].y ^ pw[2].z ^ pw[3].w); } }
        if (a1 < 0) break;
        a0 = a1; b0 = b1; a1 = a2; b1 = b2; bc = (bc + 1) % 3;
        if (abl & 8) { if (a1 >= 0 && false) {} }
    }
#undef DMAP
    LDS_BAR();
}
struct RangeIt { int j, end; __device__ __forceinline__ int next() { return (j < end) ? j++ : -1; } };
struct BitIt { unsigned m; __device__ __forceinline__ int next() { if (!m) return -1; const int j = __builtin_ctz(m); m &= m - 1; return j; } };

__device__ __forceinline__ void mla_attn_unit(Frame& F, int b, int h, int qb, int abl = 0) {
    const int lane = F.lane, wave = F.wave, r32 = lane & 31, hi = lane >> 5;
    const int q0 = qb * 256 + wave * 32, t = q0 + r32;
    const size_t rb = (size_t)b * S;
    const bf16_t* Q = (const bf16_t*)(F.ws + S_Q96) + (rb + t) * 768 + h * 96;
    const bf16_t* KN = (const bf16_t*)(F.ws + S_KN) + rb * 512 + h * 64; const bf16_t* KR = (const bf16_t*)(F.ws + S_KRB) + rb * 32; const bf16_t* V = (const bf16_t*)(F.ws + S_V) + rb * 512 + h * 64;
    bf16x8 qf[6];
#pragma unroll
    for (int ks = 0; ks < 6; ++ks) qf[ks] = ld8g(Q + ks * 16 + hi * 8);
    asm volatile("" : "+v"(qf[0]), "+v"(qf[1]), "+v"(qf[2]), "+v"(qf[3]), "+v"(qf[4]), "+v"(qf[5]));
    AttnSt st; attn_reset(st);
    struct Src { const unsigned char *KN, *KR, *V; unsigned kpitch, vpitch;
        __device__ __forceinline__ const unsigned char* kbase(int j) const { return KN + (size_t)j * 64 * 1024; }
        __device__ __forceinline__ const unsigned char* vbase(int j) const { return V + (size_t)j * 64 * 1024; }
        __device__ __forceinline__ const unsigned char* rbase(int j) const { return KR + (size_t)j * 64 * 64; } } src{(const unsigned char*)KN, (const unsigned char*)KR, (const unsigned char*)V, 1024u, 1024u};
    const int wlast = (q0 + 31) >> 6;
    struct MaskC { int t, tmin; __device__ __forceinline__ bool need(int j) const { return j * 64 + 63 > tmin; } __device__ __forceinline__ bool valid(int j, int key) const { return j * 64 + key <= t; }
        __device__ __forceinline__ bool lanebit(int) const { return true; } } mk{t, q0};
    if (!(abl & 32)) attn_loop<6>(st, qf, RangeIt{0, qb * 4 + 4}, src, [&](int j) { return j <= wlast; }, mk, F.lds + RING_OFF, F.tid, lane, abl); if (abl & 64) return;
    float l = st.l + __shfl_xor(st.l, 32); const float inv = 1.f / l;
    bf16_t* O = (bf16_t*)(F.ws + S_H0B) + (rb + t) * 1536 + 512 + h * 64 + 4 * hi;
#pragma unroll
    for (int db = 0; db < 2; ++db)
#pragma unroll
        for (int g4 = 0; g4 < 4; ++g4) store4(O + db * 32 + 8 * g4, st.o[db][4 * g4] * inv, st.o[db][4 * g4 + 1] * inv, st.o[db][4 * g4 + 2] * inv, st.o[db][4 * g4 + 3] * inv);
}

constexpr int NSA_IMP_OFF = 3 * KvL<false>::BUF, NSA_SEL_OFF = NSA_IMP_OFF + 8 * 32 * 33 * 4;
__device__ __forceinline__ void ob_add(u32x2 (&ob)[2][4], const f32x16 (&o)[2], float f, bool first) {
#pragma unroll
    for (int db = 0; db < 2; ++db)
#pragma unroll
        for (int g4 = 0; g4 < 4; ++g4) { float a0 = 0.f, a1 = 0.f, a2 = 0.f, a3 = 0.f;
            if (!first) { a0 = __uint_as_float(ob[db][g4].x << 16); a1 = __uint_as_float(ob[db][g4].x & 0xffff0000u); a2 = __uint_as_float(ob[db][g4].y << 16); a3 = __uint_as_float(ob[db][g4].y & 0xffff0000u); }
            ob[db][g4].x = pk(a0 + f * o[db][4 * g4], a1 + f * o[db][4 * g4 + 1]); ob[db][g4].y = pk(a2 + f * o[db][4 * g4 + 2], a3 + f * o[db][4 * g4 + 3]); }
}
__device__ __forceinline__ void nsa_unit(Frame& F, int b, int g, int tblk  , bool dry = false, int abl = 0) {
    const int lane = F.lane, wave = F.wave, tid = F.tid, r32 = lane & 31, hi = lane >> 5;
    const int t0 = tblk * 32, t = t0 + r32, tb = t0 >> 6, h = g * 8 + wave;
    const size_t rb = (size_t)b * S;
    bf16_t* H1B = (bf16_t*)(F.ws + S_H1B);
    bf16_t* qrow = H1B + (rb + t) * 2048;
    LAS unsigned char* kv = F.lds + RING_OFF;
    LAS float* impw = (LAS float*)(F.lds + NSA_IMP_OFF); LAS unsigned* selw = (LAS unsigned*)(F.lds + NSA_SEL_OFF);
    struct Src { const unsigned char *K, *V; unsigned kpitch, vpitch;
        __device__ __forceinline__ const unsigned char* kbase(int j) const { return K + (size_t)j * 64 * kpitch; }
        __device__ __forceinline__ const unsigned char* vbase(int j) const { return V + (size_t)j * 64 * vpitch; }
        __device__ __forceinline__ const unsigned char* rbase(int) const { return K; } };
    const int nk = (t0 >> 4) + 1;
    const int ntile = (nk + 63) >> 6;
    { Src sc{(const unsigned char*)((const bf16_t*)(F.ws + S_KCMP) + (size_t)(b * 2 + g) * 128 * 64), (const unsigned char*)((const bf16_t*)(F.ws + S_VCMP) + (size_t)(b * 2 + g) * 128 * 64), 128u, 128u};
      const int row = wave * 8 + (lane >> 3), c = lane & 7; const unsigned koff = (unsigned)row * 128u + (unsigned)((c ^ ((row >> 1) & 7)) << 4), voff = (unsigned)row * 128u + (unsigned)((c ^ (((row >> 1) & 1) << 2)) << 4);
      dma_tile<false>(sc, 0, kv, wave, koff, voff, 0u); if (ntile > 1) dma_tile<false>(sc, 1, kv + KvL<false>::SUB, wave, koff, voff, 0u); }
    bf16x8 qf[4];
#pragma unroll
    for (int ks = 0; ks < 4; ++ks) qf[ks] = ld8g(qrow + h * 64 + ks * 16 + hi * 8);
    bf16_t* orow = (dry ? ((bf16_t*)(F.ws + WS_Z1) + (qrow - H1B)) : qrow) + h * 64 + 4 * hi;
    const float* gate_b = (const float*)F.in[19];
    float gate[3];
#pragma unroll
    for (int br = 0; br < 3; ++br) { const float x = bf2f(qrow[1792 + br * 16 + h]) + gate_b[br * 16 + h]; gate[br] = __builtin_amdgcn_rcpf(1.f + ex2(-LOG2E * x)); }
    asm volatile("" : "+v"(qf[0]), "+v"(qf[1]), "+v"(qf[2]), "+v"(qf[3]), "+v"(gate[0]), "+v"(gate[1]), "+v"(gate[2]));
    if (tid == 0) selw[32] = 0u;
    u32x2 ob[2][4];
    {
        const int tid = launder(F.tid), lane = tid & 63, r32 = lane & 31, hi = lane >> 5;
        VMW(0); LDS_BAR();
        if (abl & 32) { f32x16 z2[2] = {f32x16{}, f32x16{}}; ob_add(ob, z2, 0.f, true); } else {
        f32x16 p[2][2]; float mx = NEGF;
#pragma unroll
        for (int tl = 0; tl < 2; ++tl) { __builtin_amdgcn_sched_barrier(0); if (tl < ntile) { qk_tile<4>(p[tl][0], p[tl][1], kv + tl * KvL<false>::SUB, qf, f32x16{}, lane);
#pragma unroll
                for (int kb = 0; kb < 2; ++kb)
#pragma unroll
                    for (int r = 0; r < 16; ++r) { const int n = tl * 64 + kb * 32 + crow(r, hi); if (t < 16 * n + 31) p[tl][kb][r] = NEGF; mx = fmaxf(mx, p[tl][kb][r]); } }
            else { p[tl][0] = f32x16{}; p[tl][1] = f32x16{};
#pragma unroll
                for (int r = 0; r < 16; ++r) { p[tl][0][r] = NEGF; p[tl][1][r] = NEGF; } } }
        mx = fmaxf(mx, __shfl_xor(mx, 32));
        const float muse = (mx < -1e29f) ? 0.f : mx; float sum = 0.f;
#pragma unroll
        for (int tl = 0; tl < 2; ++tl)
#pragma unroll
            for (int kb = 0; kb < 2; ++kb)
#pragma unroll
                for (int r = 0; r < 16; ++r) { p[tl][kb][r] = ex2(p[tl][kb][r] - muse); sum += p[tl][kb][r]; }
        sum += __shfl_xor(sum, 32);
        const float inv = (sum > 0.f) ? __builtin_amdgcn_rcpf(sum) : 0.f;
#pragma unroll
        for (int tl = 0; tl < 2; ++tl)
#pragma unroll
            for (int kb = 0; kb < 2; ++kb)
#pragma unroll
                for (int r = 0; r < 16; ++r) p[tl][kb][r] *= inv;
        { float carried = 0.f;
#pragma unroll
        for (int tl = 0; tl < 2; ++tl)
#pragma unroll
            for (int kb = 0; kb < 2; ++kb)
#pragma unroll
                for (int q4 = 0; q4 < 4; ++q4) { const int m = 8 * tl + 4 * kb + q4;
                    const float Gm = (p[tl][kb][4 * q4] + p[tl][kb][4 * q4 + 1]) + (p[tl][kb][4 * q4 + 2] + p[tl][kb][4 * q4 + 3]);
                    const float other = __shfl_xor(p[tl][kb][4 * q4 + 3], 32);
                    const float prev = hi ? other : carried; carried = other;
                    impw[(wave * 32 + r32) * 33 + 2 * m + hi] = Gm + prev; } }
        __builtin_amdgcn_sched_barrier(0);
        { f32x16 oc[2] = {f32x16{}, f32x16{}}; u32x4 pwa[4], pwb[4]; pack_p(pwa, p[0][0], p[0][1]); pack_p(pwb, p[1][0], p[1][1]); __builtin_amdgcn_sched_barrier(0);
          pv_packed(oc, kv + KvL<false>::V, pwa, lane); __builtin_amdgcn_sched_barrier(0);
          if (ntile > 1) pv_packed(oc, kv + KvL<false>::SUB + KvL<false>::V, pwb, lane); __builtin_amdgcn_sched_barrier(0);
          ob_add(ob, oc, gate[0], true); } }
        LDS_BAR();
    }
#pragma unroll 1
    for (int ps = (abl & 64) ? 2 : 0; ps < 2; ++ps) { const int lane = launder(F.tid) & 63, r32 = lane & 31, hi = lane >> 5; const int tokl = 4 * wave + 2 * ps + hi, j = r32; float a = 0.f;
#pragma unroll
        for (int w = 0; w < 8; ++w) a += impw[(w * 32 + tokl) * 33 + j];
        const bool forced = (j == 0) || (j == tb) || (j == tb - 1); const float sc = forced ? 1e4f : (j <= tb ? a : -1e4f);
        const int scb = __builtin_bit_cast(int, sc); int rank = 0;
#pragma unroll
        for (int k = 0; k < 32; ++k) { const float o0 = __builtin_bit_cast(float, __builtin_amdgcn_readlane(scb, k)), o1 = __builtin_bit_cast(float, __builtin_amdgcn_readlane(scb, 32 + k)); const float o = hi ? o1 : o0;
            rank += ((o > sc) || (o == sc && k < j)) ? 1 : 0; }
        const unsigned long long bal = __ballot(rank < 8);
        const unsigned mine = hi ? (unsigned)(bal >> 32) : (unsigned)bal;
        if (r32 == 0) { selw[tokl] = mine; __hip_atomic_fetch_or(&selw[32], mine, __ATOMIC_RELAXED, __HIP_MEMORY_SCOPE_WORKGROUP); } }
    LDS_BAR();
    const unsigned mysel = selw[r32]; const unsigned uni = selw[32] & ((tb >= 31) ? 0xffffffffu : ((2u << tb) - 1u));
    {
        AttnSt st; attn_reset(st);
        Src src{(const unsigned char*)(H1B + rb * 2048 + 1280 + g * 64), (const unsigned char*)(H1B + rb * 2048 + 1408 + g * 64), 4096u, 4096u};
        struct MaskS { int t, tb; unsigned sel; __device__ __forceinline__ bool need(int j) const { return j == tb; } __device__ __forceinline__ bool valid(int j, int key) const { return j * 64 + key <= t; }
            __device__ __forceinline__ bool lanebit(int j) const { return (sel >> j) & 1u; } } mk{t, tb, mysel};
        if (!(abl & 512)) attn_loop<4>(st, qf, BitIt{uni}, src, [&](int) { return true; }, mk, kv, tid, lane, abl);
        const float l = st.l + __shfl_xor(st.l, 32); ob_add(ob, st.o, gate[1] * __builtin_amdgcn_rcpf(l), false);
    }
    {
        AttnSt st; attn_reset(st);
        Src src{(const unsigned char*)(H1B + rb * 2048 + 1536 + g * 64), (const unsigned char*)(H1B + rb * 2048 + 1664 + g * 64), 4096u, 4096u};
        const int jlo = (t0 - 511 > 0) ? ((t0 - 511) >> 6) : 0;
        struct MaskW { int t, tb, t0; __device__ __forceinline__ bool need(int j) const { return (j == tb) || (64 * j <= t0 + 31 - 512); }
            __device__ __forceinline__ bool valid(int j, int key) const { const int k = j * 64 + key; return (k <= t) && (k > t - 512); } __device__ __forceinline__ bool lanebit(int) const { return true; } } mk{t, tb, t0};
        if (!(abl & 512)) attn_loop<4>(st, qf, RangeIt{jlo, tb + 1}, src, [&](int) { return true; }, mk, kv, tid, lane, abl);
        const float l = st.l + __shfl_xor(st.l, 32); ob_add(ob, st.o, gate[2] * __builtin_amdgcn_rcpf(l), false);
    }
#pragma unroll
    for (int db = 0; db < 2; ++db)
#pragma unroll
        for (int g4 = 0; g4 < 4; ++g4) *(u32x2*)(orow + db * 32 + 8 * g4) = ob[db][g4];
}

__device__ __forceinline__ void cmp_item(Frame& F, int item) {
    const int lane = F.lane, wave = F.wave, r32 = lane & 31, hi = lane >> 5;
    const int rblk = item & 63, gk = item >> 6, g = gk & 1, kvsel = gk >> 1;
    const int row = rblk * 32 + r32, b = row >> 7, n = row & 127;
    const bf16_t* H1B = (const bf16_t*)(F.ws + S_H1B);
    const int ncl = (n < 127) ? n : 126;
    const bf16_t* src = H1B + ((size_t)b * S + 16 * ncl) * 2048 + 1024 + kvsel * 128 + g * 64 + hi * 8;
    (void)src;
    const unsigned char* W1 = (const unsigned char*)(F.ws + (kvsel ? WS_WCV1 : WS_WCK1)) + (size_t)(wave * 32) * 4096;
    LAS unsigned char* wl = F.lds + RING_OFF + wave * 16384;
    const unsigned char* xrow[4];
#pragma unroll
    for (int i = 0; i < 4; ++i) { const int rr = rblk * 32 + 8 * i + (lane >> 3), bb = rr >> 7, nn = rr & 127, nc = (nn < 127) ? nn : 126;
        xrow[i] = (const unsigned char*)(H1B + ((size_t)bb * S + 16 * nc) * 2048 + 1024 + kvsel * 128 + g * 64) + (lane & 7) * 16; }
    f32x16 acc = {};
    u32x4 wv[2][4], xv[2][4];
#pragma unroll
    for (int c = 0; c < 2; ++c) { wt_load(wv[c], W1 + c * 128, 4096u, lane);
#pragma unroll
        for (int i = 0; i < 4; ++i) xv[c][i] = *(const u32x4*)(xrow[i] + (size_t)c * 4096); }
#pragma unroll 1
    for (int l0 = 0; l0 < 32; l0 += 2) {
#pragma unroll
        for (int c = 0; c < 2; ++c) { wt_store(wl + c * 4096, wv[c], lane); wt_store(wl + (2 + c) * 4096, xv[c], lane); }
        if (l0 + 2 < 32) {
#pragma unroll
            for (int c = 0; c < 2; ++c) { wt_load(wv[c], W1 + (size_t)(l0 + 2 + c) * 128, 4096u, lane);
#pragma unroll
                for (int i = 0; i < 4; ++i) xv[c][i] = *(const u32x4*)(xrow[i] + (size_t)(l0 + 2 + c) * 4096); } }
#pragma unroll
        for (int c = 0; c < 2; ++c)
#pragma unroll
            for (int q = 0; q < 4; ++q) acc = mfma32(wt_frag(wl + c * 4096, q, lane), wt_frag(wl + (2 + c) * 4096, q, lane), acc);
    }
    const float* cb = (const float*)(F.ws + WS_CBIAS) + kvsel * 256 + wave * 32;
    LAS unsigned char* hid = F.lds + RING_OFF;
    __syncthreads();
#pragma unroll
    for (int g4 = 0; g4 < 4; ++g4) { const int c = 8 * g4 + 4 * hi; u32x2 w; w.x = pk(gelu_t(acc[4 * g4] + cb[c]), gelu_t(acc[4 * g4 + 1] + cb[c + 1])); w.y = pk(gelu_t(acc[4 * g4 + 2] + cb[c + 2]), gelu_t(acc[4 * g4 + 3] + cb[c + 3]));
        *(LAS u32x2*)(hid + r32 * 528 + (wave * 32 + c) * 2) = w; }
    __syncthreads();
    if (wave < 2) {
        const bf16_t* W2 = (const bf16_t*)(F.ws + (kvsel ? WS_WCV2 : WS_WCK2)) + (size_t)(wave * 32 + r32) * 256 + hi * 8;
        f32x16 o = {};
#pragma unroll
        for (int ks = 0; ks < 16; ++ks) o = mfma32(ld8g(W2 + ks * 16), *(const LAS bf16x8*)(hid + r32 * 528 + ks * 32 + hi * 16), o);
        bf16_t* dst = (bf16_t*)(F.ws + (kvsel ? S_VCMP : S_KCMP)) + ((size_t)(b * 2 + g) * 128 + n) * 64 + wave * 32 + 4 * hi;
        const float z = (n < 127) ? 1.f : 0.f;
#pragma unroll
        for (int g4 = 0; g4 < 4; ++g4) store4(dst + 8 * g4, o[4 * g4] * z, o[4 * g4 + 1] * z, o[4 * g4 + 2] * z, o[4 * g4 + 3] * z);
    }
    __syncthreads();
}

__device__ __forceinline__ void ln_route_wg(Frame& F, int layer, int cset) {
    const int lane = F.lane, wave = F.wave, tid = F.tid, r32 = lane & 31, hi = lane >> 5;
    const int tok0 = F.vcu * 128;
    const float* Z = (const float*)(F.ws + WS_Z1);
    const float* g1 = (const float*)F.in[28] + layer * 1024; const float* b1 = (const float*)F.in[29] + layer * 1024;
    const float* wrg = (const float*)F.in[21] + (size_t)layer * 4096; const float* brg = (const float*)F.in[22] + layer * 4;
    const float* wre = (const float*)F.in[23] + (size_t)layer * 32768; const float* bre = (const float*)F.in[24] + layer * 32;
    LAS float* part = (LAS float*)(F.lds + RING_OFF);
    LAS float* glog = (LAS float*)(F.lds + LDS_SCR); LAS float* stl = (LAS float*)(F.lds + LDS_SCR + 2048);
    LAS int* lcnt = (LAS int*)(F.lds + LDS_SCR + 3072); LAS int* gbase = (LAS int*)(F.lds + LDS_SCR + 3200); LAS int* ent = (LAS int*)(F.lds + LDS_SCR + 3328);
    bf16_t* X1B = (bf16_t*)(F.ws + S_X1B); bf16_t* X1L = (bf16_t*)(F.ws + S_XP); float* stats = (float*)(F.ws + WS_STATS);
    if (tid < 32) lcnt[tid] = 0;
    {
        f32x4 gg[4], bb[4];
#pragma unroll
        for (int j = 0; j < 4; ++j) { gg[j] = *(const f32x4*)(g1 + lane * 4 + 256 * j); bb[j] = *(const f32x4*)(b1 + lane * 4 + 256 * j); }
#pragma unroll 1
        for (int i0 = 0; i0 < 16; i0 += 4) {
            f32x4 v[4][4]; float mean[4], rstd[4];
#pragma unroll
            for (int u = 0; u < 4; ++u) { const float* z = Z + (size_t)(tok0 + wave * 16 + i0 + u) * D;
#pragma unroll
                for (int j = 0; j < 4; ++j) v[u][j] = *(const f32x4*)(z + lane * 4 + 256 * j); }
#pragma unroll
            for (int u = 0; u < 4; ++u) { float s = 0.f;
#pragma unroll
                for (int j = 0; j < 4; ++j) s += (v[u][j][0] + v[u][j][1]) + (v[u][j][2] + v[u][j][3]);
                mean[u] = wsum(s) * (1.f / D); float q = 0.f;
#pragma unroll
                for (int j = 0; j < 4; ++j) { v[u][j] = v[u][j] - mean[u]; q += (v[u][j][0] * v[u][j][0] + v[u][j][1] * v[u][j][1]) + (v[u][j][2] * v[u][j][2] + v[u][j][3] * v[u][j][3]); }
                rstd[u] = rsqrtf(wsum(q) * (1.f / D) + LN_EPS); }
            f32x4 lg[4] = {f32x4{0.f, 0.f, 0.f, 0.f}, f32x4{0.f, 0.f, 0.f, 0.f}, f32x4{0.f, 0.f, 0.f, 0.f}, f32x4{0.f, 0.f, 0.f, 0.f}};
#pragma unroll
            for (int j = 0; j < 4; ++j) {
#pragma unroll
                for (int u = 0; u < 4; ++u) v[u][j] = v[u][j] * rstd[u] * gg[j] + bb[j];
#pragma unroll
                for (int e = 0; e < 4; ++e) { const f32x4 wv = *(const f32x4*)(wrg + (size_t)(lane * 4 + 256 * j + e) * 4);
#pragma unroll
                    for (int u = 0; u < 4; ++u) lg[u] += wv * v[u][j][e]; } }
#pragma unroll
            for (int u = 0; u < 4; ++u) { const int row = wave * 16 + i0 + u;
#pragma unroll
                for (int j = 0; j < 4; ++j) { const f32x4 x = v[u][j];
                    u32x2 w; w.x = pk(x[0], x[1]); w.y = pk(x[2], x[3]); *(u32x2*)(X1B + (size_t)(tok0 + row) * D + lane * 4 + 256 * j) = w;
                    u32x2 wl2; wl2.x = pk(x[0] - __uint_as_float(w.x << 16), x[1] - __uint_as_float(w.x & 0xffff0000u)); wl2.y = pk(x[2] - __uint_as_float(w.y << 16), x[3] - __uint_as_float(w.y & 0xffff0000u));
                    *(u32x2*)(X1L + (size_t)(tok0 + row) * D + lane * 4 + 256 * j) = wl2; }
                float l4[4];
#pragma unroll
                for (int e = 0; e < 4; ++e) l4[e] = wsum(lg[u][e]);
                if (lane == 0) { glog[row * 4 + 0] = l4[0] + brg[0]; glog[row * 4 + 1] = l4[1] + brg[1]; glog[row * 4 + 2] = l4[2] + brg[2]; glog[row * 4 + 3] = l4[3] + brg[3];
                    stl[row * 2] = mean[u]; stl[row * 2 + 1] = rstd[u]; stats[(size_t)(tok0 + row) * 2] = mean[u]; stats[(size_t)(tok0 + row) * 2 + 1] = rstd[u]; } }
        }
    }
    __syncthreads();
    { const int lane = launder(F.tid) & 63, r32 = lane & 31, hi = lane >> 5;
        bf16x8 wh[8], wl[8];
#pragma unroll
        for (int ks = 0; ks < 8; ++ks) { unsigned hh[4], ll[4];
#pragma unroll
            for (int e2 = 0; e2 < 4; ++e2) { float a[2], ah[2];
#pragma unroll
                for (int q = 0; q < 2; ++q) { const int k = wave * 128 + ks * 16 + hi * 8 + e2 * 2 + q; a[q] = wre[(size_t)k * 32 + r32]; }
                hh[e2] = pk(a[0], a[1]); ah[0] = __uint_as_float(hh[e2] << 16); ah[1] = __uint_as_float(hh[e2] & 0xffff0000u); ll[e2] = pk(a[0] - ah[0], a[1] - ah[1]); }
            wh[ks] = __builtin_bit_cast(bf16x8, (u32x4){hh[0], hh[1], hh[2], hh[3]}); wl[ks] = __builtin_bit_cast(bf16x8, (u32x4){ll[0], ll[1], ll[2], ll[3]}); asm volatile("" ::: "memory"); }
        for (int blk = 0; blk < 4; ++blk) { const int row = blk * 32 + r32; const size_t xo = (size_t)(tok0 + row) * D + wave * 128 + hi * 8;
            f32x16 acc = {};
#pragma unroll
            for (int ks = 0; ks < 8; ++ks) { const bf16x8 xh = ld8g(X1B + xo + ks * 16), xl = ld8g(X1L + xo + ks * 16);
                acc = mfma32(wh[ks], xh, acc); acc = mfma32(wh[ks], xl, acc); acc = mfma32(wl[ks], xh, acc); }
#pragma unroll
            for (int r = 0; r < 16; ++r) part[(wave * 128 + row) * 33 + crow(r, hi)] = acc[r];
        }
    }
    __syncthreads();
    const int tid2 = launder(F.tid);
    int e0 = 0, e1 = 0; float w0 = 0.f, w1 = 0.f; int rk0 = 0, rk1 = 0;
    if (tid2 < 128) {
        const float l0 = glog[tid2 * 4], l1 = glog[tid2 * 4 + 1], l2 = glog[tid2 * 4 + 2], l3 = glog[tid2 * 4 + 3];
        int gs = 0; float gm = l0; if (l1 > gm) { gm = l1; gs = 1; } if (l2 > gm) { gm = l2; gs = 2; } if (l3 > gm) { gm = l3; gs = 3; }
        const float gw = 1.f / (expf(l0 - gm) + expf(l1 - gm) + expf(l2 - gm) + expf(l3 - gm));
        float es[8];
#pragma unroll
        for (int n = 0; n < 8; ++n) { float a = bre[gs * 8 + n];
#pragma unroll
            for (int w = 0; w < 8; ++w) a += part[(w * 128 + tid2) * 33 + gs * 8 + n];
            es[n] = a; }
        int i0 = 0; float m0 = es[0];
#pragma unroll
        for (int n = 1; n < 8; ++n) if (es[n] > m0) { m0 = es[n]; i0 = n; }
        int i1 = 0; float m1 = -3e38f;
#pragma unroll
        for (int n = 0; n < 8; ++n) if (n != i0 && es[n] > m1) { m1 = es[n]; i1 = n; }
        const float r = expf(m1 - m0); w0 = gw / (1.f + r); w1 = gw * r / (1.f + r);
        e0 = gs * 8 + i0; e1 = gs * 8 + i1;
        rk0 = __hip_atomic_fetch_add(&lcnt[e0], 1, __ATOMIC_RELAXED, __HIP_MEMORY_SCOPE_WORKGROUP); rk1 = __hip_atomic_fetch_add(&lcnt[e1], 1, __ATOMIC_RELAXED, __HIP_MEMORY_SCOPE_WORKGROUP);
    }
    __syncthreads();
    if (tid2 < 32) gbase[tid2] = (int)__hip_atomic_fetch_add((int*)(F.ctl + CW_CNT + cset * 64) + tid2, lcnt[tid2], __ATOMIC_RELAXED, __HIP_MEMORY_SCOPE_AGENT);
    __syncthreads();
    if (tid2 < 128) {
        int* rt = (int*)(F.ws + WS_ROUTE); float* rw = (float*)(F.ws + WS_ROUTE + (size_t)T * 8);
        const int tok = tok0 + tid2;
        rt[tok * 2] = (e0 << 20) | (gbase[e0] + rk0); rt[tok * 2 + 1] = (e1 << 20) | (gbase[e1] + rk1);
        int* expl = (int*)(F.ws + WS_EXPL); expl[(size_t)e0 * T + gbase[e0] + rk0] = tok; expl[(size_t)e1 * T + gbase[e1] + rk1] = tok;
        rw[tok * 2] = w0; rw[tok * 2 + 1] = w1;
    }
    __syncthreads();
}
__device__ __forceinline__ void moe_tables(Frame& F, int layer) {
    LAS int* ebase = (LAS int*)(F.lds + LDS_SCR + 4352); LAS int* pe = (LAS int*)(F.lds + LDS_SCR + 4608);
    if (F.tid == 0) { int a = 0; for (int e = 0; e < 32; ++e) { ebase[e] = a; const int c = (int)__hip_atomic_load((int*)(F.ctl + CW_CNT + layer * 64) + e, __ATOMIC_RELAXED, __HIP_MEMORY_SCOPE_AGENT); a += (c + 255) & ~255; } ebase[32] = a; }
    __syncthreads();
    for (int p = F.tid; p < MOE_PANELS; p += NTHR) { int e = 0; for (int k = 1; k < 32; ++k) if (p * 256 >= ebase[k]) e = k; pe[p] = e; }
    __syncthreads();
}
__device__ __forceinline__ void moe_gather_wg(Frame& F, int layer) {
    moe_tables(F, layer);
    LAS int* ebase = (LAS int*)(F.lds + LDS_SCR + 4352);
    const int tok0 = F.vcu * 128; int* rt = (int*)(F.ws + WS_ROUTE);
    int* rowsrc = (int*)(F.ctl + CW_ROWSRC) + layer * MOE_ROWS;
    if (F.tid < 256) { const int tok = tok0 + (F.tid >> 1), sl = F.tid & 1; const int v = rt[tok * 2 + sl]; const int row = ebase[v >> 20] + (v & 0xfffff);
        rowsrc[row] = tok; rt[4 * T + tok * 2 + sl] = row; }
}
__device__ __forceinline__ void combine_wg(Frame& F, int layer, float* xout, bf16_t* xb) {
    const int lane = F.lane, tok0 = F.vcu * 128;
    const LAS int* ebase = (const LAS int*)(F.lds + LDS_SCR + 4352);
    const float* Z = (const float*)(F.ws + WS_Z1); const float* stats = (const float*)(F.ws + WS_STATS);
    const int* rt = (const int*)(F.ws + WS_ROUTE); const float* rw = (const float*)(F.ws + WS_ROUTE + (size_t)T * 8);
    const bf16_t* YP = (const bf16_t*)(F.ws + S_YP);
    const float* g1 = (const float*)F.in[28] + layer * 1024; const float* b1 = (const float*)F.in[29] + layer * 1024;
    const float* g2 = (const float*)F.in[30] + layer * 1024; const float* b2 = (const float*)F.in[31] + layer * 1024;
    f32x4 G1[4], B1[4], G2[4], B2[4];
#pragma unroll
    for (int j = 0; j < 4; ++j) { const int c = lane * 4 + 256 * j; G1[j] = *(const f32x4*)(g1 + c); B1[j] = *(const f32x4*)(b1 + c); G2[j] = *(const f32x4*)(g2 + c); B2[j] = *(const f32x4*)(b2 + c); }
#pragma unroll 1
    for (int i0 = 0; i0 < 16; i0 += 4) {
        f32x4 z[4][4]; s16x4 ya[4][4], yb[4][4]; float mean[4], rstd[4], w0[4], w1[4];
#pragma unroll
        for (int u = 0; u < 4; ++u) { const int tok = tok0 + F.wave * 16 + i0 + u;
            mean[u] = stats[(size_t)tok * 2]; rstd[u] = stats[(size_t)tok * 2 + 1]; w0[u] = rw[tok * 2]; w1[u] = rw[tok * 2 + 1];
            const int v0 = rt[tok * 2], v1 = rt[tok * 2 + 1];
            const bf16_t* y0 = YP + (size_t)(ebase[v0 >> 20] + (v0 & 0xfffff)) * D; const bf16_t* y1 = YP + (size_t)(ebase[v1 >> 20] + (v1 & 0xfffff)) * D;
#pragma unroll
            for (int j = 0; j < 4; ++j) { const int c = lane * 4 + 256 * j; z[u][j] = *(const f32x4*)(Z + (size_t)tok * D + c); ya[u][j] = *(const s16x4*)(y0 + c); yb[u][j] = *(const s16x4*)(y1 + c); } }
        float s[4], q[4];
#pragma unroll
        for (int u = 0; u < 4; ++u) { s[u] = 0.f;
#pragma unroll
            for (int j = 0; j < 4; ++j) { const f32x4 x1 = (z[u][j] - mean[u]) * rstd[u] * G1[j] + B1[j]; f32x4 f;
#pragma unroll
                for (int e = 0; e < 4; ++e) f[e] = w0[u] * bf2f((unsigned short)ya[u][j][e]) + w1[u] * bf2f((unsigned short)yb[u][j][e]);
                z[u][j] = x1 * ALPHA + f; s[u] += (z[u][j][0] + z[u][j][1]) + (z[u][j][2] + z[u][j][3]); } }
#pragma unroll
        for (int u = 0; u < 4; ++u) { const float m2 = wsum(s[u]) * (1.f / D); q[u] = 0.f;
#pragma unroll
            for (int j = 0; j < 4; ++j) { z[u][j] = z[u][j] - m2; q[u] += (z[u][j][0] * z[u][j][0] + z[u][j][1] * z[u][j][1]) + (z[u][j][2] * z[u][j][2] + z[u][j][3] * z[u][j][3]); } }
#pragma unroll
        for (int u = 0; u < 4; ++u) { const int tok = tok0 + F.wave * 16 + i0 + u; const float r2 = rsqrtf(wsum(q[u]) * (1.f / D) + LN_EPS);
#pragma unroll
            for (int j = 0; j < 4; ++j) { const int c = lane * 4 + 256 * j; const f32x4 o = z[u][j] * r2 * G2[j] + B2[j];
                *(f32x4*)(xout + (size_t)tok * D + c) = o;
                if (xb) { u32x2 w; w.x = pk(o[0], o[1]); w.y = pk(o[2], o[3]); *(u32x2*)(xb + (size_t)tok * D + c) = w; } } }
    }
}
constexpr int NPHASE = 20;
__global__ void __launch_bounds__(NTHR, 2) mega(Args args) {
    extern __shared__ __attribute__((aligned(16))) unsigned char lds_[];
#define PHASE_FRAME() Frame F; { int t_ = (int)threadIdx.x; asm volatile("" : "+v"(t_)); GAS unsigned char* wg_ = (GAS unsigned char*)args.ws; asm volatile("" : "+s"(wg_)); unsigned char* w_ = (unsigned char*)wg_; int bx_ = (int)blockIdx.x; asm volatile("" : "+s"(bx_)); \
        F.lds = (LAS unsigned char*)lds_; F.ws = w_; F.ctl = (gu32*)(w_ + WS_CTL); F.in = args.in; F.out = args.out; F.tid = t_; F.lane = t_ & 63; F.wave = __builtin_amdgcn_readfirstlane(t_ >> 6); \
        F.G = (int)gridDim.x; F.vcu = (F.G % 8 == 0) ? (bx_ % 8) * (F.G / 8) + bx_ / 8 : bx_; } unsigned char* ws = F.ws; LAS unsigned char* ring = F.lds + RING_OFF; (void)ws; (void)ring
    Frame F0; { F0.lds = (LAS unsigned char*)lds_; F0.ws = args.ws; F0.ctl = (gu32*)(args.ws + WS_CTL); F0.tid = threadIdx.x; }
    volatile LAS unsigned* MISC = (volatile LAS unsigned*)(F0.lds + LDS_MISC);
    if (F0.tid < 64) MISC[F0.tid] = 0u;
    __syncthreads();
    const int lo = args.ph_lo, hi = args.ph_hi;
    const bool one = (hi - lo) > 1;
    XcdBarrier bar; bar.bar = (unsigned*)(F0.ctl + CW_BAR); bar.x = 0; bar.st = nullptr;
    if (one) bar = xcd_barrier_post((unsigned*)(F0.ctl + CW_BAR), MISC + 8);
#ifndef PH_MASK
#define PH_MASK 0xFFFFFFFFu
#endif
#define IN(k) ((((PH_MASK) >> (k)) & 1u) && lo <= (k) && (k) < hi)
#ifndef ABL
#define ABL 0
#endif
#ifndef DUP_PHASE
#define DUP_PHASE -1
#endif
#define REP(k) for (int rep = ((k) == DUP_PHASE ? 0 : 1); rep < 2; ++rep)
#define REPSYNC() do { if (rep == 0) xcd_barrier(bar); } while (0)
#ifndef BARX
#define BARX 1
#endif
#define SEAM(k) do { if (IN(k) && IN((k) + 1)) { for (int bx_ = 0; bx_ < BARX; ++bx_) xcd_barrier(bar); } } while (0)

    if (IN(0)) REP(0) { PHASE_FRAME(); const bool dry = (rep == 0); (void)dry; p0_prologue(F); REPSYNC(); } SEAM(0);
    if (IN(1)) REP(1) { PHASE_FRAME(); const bool dry = (rep == 0); (void)dry; Gemm g{(const bf16_t*)(ws + S_XB), (const bf16_t*)(ws + WS_W0IN), T, 1536, 1024, 1024, nullptr}; pg8::StaticOrder So; So.init(T, 1536, F.G, (int)blockIdx.x);
        EpiTile E{(bf16_t*)(ws + S_H0B), 1536, 4, 0, 1.f, 0};
        pg8::gemm_phase<EpiTile, pg8::StaticOrder, true, true>(ring, g, So, E); REPSYNC(); } SEAM(1);
    if (IN(2)) REP(2) { PHASE_FRAME(); const bool dry = (rep == 0); (void)dry; mla_prep_rows(F);
        for (int ch = F.vcu; ch < 256; ch += F.G) gmlp_chunk(F, ch, dry); REPSYNC(); } SEAM(2);
    if (IN(3)) REP(3) { PHASE_FRAME(); const bool dry = (rep == 0); (void)dry;
        { Gemm g{(const bf16_t*)(ws + S_H0B) + 1024, (const bf16_t*)(ws + WS_WUQ), T, 768, 256, 1536, nullptr}; pg8::StaticOrder So; So.init(T, 768, F.G, (int)blockIdx.x);
          EpiQ E{ws};
#ifndef NO_Q
          pg8::gemm_phase<EpiQ, pg8::StaticOrder, true, true>(ring, g, So, E);
#endif
        }
        { Gemm g{(const bf16_t*)(ws + S_H0B) + 1280, (const bf16_t*)(ws + WS_WUKV), T, 1024, 256, 1536, nullptr}; pg8::StaticOrder So; So.init(T, 1024, F.G, (int)blockIdx.x);
          EpiKV E{ws};
#ifndef NO_KV
          pg8::gemm_phase<EpiKV, pg8::StaticOrder, true, true>(ring, g, So, E);
#endif
        }
        REPSYNC(); } SEAM(3);
    if (IN(4)) REP(4) { PHASE_FRAME(); const bool dry = (rep == 0); (void)dry; for (int c = F.vcu; c < 256; c += F.G) { const int bh = c >> 1;
#pragma unroll 1
            for (int i = 0; i < 4; ++i) { const int qb = (c & 1) ? ((i == 0) ? 6 : (i == 1) ? 1 : (i == 2) ? 5 : 2) : ((i == 0) ? 7 : (i == 1) ? 0 : (i == 2) ? 4 : 3); mla_attn_unit(F, bh >> 3, bh & 7, qb, dry ? ABL : 0); } } REPSYNC(); } SEAM(4);
    if (IN(5)) REP(5) { PHASE_FRAME(); const bool dry = (rep == 0); (void)dry; Gemm g{(const bf16_t*)(ws + S_H0B), (const bf16_t*)(ws + WS_W0O), T, 1024, 1024, 1536, nullptr}; pg8::StaticOrder So; So.init(T, 1024, F.G, (int)blockIdx.x);
        EpiResid E{(const float*)args.in[0], (float*)(ws + WS_Z1)};
        pg8::gemm_phase<EpiResid, pg8::StaticOrder, true, true>(ring, g, So, E); REPSYNC(); } SEAM(5);
#pragma unroll
    for (int layer = 0; layer < 2; ++layer) {
        const int pb = layer ? 15 : 6;
        if (IN(pb)) REP(pb) { PHASE_FRAME(); const bool dry = (rep == 0); (void)dry; for (int c = F.vcu; c < 256; c += F.G) { Frame F2 = F; F2.vcu = c; ln_route_wg(F2, layer, dry ? 2 + layer : layer); } REPSYNC(); } SEAM(pb);
        if (IN(pb + 2)) REP(pb + 2) { PHASE_FRAME(); const bool dry = (rep == 0); (void)dry; moe_tables(F, layer); const LAS int* eb = (const LAS int*)(F.lds + LDS_SCR + 4352);
            Gemm g{(const bf16_t*)(ws + S_X1B), (const bf16_t*)(ws + WS_WGU) + (size_t)layer * 32 * 512 * 1024, MOE_ROWS, 512, 1024, 1024, nullptr};
            MoeOrder<2> So{(const LAS int*)(F.lds + LDS_SCR + 4608), (eb[32] >> 8) * 2, F.G, F.vcu, eb, (const int*)(ws + WS_EXPL)}; EpiMoeUp E{(bf16_t*)(ws + S_HP)};
            pg8::gemm_phase<EpiMoeUp, MoeOrder<2>, true, true, true>(ring, g, So, E); REPSYNC(); } SEAM(pb + 2);
        if (IN(pb + 3)) REP(pb + 3) { PHASE_FRAME(); const bool dry = (rep == 0); (void)dry; moe_tables(F, layer); const LAS int* eb = (const LAS int*)(F.lds + LDS_SCR + 4352);
            Gemm g{(const bf16_t*)(ws + S_HP), (const bf16_t*)(ws + WS_WD) + (size_t)layer * 32 * 1024 * 256, MOE_ROWS, 1024, 256, 256, nullptr};
            MoeOrder<4> So{(const LAS int*)(F.lds + LDS_SCR + 4608), (eb[32] >> 8) * 4, F.G, F.vcu, eb, (const int*)(ws + WS_EXPL)}; EpiMoeDown E{(bf16_t*)(ws + S_YP)};
            pg8::gemm_phase<EpiMoeDown, MoeOrder<4>, true, true>(ring, g, So, E); REPSYNC(); } SEAM(pb + 3);
        if (IN(pb + 4)) REP(pb + 4) { PHASE_FRAME(); const bool dry = (rep == 0); (void)dry; moe_tables(F, layer); for (int c = F.vcu; c < 256; c += F.G) { Frame F2 = F; F2.vcu = c; combine_wg(F2, layer, args.out, layer ? nullptr : (bf16_t*)(ws + S_X2B)); } REPSYNC(); }
        if (layer == 0) {
            SEAM(10);
            if (IN(11)) REP(11) { PHASE_FRAME(); const bool dry = (rep == 0); (void)dry; Gemm g{(const bf16_t*)(ws + S_X2B), (const bf16_t*)(ws + WS_W1IN), T, 2048, 1024, 1024, nullptr}; pg8::StaticOrder So; So.init(T, 2048, F.G, (int)blockIdx.x);
                EpiTile E{(bf16_t*)(ws + S_H1B), 2048, 0, 4, QS_NSA, 0};
                pg8::gemm_phase<EpiTile, pg8::StaticOrder, true, true>(ring, g, So, E); REPSYNC(); } SEAM(11);
            if (IN(12)) REP(12) { PHASE_FRAME(); const bool dry = (rep == 0); (void)dry; for (int it = F.vcu; it < 256; it += F.G) cmp_item(F, it); REPSYNC(); } SEAM(12);
            if (IN(13)) REP(13) { PHASE_FRAME(); const bool dry = (rep == 0); (void)dry; for (int c = F.vcu; c < 256; c += F.G) { const int bg = c >> 3, s = c & 7;
#pragma unroll 1
                    for (int i = 0; i < 8; ++i) { const int k = i >> 1; const int blk = (k == 0) ? 31 - s : (k == 1) ? 16 + s : (k == 2) ? 15 - s : s; nsa_unit(F, bg >> 1, bg & 1, blk * 2 + (i & 1), dry, dry ? ABL : 0); } } REPSYNC(); } SEAM(13);
            if (IN(14)) REP(14) { PHASE_FRAME(); const bool dry = (rep == 0); (void)dry; Gemm g{(const bf16_t*)(ws + S_H1B), (const bf16_t*)(ws + WS_W1O), T, 1024, 1024, 2048, nullptr}; pg8::StaticOrder So; So.init(T, 1024, F.G, (int)blockIdx.x);
                EpiResid E{(const float*)args.out, (float*)(ws + WS_Z1)};
                pg8::gemm_phase<EpiResid, pg8::StaticOrder, true, true>(ring, g, So, E); REPSYNC(); } SEAM(14);
        }
    }
#undef IN
#undef SEAM
}

#ifndef MK_SPLIT
#define MK_SPLIT 0
#endif
static void launch_all(void* const* d_in, float* out, unsigned char* ws, hipStream_t stream) {
    static int grid = 0;
    if (grid == 0) {
        int dev = 0, cus = 0, per_cu = 0;
        if (hipGetDevice(&dev) != hipSuccess || hipDeviceGetAttribute(&cus, hipDeviceAttributeMultiprocessorCount, dev) != hipSuccess) { grid = -1; return; }
        if (hipFuncSetAttribute((const void*)mega, hipFuncAttributeMaxDynamicSharedMemorySize, LDS_BYTES) != hipSuccess) { fprintf(stderr, "kernel_launch: hipFuncSetAttribute failed\n"); grid = -1; return; }
        if (hipOccupancyMaxActiveBlocksPerMultiprocessor(&per_cu, (const void*)mega, NTHR, LDS_BYTES) != hipSuccess || per_cu < 1) fprintf(stderr, "kernel_launch: occupancy query says %d\n", per_cu);
        (void)hipGetLastError();
        grid = cus < 256 ? cus : 256;
    }
    if (grid < 0) return;
    (void)hipMemsetAsync(ws + WS_CTL, 0, CTL_ZERO_BYTES, stream);
    Args a{};
    for (int i = 0; i < 32; ++i) a.in[i] = d_in[i];
    a.out = out; a.ws = ws;
#if MK_SPLIT
    for (int p = 0; p < NPHASE; ++p) { a.ph_lo = p; a.ph_hi = p + 1; hipLaunchKernelGGL(mega, dim3(grid), dim3(NTHR), LDS_BYTES, stream, a); }
#else
    a.ph_lo = 0; a.ph_hi = NPHASE; hipLaunchKernelGGL(mega, dim3(grid), dim3(NTHR), LDS_BYTES, stream, a);
#endif
}
}

extern "C" void kernel_launch(void* const* d_in, const int* in_sizes, int n_in, void* d_out, int out_size, void* d_ws, size_t ws_size, hipStream_t stream) {
    fk::launch_all(d_in, (float*)d_out, (unsigned char*)d_ws, stream);
}
```

```cpp
#include <hip/hip_runtime.h>
#include <stdint.h>
#include <math.h>
#include <cstdio>
namespace pg8 {
#define PG8_LAS __attribute__((address_space(3)))
typedef unsigned short bf16_t;
typedef short bf16x8 __attribute__((ext_vector_type(8)));
typedef float f32x4 __attribute__((ext_vector_type(4)));
typedef unsigned u32x4 __attribute__((ext_vector_type(4)));
constexpr int BM = 256, BK = 64, HALF = 128, HTB = HALF * BK * 2  , STAGE_BYTES = 8 * HTB, NXCD = 8, WGM = 8;

__host__ __device__ __forceinline__ int lds_byte(int r, int c) { const int st = (r >> 4) * 2 + (c >> 5), rr = r & 15, cc = c & 31, ob = rr * 64 + cc * 2; return st * 1024 + (ob ^ (((ob >> 9) & 1) << 5)); }
__host__ __device__ __forceinline__ void stage_rc(int b, int& R, int& C) { const int st = b / 1024, sb = b % 1024, swz = sb ^ (((sb >> 9) & 1) << 5); R = (st >> 1) * 16 + swz / 64; C = (st & 1) * 32 + (swz % 64) / 2; }
__host__ __device__ __forceinline__ int perm32(int rho) { const int n = rho >> 4, i = rho & 15; return 8 * (i >> 2) + 4 * n + (i & 3); }

struct Unit { int pm, pn; };
struct Gemm { const bf16_t* A; const bf16_t* Bt; int M, N, K, lda; const int* rowsrc; };

struct StaticOrder {
    int nM, nN, nwg, G, c;
    __host__ __device__ void init(int M, int N, int G_, int c_) { nM = M / BM; nN = N / BM; nwg = nM * nN; G = G_; c = c_; }
    __host__ __device__ bool next(int i, Unit& u) const {
        const long L = (long)i * G + c; if (L >= nwg) return false;
        int wgid = (int)L; { const int q = nwg / NXCD, r = nwg % NXCD, xcd = wgid % NXCD, off = wgid / NXCD; wgid = (xcd < r ? xcd * (q + 1) : r * (q + 1) + (xcd - r) * q) + off; }
        const int nig = WGM * nN, gid = wgid / nig, fm = gid * WGM, gsz = (nM - fm) < WGM ? (nM - fm) : WGM;
        u.pm = fm + ((wgid % nig) % gsz); u.pn = (wgid % nig) / gsz; return true;
    }
    __device__ __forceinline__ void a_ready(const Unit&) const {}
    __device__ __forceinline__ void done(const Unit&) const {}
};

__device__ __forceinline__ unsigned cvt_pk_bf16(float lo, float hi) { unsigned r; asm volatile("v_cvt_pk_bf16_f32 %0, %1, %2" : "=v"(r) : "v"(lo), "v"(hi)); return r; }
typedef float f32x2 __attribute__((ext_vector_type(2)));
template <class Epi, class Sched, bool ALIGN_EPI = false, bool SP2 = false, bool GATHER = false>
__device__ __forceinline__ void gemm_phase(PG8_LAS unsigned char* lds, const Gemm g, const Sched& S, const Epi& E) {
    int tid_l = (int)threadIdx.x; asm volatile("" : "+v"(tid_l));
    const int tid = tid_l, wid = __builtin_amdgcn_readfirstlane(tid >> 6), lane = tid & 63, wr = wid >> 2, wc = wid & 3, fr = lane & 15, fq = lane >> 4;
    const int K = g.K, nt = K / BK;
    unsigned voffA[2], voffB[2], voffA1[2] = {0u, 0u}, nvoffA[2] = {0u, 0u}, nvoffA1[2] = {0u, 0u}; int RA[2], CA[2];
#pragma unroll
    for (int i = 0; i < 2; ++i) { int R, C; stage_rc(tid * 16 + i * 8192, R, C); const int Rb = Epi::PERM ? ((R & ~31) + perm32(R & 31)) : R;
        voffA[i] = (unsigned)(R * g.lda + C) * 2u; voffB[i] = (unsigned)(Rb * K + C) * 2u; RA[i] = R; CA[i] = C; }
    const size_t kstep = (size_t)(BK * 2);
    const size_t hstepA = (size_t)HALF * g.lda * 2, hstepB = (size_t)HALF * K * 2;
    const size_t tstepA = 2 * hstepA, tstepB = 2 * hstepB;
    const unsigned ldsw = (unsigned)wid * 1024u;
    const int aoff = lds_byte(wr * 64 + fr, fq * 8), boff = lds_byte(wc * 32 + fr, fq * 8);
#define PG8_SA(b, h) (((b) * 2 + (h)) * HTB)
#define PG8_SB(b, h) ((4 + (b) * 2 + (h)) * HTB)
#define PG8_STAGE(bufoff, gbase, voff) do { _Pragma("unroll") for (int _i = 0; _i < 2; ++_i) \
        __builtin_amdgcn_global_load_lds((const unsigned*)((const char*)(gbase) + (voff)[_i]), (PG8_LAS unsigned*)(lds + (bufoff) + ldsw + _i * 8192), 16, 0, 0); } while (0)
#define PG8_GSET(u, v0, v1) do { _Pragma("unroll") for (int _i = 0; _i < 2; ++_i) { v0[_i] = (unsigned)(S.arow((u), RA[_i]) * g.lda + CA[_i]) * 2u; v1[_i] = (unsigned)(S.arow((u), HALF + RA[_i]) * g.lda + CA[_i]) * 2u; } } while (0)
#define PG8_STA0(slot, P, NX) do { if constexpr (GATHER) { if (NX) PG8_STAGE(slot, P, nvoffA); else PG8_STAGE(slot, P, voffA); } else PG8_STAGE(slot, P, voffA); } while (0)
#define PG8_STA1(slot, P, NX) do { if constexpr (GATHER) { if (NX) PG8_STAGE(slot, P, nvoffA1); else PG8_STAGE(slot, P, voffA1); } else PG8_STAGE(slot, (P) + hstepA, voffA); } while (0)
#define PG8_LDA(dst, b, h) do { _Pragma("unroll") for (int m = 0; m < 4; ++m) _Pragma("unroll") for (int k = 0; k < 2; ++k) dst[m][k] = *(const PG8_LAS bf16x8*)(lds + PG8_SA(b, h) + aoff + m * 2048 + k * 1024); } while (0)
#define PG8_LDB(dst, b, h) do { _Pragma("unroll") for (int n = 0; n < 2; ++n) _Pragma("unroll") for (int k = 0; k < 2; ++k) dst[n][k] = *(const PG8_LAS bf16x8*)(lds + PG8_SB(b, h) + boff + n * 2048 + k * 1024); } while (0)
#define PG8_MMA(ai, bj, At, Bt) do { __builtin_amdgcn_s_setprio(1); _Pragma("unroll") for (int m = 0; m < 4; ++m) _Pragma("unroll") for (int n = 0; n < 2; ++n) _Pragma("unroll") for (int k = 0; k < 2; ++k) \
        acc[ai][bj][m][n] = __builtin_amdgcn_mfma_f32_16x16x32_bf16(Bt[n][k], At[m][k], acc[ai][bj][m][n], 0, 0, 0); __builtin_amdgcn_s_setprio(0); } while (0)
#define PG8_WAIT_V(n) asm volatile("s_waitcnt vmcnt(" #n ")" ::: "memory")
#define PG8_WAIT_L(n) asm volatile("s_waitcnt lgkmcnt(" #n ")" ::: "memory")
#define PG8_BAR __builtin_amdgcn_s_barrier()
#define PG8_SCHED __builtin_amdgcn_sched_barrier(0)
    Unit cur, nxt; int ui = 0;
    if (!S.next(0, cur)) return;
    f32x4 acc[2][2][4][2];
#pragma unroll
    for (int a = 0; a < 2; ++a)
#pragma unroll
        for (int b = 0; b < 2; ++b)
#pragma unroll
            for (int m = 0; m < 4; ++m)
#pragma unroll
                for (int n = 0; n < 2; ++n) acc[a][b][m][n] = (f32x4){0.f, 0.f, 0.f, 0.f};
    bf16x8 At[4][2], B0[2][2], B1[2][2];
    const char* cA = GATHER ? (const char*)g.A : (const char*)g.A + (size_t)cur.pm * tstepA; if constexpr (GATHER) PG8_GSET(cur, voffA, voffA1);
    const char* cB = (const char*)g.Bt + (size_t)cur.pn * tstepB;
    S.a_ready(cur);
    if constexpr (SP2) {
        PG8_STAGE(PG8_SB(0, 0), cB, voffB); PG8_STAGE(PG8_SB(0, 1), cB + hstepB, voffB); PG8_STA0(PG8_SA(0, 0), cA, false); PG8_STA1(PG8_SA(0, 1), cA, false);
        if (wr == 1) PG8_BAR;
        PG8_WAIT_V(2); PG8_BAR;
        PG8_STAGE(PG8_SB(1, 0), cB + kstep, voffB); PG8_STA0(PG8_SA(1, 0), cA + kstep, false); PG8_STAGE(PG8_SB(1, 1), cB + hstepB + kstep, voffB);
        PG8_WAIT_V(6); PG8_BAR;
    } else {
        PG8_STAGE(PG8_SB(0, 0), cB, voffB); PG8_STA0(PG8_SA(0, 0), cA, false); PG8_STAGE(PG8_SB(0, 1), cB + hstepB, voffB); PG8_STA1(PG8_SA(0, 1), cA, false);
        if (wr == 1) PG8_BAR;
        PG8_WAIT_V(4); PG8_BAR;
        PG8_STAGE(PG8_SB(1, 0), cB + kstep, voffB); PG8_STA0(PG8_SA(1, 0), cA + kstep, false); PG8_STAGE(PG8_SB(1, 1), cB + hstepB + kstep, voffB);
        PG8_WAIT_V(6); PG8_BAR;
    }
    for (;;) {
        const bool has_next = S.next(ui + 1, nxt);
        const char* nA = has_next ? (GATHER ? (const char*)g.A : (const char*)g.A + (size_t)nxt.pm * tstepA) : cA; if constexpr (GATHER) { if (has_next) PG8_GSET(nxt, nvoffA, nvoffA1); } const char* nB = has_next ? (const char*)g.Bt + (size_t)nxt.pn * tstepB : cB;
#pragma unroll 1
        for (int t = 0; t < nt; t += 2) {
            const bool last = (t == nt - 2);
            const char* a1 = cA + (size_t)(t + 1) * kstep;
            const char* a2 = last ? nA : cA + (size_t)(t + 2) * kstep; const char* b2 = last ? nB : cB + (size_t)(t + 2) * kstep;
            const char* a3 = a2 + kstep; const char* b3 = b2 + kstep;
            if (last && has_next) S.a_ready(nxt);
            if constexpr (SP2) {
            PG8_LDB(B0, 0, 0); PG8_LDB(B1, 0, 1); PG8_SCHED; PG8_LDA(At, 0, 0); PG8_STA1(PG8_SA(1, 1), a1, false);
            PG8_WAIT_V(8); PG8_WAIT_L(0); PG8_BAR; PG8_MMA(0, 0, At, B0); PG8_MMA(0, 1, At, B1); PG8_BAR; PG8_SCHED;
            PG8_LDA(At, 0, 1); PG8_STAGE(PG8_SB(0, 0), b2, voffB); PG8_STAGE(PG8_SB(0, 1), b2 + hstepB, voffB); PG8_STA0(PG8_SA(0, 0), a2, last && has_next);
            PG8_WAIT_V(8); PG8_WAIT_L(0); PG8_BAR; PG8_MMA(1, 0, At, B0); PG8_MMA(1, 1, At, B1); PG8_BAR; PG8_SCHED;
            PG8_LDB(B0, 1, 0); PG8_LDB(B1, 1, 1); PG8_SCHED; PG8_LDA(At, 1, 0); PG8_STA1(PG8_SA(0, 1), a2, last && has_next);
            PG8_WAIT_V(8); PG8_WAIT_L(0); PG8_BAR; PG8_MMA(0, 0, At, B0); PG8_MMA(0, 1, At, B1); PG8_BAR; PG8_SCHED;
            PG8_LDA(At, 1, 1); PG8_STAGE(PG8_SB(1, 0), b3, voffB); PG8_STAGE(PG8_SB(1, 1), b3 + hstepB, voffB); PG8_STA0(PG8_SA(1, 0), a3, last && has_next);
            PG8_WAIT_V(8); PG8_WAIT_L(0); PG8_BAR; PG8_MMA(1, 0, At, B0); PG8_MMA(1, 1, At, B1); PG8_BAR; PG8_SCHED;
            } else {
            PG8_LDB(B0, 0, 0); PG8_SCHED; PG8_LDA(At, 0, 0); PG8_STA1(PG8_SA(1, 1), a1, false);
            PG8_WAIT_L(8); PG8_BAR; PG8_WAIT_L(0); PG8_MMA(0, 0, At, B0); PG8_BAR; PG8_SCHED;
            PG8_LDB(B1, 0, 1); PG8_STAGE(PG8_SB(0, 0), b2, voffB);
            PG8_BAR; PG8_WAIT_L(0); PG8_MMA(0, 1, At, B1); PG8_BAR;
            PG8_LDA(At, 0, 1); PG8_STA0(PG8_SA(0, 0), a2, last && has_next);
            PG8_BAR; PG8_WAIT_L(0); PG8_MMA(1, 0, At, B0); PG8_BAR; PG8_SCHED;
            PG8_STAGE(PG8_SB(0, 1), b2 + hstepB, voffB);
            PG8_WAIT_V(6); PG8_BAR; PG8_MMA(1, 1, At, B1); PG8_BAR;
            PG8_LDB(B0, 1, 0); PG8_SCHED; PG8_LDA(At, 1, 0); PG8_STA1(PG8_SA(0, 1), a2, last && has_next);
            PG8_WAIT_L(8); PG8_BAR; PG8_WAIT_L(0); PG8_MMA(0, 0, At, B0); PG8_BAR; PG8_SCHED;
            PG8_LDB(B1, 1, 1); PG8_STAGE(PG8_SB(1, 0), b3, voffB);
            PG8_BAR; PG8_WAIT_L(0); PG8_MMA(0, 1, At, B1); PG8_BAR;
            PG8_LDA(At, 1, 1); PG8_STA0(PG8_SA(1, 0), a3, last && has_next);
            PG8_BAR; PG8_WAIT_L(0); PG8_MMA(1, 0, At, B0); PG8_BAR; PG8_SCHED;
            PG8_STAGE(PG8_SB(1, 1), b3 + hstepB, voffB);
            PG8_WAIT_V(6); PG8_BAR; PG8_MMA(1, 1, At, B1); PG8_BAR;
            }
        }
        if constexpr (ALIGN_EPI) { if (wr == 0) PG8_BAR; }
        if constexpr (!Epi::AFTER_DRAIN) { E(acc, cur, wr, wc, fr, fq); S.done(cur); }
        if (!has_next) break;
#pragma unroll
        for (int a = 0; a < 2; ++a)
#pragma unroll
            for (int b = 0; b < 2; ++b)
#pragma unroll
                for (int m = 0; m < 4; ++m)
#pragma unroll
                    for (int n = 0; n < 2; ++n) acc[a][b][m][n] = (f32x4){0.f, 0.f, 0.f, 0.f};
        cur = nxt; cA = nA; cB = nB; ++ui;
        if constexpr (GATHER) { voffA[0] = nvoffA[0]; voffA[1] = nvoffA[1]; voffA1[0] = nvoffA1[0]; voffA1[1] = nvoffA1[1]; }
        if constexpr (ALIGN_EPI) { if (wr == 1) PG8_BAR; }
    }
    PG8_WAIT_V(0);
    if constexpr (!ALIGN_EPI) { if (wr == 0) PG8_BAR; }
    PG8_BAR;
    if constexpr (Epi::AFTER_DRAIN) { E.fused(acc, cur, wr, wc, fr, fq, lds, wid, lane); S.done(cur); }
#undef PG8_SA
#undef PG8_SB
#undef PG8_STAGE
#undef PG8_GSET
#undef PG8_STA0
#undef PG8_STA1
#undef PG8_LDA
#undef PG8_LDB
#undef PG8_MMA
#undef PG8_WAIT_V
#undef PG8_WAIT_L
#undef PG8_BAR
#undef PG8_SCHED
}
}
#define GAS __attribute__((address_space(1)))
#define LAS __attribute__((address_space(3)))
typedef unsigned short bf16;
typedef unsigned v4u __attribute__((ext_vector_type(4)));
typedef float f32x4 __attribute__((ext_vector_type(4)));
typedef short bf16x8 __attribute__((ext_vector_type(8)));
typedef GAS unsigned gu32;
typedef GAS unsigned long long gu64;
#define RLX_AGENT __ATOMIC_RELAXED, __HIP_MEMORY_SCOPE_AGENT
#define LDS_WAIT() asm volatile("s_waitcnt lgkmcnt(0)" ::: "memory")
#define VM_WAIT() asm volatile("s_waitcnt vmcnt(0)" ::: "memory")
__device__ __forceinline__ unsigned long long rt() { return __builtin_amdgcn_s_memrealtime(); }
__device__ __forceinline__ unsigned f2bf(float f) { unsigned u = __builtin_bit_cast(unsigned, f); return (u + 0x7fffu + ((u >> 16) & 1u)) >> 16; }
__device__ __forceinline__ unsigned pk2(float lo, float hi) { return f2bf(lo) | (f2bf(hi) << 16); }

#define XB_TMO      128
#define XB_XCNT(j)  (256  + 64 * (j))
#define XB_XSUB(j)  (1280 + 64 * (j))
#define XB_XGEN(j)  (2304 + 64 * (j))
#define XB_TOP      3328
#define XB_TOPGEN   3392
#define XCD_BAR_WORDS 3456
#define XB_SPIN_CAP (1u << 18)

__device__ __forceinline__ unsigned xb_ld(unsigned* p)              { return __hip_atomic_load(p, __ATOMIC_RELAXED, __HIP_MEMORY_SCOPE_AGENT); }
__device__ __forceinline__ unsigned xb_add(unsigned* p, unsigned v) { return __hip_atomic_fetch_add(p, v, __ATOMIC_RELAXED, __HIP_MEMORY_SCOPE_AGENT); }
__device__ __forceinline__ unsigned xb_xcc_id() { return (unsigned)__builtin_amdgcn_s_getreg((3 << 11) | 20) & 0xFu; }
#define XB_SPIN(cond, bar) do { unsigned _sp = 0; while (cond) { __builtin_amdgcn_s_sleep(1); \
    if ((++_sp & 255u) == 0u) { if (xb_ld(&(bar)[XB_TMO])) break; if (_sp > XB_SPIN_CAP) { atomicAdd(&(bar)[XB_TMO], 1u); break; } } } } while (0)

struct XcdBarrier {
    unsigned* bar; unsigned x;
    volatile LAS unsigned* st;
};

__device__ __forceinline__ XcdBarrier xcd_barrier_post(unsigned* bar, volatile LAS unsigned* st) {
    XcdBarrier b; b.bar = bar; b.x = xb_xcc_id(); b.st = st;
    if (threadIdx.x == 0) (void)xb_add(&bar[XB_XCNT(b.x)], 1u);
    return b;
}
__device__ __forceinline__ void xcd_barrier_complete(unsigned* bar, unsigned x, unsigned& nloc, unsigned& nx) {
    const unsigned G = gridDim.x * gridDim.y * gridDim.z;
    unsigned sum, cnt, mine, sp = 0u;
    for (;;) {
        sum = 0u; cnt = 0u; mine = 0u;
#pragma unroll
        for (unsigned j = 0; j < 16; ++j) { const unsigned c = xb_ld(&bar[XB_XCNT(j)]); sum += c; cnt += (c > 0u) ? 1u : 0u; mine = (j == x) ? c : mine; }
        if (sum == G) break;
        __builtin_amdgcn_s_sleep(1);
        if ((++sp & 255u) == 0u) { if (xb_ld(&bar[XB_TMO])) break; if (sp > XB_SPIN_CAP) { atomicAdd(&bar[XB_TMO], 1u); break; } }
    }
    nloc = mine > 0u ? mine : 1u; nx = cnt > 0u ? cnt : 1u;
}

__device__ __forceinline__ void xcd_barrier(const XcdBarrier& b) {
    asm volatile("s_waitcnt vmcnt(0)" ::: "memory");
    __syncthreads();
    if (threadIdx.x == 0) {
        unsigned* bar = b.bar;
        __builtin_amdgcn_s_waitcnt(0);
        unsigned nloc = b.st[0], nx = b.st[1];
        if (nloc == 0u) { xcd_barrier_complete(bar, b.x, nloc, nx); b.st[0] = nloc; b.st[1] = nx; }
        const unsigned old = xb_add(&bar[XB_XSUB(b.x)], 1u);
        const unsigned gen = old / nloc;
        if (old + 1u == (gen + 1u) * nloc) {
            __builtin_amdgcn_fence(__ATOMIC_RELEASE, "agent");
            asm volatile("s_waitcnt vmcnt(0)" ::: "memory");
            const unsigned og = xb_add(&bar[XB_TOP], 1u);
            const unsigned tg = og / nx;
            if (og + 1u == (tg + 1u) * nx) xb_add(&bar[XB_TOPGEN], 1u);
            else XB_SPIN(xb_ld(&bar[XB_TOPGEN]) == tg, bar);
            __builtin_amdgcn_fence(__ATOMIC_ACQUIRE, "agent");
            xb_add(&bar[XB_XGEN(b.x)], 1u);
            asm volatile("s_waitcnt vmcnt(0)" ::: "memory");
        } else {
            XB_SPIN(xb_ld(&bar[XB_XGEN(b.x)]) == gen, bar);
            __builtin_amdgcn_fence(__ATOMIC_ACQUIRE, "agent");
            asm volatile("s_waitcnt vmcnt(0)" ::: "memory");
        }
    }
    __syncthreads();
}
namespace fk {
using pg8::bf16_t; using pg8::f32x4; using pg8::u32x4; using pg8::Unit; using pg8::Gemm;
typedef float f32x16 __attribute__((ext_vector_type(16)));
typedef float f32x2 __attribute__((ext_vector_type(2)));
typedef unsigned u32x2 __attribute__((ext_vector_type(2)));
typedef short s16x4 __attribute__((ext_vector_type(4)));
constexpr int NB = 16, S = 2048, D = 1024, T = NB * S;
constexpr float ALPHA = 1.41421356237309515f, LN_EPS = 1e-5f, LOG2E = 1.4426950408889634f;
constexpr float QS_MLA = 0.10206207261596575f * LOG2E;
constexpr float QS_NSA = 0.125f * LOG2E;
constexpr int NWAVES = 8, NTHR = 512;
constexpr int MOE_ROWS = 73728, MOE_PANELS = MOE_ROWS / 256;

constexpr size_t MiB = 1u << 20;
constexpr size_t WS_CTL = 0, CTL_ZERO_BYTES = 1 * MiB;
constexpr size_t WS_W0IN = 1 * MiB, WS_WUQ = 4 * MiB, WS_WUKV = WS_WUQ + 512 * 1024, WS_W0O = 5 * MiB, WS_W1IN = 7 * MiB, WS_WCK1 = 11 * MiB, WS_WCV1 = 12 * MiB,
                 WS_WCK2 = 13 * MiB, WS_WCV2 = 13 * MiB + 64 * 1024, WS_WSB = 13 * MiB + 128 * 1024, WS_CBIAS = 13 * MiB + 512 * 1024, WS_W1O = 14 * MiB, WS_WGU = 16 * MiB, WS_WD = 80 * MiB;
constexpr size_t WS_Z1 = 113 * MiB;
constexpr size_t WS_STATS = 241 * MiB;
constexpr size_t WS_ROUTE = WS_STATS + 256 * 1024;
constexpr size_t WS_S = 242 * MiB;
constexpr size_t S_XB = WS_S, S_H0B = WS_S + 64 * MiB, S_Q96 = WS_S, S_KN = WS_S + 160 * MiB, S_V = WS_S + 192 * MiB, S_KRB = WS_S + 224 * MiB;
constexpr size_t S_X1B = WS_S, S_XP = WS_S + 64 * MiB, S_HP = WS_S + 208 * MiB, S_YP = WS_S, S_X2B = WS_S + 144 * MiB;
constexpr size_t S_H1B = WS_S, S_KCMP = WS_S + 208 * MiB, S_VCMP = S_KCMP + 1 * MiB;
constexpr size_t WS_END = WS_S + 244 * MiB;
constexpr size_t WS_EXPL = 488 * MiB;
constexpr size_t WS_ROPE = 492 * MiB;
constexpr size_t WS_RINV = 496 * MiB;
static_assert(WS_END <= 512 * MiB, "workspace map");
constexpr int CW_BAR = 4096, CW_CNT = 16384  , CW_ROWSRC = 32768  ;
static_assert((CW_ROWSRC + 2 * 73728) * 4 <= (int)CTL_ZERO_BYTES, "control words inside the per-call memset");

constexpr int RING_OFF = 0, LDS_MISC = 139264, LDS_SCR = LDS_MISC + 256, LDS_BYTES = 163840;

struct Args { const void* in[32]; float* out; unsigned char* ws; int ph_lo, ph_hi; };

__device__ __forceinline__ float bf2f(unsigned short b) { return __uint_as_float((unsigned)b << 16); }
__device__ __forceinline__ unsigned pk(float lo, float hi) { return pg8::cvt_pk_bf16(lo, hi); }
template <int CTRL> __device__ __forceinline__ float dppf(float v) { return __builtin_bit_cast(float, __builtin_amdgcn_update_dpp(0, __builtin_bit_cast(int, v), CTRL, 0xf, 0xf, true)); }
__device__ __forceinline__ float wsum(float v) {
    v += dppf<0xB1>(v); v += dppf<0x4E>(v); v += dppf<0x141>(v); v += dppf<0x140>(v);
    const int b = __builtin_bit_cast(int, v);
    return (__builtin_bit_cast(float, __builtin_amdgcn_readlane(b, 0)) + __builtin_bit_cast(float, __builtin_amdgcn_readlane(b, 16))) + (__builtin_bit_cast(float, __builtin_amdgcn_readlane(b, 32)) + __builtin_bit_cast(float, __builtin_amdgcn_readlane(b, 48)));
}
__device__ __forceinline__ int launder(int x) { asm volatile("" : "+v"(x)); return x; }
__device__ __forceinline__ float ex2(float x) { return __builtin_amdgcn_exp2f(x); }
__device__ __forceinline__ float gelu_t(float x) {
    const float u = 0.7978845608028654f * (x + 0.044715f * x * x * x);
    return x * __builtin_amdgcn_rcpf(1.f + ex2(-2.f * LOG2E * u));
}
__device__ __forceinline__ int crow(int r, int hi) { return (r & 3) + 8 * (r >> 2) + 4 * hi; }
__device__ __forceinline__ f32x16 mfma32(bf16x8 a, bf16x8 b, f32x16 c) { return __builtin_amdgcn_mfma_f32_32x32x16_bf16(a, b, c, 0, 0, 0); }
__device__ __forceinline__ bf16x8 ld8g(const bf16_t* p) { return *(const bf16x8*)p; }
typedef short v4i16_t __attribute__((ext_vector_type(4)));
__device__ __forceinline__ s16x4 trld(const LAS unsigned char* p) { return __builtin_bit_cast(s16x4, __builtin_amdgcn_ds_read_tr16_b64_v4i16((LAS v4i16_t*)p)); }

struct Frame {
    LAS unsigned char* lds; gu32* ctl; unsigned char* ws;
    int tid, lane, wave, vcu, G;
    const void* const* in; float* out;
};

struct EpiTile {
    static constexpr bool PERM = true, AFTER_DRAIN = false;
    bf16_t* O; int ldc; int ngelu; int nscale; float scale; int pad;
    __device__ __forceinline__ void operator()(const f32x4 (&acc)[2][2][4][2], const Unit& u, int wr, int wc, int fr, int fq) const {
        const int row0 = u.pm * 256 + wr * 64 + fr, col0 = u.pn * 256 + wc * 32 + 8 * fq;
        const bool dg = u.pn < ngelu; const float sc = (u.pn < nscale) ? scale : 1.f;
#pragma unroll
        for (int ai = 0; ai < 2; ++ai)
#pragma unroll
            for (int m = 0; m < 4; ++m) { bf16_t* rowp = O + (size_t)(row0 + ai * 128 + m * 16) * ldc + col0;
#pragma unroll
                for (int bj = 0; bj < 2; ++bj) { f32x4 v0 = acc[ai][bj][m][0], v1 = acc[ai][bj][m][1];
                    if (dg) { v0 = (f32x4){gelu_t(v0[0]), gelu_t(v0[1]), gelu_t(v0[2]), gelu_t(v0[3])}; v1 = (f32x4){gelu_t(v1[0]), gelu_t(v1[1]), gelu_t(v1[2]), gelu_t(v1[3])}; }
                    v0 = v0 * sc; v1 = v1 * sc;
                    u32x4 w; w.x = pk(v0[0], v0[1]); w.y = pk(v0[2], v0[3]); w.z = pk(v1[0], v1[1]); w.w = pk(v1[2], v1[3]);
                    *(u32x4*)(rowp + bj * 128) = w; } }
    }
};
struct EpiResid {
    static constexpr bool PERM = false, AFTER_DRAIN = false;
    const float* X; float* Z;
    __device__ __forceinline__ void operator()(const f32x4 (&acc)[2][2][4][2], const Unit& u, int wr, int wc, int fr, int fq) const {
        const int col0 = u.pn * 256 + wc * 32 + 4 * fq;
#pragma unroll
        for (int ai = 0; ai < 2; ++ai)
#pragma unroll
            for (int mp = 0; mp < 2; ++mp) { f32x4 x[2][2][2];
#pragma unroll
                for (int m2 = 0; m2 < 2; ++m2) { const size_t off = (size_t)(u.pm * 256 + ai * 128 + wr * 64 + (2 * mp + m2) * 16 + fr) * D + col0;
#pragma unroll
                    for (int bj = 0; bj < 2; ++bj)
#pragma unroll
                        for (int n = 0; n < 2; ++n) x[m2][bj][n] = __builtin_nontemporal_load((const f32x4*)(X + off + bj * 128 + n * 16)); }
#pragma unroll
                for (int m2 = 0; m2 < 2; ++m2) { const size_t off = (size_t)(u.pm * 256 + ai * 128 + wr * 64 + (2 * mp + m2) * 16 + fr) * D + col0;
#pragma unroll
                    for (int bj = 0; bj < 2; ++bj)
#pragma unroll
                        for (int n = 0; n < 2; ++n) *(f32x4*)(Z + off + bj * 128 + n * 16) = x[m2][bj][n] * ALPHA + acc[ai][bj][2 * mp + m2][n]; } }
    }
};
struct EpiQ {
    static constexpr bool PERM = false, AFTER_DRAIN = false;
    unsigned char* ws;
    __device__ __forceinline__ void operator()(const f32x4 (&acc)[2][2][4][2], const Unit& u, int wr, int wc, int fr, int fq) const {
        bf16_t* Q = (bf16_t*)(ws + S_Q96); const float* rinv = (const float*)(ws + WS_RINV); const float* rope = (const float*)(ws + WS_ROPE);
#pragma unroll
        for (int ai = 0; ai < 2; ++ai)
#pragma unroll
            for (int m = 0; m < 4; ++m) { const int row = u.pm * 256 + ai * 128 + wr * 64 + m * 16 + fr; const float sc = rinv[row * 2];
#pragma unroll
                for (int bj = 0; bj < 2; ++bj) { const int blk = u.pn * 8 + bj * 4 + wc; f32x4 x1 = acc[ai][bj][m][0] * sc, x2 = acc[ai][bj][m][1] * sc;
                    if (blk % 3 == 2) { const f32x4 c = *(const f32x4*)(rope + (size_t)row * 32 + 4 * fq), sn = *(const f32x4*)(rope + (size_t)row * 32 + 16 + 4 * fq);
                        const f32x4 y1 = x1 * c - x2 * sn, y2 = x1 * sn + x2 * c; x1 = y1; x2 = y2; }
                    const auto s0 = __builtin_amdgcn_permlane16_swap(pk(x2[0], x2[1]), pk(x1[0], x1[1]), false, false), s1 = __builtin_amdgcn_permlane16_swap(pk(x2[2], x2[3]), pk(x1[2], x1[3]), false, false);
                    const u32x4 w = {s0[0], s1[0], s0[1], s1[1]};
                    *(u32x4*)(Q + (size_t)row * 768 + blk * 32 + ((fq & 1) ? 0 : 16) + ((fq & 2) ? 8 : 0)) = w; }
                asm volatile("" ::: "memory"); }
    }
};
struct EpiKV {
    static constexpr bool PERM = true, AFTER_DRAIN = false;
    unsigned char* ws;
    __device__ __forceinline__ void operator()(const f32x4 (&acc)[2][2][4][2], const Unit& u, int wr, int wc, int fr, int fq) const {
        const float* rinv = (const float*)(ws + WS_RINV);
        bf16_t* O = (bf16_t*)(ws + ((u.pn < 2) ? S_KN : S_V)); const int col0 = (u.pn & 1) * 256 + wc * 32 + 8 * fq;
#pragma unroll
        for (int ai = 0; ai < 2; ++ai)
#pragma unroll
            for (int m = 0; m < 4; ++m) { const int row = u.pm * 256 + ai * 128 + wr * 64 + m * 16 + fr; const float sc = rinv[row * 2 + 1];
#pragma unroll
                for (int bj = 0; bj < 2; ++bj) { const f32x4 v0 = acc[ai][bj][m][0] * sc, v1 = acc[ai][bj][m][1] * sc;
                    u32x4 w; w.x = pk(v0[0], v0[1]); w.y = pk(v0[2], v0[3]); w.z = pk(v1[0], v1[1]); w.w = pk(v1[2], v1[3]);
                    *(u32x4*)(O + (size_t)row * 512 + col0 + bj * 128) = w; }
                asm volatile("" ::: "memory"); }
    }
};
struct EpiMoeUp {
    static constexpr bool PERM = true, AFTER_DRAIN = false;
    bf16_t* H;
    __device__ __forceinline__ void operator()(const f32x4 (&acc)[2][2][4][2], const Unit& u, int wr, int wc, int fr, int fq) const {
        const int row0 = u.pm * 256 + wr * 64 + fr, col0 = (u.pn & 1) * 128 + wc * 16 + ((fq & 1) ? 0 : 64) + ((fq & 2) ? 8 : 0);
#pragma unroll
        for (int ai = 0; ai < 2; ++ai)
#pragma unroll
            for (int m = 0; m < 4; ++m) { bf16_t* rowp = H + (size_t)(row0 + ai * 128 + m * 16) * 256 + col0;
                u32x2 hw[2];
#pragma unroll
                for (int bj = 0; bj < 2; ++bj) { const f32x4 g = acc[ai][bj][m][0], up = acc[ai][bj][m][1]; f32x4 h;
#pragma unroll
                    for (int e = 0; e < 4; ++e) h[e] = g[e] * __builtin_amdgcn_rcpf(1.f + ex2(-LOG2E * g[e])) * up[e];
                    hw[bj].x = pk(h[0], h[1]); hw[bj].y = pk(h[2], h[3]); }
                const auto s0 = __builtin_amdgcn_permlane16_swap(hw[1].x, hw[0].x, false, false), s1 = __builtin_amdgcn_permlane16_swap(hw[1].y, hw[0].y, false, false);
                const u32x4 w = {s0[0], s1[0], s0[1], s1[1]};
                *(u32x4*)rowp = w; }
    }
};
struct EpiMoeDown {
    static constexpr bool PERM = true, AFTER_DRAIN = false;
    bf16_t* Y;
    __device__ __forceinline__ void operator()(const f32x4 (&acc)[2][2][4][2], const Unit& u, int wr, int wc, int fr, int fq) const {
        const int row0 = u.pm * 256 + wr * 64 + fr, col0 = (u.pn & 3) * 256 + wc * 32 + 8 * fq;
#pragma unroll
        for (int ai = 0; ai < 2; ++ai)
#pragma unroll
            for (int m = 0; m < 4; ++m) { bf16_t* rowp = Y + (size_t)(row0 + ai * 128 + m * 16) * D + col0;
#pragma unroll
                for (int bj = 0; bj < 2; ++bj) { const f32x4 v0 = acc[ai][bj][m][0], v1 = acc[ai][bj][m][1];
                    u32x4 w; w.x = pk(v0[0], v0[1]); w.y = pk(v0[2], v0[3]); w.z = pk(v1[0], v1[1]); w.w = pk(v1[2], v1[3]);
                    *(u32x4*)(rowp + bj * 128) = w; } }
    }
};
template <int NC> struct MoeOrder {
    const LAS int* pe; int nunits, G, c;
    const LAS int* ebase; const int* expl;
    __device__ __forceinline__ int arow(const Unit& u, int r) const { const int e = u.pn / NC; return expl[(size_t)e * T + (u.pm * 256 + r - ebase[e])] & (T - 1); }
    __device__ __forceinline__ bool next(int i, Unit& u) const { const int L = i * G + c; if (L >= nunits) return false; const int p = L / NC; u.pm = p; u.pn = pe[p] * NC + (L % NC); return true; }
    __device__ __forceinline__ void a_ready(const Unit&) const {}
    __device__ __forceinline__ void done(const Unit&) const {}
};

__device__ __forceinline__ void p0_load(float (&wv)[64], const float* W, int ldw, int N, int item, int lane) {
    const int nblk = (N + 63) / 64, kb = item / nblk, nb = item % nblk, k0 = 64 * kb, n0 = 64 * nb, nn = n0 + lane;
#pragma unroll
    for (int i = 0; i < 64; ++i) wv[i] = (nn < N) ? __builtin_nontemporal_load(W + (size_t)(k0 + i) * ldw + nn) : 0.f;
}
__device__ __forceinline__ void p0_finish(const float (&wv)[64], int K, int N, bf16_t* WT, int rmode, int row_off, const float* kscale, LAS float* scr, int item, int lane) {
    const int nblk = (N + 63) / 64, kb = item / nblk, nb = item % nblk, k0 = 64 * kb, n0 = 64 * nb;
#pragma unroll
    for (int i = 0; i < 64; ++i) { float v = wv[i]; if (kscale) v *= kscale[k0 + i]; scr[i * 65 + lane] = v; }
    LDS_WAIT(); asm volatile("" ::: "memory");
    const int c = lane & 7;
#pragma unroll
    for (int j = 0; j < 8; ++j) { const int n = (lane >> 3) + 8 * j; const LAS float* s = scr + (8 * c) * 65 + n;
        v4u o; o.x = pk(s[0 * 65], s[1 * 65]); o.y = pk(s[2 * 65], s[3 * 65]); o.z = pk(s[4 * 65], s[5 * 65]); o.w = pk(s[6 * 65], s[7 * 65]);
        const int ng = n0 + n; const int r = (rmode == 0) ? row_off + ng : (row_off + (ng >> 2) * 8 + (rmode == 2 ? 4 : 0) + (ng & 3));
        if (ng < ((N + 31) & ~31)) *(GAS v4u*)(WT + (size_t)r * K + k0 + 8 * c) = o; }
    LDS_WAIT(); asm volatile("" ::: "memory");
}
__device__ __forceinline__ void p0_item(const float* W, int ldw, int K, int N, bf16_t* WT, int rmode, int row_off, const float* kscale, LAS float* scr, int item, int lane) {
    float wv[64]; p0_load(wv, W, ldw, N, item, lane); p0_finish(wv, K, N, WT, rmode, row_off, kscale, scr, item, lane);
}
__device__ __forceinline__ void p0_item_k(const float* W, int ldw, int K, int KP, int N, bf16_t* WT, int rmode, int row_off, const float* kscale, LAS float* scr, int item, int lane) {
    (void)K; float wv[64]; p0_load(wv, W, ldw, N, item, lane); p0_finish(wv, KP, N, WT, rmode, row_off, kscale, scr, item, lane);
}
struct ConvJob { const float* W; int ldw, K, N; bf16_t* WT; int rmode, row_off; const float* kscale; int nitems; };

__device__ __forceinline__ void p0_moe(Frame& F, int le_lo, int le_hi, bool down, int gw, int ngw) {
    LAS float* scr = (LAS float*)(F.lds + RING_OFF + F.wave * 16640);
    unsigned char* ws = F.ws;
    constexpr int IG = 16 * 4, ID = 4 * 16;
    const int PER = down ? ID : 2 * IG;
    for (int it0 = le_lo * PER + gw; it0 < le_hi * PER; it0 += ngw) { const int le = it0 / PER; int it = it0 % PER;
        bf16_t* gu = (bf16_t*)(ws + WS_WGU) + (size_t)le * 512 * 1024; bf16_t* wd = (bf16_t*)(ws + WS_WD) + (size_t)le * 1024 * 256;
        if (down) { p0_item((const float*)F.in[27] + (size_t)le * 256 * 1024, 1024, 256, 1024, wd, 0, 0, nullptr, scr, it, F.lane); continue; }
        if (it < IG) { p0_item((const float*)F.in[25] + (size_t)le * 1024 * 256, 256, 1024, 256, gu, 1, 0, nullptr, scr, it, F.lane); continue; } it -= IG;
        p0_item((const float*)F.in[26] + (size_t)le * 1024 * 256, 256, 1024, 256, gu, 2, 0, nullptr, scr, it, F.lane);
    }
}
__device__ __forceinline__ void p0_cbias_part(Frame& F, int gw, int ngw) {
    float* part = (float*)(F.ws + WS_CBIAS + 4096);
    for (int task = gw; task < 64; task += ngw) { const int kv = task >> 5, kc = task & 31;
        const float* w1 = (const float*)F.in[kv ? 17 : 15] + (size_t)kc * 64 * 256 + F.lane * 4;
        const int pv = __float_as_int(((const float*)F.in[14])[kv * 2048 + kc * 64 + F.lane]);
        f32x4 a = {0.f, 0.f, 0.f, 0.f};
#pragma unroll 16
        for (int i = 0; i < 64; ++i) a += *(const f32x4*)(w1 + (size_t)i * 256) * __int_as_float(__builtin_amdgcn_readlane(pv, i));
        *(f32x4*)(part + (size_t)task * 256 + F.lane * 4) = a; }
}
__device__ __forceinline__ void p0_cbias_sum(Frame& F) {
    const float* part = (const float*)(F.ws + WS_CBIAS + 4096); float* cb = (float*)(F.ws + WS_CBIAS);
    const int o = F.tid, kv = o >> 8, h = o & 255; float a = 0.f;
    for (int kc = 0; kc < 32; ++kc) a += part[(size_t)(kv * 32 + kc) * 256 + h];
    cb[o] = a;
}
__device__ __forceinline__ void idle_share(int nunits, int G, int c, int& idx, int& n) { const int rem = nunits % G; if (rem == 0) { idx = c; n = G; } else if (c >= rem) { idx = c - rem; n = G - rem; } else { idx = 0; n = 0; } }
__device__ __forceinline__ void p0_prologue(Frame& F) {
    LAS float* scr = (LAS float*)(F.lds + RING_OFF + F.wave * 16640);
    const int gw = F.vcu * NWAVES + F.wave, NGW = F.G * NWAVES;
    unsigned char* ws = F.ws;
    {
        const float* in2 = (const float*)F.in[2];
#define JOB2(Wp, ldw_, K_, N_, dst, rm, ro, ks) { const int nit = ((K_) / 64) * (((N_) + 63) / 64); if (it < nit) { p0_item_k((const float*)(Wp), ldw_, K_, 256, N_, (bf16_t*)(dst), rm, ro, ks, scr, it, F.lane); continue; } it -= nit; }
#define JOB(Wp, ldw_, K_, N_, dst, rm, ro, ks) { const int nit = ((K_) / 64) * (((N_) + 63) / 64); if (it < nit) { p0_item((const float*)(Wp), ldw_, K_, N_, (bf16_t*)(dst), rm, ro, ks, scr, it, F.lane); continue; } it -= nit; }
        constexpr int TOT = 16 * 23 + 4 * 12 + 2 * 8 + 2 * 8 + 16 * 16 + 16 * 29 + 32 * 4 * 2 + 4 * 1 * 2 + 16 * 16;
        for (int it0 = gw; it0 < TOT; it0 += NGW) { int it = it0;
            JOB(in2, 1440, 1024, 1440, ws + WS_W0IN, 0, 0, nullptr)
            JOB(F.in[9], 768, 256, 768, ws + WS_WUQ, 0, 0, (const float*)F.in[7])
            JOB2(F.in[10], 512, 128, 512, ws + WS_WUKV, 0, 0, (const float*)F.in[8])
            JOB2(F.in[11], 512, 128, 512, ws + WS_WUKV, 0, 512, (const float*)F.in[8])
            JOB(F.in[12], 1024, 1024, 1024, ws + WS_W0O, 0, 0, nullptr)
            JOB(F.in[13], 1840, 1024, 1840, ws + WS_W1IN, 0, 0, nullptr)
            JOB(F.in[15], 256, 2048, 256, ws + WS_WCK1, 0, 0, nullptr)
            JOB(F.in[17], 256, 2048, 256, ws + WS_WCV1, 0, 0, nullptr)
            JOB(F.in[16], 64, 256, 64, ws + WS_WCK2, 0, 0, nullptr)
            JOB(F.in[18], 64, 256, 64, ws + WS_WCV2, 0, 0, nullptr)
            JOB(F.in[20], 1024, 1024, 1024, ws + WS_W1O, 0, 0, nullptr)
        }
#undef JOB
#undef JOB2
    }
    p0_moe(F, 0, 32, false, gw, NGW);
    const int gt = F.vcu * NTHR + F.tid, NGT = F.G * NTHR;
    { v4u z = {0u, 0u, 0u, 0u};
      for (int i = gt; i < 96 * 128; i += NGT) *(GAS v4u*)((bf16_t*)(ws + WS_W0IN) + (size_t)1440 * 1024 + (size_t)i * 8) = z;
      for (int i = gt; i < 192 * 128; i += NGT) *(GAS v4u*)((bf16_t*)(ws + WS_W1IN) + (size_t)1856 * 1024 + (size_t)i * 8) = z; }
    { float* rope = (float*)(ws + WS_ROPE); const int* pos = (const int*)F.in[1];
      for (int i = gt; i < T * 16; i += NGT) { const int tok = i >> 4, j = i & 15; const float ang = (float)pos[tok] * expf(-9.210340371976184f * (float)j * (1.f / 16.f));
          double a = (double)ang; a -= 6.283185307179586 * rint(a * 0.15915494309189535); const float r = (float)a;
          rope[tok * 32 + j] = cosf(r); rope[tok * 32 + 16 + j] = sinf(r); }
      v4u z = {0u, 0u, 0u, 0u};
      for (int i = gt; i < 1024 * 16; i += NGT) *(GAS v4u*)((bf16_t*)(ws + WS_WUKV) + (size_t)(i >> 4) * 256 + 128 + (i & 15) * 8) = z; }
    { const float* gws = (const float*)F.in[5]; bf16_t* wsb = (bf16_t*)(ws + WS_WSB);
      for (int i = gt; i < 4 * 128 * 128; i += NGT) { const int s = i & 127, t = (i >> 7) & 127; wsb[i] = (bf16_t)(pk(s <= t ? gws[i] : 0.f, 0.f) & 0xffffu); } }
    p0_cbias_part(F, NGW - 1 - gw, NGW);
    { const float* x = (const float*)F.in[0]; bf16_t* xb = (bf16_t*)(ws + S_XB);
      const int gwv = gt >> 6, NW = NGT >> 6, ln = F.lane; const bool odd = ln & 1;
      for (int c0 = gwv; c0 < T * D / 512; c0 += 4 * NW) { f32x4 a[4], b[4];
#pragma unroll
          for (int u = 0; u < 4; ++u) { const size_t base = ((size_t)c0 + (size_t)u * NW) * 512; a[u] = __builtin_nontemporal_load((const GAS f32x4*)(x + base + ln * 4)); b[u] = __builtin_nontemporal_load((const GAS f32x4*)(x + base + 256 + ln * 4)); }
#pragma unroll
          for (int u = 0; u < 4; ++u) { const size_t base = ((size_t)c0 + (size_t)u * NW) * 512;
              const unsigned ax = pk(a[u][0], a[u][1]), ay = pk(a[u][2], a[u][3]), bx = pk(b[u][0], b[u][1]), by = pk(b[u][2], b[u][3]);
              const unsigned rx = (unsigned)__builtin_amdgcn_update_dpp(0, (int)(odd ? ax : bx), 0xB1, 0xf, 0xf, true), ry = (unsigned)__builtin_amdgcn_update_dpp(0, (int)(odd ? ay : by), 0xB1, 0xf, 0xf, true);
              v4u o; o.x = odd ? rx : ax; o.y = odd ? ry : ay; o.z = odd ? bx : rx; o.w = odd ? by : ry;
              *(GAS v4u*)(xb + base + (odd ? 256 : 0) + (ln >> 1) * 8) = o; } } }
}

__device__ __forceinline__ void wt_load(u32x4 (&v)[4], const unsigned char* base, unsigned pitch, int lane) {
#pragma unroll
    for (int i = 0; i < 4; ++i) v[i] = *(const u32x4*)(base + (size_t)(8 * i + (lane >> 3)) * pitch + (lane & 7) * 16);
}
__device__ __forceinline__ void wt_store(LAS unsigned char* t, const u32x4 (&v)[4], int lane) {
#pragma unroll
    for (int i = 0; i < 4; ++i) { const int row = 8 * i + (lane >> 3); *(LAS u32x4*)(t + row * 128 + (((lane & 7) ^ ((row >> 1) & 7)) << 4)) = v[i]; }
}
__device__ __forceinline__ bf16x8 wt_frag(const LAS unsigned char* t, int ks, int lane) { const int r32 = lane & 31; return *(const LAS bf16x8*)(t + r32 * 128 + (((2 * ks + (lane >> 5)) ^ ((r32 >> 1) & 7)) << 4)); }

__device__ __forceinline__ void store4(bf16_t* p, float a, float b, float c, float d) { u32x2 w; w.x = pk(a, b); w.y = pk(c, d); *(u32x2*)p = w; }
__device__ __forceinline__ void mla_prep_rows(Frame& F) {
    const int lane = F.lane; const bf16_t* H0B = (const bf16_t*)(F.ws + S_H0B);
    float* rinv = (float*)(F.ws + WS_RINV); const float* rope = (const float*)(F.ws + WS_ROPE); bf16_t* KRB = (bf16_t*)(F.ws + S_KRB);
    const int gw = F.vcu * NWAVES + F.wave, NGW = F.G * NWAVES;
    for (int t0 = gw * 4; t0 < T; t0 += NGW * 4) {
        s16x4 cq[4]; unsigned ck[4]; float x1[4], x2[4], cc[4], ss[4];
#pragma unroll
        for (int u = 0; u < 4; ++u) { const bf16_t* h = H0B + (size_t)(t0 + u) * 1536; cq[u] = *(const s16x4*)(h + 1024 + lane * 4); ck[u] = *(const unsigned*)(h + 1280 + lane * 2);
            x1[u] = bf2f(h[1408 + (lane & 15)]); x2[u] = bf2f(h[1408 + 16 + (lane & 15)]); cc[u] = rope[(size_t)(t0 + u) * 32 + (lane & 15)]; ss[u] = rope[(size_t)(t0 + u) * 32 + 16 + (lane & 15)]; }
#pragma unroll
        for (int u = 0; u < 4; ++u) { float q = 0.f;
#pragma unroll
            for (int e = 0; e < 4; ++e) { const float v = bf2f((unsigned short)cq[u][e]); q += v * v; }
            const float a = __uint_as_float(ck[u] << 16), b = __uint_as_float(ck[u] & 0xffff0000u); const float k = a * a + b * b;
            const float sq = wsum(q), sk = wsum(k);
            if (lane == 0) { rinv[(size_t)(t0 + u) * 2] = rsqrtf(sq * (1.f / 256.f) + LN_EPS) * QS_MLA; rinv[(size_t)(t0 + u) * 2 + 1] = rsqrtf(sk * (1.f / 128.f) + LN_EPS); }
            if (lane < 16) { KRB[(size_t)(t0 + u) * 32 + lane] = (bf16_t)(pk(x1[u] * cc[u] - x2[u] * ss[u], 0.f) & 0xffffu); KRB[(size_t)(t0 + u) * 32 + 16 + lane] = (bf16_t)(pk(x1[u] * ss[u] + x2[u] * cc[u], 0.f) & 0xffffu); } }
    }
}

constexpr int VN_STR = 1088;
__device__ __forceinline__ void gmlp_chunk(Frame& F, int chunk, bool dry = false) {
    const int lane = F.lane, wave = F.wave, r32 = lane & 31, hi = lane >> 5;
    bf16_t* H0B = (bf16_t*)(F.ws + S_H0B);
    const float* lng = (const float*)F.in[3]; const float* lnb = (const float*)F.in[4];
    LAS unsigned char* img = F.lds + RING_OFF;
    float g8[8], b8[8];
#pragma unroll
    for (int e = 0; e < 8; ++e) { g8[e] = lng[lane * 8 + e]; b8[e] = lnb[lane * 8 + e]; }
    bf16x8 xr[16];
#pragma unroll
    for (int i = 0; i < 16; ++i) xr[i] = ld8g(H0B + (size_t)(chunk * 128 + wave * 16 + i) * 1536 + 512 + lane * 8);
#pragma unroll
    for (int i = 0; i < 16; ++i) { const int row = wave * 16 + i; const bf16x8 x = xr[i];
        float v[8]; float s = 0.f;
#pragma unroll
        for (int e = 0; e < 8; ++e) { v[e] = bf2f((unsigned short)x[e]); s += v[e]; }
        const float mean = wsum(s) * (1.f / 512.f); float q = 0.f;
#pragma unroll
        for (int e = 0; e < 8; ++e) { v[e] -= mean; q += v[e] * v[e]; }
        const float rstd = rsqrtf(wsum(q) * (1.f / 512.f) + LN_EPS);
#pragma unroll
        for (int e = 0; e < 8; ++e) v[e] = v[e] * rstd * g8[e] + b8[e];
        u32x4 w; w.x = pk(v[0], v[1]); w.y = pk(v[2], v[3]); w.z = pk(v[4], v[5]); w.w = pk(v[6], v[7]);
        *(LAS u32x4*)(img + row * VN_STR + lane * 16) = w; }
    __syncthreads();
    const int g = wave >> 1, th = wave & 1;
    const bf16_t* wsb = (const bf16_t*)(F.ws + WS_WSB) + (size_t)g * 128 * 128;
    const float* bs = (const float*)F.in[6] + g * 128;
    const int i15 = lane & 15, g1 = (lane >> 4) & 1;
#pragma unroll 1
    for (int nt = 0; nt < 2; ++nt) {
        const int t = th * 64 + nt * 32 + r32;
        const int nks = (th * 64 + nt * 32 + 31) / 16 + 1;
        bf16x8 bw[8];
#pragma unroll
        for (int ks = 0; ks < 8; ++ks) bw[ks] = ld8g(wsb + (size_t)t * 128 + ks * 16 + hi * 8);
        const float bias = bs[t];
        bf16x8 uq[4][2];
#pragma unroll
        for (int ct = 0; ct < 4; ++ct)
#pragma unroll
            for (int i = 0; i < 2; ++i) uq[ct][i] = *(const bf16x8*)(H0B + (size_t)(chunk * 128 + t) * 1536 + g * 128 + ct * 32 + (hi ? 0 : 8) + 16 * i);
#pragma unroll
        for (int ct = 0; ct < 4; ++ct) {
            const LAS unsigned char* abase = img + (8 * hi + (i15 >> 2)) * VN_STR + (g * 128 + ct * 32 + 16 * g1 + 4 * (i15 & 3)) * 2;
            f32x16 acc = {};
#pragma unroll
            for (int ks = 0; ks < 8; ++ks) { if (ks < nks) {
                const s16x4 lo = trld(abase + (16 * ks) * VN_STR), hi4 = trld(abase + (16 * ks + 4) * VN_STR);
                const bf16x8 a = {lo[0], lo[1], lo[2], lo[3], hi4[0], hi4[1], hi4[2], hi4[3]};
                acc = mfma32(a, bw[ks], acc); } }
            bf16_t* urow = H0B + (size_t)(chunk * 128 + t) * 1536 + g * 128 + ct * 32 + (hi ? 0 : 8);
            bf16_t* orow = (dry ? ((bf16_t*)(F.ws + WS_Z1) + (urow - H0B)) : urow) + 512;
#pragma unroll
            for (int i = 0; i < 2; ++i) { const bf16x8 uu = uq[ct][i]; float lo4[4], hi4f[4];
#pragma unroll
                for (int e = 0; e < 4; ++e) { const auto r = __builtin_amdgcn_permlane32_swap(__float_as_uint(acc[4 * (2 * i + 1) + e] + bias), __float_as_uint(acc[4 * (2 * i) + e] + bias), false, false);
                    lo4[e] = __uint_as_float(r[0]); hi4f[e] = __uint_as_float(r[1]); }
                u32x4 w; w.x = pk(bf2f((unsigned short)uu[0]) * lo4[0], bf2f((unsigned short)uu[1]) * lo4[1]); w.y = pk(bf2f((unsigned short)uu[2]) * lo4[2], bf2f((unsigned short)uu[3]) * lo4[3]);
                w.z = pk(bf2f((unsigned short)uu[4]) * hi4f[0], bf2f((unsigned short)uu[5]) * hi4f[1]); w.w = pk(bf2f((unsigned short)uu[6]) * hi4f[2], bf2f((unsigned short)uu[7]) * hi4f[3]);
                *(u32x4*)(orow + 16 * i) = w; }
        }
    }
    __syncthreads();
}

constexpr float NEGF = -1e30f;
__device__ __forceinline__ void pack_p(u32x4 (&pw)[4], const f32x16& p0, const f32x16& p1) {
    pw[0] = (u32x4){pk(p0[0], p0[1]), pk(p0[2], p0[3]), pk(p0[4], p0[5]), pk(p0[6], p0[7])}; pw[1] = (u32x4){pk(p0[8], p0[9]), pk(p0[10], p0[11]), pk(p0[12], p0[13]), pk(p0[14], p0[15])};
    pw[2] = (u32x4){pk(p1[0], p1[1]), pk(p1[2], p1[3]), pk(p1[4], p1[5]), pk(p1[6], p1[7])}; pw[3] = (u32x4){pk(p1[8], p1[9]), pk(p1[10], p1[11]), pk(p1[12], p1[13]), pk(p1[14], p1[15])};
}
struct AttnSt { f32x16 o[2]; f32x16 negm; float mref, l; int started; };
__device__ __forceinline__ void attn_reset(AttnSt& st) { st.o[0] = f32x16{}; st.o[1] = f32x16{}; st.negm = f32x16{}; st.mref = 0.f; st.l = 0.f; st.started = 0; }
constexpr int KV_ROPE = 8192;
template <bool ROPE> struct KvL { static constexpr int V = ROPE ? 12288 : 8192, SUB = ROPE ? 20480 : 16384, BUF = 2 * SUB; };
template <int NKS>
__device__ __forceinline__ void qk_tile(f32x16& p0, f32x16& p1, const LAS unsigned char* Kt, const bf16x8* qf, const f32x16& cinit, int lane) {
    const int r32 = lane & 31, hi = lane >> 5, sw = (r32 >> 1) & 7;
    const LAS unsigned char* kp = Kt + r32 * 128;
#pragma unroll
    for (int ks = 0; ks < NKS; ++ks) {
        bf16x8 a0, a1;
        if (ks < 4) { const int off = ((2 * ks + hi) ^ sw) << 4; a0 = *(const LAS bf16x8*)(kp + off); a1 = *(const LAS bf16x8*)(kp + 4096 + off); }
        else { const LAS unsigned char* rp = Kt + KV_ROPE + r32 * 64 + (((2 * (ks - 4) + hi) ^ ((r32 >> 2) & 3)) << 4); a0 = *(const LAS bf16x8*)rp; a1 = *(const LAS bf16x8*)(rp + 2048); }
        if (ks == 0) { p0 = mfma32(a0, qf[0], cinit); p1 = mfma32(a1, qf[0], cinit); } else { p0 = mfma32(a0, qf[ks], p0); p1 = mfma32(a1, qf[ks], p1); } }
}
__device__ __forceinline__ float max3(float a, float b, float c) { return fmaxf(fmaxf(a, b), c); }
constexpr float ATT_THR = 8.f;
template <class Mask>
__device__ __forceinline__ void softmax2(f32x16& p0, f32x16& p1, AttnSt& st, bool need_mask, const Mask& valid, bool lanebit, int lane, u32x4 (&pw)[4]) {
    const int hi = lane >> 5;
    if (need_mask) {
#pragma unroll
        for (int r = 0; r < 16; ++r) { const int k0 = crow(r, hi); if (!valid(k0)) p0[r] = NEGF; if (!valid(k0 + 32)) p1[r] = NEGF; } }
    float ma = max3(p0[0], p0[1], p1[0]), mb = max3(p0[2], p0[3], p1[1]); ma = max3(ma, p1[2], p1[3]);
#pragma unroll
    for (int r = 4; r < 16; r += 4) { ma = max3(ma, p0[r], p0[r + 1]); mb = max3(mb, p0[r + 2], p0[r + 3]); ma = max3(ma, p1[r], p1[r + 1]); mb = max3(mb, p1[r + 2], p1[r + 3]); }
    float mx = fmaxf(ma, mb); mx = fmaxf(mx, __shfl_xor(mx, 32));
    if (!lanebit) mx = NEGF;
    const bool has = mx > -1e29f, fresh = has && !st.started;
    if (__any((mx > ATT_THR) || fresh)) {
        const float dl = has ? (fresh ? mx : fmaxf(mx, 0.f)) : 0.f;
        st.mref += dl; const float f = ex2(-dl); st.l *= f;
#pragma unroll
        for (int r = 0; r < 16; ++r) { p0[r] -= dl; p1[r] -= dl; st.o[0][r] *= f; st.o[1][r] *= f; st.negm[r] = -st.mref; }
        st.started |= has ? 1 : 0;
    }
    float sa = 0.f, sb = 0.f;
#pragma unroll
    for (int r = 0; r < 16; ++r) { p0[r] = ex2(p0[r]); p1[r] = ex2(p1[r]); sa += p0[r]; sb += p1[r]; }
    pack_p(pw, p0, p1);
    float sum = sa + sb;
    if (!lanebit) { sum = 0.f;
#pragma unroll
        for (int i = 0; i < 4; ++i) pw[i] = (u32x4){0u, 0u, 0u, 0u}; }
    st.l += sum;
}
__device__ __forceinline__ void pv_packed(f32x16 (&o)[2], const LAS unsigned char* Vt, const u32x4 (&pw)[4], int lane) {
    const int i15 = lane & 15, g1 = (lane >> 4) & 1, hi = lane >> 5, bsw = (i15 >> 3) & 1;
    const LAS unsigned char* vrow = Vt + (4 * hi + (i15 >> 2)) * 128 + (2 * g1 + ((i15 & 3) >> 1)) * 16 + (i15 & 1) * 8;
    const LAS unsigned char* vb0 = vrow + 64 * bsw; const LAS unsigned char* vb1 = vrow + 64 * (bsw ^ 1);
#pragma unroll
    for (int db = 0; db < 2; ++db)
#pragma unroll
        for (int s = 0; s < 4; ++s) { const LAS unsigned char* vb = db ? vb1 : vb0; const s16x4 lo = trld(vb + s * 2048), h4 = trld(vb + s * 2048 + 1024);
            const bf16x8 a = {lo[0], lo[1], lo[2], lo[3], h4[0], h4[1], h4[2], h4[3]};
            o[db] = mfma32(a, __builtin_bit_cast(bf16x8, pw[s]), o[db]); }
}
#define LDS_BAR() asm volatile("s_waitcnt lgkmcnt(0)\n\ts_barrier" ::: "memory")
__device__ __forceinline__ void glds16(const void* gsrc, unsigned lds_dst) { unsigned keep;
    asm volatile("s_mov_b32 %0, m0\n\ts_mov_b32 m0, %2\n\ts_nop 0\n\tglobal_load_lds_dwordx4 %1, off\n\ts_mov_b32 m0, %0" : "=&s"(keep) : "v"(gsrc), "s"(lds_dst) : "memory"); }
template <bool ROPE, class Src>
__device__ __forceinline__ void dma_tile(const Src& src, int j, LAS unsigned char* buf, int wave, unsigned koff, unsigned voff, unsigned roff) {
    const unsigned b = (unsigned)(size_t)buf;
    glds16(src.kbase(j) + koff, (unsigned)__builtin_amdgcn_readfirstlane(b + wave * 1024));
    glds16(src.vbase(j) + voff, (unsigned)__builtin_amdgcn_readfirstlane(b + KvL<ROPE>::V + wave * 1024));
    if (ROPE) glds16(src.rbase(j) + roff, (unsigned)__builtin_amdgcn_readfirstlane(b + KV_ROPE + (wave & 3) * 1024));
}
#define VMW(n) asm volatile("s_waitcnt vmcnt(" #n ")" ::: "memory")
struct NoHook { __device__ __forceinline__ void operator()(int) const {} };
template <int NKS, int NT, class It, class Src, class Act, class Mask, class Hook = NoHook>
__device__ __forceinline__ void attn_loop(AttnSt& st, const bf16x8* qf, It it, const Src& src, const Act& active, const Mask& mask, LAS unsigned char* kv, int tid_, int lane_, int abl = 0, const Hook& hook = Hook()) {
    const int tid = launder(tid_), lane = tid & 63, wave = __builtin_amdgcn_readfirstlane(tid >> 6); (void)lane_;
    constexpr bool ROPE = (NKS > 4); constexpr int SUB = KvL<ROPE>::SUB, BUF = NT * SUB, VO = KvL<ROPE>::V;
    int cur[NT], nxt[NT];
#pragma unroll
    for (int i = 0; i < NT; ++i) cur[i] = (i == 0 || cur[i > 0 ? i - 1 : 0] >= 0) ? it.next() : -1;
    if (cur[0] < 0) return;
    unsigned koff, voff, roff;
    { const int row = wave * 8 + (lane >> 3), c = lane & 7; koff = (unsigned)row * src.kpitch + (unsigned)((c ^ ((row >> 1) & 7)) << 4); voff = (unsigned)row * src.vpitch + (unsigned)((c ^ (((row >> 1) & 1) << 2)) << 4);
      const int rr = (wave & 3) * 16 + (lane >> 2), rc = lane & 3; roff = (unsigned)rr * 64u + (unsigned)((rc ^ ((rr >> 2) & 3)) << 4); }
#pragma unroll
    for (int i = 0; i < NT; ++i) if (cur[i] >= 0) dma_tile<ROPE>(src, cur[i], kv + i * SUB, wave, koff, voff, roff);
    int bc = 0;
    for (;;) {
        VMW(0);
        if (!(abl & 16)) LDS_BAR();
#pragma unroll
        for (int i = 0; i < NT; ++i) nxt[i] = (cur[NT - 1] >= 0 && (i == 0 || nxt[i > 0 ? i - 1 : 0] >= 0)) ? it.next() : -1;
        if (!(abl & 8)) {
#pragma unroll
            for (int i = 0; i < NT; ++i) if (nxt[i] >= 0) dma_tile<ROPE>(src, nxt[i], kv + (bc ^ 1) * BUF + i * SUB, wave, koff, voff, roff); }
#pragma unroll
        for (int sub = 0; sub < NT; ++sub) { const int jc = cur[sub];
            if (jc >= 0 && active(jc)) { const LAS unsigned char* kb = kv + bc * BUF + sub * SUB;
                hook(jc);
                f32x16 p0, p1; u32x4 pw[4]; __builtin_amdgcn_sched_barrier(0);
                if (!(abl & 1)) qk_tile<NKS>(p0, p1, kb, qf, st.negm, lane); else { p0 = st.negm; p1 = st.negm; } __builtin_amdgcn_sched_barrier(0);
                if (!(abl & 2)) softmax2(p0, p1, st, mask.need(jc), [&](int key) { return mask.valid(jc, key); }, mask.lanebit(jc), lane, pw); else pack_p(pw, p0, p1); __builtin_amdgcn_sched_barrier(0);
                if (!(abl & 4)) pv_packed(st.o, kb + VO, pw, lane); else st.o[0][0] += __uint_as_float(pw[0].x ^ pw[1].y ^ pw[2].z ^ pw[3].w); __builtin_amdgcn_sched_barrier(0); } }
        if (nxt[0] < 0) break;
#pragma unroll
        for (int i = 0; i < NT; ++i) cur[i] = nxt[i];
        bc ^= 1;
    }
    LDS_BAR();
}
struct RangeIt { int j, end; __device__ __forceinline__ int next() { return (j < end) ? j++ : -1; } };
struct BitIt { unsigned m; __device__ __forceinline__ int next() { if (!m) return -1; const int j = __builtin_ctz(m); m &= m - 1; return j; } };

__device__ __forceinline__ void store_wide(bf16_t* base, const u32x2 (&w)[4], int hi) {
#pragma unroll
    for (int i = 0; i < 2; ++i) {
        const auto r0 = __builtin_amdgcn_permlane32_swap(w[2 * i + 1].x, w[2 * i].x, false, false), r1 = __builtin_amdgcn_permlane32_swap(w[2 * i + 1].y, w[2 * i].y, false, false);
        const u32x4 v = {r0[0], r1[0], r0[1], r1[1]};
        *(u32x4*)(base + 16 * i + (hi ? 0 : 8)) = v; }
}
__device__ __forceinline__ void mla_attn_unit(Frame& F, int b, int h, int qb, int abl = 0) {
    const int lane = F.lane, wave = F.wave, r32 = lane & 31, hi = lane >> 5;
    const int q0 = qb * 256 + wave * 32, t = q0 + r32;
    const size_t rb = (size_t)b * S;
    const bf16_t* Q = (const bf16_t*)(F.ws + S_Q96) + (rb + t) * 768 + h * 96;
    const bf16_t* KN = (const bf16_t*)(F.ws + S_KN) + rb * 512 + h * 64; const bf16_t* KR = (const bf16_t*)(F.ws + S_KRB) + rb * 32; const bf16_t* V = (const bf16_t*)(F.ws + S_V) + rb * 512 + h * 64;
    bf16x8 qf[6];
#pragma unroll
    for (int ks = 0; ks < 6; ++ks) qf[ks] = ld8g(Q + ks * 16 + hi * 8);
    asm volatile("" : "+v"(qf[0]), "+v"(qf[1]), "+v"(qf[2]), "+v"(qf[3]), "+v"(qf[4]), "+v"(qf[5]));
    AttnSt st; attn_reset(st);
    struct Src { const unsigned char *KN, *KR, *V; unsigned kpitch, vpitch;
        __device__ __forceinline__ const unsigned char* kbase(int j) const { return KN + (size_t)j * 64 * 1024; }
        __device__ __forceinline__ const unsigned char* vbase(int j) const { return V + (size_t)j * 64 * 1024; }
        __device__ __forceinline__ const unsigned char* rbase(int j) const { return KR + (size_t)j * 64 * 64; } } src{(const unsigned char*)KN, (const unsigned char*)KR, (const unsigned char*)V, 1024u, 1024u};
    const int wlast = (q0 + 31) >> 6;
    struct MaskC { int t, tmin; __device__ __forceinline__ bool need(int j) const { return j * 64 + 63 > tmin; } __device__ __forceinline__ bool valid(int j, int key) const { return j * 64 + key <= t; }
        __device__ __forceinline__ bool lanebit(int) const { return true; } } mk{t, q0};
    if (!(abl & 32)) attn_loop<6, 3>(st, qf, RangeIt{0, qb * 4 + 4}, src, [&](int j) { return j <= wlast; }, mk, F.lds + RING_OFF, F.tid, lane, abl); if (abl & 64) return;
    float l = st.l + __shfl_xor(st.l, 32); const float inv = 1.f / l;
    bf16_t* O = (bf16_t*)(F.ws + S_H0B) + (rb + t) * 1536 + 1024 + h * 64;
#pragma unroll
    for (int db = 0; db < 2; ++db)
    { u32x2 w[4];
#pragma unroll
        for (int g4 = 0; g4 < 4; ++g4) { w[g4].x = pk(st.o[db][4 * g4] * inv, st.o[db][4 * g4 + 1] * inv); w[g4].y = pk(st.o[db][4 * g4 + 2] * inv, st.o[db][4 * g4 + 3] * inv); }
        store_wide(O + db * 32, w, hi); }
}

constexpr int NSA_IMP_OFF = 4 * KvL<false>::SUB  , NSA_SEL_OFF = LDS_SCR + 8192;
__device__ __forceinline__ void ob_add(u32x2 (&ob)[2][4], const f32x16 (&o)[2], float f, bool first) {
#pragma unroll
    for (int db = 0; db < 2; ++db)
#pragma unroll
        for (int g4 = 0; g4 < 4; ++g4) { float a0 = 0.f, a1 = 0.f, a2 = 0.f, a3 = 0.f;
            if (!first) { a0 = __uint_as_float(ob[db][g4].x << 16); a1 = __uint_as_float(ob[db][g4].x & 0xffff0000u); a2 = __uint_as_float(ob[db][g4].y << 16); a3 = __uint_as_float(ob[db][g4].y & 0xffff0000u); }
            ob[db][g4].x = pk(a0 + f * o[db][4 * g4], a1 + f * o[db][4 * g4 + 1]); ob[db][g4].y = pk(a2 + f * o[db][4 * g4 + 2], a3 + f * o[db][4 * g4 + 3]); }
}
__device__ __forceinline__ void nsa_unit(Frame& F, int b, int g, int tblk  , bool dry = false, int abl = 0) {
    const int lane = F.lane, wave = F.wave, tid = F.tid, r32 = lane & 31, hi = lane >> 5;
    const int t0 = tblk * 32, t = t0 + r32, tb = t0 >> 6, h = g * 8 + wave;
    const size_t rb = (size_t)b * S;
    bf16_t* H1B = (bf16_t*)(F.ws + S_H1B);
    bf16_t* qrow = H1B + (rb + t) * 2048;
    LAS unsigned char* kv = F.lds + RING_OFF;
    LAS float* impw = (LAS float*)(F.lds + NSA_IMP_OFF); LAS unsigned* selw = (LAS unsigned*)(F.lds + NSA_SEL_OFF);
    struct Src { const unsigned char *K, *V; unsigned kpitch, vpitch;
        __device__ __forceinline__ const unsigned char* kbase(int j) const { return K + (size_t)j * 64 * kpitch; }
        __device__ __forceinline__ const unsigned char* vbase(int j) const { return V + (size_t)j * 64 * vpitch; }
        __device__ __forceinline__ const unsigned char* rbase(int) const { return K; } };
    const int nk = (t0 >> 4) + 1;
    const int ntile = (nk + 63) >> 6;
    { Src sc{(const unsigned char*)((const bf16_t*)(F.ws + S_KCMP) + (size_t)(b * 2 + g) * 128 * 64), (const unsigned char*)((const bf16_t*)(F.ws + S_VCMP) + (size_t)(b * 2 + g) * 128 * 64), 128u, 128u};
      const int row = wave * 8 + (lane >> 3), c = lane & 7; const unsigned koff = (unsigned)row * 128u + (unsigned)((c ^ ((row >> 1) & 7)) << 4), voff = (unsigned)row * 128u + (unsigned)((c ^ (((row >> 1) & 1) << 2)) << 4);
      dma_tile<false>(sc, 0, kv, wave, koff, voff, 0u); if (ntile > 1) dma_tile<false>(sc, 1, kv + KvL<false>::SUB, wave, koff, voff, 0u); }
    bf16x8 qf[4];
#pragma unroll
    for (int ks = 0; ks < 4; ++ks) qf[ks] = ld8g(qrow + h * 64 + ks * 16 + hi * 8);
    bf16_t* orow = (dry ? ((bf16_t*)(F.ws + WS_Z1) + (qrow - H1B)) : qrow) + h * 64;
    const float* gate_b = (const float*)F.in[19];
    float gate[3];
#pragma unroll
    for (int br = 0; br < 3; ++br) { const float x = bf2f(qrow[1792 + br * 16 + h]) + gate_b[br * 16 + h]; gate[br] = __builtin_amdgcn_rcpf(1.f + ex2(-LOG2E * x)); }
    asm volatile("" : "+v"(qf[0]), "+v"(qf[1]), "+v"(qf[2]), "+v"(qf[3]), "+v"(gate[0]), "+v"(gate[1]), "+v"(gate[2]));
    if (tid == 0) selw[32] = 0u;
    u32x2 ob[2][4];
    {
        const int tid = launder(F.tid), lane = tid & 63, r32 = lane & 31, hi = lane >> 5;
        VMW(0); LDS_BAR();
        if (abl & 32) { f32x16 z2[2] = {f32x16{}, f32x16{}}; ob_add(ob, z2, 0.f, true); } else {
        f32x16 p[2][2]; float mx = NEGF;
#pragma unroll
        for (int tl = 0; tl < 2; ++tl) { __builtin_amdgcn_sched_barrier(0); if (tl < ntile) { qk_tile<4>(p[tl][0], p[tl][1], kv + tl * KvL<false>::SUB, qf, f32x16{}, lane);
#pragma unroll
                for (int kb = 0; kb < 2; ++kb)
#pragma unroll
                    for (int r = 0; r < 16; ++r) { const int n = tl * 64 + kb * 32 + crow(r, hi); if (t < 16 * n + 31) p[tl][kb][r] = NEGF; mx = fmaxf(mx, p[tl][kb][r]); } }
            else { p[tl][0] = f32x16{}; p[tl][1] = f32x16{};
#pragma unroll
                for (int r = 0; r < 16; ++r) { p[tl][0][r] = NEGF; p[tl][1][r] = NEGF; } } }
        mx = fmaxf(mx, __shfl_xor(mx, 32));
        const float muse = (mx < -1e29f) ? 0.f : mx; float sum = 0.f;
#pragma unroll
        for (int tl = 0; tl < 2; ++tl)
#pragma unroll
            for (int kb = 0; kb < 2; ++kb)
#pragma unroll
                for (int r = 0; r < 16; ++r) { p[tl][kb][r] = ex2(p[tl][kb][r] - muse); sum += p[tl][kb][r]; }
        sum += __shfl_xor(sum, 32);
        const float inv = (sum > 0.f) ? __builtin_amdgcn_rcpf(sum) : 0.f;
#pragma unroll
        for (int tl = 0; tl < 2; ++tl)
#pragma unroll
            for (int kb = 0; kb < 2; ++kb)
#pragma unroll
                for (int r = 0; r < 16; ++r) p[tl][kb][r] *= inv;
        { float carried = 0.f;
#pragma unroll
        for (int tl = 0; tl < 2; ++tl)
#pragma unroll
            for (int kb = 0; kb < 2; ++kb)
#pragma unroll
                for (int q4 = 0; q4 < 4; ++q4) { const int m = 8 * tl + 4 * kb + q4;
                    const float Gm = (p[tl][kb][4 * q4] + p[tl][kb][4 * q4 + 1]) + (p[tl][kb][4 * q4 + 2] + p[tl][kb][4 * q4 + 3]);
                    const float other = __shfl_xor(p[tl][kb][4 * q4 + 3], 32);
                    const float prev = hi ? other : carried; carried = other;
                    impw[(wave * 32 + r32) * 33 + 2 * m + hi] = Gm + prev; } }
        __builtin_amdgcn_sched_barrier(0);
        { f32x16 oc[2] = {f32x16{}, f32x16{}}; u32x4 pwa[4], pwb[4]; pack_p(pwa, p[0][0], p[0][1]); pack_p(pwb, p[1][0], p[1][1]); __builtin_amdgcn_sched_barrier(0);
          pv_packed(oc, kv + KvL<false>::V, pwa, lane); __builtin_amdgcn_sched_barrier(0);
          if (ntile > 1) pv_packed(oc, kv + KvL<false>::SUB + KvL<false>::V, pwb, lane); __builtin_amdgcn_sched_barrier(0);
          ob_add(ob, oc, gate[0], true); } }
        LDS_BAR();
    }
#pragma unroll 1
    for (int ps = (abl & 64) ? 2 : 0; ps < 2; ++ps) { const int lane = launder(F.tid) & 63, r32 = lane & 31, hi = lane >> 5; const int tokl = 4 * wave + 2 * ps + hi, j = r32; float a = 0.f;
#pragma unroll
        for (int w = 0; w < 8; ++w) a += impw[(w * 32 + tokl) * 33 + j];
        const bool forced = (j == 0) || (j == tb) || (j == tb - 1); const float sc = forced ? 1e4f : (j <= tb ? a : -1e4f);
        const int scb = __builtin_bit_cast(int, sc); int rank = 0;
#pragma unroll
        for (int k = 0; k < 32; ++k) { const float o0 = __builtin_bit_cast(float, __builtin_amdgcn_readlane(scb, k)), o1 = __builtin_bit_cast(float, __builtin_amdgcn_readlane(scb, 32 + k)); const float o = hi ? o1 : o0;
            rank += ((o > sc) || (o == sc && k < j)) ? 1 : 0; }
        const unsigned long long bal = __ballot(rank < 8);
        const unsigned mine = hi ? (unsigned)(bal >> 32) : (unsigned)bal;
        if (r32 == 0) { selw[tokl] = mine; __hip_atomic_fetch_or(&selw[32], mine, __ATOMIC_RELAXED, __HIP_MEMORY_SCOPE_WORKGROUP); } }
    LDS_BAR();
    const unsigned mysel = selw[r32]; const unsigned uni = selw[32] & ((tb >= 31) ? 0xffffffffu : ((2u << tb) - 1u));
    {
        AttnSt st; attn_reset(st);
        Src src{(const unsigned char*)(H1B + rb * 2048 + 1280 + g * 64), (const unsigned char*)(H1B + rb * 2048 + 1408 + g * 64), 4096u, 4096u};
        struct MaskS { int t, tb; unsigned sel; __device__ __forceinline__ bool need(int j) const { return j == tb; } __device__ __forceinline__ bool valid(int j, int key) const { return j * 64 + key <= t; }
            __device__ __forceinline__ bool lanebit(int j) const { return (sel >> j) & 1u; } } mk{t, tb, mysel};
        if (!(abl & 512)) attn_loop<4, 4>(st, qf, BitIt{uni}, src, [&](int) { return true; }, mk, kv, tid, lane, abl);
        const float l = st.l + __shfl_xor(st.l, 32); ob_add(ob, st.o, gate[1] * __builtin_amdgcn_rcpf(l), false);
    }
    {
        AttnSt st; attn_reset(st);
        Src src{(const unsigned char*)(H1B + rb * 2048 + 1536 + g * 64), (const unsigned char*)(H1B + rb * 2048 + 1664 + g * 64), 4096u, 4096u};
        const int jlo = (t0 - 511 > 0) ? ((t0 - 511) >> 6) : 0;
        struct MaskW { int t, tb, t0; __device__ __forceinline__ bool need(int j) const { return (j == tb) || (64 * j <= t0 + 31 - 512); }
            __device__ __forceinline__ bool valid(int j, int key) const { const int k = j * 64 + key; return (k <= t) && (k > t - 512); } __device__ __forceinline__ bool lanebit(int) const { return true; } } mk{t, tb, t0};
        if (!(abl & 512)) attn_loop<4, 4>(st, qf, RangeIt{jlo, tb + 1}, src, [&](int) { return true; }, mk, kv, tid, lane, abl);
        const float l = st.l + __shfl_xor(st.l, 32); ob_add(ob, st.o, gate[2] * __builtin_amdgcn_rcpf(l), false);
    }
#pragma unroll
    for (int db = 0; db < 2; ++db) store_wide(orow + db * 32, ob[db], hi);
}

__device__ __forceinline__ void cmp_item(Frame& F, int item) {
    const int lane = F.lane, wave = F.wave, r32 = lane & 31, hi = lane >> 5;
    const int rblk = item & 63, gk = item >> 6, g = gk & 1, kvsel = gk >> 1;
    const int row = rblk * 32 + r32, b = row >> 7, n = row & 127;
    const bf16_t* H1B = (const bf16_t*)(F.ws + S_H1B);
    const int ncl = (n < 127) ? n : 126;
    const bf16_t* src = H1B + ((size_t)b * S + 16 * ncl) * 2048 + 1024 + kvsel * 128 + g * 64 + hi * 8;
    (void)src;
    const unsigned char* W1 = (const unsigned char*)(F.ws + (kvsel ? WS_WCV1 : WS_WCK1)) + (size_t)(wave * 32) * 4096;
    LAS unsigned char* wl = F.lds + RING_OFF + wave * 16384;
    const unsigned char* xrow[4];
#pragma unroll
    for (int i = 0; i < 4; ++i) { const int rr = rblk * 32 + 8 * i + (lane >> 3), bb = rr >> 7, nn = rr & 127, nc = (nn < 127) ? nn : 126;
        xrow[i] = (const unsigned char*)(H1B + ((size_t)bb * S + 16 * nc) * 2048 + 1024 + kvsel * 128 + g * 64) + (lane & 7) * 16; }
    f32x16 acc = {};
    u32x4 wv[2][4], xv[2][4];
#pragma unroll
    for (int c = 0; c < 2; ++c) { wt_load(wv[c], W1 + c * 128, 4096u, lane);
#pragma unroll
        for (int i = 0; i < 4; ++i) xv[c][i] = *(const u32x4*)(xrow[i] + (size_t)c * 4096); }
#pragma unroll 1
    for (int l0 = 0; l0 < 32; l0 += 2) {
#pragma unroll
        for (int c = 0; c < 2; ++c) { wt_store(wl + c * 4096, wv[c], lane); wt_store(wl + (2 + c) * 4096, xv[c], lane); }
        if (l0 + 2 < 32) {
#pragma unroll
            for (int c = 0; c < 2; ++c) { wt_load(wv[c], W1 + (size_t)(l0 + 2 + c) * 128, 4096u, lane);
#pragma unroll
                for (int i = 0; i < 4; ++i) xv[c][i] = *(const u32x4*)(xrow[i] + (size_t)(l0 + 2 + c) * 4096); } }
#pragma unroll
        for (int c = 0; c < 2; ++c)
#pragma unroll
            for (int q = 0; q < 4; ++q) acc = mfma32(wt_frag(wl + c * 4096, q, lane), wt_frag(wl + (2 + c) * 4096, q, lane), acc);
    }
    const float* cb = (const float*)(F.ws + WS_CBIAS) + kvsel * 256 + wave * 32;
    LAS unsigned char* hid = F.lds + RING_OFF;
    __syncthreads();
#pragma unroll
    for (int g4 = 0; g4 < 4; ++g4) { const int c = 8 * g4 + 4 * hi; u32x2 w; w.x = pk(gelu_t(acc[4 * g4] + cb[c]), gelu_t(acc[4 * g4 + 1] + cb[c + 1])); w.y = pk(gelu_t(acc[4 * g4 + 2] + cb[c + 2]), gelu_t(acc[4 * g4 + 3] + cb[c + 3]));
        *(LAS u32x2*)(hid + r32 * 528 + (wave * 32 + c) * 2) = w; }
    __syncthreads();
    if (wave < 2) {
        const bf16_t* W2 = (const bf16_t*)(F.ws + (kvsel ? WS_WCV2 : WS_WCK2)) + (size_t)(wave * 32 + r32) * 256 + hi * 8;
        f32x16 o = {};
#pragma unroll
        for (int ks = 0; ks < 16; ++ks) o = mfma32(ld8g(W2 + ks * 16), *(const LAS bf16x8*)(hid + r32 * 528 + ks * 32 + hi * 16), o);
        bf16_t* dst = (bf16_t*)(F.ws + (kvsel ? S_VCMP : S_KCMP)) + ((size_t)(b * 2 + g) * 128 + n) * 64 + wave * 32 + 4 * hi;
        const float z = (n < 127) ? 1.f : 0.f;
#pragma unroll
        for (int g4 = 0; g4 < 4; ++g4) store4(dst + 8 * g4, o[4 * g4] * z, o[4 * g4 + 1] * z, o[4 * g4 + 2] * z, o[4 * g4 + 3] * z);
    }
    __syncthreads();
}

__device__ __forceinline__ void ln_route_wg(Frame& F, int layer, int cset) {
    const int lane = F.lane, wave = F.wave, tid = F.tid, r32 = lane & 31, hi = lane >> 5;
    const int tok0 = F.vcu * 128;
    const float* Z = (const float*)(F.ws + WS_Z1);
    const float* g1 = (const float*)F.in[28] + layer * 1024; const float* b1 = (const float*)F.in[29] + layer * 1024;
    const float* wrg = (const float*)F.in[21] + (size_t)layer * 4096; const float* brg = (const float*)F.in[22] + layer * 4;
    const float* wre = (const float*)F.in[23] + (size_t)layer * 32768; const float* bre = (const float*)F.in[24] + layer * 32;
    LAS float* part = (LAS float*)(F.lds + RING_OFF);
    LAS float* glog = (LAS float*)(F.lds + LDS_SCR); LAS float* stl = (LAS float*)(F.lds + LDS_SCR + 2048);
    LAS int* lcnt = (LAS int*)(F.lds + LDS_SCR + 3072); LAS int* gbase = (LAS int*)(F.lds + LDS_SCR + 3200); LAS int* ent = (LAS int*)(F.lds + LDS_SCR + 3328);
    bf16_t* X1B = (bf16_t*)(F.ws + S_X1B); bf16_t* X1L = (bf16_t*)(F.ws + S_XP); float* stats = (float*)(F.ws + WS_STATS);
    if (tid < 32) lcnt[tid] = 0;
    {
        f32x4 gg[4], bb[4];
#pragma unroll
        for (int j = 0; j < 4; ++j) { gg[j] = *(const f32x4*)(g1 + lane * 4 + 256 * j); bb[j] = *(const f32x4*)(b1 + lane * 4 + 256 * j); }
#pragma unroll 1
        for (int i0 = 0; i0 < 16; i0 += 4) {
            f32x4 v[4][4]; float mean[4], rstd[4];
#pragma unroll
            for (int u = 0; u < 4; ++u) { const float* z = Z + (size_t)(tok0 + wave * 16 + i0 + u) * D;
#pragma unroll
                for (int j = 0; j < 4; ++j) v[u][j] = __builtin_nontemporal_load((const f32x4*)(z + lane * 4 + 256 * j)); }
#pragma unroll
            for (int u = 0; u < 4; ++u) { float s = 0.f;
#pragma unroll
                for (int j = 0; j < 4; ++j) s += (v[u][j][0] + v[u][j][1]) + (v[u][j][2] + v[u][j][3]);
                mean[u] = wsum(s) * (1.f / D); float q = 0.f;
#pragma unroll
                for (int j = 0; j < 4; ++j) { v[u][j] = v[u][j] - mean[u]; q += (v[u][j][0] * v[u][j][0] + v[u][j][1] * v[u][j][1]) + (v[u][j][2] * v[u][j][2] + v[u][j][3] * v[u][j][3]); }
                rstd[u] = rsqrtf(wsum(q) * (1.f / D) + LN_EPS); }
            f32x4 lg[4] = {f32x4{0.f, 0.f, 0.f, 0.f}, f32x4{0.f, 0.f, 0.f, 0.f}, f32x4{0.f, 0.f, 0.f, 0.f}, f32x4{0.f, 0.f, 0.f, 0.f}};
#pragma unroll
            for (int j = 0; j < 4; ++j) {
#pragma unroll
                for (int u = 0; u < 4; ++u) v[u][j] = v[u][j] * rstd[u] * gg[j] + bb[j];
#pragma unroll
                for (int e = 0; e < 4; ++e) { const f32x4 wv = *(const f32x4*)(wrg + (size_t)(lane * 4 + 256 * j + e) * 4);
#pragma unroll
                    for (int u = 0; u < 4; ++u) lg[u] += wv * v[u][j][e]; } }
#pragma unroll
            for (int u = 0; u < 4; ++u) { const int row = wave * 16 + i0 + u;
#pragma unroll
                for (int j = 0; j < 4; ++j) { const f32x4 x = v[u][j];
                    u32x2 w; w.x = pk(x[0], x[1]); w.y = pk(x[2], x[3]); *(u32x2*)(X1B + (size_t)(tok0 + row) * D + lane * 4 + 256 * j) = w;
                    u32x2 wl2; wl2.x = pk(x[0] - __uint_as_float(w.x << 16), x[1] - __uint_as_float(w.x & 0xffff0000u)); wl2.y = pk(x[2] - __uint_as_float(w.y << 16), x[3] - __uint_as_float(w.y & 0xffff0000u));
                    *(u32x2*)(X1L + (size_t)(tok0 + row) * D + lane * 4 + 256 * j) = wl2; }
                float l4[4];
#pragma unroll
                for (int e = 0; e < 4; ++e) l4[e] = wsum(lg[u][e]);
                if (lane == 0) { glog[row * 4 + 0] = l4[0] + brg[0]; glog[row * 4 + 1] = l4[1] + brg[1]; glog[row * 4 + 2] = l4[2] + brg[2]; glog[row * 4 + 3] = l4[3] + brg[3];
                    stl[row * 2] = mean[u]; stl[row * 2 + 1] = rstd[u]; stats[(size_t)(tok0 + row) * 2] = mean[u]; stats[(size_t)(tok0 + row) * 2 + 1] = rstd[u]; } }
        }
    }
    __syncthreads();
    { const int lane = launder(F.tid) & 63, r32 = lane & 31, hi = lane >> 5;
        bf16x8 wh[8], wl[8];
#pragma unroll
        for (int ks = 0; ks < 8; ++ks) { unsigned hh[4], ll[4];
#pragma unroll
            for (int e2 = 0; e2 < 4; ++e2) { float a[2], ah[2];
#pragma unroll
                for (int q = 0; q < 2; ++q) { const int k = wave * 128 + ks * 16 + hi * 8 + e2 * 2 + q; a[q] = wre[(size_t)k * 32 + r32]; }
                hh[e2] = pk(a[0], a[1]); ah[0] = __uint_as_float(hh[e2] << 16); ah[1] = __uint_as_float(hh[e2] & 0xffff0000u); ll[e2] = pk(a[0] - ah[0], a[1] - ah[1]); }
            wh[ks] = __builtin_bit_cast(bf16x8, (u32x4){hh[0], hh[1], hh[2], hh[3]}); wl[ks] = __builtin_bit_cast(bf16x8, (u32x4){ll[0], ll[1], ll[2], ll[3]}); asm volatile("" ::: "memory"); }
        for (int blk = 0; blk < 4; ++blk) { const int row = blk * 32 + r32; const size_t xo = (size_t)(tok0 + row) * D + wave * 128 + hi * 8;
            f32x16 acc = {};
#pragma unroll
            for (int ks = 0; ks < 8; ++ks) { const bf16x8 xh = ld8g(X1B + xo + ks * 16), xl = ld8g(X1L + xo + ks * 16);
                acc = mfma32(wh[ks], xh, acc); acc = mfma32(wh[ks], xl, acc); acc = mfma32(wl[ks], xh, acc); }
#pragma unroll
            for (int r = 0; r < 16; ++r) part[(wave * 128 + row) * 33 + crow(r, hi)] = acc[r];
        }
    }
    __syncthreads();
    const int tid2 = launder(F.tid);
    int e0 = 0, e1 = 0; float w0 = 0.f, w1 = 0.f; int rk0 = 0, rk1 = 0;
    if (tid2 < 128) {
        const float l0 = glog[tid2 * 4], l1 = glog[tid2 * 4 + 1], l2 = glog[tid2 * 4 + 2], l3 = glog[tid2 * 4 + 3];
        int gs = 0; float gm = l0; if (l1 > gm) { gm = l1; gs = 1; } if (l2 > gm) { gm = l2; gs = 2; } if (l3 > gm) { gm = l3; gs = 3; }
        const float gw = 1.f / (expf(l0 - gm) + expf(l1 - gm) + expf(l2 - gm) + expf(l3 - gm));
        float es[8];
#pragma unroll
        for (int n = 0; n < 8; ++n) { float a = bre[gs * 8 + n];
#pragma unroll
            for (int w = 0; w < 8; ++w) a += part[(w * 128 + tid2) * 33 + gs * 8 + n];
            es[n] = a; }
        int i0 = 0; float m0 = es[0];
#pragma unroll
        for (int n = 1; n < 8; ++n) if (es[n] > m0) { m0 = es[n]; i0 = n; }
        int i1 = 0; float m1 = -3e38f;
#pragma unroll
        for (int n = 0; n < 8; ++n) if (n != i0 && es[n] > m1) { m1 = es[n]; i1 = n; }
        const float r = expf(m1 - m0); w0 = gw / (1.f + r); w1 = gw * r / (1.f + r);
        e0 = gs * 8 + i0; e1 = gs * 8 + i1;
        rk0 = __hip_atomic_fetch_add(&lcnt[e0], 1, __ATOMIC_RELAXED, __HIP_MEMORY_SCOPE_WORKGROUP); rk1 = __hip_atomic_fetch_add(&lcnt[e1], 1, __ATOMIC_RELAXED, __HIP_MEMORY_SCOPE_WORKGROUP);
    }
    __syncthreads();
    if (tid2 < 32) gbase[tid2] = (int)__hip_atomic_fetch_add((int*)(F.ctl + CW_CNT + cset * 64) + tid2, lcnt[tid2], __ATOMIC_RELAXED, __HIP_MEMORY_SCOPE_AGENT);
    __syncthreads();
    if (tid2 < 128) {
        int* rt = (int*)(F.ws + WS_ROUTE); float* rw = (float*)(F.ws + WS_ROUTE + (size_t)T * 8);
        const int tok = tok0 + tid2;
        rt[tok * 2] = (e0 << 20) | (gbase[e0] + rk0); rt[tok * 2 + 1] = (e1 << 20) | (gbase[e1] + rk1);
        int* expl = (int*)(F.ws + WS_EXPL); expl[(size_t)e0 * T + gbase[e0] + rk0] = tok; expl[(size_t)e1 * T + gbase[e1] + rk1] = tok;
        rw[tok * 2] = w0; rw[tok * 2 + 1] = w1;
    }
    __syncthreads();
}
__device__ __forceinline__ void moe_tables(Frame& F, int layer) {
    LAS int* ebase = (LAS int*)(F.lds + LDS_SCR + 4352); LAS int* pe = (LAS int*)(F.lds + LDS_SCR + 4608);
    if (F.tid < 64) {
        const int e = F.lane; const int c = (e < 32) ? (int)__hip_atomic_load((int*)(F.ctl + CW_CNT + layer * 64) + e, __ATOMIC_RELAXED, __HIP_MEMORY_SCOPE_AGENT) : 0;
        const int padded = (c + 255) & ~255; int incl = padded;
#pragma unroll
        for (int d = 1; d < 32; d <<= 1) { const int t = __shfl_up(incl, d); if (e >= d) incl += t; }
        if (e < 32) ebase[e] = incl - padded;
        if (e == 31) ebase[32] = incl; }
    __syncthreads();
    for (int p = F.tid; p < MOE_PANELS; p += NTHR) { int e = 0; for (int k = 1; k < 32; ++k) if (p * 256 >= ebase[k]) e = k; pe[p] = e; }
    __syncthreads();
}
__device__ __forceinline__ void moe_gather_wg(Frame& F, int layer) {
    moe_tables(F, layer);
    LAS int* ebase = (LAS int*)(F.lds + LDS_SCR + 4352);
    const int tok0 = F.vcu * 128; int* rt = (int*)(F.ws + WS_ROUTE);
    int* rowsrc = (int*)(F.ctl + CW_ROWSRC) + layer * MOE_ROWS;
    if (F.tid < 256) { const int tok = tok0 + (F.tid >> 1), sl = F.tid & 1; const int v = rt[tok * 2 + sl]; const int row = ebase[v >> 20] + (v & 0xfffff);
        rowsrc[row] = tok; rt[4 * T + tok * 2 + sl] = row; }
}
__device__ __forceinline__ void combine_wg(Frame& F, int layer, float* xout, bf16_t* xb) {
    const int lane = F.lane, tok0 = F.vcu * 128;
    const LAS int* ebase = (const LAS int*)(F.lds + LDS_SCR + 4352);
    const float* Z = (const float*)(F.ws + WS_Z1); const float* stats = (const float*)(F.ws + WS_STATS);
    const int* rt = (const int*)(F.ws + WS_ROUTE); const float* rw = (const float*)(F.ws + WS_ROUTE + (size_t)T * 8);
    const bf16_t* YP = (const bf16_t*)(F.ws + S_YP);
    const float* g1 = (const float*)F.in[28] + layer * 1024; const float* b1 = (const float*)F.in[29] + layer * 1024;
    const float* g2 = (const float*)F.in[30] + layer * 1024; const float* b2 = (const float*)F.in[31] + layer * 1024;
    f32x4 G1[4], B1[4], G2[4], B2[4];
#pragma unroll
    for (int j = 0; j < 4; ++j) { const int c = lane * 4 + 256 * j; G1[j] = *(const f32x4*)(g1 + c); B1[j] = *(const f32x4*)(b1 + c); G2[j] = *(const f32x4*)(g2 + c); B2[j] = *(const f32x4*)(b2 + c); }
#pragma unroll 1
    for (int i0 = 0; i0 < 16; i0 += 4) {
        f32x4 z[4][4]; s16x4 ya[4][4], yb[4][4]; float mean[4], rstd[4], w0[4], w1[4];
#pragma unroll
        for (int u = 0; u < 4; ++u) { const int tok = tok0 + F.wave * 16 + i0 + u;
            mean[u] = stats[(size_t)tok * 2]; rstd[u] = stats[(size_t)tok * 2 + 1]; w0[u] = rw[tok * 2]; w1[u] = rw[tok * 2 + 1];
            const int v0 = rt[tok * 2], v1 = rt[tok * 2 + 1];
            const bf16_t* y0 = YP + (size_t)(ebase[v0 >> 20] + (v0 & 0xfffff)) * D; const bf16_t* y1 = YP + (size_t)(ebase[v1 >> 20] + (v1 & 0xfffff)) * D;
#pragma unroll
            for (int j = 0; j < 4; ++j) { const int c = lane * 4 + 256 * j; z[u][j] = __builtin_nontemporal_load((const f32x4*)(Z + (size_t)tok * D + c)); ya[u][j] = __builtin_nontemporal_load((const s16x4*)(y0 + c)); yb[u][j] = __builtin_nontemporal_load((const s16x4*)(y1 + c)); } }
        float s[4], q[4];
#pragma unroll
        for (int u = 0; u < 4; ++u) { s[u] = 0.f;
#pragma unroll
            for (int j = 0; j < 4; ++j) { const f32x4 x1 = (z[u][j] - mean[u]) * rstd[u] * G1[j] + B1[j]; f32x4 f;
#pragma unroll
                for (int e = 0; e < 4; ++e) f[e] = w0[u] * bf2f((unsigned short)ya[u][j][e]) + w1[u] * bf2f((unsigned short)yb[u][j][e]);
                z[u][j] = x1 * ALPHA + f; s[u] += (z[u][j][0] + z[u][j][1]) + (z[u][j][2] + z[u][j][3]); } }
#pragma unroll
        for (int u = 0; u < 4; ++u) { const float m2 = wsum(s[u]) * (1.f / D); q[u] = 0.f;
#pragma unroll
            for (int j = 0; j < 4; ++j) { z[u][j] = z[u][j] - m2; q[u] += (z[u][j][0] * z[u][j][0] + z[u][j][1] * z[u][j][1]) + (z[u][j][2] * z[u][j][2] + z[u][j][3] * z[u][j][3]); } }
#pragma unroll
        for (int u = 0; u < 4; ++u) { const int tok = tok0 + F.wave * 16 + i0 + u; const float r2 = rsqrtf(wsum(q[u]) * (1.f / D) + LN_EPS);
#pragma unroll
            for (int j = 0; j < 4; ++j) { const int c = lane * 4 + 256 * j; const f32x4 o = z[u][j] * r2 * G2[j] + B2[j];
                __builtin_nontemporal_store(o, (f32x4*)(xout + (size_t)tok * D + c));
                if (xb) { u32x2 w; w.x = pk(o[0], o[1]); w.y = pk(o[2], o[3]); *(u32x2*)(xb + (size_t)tok * D + c) = w; } } }
    }
}
constexpr int NPHASE = 20;
__global__ void __launch_bounds__(NTHR, 2) mega(Args args) {
    extern __shared__ __attribute__((aligned(16))) unsigned char lds_[];
#define PHASE_FRAME() Frame F; { int t_ = (int)threadIdx.x; asm volatile("" : "+v"(t_)); GAS unsigned char* wg_ = (GAS unsigned char*)args.ws; asm volatile("" : "+s"(wg_)); unsigned char* w_ = (unsigned char*)wg_; int bx_ = (int)blockIdx.x; asm volatile("" : "+s"(bx_)); \
        F.lds = (LAS unsigned char*)lds_; F.ws = w_; F.ctl = (gu32*)(w_ + WS_CTL); F.in = args.in; F.out = args.out; F.tid = t_; F.lane = t_ & 63; F.wave = __builtin_amdgcn_readfirstlane(t_ >> 6); \
        F.G = (int)gridDim.x; F.vcu = (F.G % 8 == 0) ? (bx_ % 8) * (F.G / 8) + bx_ / 8 : bx_; } unsigned char* ws = F.ws; LAS unsigned char* ring = F.lds + RING_OFF; (void)ws; (void)ring
    Frame F0; { F0.lds = (LAS unsigned char*)lds_; F0.ws = args.ws; F0.ctl = (gu32*)(args.ws + WS_CTL); F0.tid = threadIdx.x; }
    volatile LAS unsigned* MISC = (volatile LAS unsigned*)(F0.lds + LDS_MISC);
    if (F0.tid < 64) MISC[F0.tid] = 0u;
    __syncthreads();
    const int lo = args.ph_lo, hi = args.ph_hi;
    const bool one = (hi - lo) > 1;
    XcdBarrier bar; bar.bar = (unsigned*)(F0.ctl + CW_BAR); bar.x = 0; bar.st = nullptr;
    if (one) bar = xcd_barrier_post((unsigned*)(F0.ctl + CW_BAR), MISC + 8);
#ifndef PH_MASK
#define PH_MASK 0xFFFFFFFFu
#endif
#define IN(k) ((((PH_MASK) >> (k)) & 1u) && lo <= (k) && (k) < hi)
#ifndef ABL
#define ABL 0
#endif
#ifndef DUP_PHASE
#define DUP_PHASE -1
#endif
#define REP(k) for (int rep = ((k) == DUP_PHASE ? 0 : 1); rep < 2; ++rep)
#define REPSYNC() do { if (rep == 0) xcd_barrier(bar); } while (0)
#ifndef BARX
#define BARX 1
#endif
#define SEAM(k) do { if (IN(k) && IN((k) + 1)) { for (int bx_ = 0; bx_ < BARX; ++bx_) xcd_barrier(bar); } } while (0)

    if (IN(0)) REP(0) { PHASE_FRAME(); const bool dry = (rep == 0); (void)dry; p0_prologue(F); REPSYNC(); } SEAM(0);
    if (IN(1)) REP(1) { PHASE_FRAME(); const bool dry = (rep == 0); (void)dry; Gemm g{(const bf16_t*)(ws + S_XB), (const bf16_t*)(ws + WS_W0IN), T, 1536, 1024, 1024, nullptr}; pg8::StaticOrder So; So.init(T, 1536, F.G, (int)blockIdx.x);
        EpiTile E{(bf16_t*)(ws + S_H0B), 1536, 4, 0, 1.f, 0};
        pg8::gemm_phase<EpiTile, pg8::StaticOrder, true, true>(ring, g, So, E); REPSYNC(); } SEAM(1);
    if (IN(2)) REP(2) { PHASE_FRAME(); const bool dry = (rep == 0); (void)dry; mla_prep_rows(F); REPSYNC(); } SEAM(2);
    if (IN(3)) REP(3) { PHASE_FRAME(); const bool dry = (rep == 0); (void)dry;
        { Gemm g{(const bf16_t*)(ws + S_H0B) + 1024, (const bf16_t*)(ws + WS_WUQ), T, 768, 256, 1536, nullptr}; pg8::StaticOrder So; So.init(T, 768, F.G, (int)blockIdx.x);
          EpiQ E{ws};
#ifndef NO_Q
          pg8::gemm_phase<EpiQ, pg8::StaticOrder, true, true>(ring, g, So, E);
#endif
        }
        { Gemm g{(const bf16_t*)(ws + S_H0B) + 1280, (const bf16_t*)(ws + WS_WUKV), T, 1024, 256, 1536, nullptr}; pg8::StaticOrder So; So.init(T, 1024, F.G, (int)blockIdx.x);
          EpiKV E{ws};
#ifndef NO_KV
          pg8::gemm_phase<EpiKV, pg8::StaticOrder, true, true>(ring, g, So, E);
#endif
        }
        REPSYNC(); } SEAM(3);
    if (IN(4)) REP(4) { PHASE_FRAME(); const bool dry = (rep == 0); (void)dry; for (int c = F.vcu; c < 256; c += F.G) { const int bh = c >> 1;
#pragma unroll 1
            for (int i = 0; i < 4; ++i) { const int qb = (c & 1) ? ((i == 0) ? 6 : (i == 1) ? 1 : (i == 2) ? 5 : 2) : ((i == 0) ? 7 : (i == 1) ? 0 : (i == 2) ? 4 : 3);
                if (i == (c & 3)) gmlp_chunk(F, c, dry);
                mla_attn_unit(F, bh >> 3, bh & 7, qb, dry ? ABL : 0); } } REPSYNC(); } SEAM(4);
    if (IN(5)) REP(5) { PHASE_FRAME(); const bool dry = (rep == 0); (void)dry; Gemm g{(const bf16_t*)(ws + S_H0B) + 512, (const bf16_t*)(ws + WS_W0O), T, 1024, 1024, 1536, nullptr}; pg8::StaticOrder So; So.init(T, 1024, F.G, (int)blockIdx.x);
        EpiResid E{(const float*)args.in[0], (float*)(ws + WS_Z1)};
        pg8::gemm_phase<EpiResid, pg8::StaticOrder, true, true>(ring, g, So, E); REPSYNC(); } SEAM(5);
#pragma unroll
    for (int layer = 0; layer < 2; ++layer) {
        const int pb = layer ? 15 : 6;
        if (IN(pb)) REP(pb) { PHASE_FRAME(); const bool dry = (rep == 0); (void)dry; for (int c = F.vcu; c < 256; c += F.G) { Frame F2 = F; F2.vcu = c; ln_route_wg(F2, layer, dry ? 2 + layer : layer); } REPSYNC(); } SEAM(pb);
        if (IN(pb + 2)) REP(pb + 2) { PHASE_FRAME(); const bool dry = (rep == 0); (void)dry; moe_tables(F, layer); const LAS int* eb = (const LAS int*)(F.lds + LDS_SCR + 4352);
            Gemm g{(const bf16_t*)(ws + S_X1B), (const bf16_t*)(ws + WS_WGU) + (size_t)layer * 32 * 512 * 1024, MOE_ROWS, 512, 1024, 1024, nullptr};
            MoeOrder<2> So{(const LAS int*)(F.lds + LDS_SCR + 4608), (eb[32] >> 8) * 2, F.G, F.vcu, eb, (const int*)(ws + WS_EXPL)}; EpiMoeUp E{(bf16_t*)(ws + S_HP)};
            pg8::gemm_phase<EpiMoeUp, MoeOrder<2>, true, true, true>(ring, g, So, E);
            { int ix, n; idle_share(So.nunits, F.G, F.vcu, ix, n); if (n) { const int w_ = ix * NWAVES + F.wave, nw_ = n * NWAVES;
                if (layer == 0) { if (ix == 0) p0_cbias_sum(F); p0_moe(F, 0, 32, true, w_, nw_); p0_moe(F, 32, 46, false, w_, nw_); } else p0_moe(F, 32, 64, true, w_, nw_); } }
            REPSYNC(); } SEAM(pb + 2);
        if (IN(pb + 3)) REP(pb + 3) { PHASE_FRAME(); const bool dry = (rep == 0); (void)dry; moe_tables(F, layer); const LAS int* eb = (const LAS int*)(F.lds + LDS_SCR + 4352);
            Gemm g{(const bf16_t*)(ws + S_HP), (const bf16_t*)(ws + WS_WD) + (size_t)layer * 32 * 1024 * 256, MOE_ROWS, 1024, 256, 256, nullptr};
            MoeOrder<4> So{(const LAS int*)(F.lds + LDS_SCR + 4608), (eb[32] >> 8) * 4, F.G, F.vcu, eb, (const int*)(ws + WS_EXPL)}; EpiMoeDown E{(bf16_t*)(ws + S_YP)};
            pg8::gemm_phase<EpiMoeDown, MoeOrder<4>, true, true>(ring, g, So, E);
            if (layer == 0) { int ix, n; idle_share(So.nunits, F.G, F.vcu, ix, n); if (n) p0_moe(F, 46, 64, false, ix * NWAVES + F.wave, n * NWAVES); }
            REPSYNC(); } SEAM(pb + 3);
        if (IN(pb + 4)) REP(pb + 4) { PHASE_FRAME(); const bool dry = (rep == 0); (void)dry; moe_tables(F, layer); for (int c = F.vcu; c < 256; c += F.G) { Frame F2 = F; F2.vcu = c; combine_wg(F2, layer, args.out, layer ? nullptr : (bf16_t*)(ws + S_X2B)); } REPSYNC(); }
        if (layer == 0) {
            SEAM(10);
            if (IN(11)) REP(11) { PHASE_FRAME(); const bool dry = (rep == 0); (void)dry; Gemm g{(const bf16_t*)(ws + S_X2B), (const bf16_t*)(ws + WS_W1IN), T, 2048, 1024, 1024, nullptr}; pg8::StaticOrder So; So.init(T, 2048, F.G, (int)blockIdx.x);
                EpiTile E{(bf16_t*)(ws + S_H1B), 2048, 0, 4, QS_NSA, 0};
                pg8::gemm_phase<EpiTile, pg8::StaticOrder, true, true>(ring, g, So, E); REPSYNC(); } SEAM(11);
            if (IN(12)) REP(12) { PHASE_FRAME(); const bool dry = (rep == 0); (void)dry; for (int it = F.vcu; it < 256; it += F.G) cmp_item(F, it); REPSYNC(); } SEAM(12);
            if (IN(13)) REP(13) { PHASE_FRAME(); const bool dry = (rep == 0); (void)dry; for (int c = F.vcu; c < 256; c += F.G) { const int bg = c >> 3, s = c & 7;
#pragma unroll 1
                    for (int i = 0; i < 8; ++i) { const int k = i >> 1; const int blk = (k == 0) ? 31 - s : (k == 1) ? 16 + s : (k == 2) ? 15 - s : s; nsa_unit(F, bg >> 1, bg & 1, blk * 2 + (i & 1), dry, dry ? ABL : 0); } } REPSYNC(); } SEAM(13);
            if (IN(14)) REP(14) { PHASE_FRAME(); const bool dry = (rep == 0); (void)dry; Gemm g{(const bf16_t*)(ws + S_H1B), (const bf16_t*)(ws + WS_W1O), T, 1024, 1024, 2048, nullptr}; pg8::StaticOrder So; So.init(T, 1024, F.G, (int)blockIdx.x);
                EpiResid E{(const float*)args.out, (float*)(ws + WS_Z1)};
                pg8::gemm_phase<EpiResid, pg8::StaticOrder, true, true>(ring, g, So, E); REPSYNC(); } SEAM(14);
        }
    }
#undef IN
#undef SEAM
}

#ifndef MK_SPLIT
#define MK_SPLIT 0
#endif
static void launch_all(void* const* d_in, float* out, unsigned char* ws, hipStream_t stream) {
    static int grid = 0;
    if (grid == 0) {
        int dev = 0, cus = 0, per_cu = 0;
        if (hipGetDevice(&dev) != hipSuccess || hipDeviceGetAttribute(&cus, hipDeviceAttributeMultiprocessorCount, dev) != hipSuccess) { grid = -1; return; }
        if (hipFuncSetAttribute((const void*)mega, hipFuncAttributeMaxDynamicSharedMemorySize, LDS_BYTES) != hipSuccess) { fprintf(stderr, "kernel_launch: hipFuncSetAttribute failed\n"); grid = -1; return; }
        if (hipOccupancyMaxActiveBlocksPerMultiprocessor(&per_cu, (const void*)mega, NTHR, LDS_BYTES) != hipSuccess || per_cu < 1) fprintf(stderr, "kernel_launch: occupancy query says %d\n", per_cu);
        (void)hipGetLastError();
        grid = cus < 256 ? cus : 256;
    }
    if (grid < 0) return;
    (void)hipMemsetAsync(ws + WS_CTL, 0, CTL_ZERO_BYTES, stream);
    Args a{};
    for (int i = 0; i < 32; ++i) a.in[i] = d_in[i];
    a.out = out; a.ws = ws;
#if MK_SPLIT
    for (int p = 0; p < NPHASE; ++p) { a.ph_lo = p; a.ph_hi = p + 1; hipLaunchKernelGGL(mega, dim3(grid), dim3(NTHR), LDS_BYTES, stream, a); }
#else
    a.ph_lo = 0; a.ph_hi = NPHASE; hipLaunchKernelGGL(mega, dim3(grid), dim3(NTHR), LDS_BYTES, stream, a);
#endif
}
}

extern "C" void kernel_launch(void* const* d_in, const int* in_sizes, int n_in, void* d_out, int out_size, void* d_ws, size_t ws_size, hipStream_t stream) {
    fk::launch_all(d_in, (float*)d_out, (unsigned char*)d_ws, stream);
}
```
